# Optimizing an MI355X kernel written in HIP

```python
import math
import jax, jax.numpy as jnp
from jax import lax
import numpy as np

D_MODEL = 1024
BATCH = 4
SEQ = 8192
DEPTH = 4

N_MIXERS = 4
N_HEADS = 8
HEAD_DIM = D_MODEL // N_HEADS
ROPE_THETA = 10000.0
Q_BLOCK = 128
HG_CHUNK = 64
DA_HALF = HEAD_DIM // 2
NSA_GROUPS = 2
NSA_HPG = N_HEADS // NSA_GROUPS
CMP_BLOCK = 32
CMP_STRIDE = 16
SLC_BLOCK = 64
SLC_TOPK = 16
WINDOW = 512
NSA_Q_BLOCK = 64
D_FF = 2816
N_EXPERTS = 8
TOP_K = 2
D_FF_EXPERT = 3584
MOE_BLOCK = 128
LN_EPS = 1e-5
NEG = -1e30
FORCE = 1e9
DEEPNORM_ALPHA = (2 * DEPTH) ** 0.25
DEEPNORM_BETA = (8 * DEPTH) ** -0.25

kernel_name = 'hybrid_hgrn2_diff_nsa_stickbreak_moe'


def layer_norm(x, g, b):
    xf = x.astype(jnp.float32)
    mu = jnp.mean(xf, axis=-1, keepdims=True)
    xc = xf - mu
    var = jnp.mean(xc * xc, axis=-1, keepdims=True)
    return (xc * lax.rsqrt(var + LN_EPS) * g.astype(jnp.float32) + b.astype(jnp.float32)).astype(x.dtype)


def rms_norm(x, g):
    xf = x.astype(jnp.float32)
    return xf * lax.rsqrt(jnp.mean(xf * xf, axis=-1, keepdims=True) + LN_EPS) * g.astype(jnp.float32)


def rope(x, pos):
    d = x.shape[-1]
    half = d // 2
    inv = ROPE_THETA ** (-jnp.arange(half, dtype=jnp.float32) / half)
    ang = pos.astype(jnp.float32)[:, None] * inv[None, :]
    shp = (1, x.shape[1]) + (1,) * (x.ndim - 3) + (half,)
    cos = jnp.cos(ang).reshape(shp)
    sin = jnp.sin(ang).reshape(shp)
    xf = x.astype(jnp.float32)
    x1, x2 = xf[..., :half], xf[..., half:]
    return jnp.concatenate([x1 * cos - x2 * sin, x2 * cos + x1 * sin], axis=-1).astype(x.dtype)


def masked_softmax(s, mask):
    s = jnp.where(mask, s.astype(jnp.float32), NEG)
    p = jax.nn.softmax(s, axis=-1)
    return jnp.where(mask, p, 0.0)


def hgrn2_mixer(h, w_in, lb_logits, norm_g, w_out, layer):
    b, s, _ = h.shape
    nh, dk = N_HEADS, HEAD_DIM
    c = HG_CHUNK
    nc = s // c
    q, f, i, g = jnp.split(h @ w_in, 4, axis=-1)
    lb = jnp.cumsum(jax.nn.softmax(lb_logits.astype(jnp.float32), axis=0), axis=0)[layer]
    forget = lb + (1.0 - lb) * jax.nn.sigmoid(f.astype(jnp.float32))
    log_f = jnp.log(forget)
    k = 1.0 - forget
    q = jax.nn.silu(q.astype(jnp.float32))
    v = i.astype(jnp.float32)

    def to_chunks(t):
        return t.reshape(b, nc, c, nh, dk).transpose(1, 0, 3, 2, 4)

    tri = jnp.tril(jnp.ones((c, c), bool))[:, :, None]

    def step(state, inp):
        qc, kc, vc, lf = inp
        cum = jnp.cumsum(lf, axis=2)
        rel = jnp.where(tri, cum[:, :, :, None, :] - cum[:, :, None, :, :], -jnp.inf)
        scores = jnp.einsum('bhtd,bhsd,bhtsd->bhts', qc, kc, jnp.exp(rel))
        out = scores @ vc + jnp.einsum('bhtd,bhdv->bhtv', qc * jnp.exp(cum), state)
        last = cum[:, :, -1:, :]
        new_state = jnp.exp(last[:, :, 0, :, None]) * state + jnp.einsum('bhsd,bhsv->bhdv', kc * jnp.exp(last - cum), vc)
        return new_state, out

    state0 = jnp.zeros((b, nh, dk, dk), jnp.float32)
    _, o = lax.scan(step, state0, (to_chunks(q), to_chunks(k), to_chunks(v), to_chunks(log_f)))
    o = o.transpose(1, 0, 3, 2, 4).reshape(b, s, nh, dk)
    o = rms_norm(o, norm_g) * jax.nn.sigmoid(g.astype(jnp.float32)).reshape(b, s, nh, dk)
    return o.reshape(b, s, D_MODEL).astype(h.dtype) @ w_out


def diff_attention_mixer(h, w_in, lam, norm_g, w_out, pos, layer):
    b, s, _ = h.shape
    q, k, v = jnp.split(h @ w_in, 3, axis=-1)
    q = rope(q.reshape(b, s, N_HEADS, 2, DA_HALF), pos).transpose(0, 2, 3, 1, 4)
    k = rope(k.reshape(b, s, N_HEADS, 2, DA_HALF), pos).transpose(0, 2, 3, 1, 4)
    v = v.reshape(b, s, N_HEADS, HEAD_DIM).transpose(0, 2, 1, 3)
    lam_init = 0.8 - 0.6 * math.exp(-0.3 * layer)
    lf = lam.astype(jnp.float32)
    lmb = jnp.exp(jnp.sum(lf[0] * lf[1])) - jnp.exp(jnp.sum(lf[2] * lf[3])) + lam_init
    kpos = jnp.arange(s)
    scale = DA_HALF ** -0.5

    def block(bi):
        s0 = bi * Q_BLOCK
        qb = lax.dynamic_slice_in_dim(q, s0, Q_BLOCK, axis=3)
        sc = jnp.einsum('bhcqd,bhckd->bhcqk', qb, k).astype(jnp.float32) * scale
        mask = (s0 + jnp.arange(Q_BLOCK))[:, None] >= kpos[None, :]
        p = masked_softmax(sc, mask)
        attn = p[:, :, 0] - lmb * p[:, :, 1]
        return jnp.einsum('bhqk,bhkd->bqhd', attn.astype(v.dtype), v)

    o = lax.map(block, jnp.arange(s // Q_BLOCK))
    o = o.transpose(1, 0, 2, 3, 4).reshape(b, s, N_HEADS, HEAD_DIM)
    o = rms_norm(o, norm_g) * (1.0 - lam_init)
    return o.reshape(b, s, D_MODEL).astype(h.dtype) @ w_out


def nsa_mixer(h, w_in, cmp_pe, cmp_w1, cmp_w2, w_out, pos):
    b, s, _ = h.shape
    G, HG, dk = NSA_GROUPS, NSA_HPG, HEAD_DIM
    proj = h @ w_in
    q, kv, gates = jnp.split(proj, [D_MODEL, D_MODEL + 6 * G * dk], axis=-1)
    q = q.reshape(b, s, N_HEADS, dk)
    kv = kv.reshape(b, s, 6, G, dk)
    k_cmp, v_cmp, k_slc, v_slc, k_win, v_win = [kv[:, :, j] for j in range(6)]
    gates = jax.nn.sigmoid(gates.astype(jnp.float32)).reshape(b, s, N_HEADS, 3)
    q_rot = rope(q, pos)
    k_slc = rope(k_slc, pos)
    k_win = rope(k_win, pos)

    n_cmp = (s - CMP_BLOCK) // CMP_STRIDE + 1
    tok_idx = np.arange(n_cmp)[:, None] * CMP_STRIDE + np.arange(CMP_BLOCK)[None, :]

    def compress(t, j):
        blk = t[:, tok_idx] + cmp_pe[j][None, None, :, None, :]
        blk = blk.transpose(0, 3, 1, 2, 4).reshape(b, G, n_cmp, CMP_BLOCK * dk)
        return jax.nn.gelu(blk @ cmp_w1[j]) @ cmp_w2[j]

    kc = compress(k_cmp, 0)
    vc = compress(v_cmp, 1)
    cmp_end = jnp.asarray(np.arange(n_cmp) * CMP_STRIDE + CMP_BLOCK - 1)
    n_slc = s // SLC_BLOCK
    cs = np.arange(n_cmp) * CMP_STRIDE
    ss_ = np.arange(n_slc) * SLC_BLOCK
    ov = np.clip(np.minimum(cs[:, None] + CMP_BLOCK, ss_[None, :] + SLC_BLOCK) - np.maximum(cs[:, None], ss_[None, :]), 0, None) / CMP_BLOCK
    cmp_to_slc = jnp.asarray(ov, jnp.float32)
    n_sel = min(SLC_TOPK, n_slc)
    ks_blk = k_slc.transpose(0, 2, 1, 3).reshape(b, G, n_slc, SLC_BLOCK * dk)
    vs_blk = v_slc.transpose(0, 2, 1, 3).reshape(b, G, n_slc, SLC_BLOCK * dk)
    kw = jnp.pad(k_win.transpose(0, 2, 1, 3), ((0, 0), (0, 0), (WINDOW, 0), (0, 0)))
    vw = jnp.pad(v_win.transpose(0, 2, 1, 3), ((0, 0), (0, 0), (WINDOW, 0), (0, 0)))
    qg = q.reshape(b, s, G, HG, dk).transpose(0, 2, 3, 1, 4)
    qrg = q_rot.reshape(b, s, G, HG, dk).transpose(0, 2, 3, 1, 4)
    scale = dk ** -0.5
    blk_id = jnp.arange(n_slc)
    qb_n = NSA_Q_BLOCK

    def block(bi):
        s0 = bi * qb_n
        tq = s0 + jnp.arange(qb_n)
        qb = lax.dynamic_slice_in_dim(qg, s0, qb_n, axis=3)
        qrb = lax.dynamic_slice_in_dim(qrg, s0, qb_n, axis=3)
        sc = jnp.einsum('bgiqd,bgcd->bgiqc', qb, kc).astype(jnp.float32) * scale
        pc = masked_softmax(sc, cmp_end[None, :] <= tq[:, None])
        o_cmp = jnp.einsum('bgiqc,bgcd->bgiqd', pc.astype(vc.dtype), vc)
        imp = jnp.einsum('bgqc,cn->bgqn', pc.sum(axis=2), cmp_to_slc)
        cur = tq // SLC_BLOCK
        forced = (blk_id[None, :] == 0) | (blk_id[None, :] == cur[:, None]) | (blk_id[None, :] == cur[:, None] - 1)
        imp = jnp.where(forced, FORCE, imp)
        imp = jnp.where(blk_id[None, :] <= cur[:, None], imp, NEG)
        top_s, top_i = lax.top_k(imp, n_sel)
        sel_ok = top_s > 0.5 * NEG
        gidx = top_i.reshape(b, G, qb_n * n_sel, 1)
        kg = jnp.take_along_axis(ks_blk, gidx, axis=2).reshape(b, G, qb_n, n_sel * SLC_BLOCK, dk)
        vg = jnp.take_along_axis(vs_blk, gidx, axis=2).reshape(b, G, qb_n, n_sel * SLC_BLOCK, dk)
        tok = top_i[..., None] * SLC_BLOCK + jnp.arange(SLC_BLOCK)
        ms = (sel_ok[..., None] & (tok <= tq[None, None, :, None, None])).reshape(b, G, 1, qb_n, n_sel * SLC_BLOCK)
        sg = jnp.einsum('bgiqd,bgqmd->bgiqm', qrb, kg).astype(jnp.float32) * scale
        ps = masked_softmax(sg, ms)
        o_slc = jnp.einsum('bgiqm,bgqmd->bgiqd', ps.astype(vg.dtype), vg)
        kwb = lax.dynamic_slice_in_dim(kw, s0, qb_n + WINDOW, axis=2)
        vwb = lax.dynamic_slice_in_dim(vw, s0, qb_n + WINDOW, axis=2)
        kp = s0 - WINDOW + jnp.arange(qb_n + WINDOW)
        mw = (kp[None, :] <= tq[:, None]) & (kp[None, :] > tq[:, None] - WINDOW) & (kp[None, :] >= 0)
        sw = jnp.einsum('bgiqd,bgkd->bgiqk', qrb, kwb).astype(jnp.float32) * scale
        pw = masked_softmax(sw, mw)
        o_win = jnp.einsum('bgiqk,bgkd->bgiqd', pw.astype(vwb.dtype), vwb)
        o = jnp.stack([o_cmp, o_slc, o_win], axis=-2)
        return o.transpose(0, 3, 1, 2, 4, 5).reshape(b, qb_n, N_HEADS, 3, dk)

    o = lax.map(block, jnp.arange(s // qb_n))
    o = o.transpose(1, 0, 2, 3, 4, 5).reshape(b, s, N_HEADS, 3, dk)
    o = jnp.einsum('bshc,bshcd->bshd', gates.astype(o.dtype), o)
    return o.reshape(b, s, D_MODEL) @ w_out


def stick_breaking_mixer(h, w_in, w_out):
    b, s, _ = h.shape
    q, k, v = jnp.split(h @ w_in, 3, axis=-1)
    q = q.reshape(b, s, N_HEADS, HEAD_DIM).transpose(0, 2, 1, 3)
    k = k.reshape(b, s, N_HEADS, HEAD_DIM).transpose(0, 2, 1, 3)
    v = v.reshape(b, s, N_HEADS, HEAD_DIM).transpose(0, 2, 1, 3)
    kpos = jnp.arange(s)
    scale = HEAD_DIM ** -0.5

    def block(bi):
        s0 = bi * Q_BLOCK
        qb = lax.dynamic_slice_in_dim(q, s0, Q_BLOCK, axis=2)
        z = jnp.einsum('bhqd,bhkd->bhqk', qb, k).astype(jnp.float32) * scale
        tq = s0 + jnp.arange(Q_BLOCK)
        strict = kpos[None, :] < tq[:, None]
        log_keep = jnp.where(strict, jax.nn.log_sigmoid(-z), 0.0)
        after = lax.cumsum(log_keep, axis=3, reverse=True) - log_keep
        a = jnp.where(strict, jnp.exp(jax.nn.log_sigmoid(z) + after), 0.0)
        return jnp.einsum('bhqk,bhkd->bqhd', a.astype(v.dtype), v)

    o = lax.map(block, jnp.arange(s // Q_BLOCK))
    o = o.transpose(1, 0, 2, 3, 4).reshape(b, s, D_MODEL)
    return o @ w_out


def swiglu(h, w_gate, w_up, w_down):
    return (jax.nn.silu(h @ w_gate) * (h @ w_up)) @ w_down


def moe_swiglu(h, w_router, w_gate, w_up, w_down):
    b, s, d = h.shape
    t = b * s
    hf = h.reshape(t, d)
    logits = (hf @ w_router).astype(jnp.float32)
    top_val, top_idx = lax.top_k(logits, TOP_K)
    gates = jax.nn.softmax(top_val, axis=-1)
    n_assign = t * TOP_K
    flat_e = top_idx.reshape(n_assign)
    flat_tok = jnp.repeat(jnp.arange(t, dtype=jnp.int32), TOP_K)
    order = jnp.argsort(flat_e)
    sorted_e = flat_e[order]
    sorted_tok = flat_tok[order]
    counts = jnp.bincount(flat_e, length=N_EXPERTS)
    padded = (counts + MOE_BLOCK - 1) // MOE_BLOCK * MOE_BLOCK
    pad_end = jnp.cumsum(padded)
    pad_start = pad_end - padded
    grp_start = jnp.cumsum(counts) - counts
    dest = (pad_start[sorted_e] + jnp.arange(n_assign) - grp_start[sorted_e]).astype(jnp.int32)
    n_blocks = -(-n_assign // MOE_BLOCK) + N_EXPERTS
    n_slots = n_blocks * MOE_BLOCK
    slot_tok = jnp.zeros((n_slots,), jnp.int32).at[dest].set(sorted_tok)
    block_e = jnp.minimum(jnp.searchsorted(pad_end, jnp.arange(n_blocks) * MOE_BLOCK, side='right'), N_EXPERTS - 1)
    xs = hf[slot_tok].reshape(n_blocks, MOE_BLOCK, d)

    def expert_block(args):
        xb, e = args
        return (jax.nn.silu(xb @ w_gate[e]) * (xb @ w_up[e])) @ w_down[e]

    ys = lax.map(expert_block, (xs, block_e)).reshape(n_slots, d)
    slot_of_assign = jnp.zeros((n_assign,), jnp.int32).at[order].set(dest)
    y = ys[slot_of_assign].reshape(t, TOP_K, d)
    out = jnp.einsum('tk,tkd->td', gates.astype(y.dtype), y)
    return out.reshape(b, s, d)


def setup_inputs(seed: int = 0) -> dict:
    key = jax.random.key(seed)
    ks = jax.random.split(key, 25)
    D = D_MODEL
    f32 = jnp.float32

    def nrm(k, shape, scale):
        return jax.random.normal(k, shape, f32) * scale

    nsa_in = D + 6 * NSA_GROUPS * HEAD_DIM + 3 * N_HEADS
    out_scale = DEEPNORM_BETA * D ** -0.5
    return {
        'x': nrm(ks[0], (BATCH, SEQ, D), 1.0),
        'hg_w_in': nrm(ks[1], (D, 4 * D), D ** -0.5),
        'hg_lb': nrm(ks[2], (DEPTH + 1, D), 0.1),
        'hg_norm_g': 1.0 + nrm(ks[3], (HEAD_DIM,), 0.01),
        'hg_w_out': nrm(ks[4], (D, D), out_scale),
        'da_w_in': nrm(ks[5], (D, 3 * D), D ** -0.5),
        'da_lam': nrm(ks[6], (4, DA_HALF), 0.1),
        'da_norm_g': 1.0 + nrm(ks[7], (HEAD_DIM,), 0.01),
        'da_w_out': nrm(ks[8], (D, D), out_scale),
        'nsa_w_in': nrm(ks[9], (D, nsa_in), D ** -0.5),
        'nsa_cmp_pe': nrm(ks[10], (2, CMP_BLOCK, HEAD_DIM), 0.02),
        'nsa_cmp_w1': nrm(ks[11], (2, CMP_BLOCK * HEAD_DIM, HEAD_DIM), (CMP_BLOCK * HEAD_DIM) ** -0.5),
        'nsa_cmp_w2': nrm(ks[12], (2, HEAD_DIM, HEAD_DIM), HEAD_DIM ** -0.5),
        'nsa_w_out': nrm(ks[13], (D, D), out_scale),
        'sb_w_in': nrm(ks[14], (D, 3 * D), D ** -0.5),
        'sb_w_out': nrm(ks[15], (D, D), out_scale),
        'ffn_w_gate': nrm(ks[16], (DEPTH // 2, D, D_FF), D ** -0.5),
        'ffn_w_up': nrm(ks[17], (DEPTH // 2, D, D_FF), D ** -0.5),
        'ffn_w_down': nrm(ks[18], (DEPTH // 2, D_FF, D), DEEPNORM_BETA * D_FF ** -0.5),
        'moe_w_router': nrm(ks[19], (DEPTH // 2, D, N_EXPERTS), D ** -0.5),
        'moe_w_gate': nrm(ks[20], (DEPTH // 2, N_EXPERTS, D, D_FF_EXPERT), D ** -0.5),
        'moe_w_up': nrm(ks[21], (DEPTH // 2, N_EXPERTS, D, D_FF_EXPERT), D ** -0.5),
        'moe_w_down': nrm(ks[22], (DEPTH // 2, N_EXPERTS, D_FF_EXPERT, D), DEEPNORM_BETA * D_FF_EXPERT ** -0.5),
        'ln_g': 1.0 + nrm(ks[23], (DEPTH, 2, D), 0.01),
        'ln_b': nrm(ks[24], (DEPTH, 2, D), 0.01),
    }


def reference(x, hg_w_in, hg_lb, hg_norm_g, hg_w_out, da_w_in, da_lam, da_norm_g, da_w_out,
              nsa_w_in, nsa_cmp_pe, nsa_cmp_w1, nsa_cmp_w2, nsa_w_out, sb_w_in, sb_w_out,
              ffn_w_gate, ffn_w_up, ffn_w_down, moe_w_router, moe_w_gate, moe_w_up, moe_w_down,
              ln_g, ln_b):
    pos = jnp.arange(x.shape[1])
    h = x
    for layer in range(DEPTH):
        m = layer % N_MIXERS
        if m == 0:
            y = hgrn2_mixer(h, hg_w_in, hg_lb, hg_norm_g, hg_w_out, layer)
        elif m == 1:
            y = diff_attention_mixer(h, da_w_in, da_lam, da_norm_g, da_w_out, pos, layer)
        elif m == 2:
            y = nsa_mixer(h, nsa_w_in, nsa_cmp_pe, nsa_cmp_w1, nsa_cmp_w2, nsa_w_out, pos)
        else:
            y = stick_breaking_mixer(h, sb_w_in, sb_w_out)
        h = layer_norm(DEEPNORM_ALPHA * h + y.astype(h.dtype), ln_g[layer, 0], ln_b[layer, 0])
        j = layer // 2
        if layer % 2 == 0:
            y = swiglu(h, ffn_w_gate[j], ffn_w_up[j], ffn_w_down[j])
        else:
            y = moe_swiglu(h, moe_w_router[j], moe_w_gate[j], moe_w_up[j], moe_w_down[j])
        h = layer_norm(DEEPNORM_ALPHA * h + y.astype(h.dtype), ln_g[layer, 1], ln_b[layer, 1])
    return h
```

```cpp
#include <hip/hip_runtime.h>
#include <stdint.h>
#include <stdio.h>

#ifndef MK_FUSED
#define MK_FUSED 1
#endif


#define LAS __attribute__((address_space(3)))
typedef unsigned short bf16_t;
typedef short bf16x8 __attribute__((ext_vector_type(8)));
typedef short s16x4 __attribute__((ext_vector_type(4)));
typedef float f32x2 __attribute__((ext_vector_type(2)));
typedef float f32x4 __attribute__((ext_vector_type(4)));
typedef float f32x16 __attribute__((ext_vector_type(16)));
typedef unsigned u32x2 __attribute__((ext_vector_type(2)));
typedef unsigned u32x4 __attribute__((ext_vector_type(4)));
typedef LAS unsigned char* ldsp_t;

constexpr int DM = 1024, NB = 4, SEQ = 8192, NT = NB * SEQ, NHEAD = 8, HDIM = 128;
constexpr int DFF = 2816, NEXP = 8, DFFE = 3584;
constexpr float ALPHA = 1.681792830507429f;
constexpr float LN_EPS = 1e-5f;
constexpr int NSA_NPAD = 2816;
constexpr int NCMP = 511, NCMP_P = 512;
constexpr int MOE_TILES_MAX = 264, MOE_CHUNK_TILES = 132, MOE_ROWS_MAX = MOE_TILES_MAX * 256, MOE_CHUNK_ROWS = MOE_CHUNK_TILES * 256;

constexpr size_t al256(size_t x) { return (x + 255) & ~(size_t)255; }
constexpr size_t WS_BAR = 0;
constexpr size_t WS_CTL = 16384;
constexpr size_t WS_ZERO_BYTES = 16384 + 4096;
constexpr size_t WS_SMALL = WS_ZERO_BYTES;
constexpr size_t WS_LBV = WS_SMALL;
constexpr size_t WS_CMPBIAS = WS_LBV + 4096;
constexpr size_t WS_ROPE_DA = WS_CMPBIAS + 32768;
constexpr size_t WS_ROPE_NSA = WS_ROPE_DA + (size_t)SEQ * 32 * 8;
constexpr size_t WS_HB = al256(WS_ROPE_NSA + (size_t)SEQ * 64 * 8);
constexpr size_t WS_OB = WS_HB + (size_t)NT * DM * 2;
constexpr size_t WS_W_HGIN = WS_OB + (size_t)NT * DM * 2;
constexpr size_t WS_W_HGOUT = WS_W_HGIN + (size_t)4096 * 1024 * 2;
constexpr size_t WS_W_DAIN = WS_W_HGOUT + (size_t)1024 * 1024 * 2;
constexpr size_t WS_W_DAOUT = WS_W_DAIN + (size_t)3072 * 1024 * 2;
constexpr size_t WS_W_NSAIN = WS_W_DAOUT + (size_t)1024 * 1024 * 2;
constexpr size_t WS_W_NSAOUT = WS_W_NSAIN + (size_t)NSA_NPAD * 1024 * 2;
constexpr size_t WS_W_SBIN = WS_W_NSAOUT + (size_t)1024 * 1024 * 2;
constexpr size_t WS_W_SBOUT = WS_W_SBIN + (size_t)3072 * 1024 * 2;
constexpr size_t WS_W_FFNGU = WS_W_SBOUT + (size_t)1024 * 1024 * 2;
constexpr size_t WS_W_FFND = WS_W_FFNGU + (size_t)2 * 5632 * 1024 * 2;
constexpr size_t WS_W_CMP1 = WS_W_FFND + (size_t)2 * 1024 * 2816 * 2;
constexpr size_t WS_W_CMP2 = WS_W_CMP1 + (size_t)2 * 128 * 4096 * 2;
constexpr size_t WS_W_MOEGU = WS_W_CMP2 + (size_t)2 * 128 * 128 * 2;
constexpr size_t WS_W_MOED = WS_W_MOEGU + (size_t)8 * 7168 * 1024 * 2;
constexpr size_t WS_SCR = al256(WS_W_MOED + (size_t)8 * 1024 * 3584 * 2);
constexpr size_t SC_HG_QS = WS_SCR;
constexpr size_t SC_HG_VV = SC_HG_QS + (size_t)NT * DM * 2;
constexpr size_t SC_HG_SG = SC_HG_VV + (size_t)NT * DM * 2;
constexpr size_t SC_HG_LF = SC_HG_SG + (size_t)NT * DM * 2;
constexpr size_t SC_HG_ST = SC_HG_LF + (size_t)NT * DM * 4;
constexpr size_t SC_HG_DEC = SC_HG_ST + (size_t)4096 * 128 * 128 * 2;
constexpr size_t SC_HG_END = SC_HG_DEC + (size_t)4096 * 128 * 4;
constexpr size_t SC_FF_ACT = WS_SCR;
constexpr size_t SC_FF_END = SC_FF_ACT + (size_t)NT * DFF * 2;
constexpr size_t SC_DA_Q = WS_SCR;
constexpr size_t SC_DA_K = SC_DA_Q + (size_t)NT * DM * 2;
constexpr size_t SC_DA_V = SC_DA_K + (size_t)NT * DM * 2;
constexpr size_t SC_DA_END = SC_DA_V + (size_t)NT * DM * 2;
constexpr size_t SC_MOE_ROUTE = WS_SCR;
constexpr size_t SC_MOE_XS = SC_MOE_ROUTE + (size_t)NT * 32;
constexpr size_t SC_MOE_ACT = SC_MOE_XS + al256((size_t)MOE_ROWS_MAX * 4);
constexpr size_t SC_MOE_Y = SC_MOE_ACT + (size_t)MOE_CHUNK_ROWS * DFFE * 2;
constexpr size_t SC_MOE_END = SC_MOE_Y + (size_t)MOE_ROWS_MAX * DM * 2;
constexpr size_t SC_NSA_Q = WS_SCR;
constexpr size_t SC_NSA_QR = SC_NSA_Q + (size_t)NT * DM * 2;
constexpr size_t SC_NSA_KV = SC_NSA_QR + (size_t)NT * DM * 2;
constexpr size_t SC_NSA_GATE = SC_NSA_KV + (size_t)6 * NT * 256 * 2;
constexpr size_t SC_NSA_KC = SC_NSA_GATE + (size_t)NT * 24 * 4;
constexpr size_t SC_NSA_OACC = SC_NSA_KC + (size_t)2 * 8 * NCMP_P * 128 * 2;
constexpr size_t SC_NSA_END = SC_NSA_OACC + (size_t)NT * DM * 4;
constexpr size_t SC_SB_Q = WS_SCR;
constexpr size_t SC_SB_K = SC_SB_Q + (size_t)NT * DM * 2;
constexpr size_t SC_SB_V = SC_SB_K + (size_t)NT * DM * 2;
constexpr size_t SC_SB_END = SC_SB_V + (size_t)NT * DM * 2;
constexpr size_t cmax(size_t a, size_t b) { return a > b ? a : b; }
constexpr size_t WS_END = cmax(cmax(cmax(SC_HG_END, SC_FF_END), cmax(SC_DA_END, SC_MOE_END)), cmax(SC_NSA_END, SC_SB_END));
static_assert(WS_END <= (size_t)981882880, "workspace budget (sum of the inputs)");

constexpr int LDS_BYTES = 152 * 1024;
constexpr int LDS_MISC = 150 * 1024;

__device__ __forceinline__ unsigned bf16_rne_bits(float f) { const unsigned u = __float_as_uint(f); return (u + 0x7fffu + ((u >> 16) & 1u)) >> 16; }
__device__ __forceinline__ unsigned cvtpk(float lo, float hi) {
    typedef __bf16 bf2_t __attribute__((ext_vector_type(2)));
    typedef float f2_t __attribute__((ext_vector_type(2)));
    const bf2_t r = __builtin_convertvector((f2_t){lo, hi}, bf2_t);
    return __builtin_bit_cast(unsigned, r);
}
__device__ __forceinline__ float bf2f(bf16_t b) { return __uint_as_float(((unsigned)b) << 16); }
__device__ __forceinline__ bf16_t f2bf(float f) { return (bf16_t)(cvtpk(f, 0.f) & 0xffffu); }
__device__ __forceinline__ bf16x8 pack8(f32x4 a, f32x4 b) { u32x4 w = {cvtpk(a[0], a[1]), cvtpk(a[2], a[3]), cvtpk(b[0], b[1]), cvtpk(b[2], b[3])}; return *reinterpret_cast<bf16x8*>(&w); }
__device__ __forceinline__ float sigmoidf_(float x) { return __builtin_amdgcn_rcpf(1.f + __expf(-x)); }
__device__ __forceinline__ float siluf_(float x) { return x * __builtin_amdgcn_rcpf(1.f + __expf(-x)); }
__device__ __forceinline__ int my_tid() { int t = threadIdx.x; asm volatile("" : "+v"(t)); return t; }
__device__ __forceinline__ float wave_sum(float v) {
#pragma unroll
    for (int o = 32; o > 0; o >>= 1) v += __shfl_xor(v, o);
    return v;
}

#define XB_TMO      128
#define XB_XCNT(j)  (256  + 64 * (j))
#define XB_XSUB(j)  (1280 + 64 * (j))
#define XB_XGEN(j)  (2304 + 64 * (j))
#define XB_TOP      3328
#define XB_TOPGEN   3392
#define XCD_BAR_WORDS 3456
#define XB_SPIN_CAP (1u << 18)
__device__ __forceinline__ unsigned xb_ld(unsigned* p)              { return __hip_atomic_load(p, __ATOMIC_RELAXED, __HIP_MEMORY_SCOPE_AGENT); }
__device__ __forceinline__ unsigned xb_add(unsigned* p, unsigned v) { return __hip_atomic_fetch_add(p, v, __ATOMIC_RELAXED, __HIP_MEMORY_SCOPE_AGENT); }
__device__ __forceinline__ unsigned xb_xcc_id() { return (unsigned)__builtin_amdgcn_s_getreg((3 << 11) | 20) & 0xFu; }
#define XB_SPIN(cond, bar) do { unsigned _sp = 0; while (cond) { __builtin_amdgcn_s_sleep(1); \
    if ((++_sp & 255u) == 0u) { if (xb_ld(&(bar)[XB_TMO])) break; if (_sp > XB_SPIN_CAP) { atomicAdd(&(bar)[XB_TMO], 1u); break; } } } } while (0)
struct XcdBarrier { unsigned* bar; unsigned x; volatile LAS unsigned* st; };
__device__ __forceinline__ XcdBarrier xcd_barrier_post(unsigned* bar, volatile LAS unsigned* st) {
    XcdBarrier b; b.bar = bar; b.x = xb_xcc_id(); b.st = st;
    if (threadIdx.x == 0) (void)xb_add(&bar[XB_XCNT(b.x)], 1u);
    return b;
}
__device__ __forceinline__ void xcd_barrier_complete(unsigned* bar, unsigned x, unsigned& nloc, unsigned& nx) {
    const unsigned G = gridDim.x * gridDim.y * gridDim.z;
    unsigned sum, cnt, mine, sp = 0u;
    for (;;) {
        sum = 0u; cnt = 0u; mine = 0u;
#pragma unroll
        for (unsigned j = 0; j < 16; ++j) { const unsigned c = xb_ld(&bar[XB_XCNT(j)]); sum += c; cnt += (c > 0u) ? 1u : 0u; mine = (j == x) ? c : mine; }
        if (sum == G) break;
        __builtin_amdgcn_s_sleep(1);
        if ((++sp & 255u) == 0u) { if (xb_ld(&bar[XB_TMO])) break; if (sp > XB_SPIN_CAP) { atomicAdd(&bar[XB_TMO], 1u); break; } }
    }
    nloc = mine > 0u ? mine : 1u; nx = cnt > 0u ? cnt : 1u;
}
__device__ __forceinline__ void xcd_barrier(const XcdBarrier& b) {
    asm volatile("s_waitcnt vmcnt(0)" ::: "memory");
    __syncthreads();
    if (threadIdx.x == 0) {
        unsigned* bar = b.bar;
        __builtin_amdgcn_s_waitcnt(0);
        unsigned nloc = b.st[0], nx = b.st[1];
        if (nloc == 0u) { xcd_barrier_complete(bar, b.x, nloc, nx); b.st[0] = nloc; b.st[1] = nx; }
        const unsigned old = xb_add(&bar[XB_XSUB(b.x)], 1u);
        const unsigned gen = old / nloc;
        if (old + 1u == (gen + 1u) * nloc) {
            __builtin_amdgcn_fence(__ATOMIC_RELEASE, "agent");
            asm volatile("s_waitcnt vmcnt(0)" ::: "memory");
            const unsigned og = xb_add(&bar[XB_TOP], 1u);
            const unsigned tg = og / nx;
            if (og + 1u == (tg + 1u) * nx) xb_add(&bar[XB_TOPGEN], 1u);
            else XB_SPIN(xb_ld(&bar[XB_TOPGEN]) == tg, bar);
            __builtin_amdgcn_fence(__ATOMIC_ACQUIRE, "agent");
            xb_add(&bar[XB_XGEN(b.x)], 1u);
            asm volatile("s_waitcnt vmcnt(0)" ::: "memory");
        } else {
            XB_SPIN(xb_ld(&bar[XB_XGEN(b.x)]) == gen, bar);
            __builtin_amdgcn_fence(__ATOMIC_ACQUIRE, "agent");
            asm volatile("s_waitcnt vmcnt(0)" ::: "memory");
        }
    }
    __syncthreads();
}

namespace pg8 {
constexpr int BM = 256, BK = 64, HALF = 128, HTB = HALF * BK * 2, STAGE_BYTES = 8 * HTB, NXCD = 8, WGM = 8;
__host__ __device__ __forceinline__ int lds_byte(int r, int c) { const int st = (r >> 4) * 2 + (c >> 5), rr = r & 15, cc = c & 31, ob = rr * 64 + cc * 2; return st * 1024 + (ob ^ (((ob >> 9) & 1) << 5)); }
__host__ __device__ __forceinline__ void stage_rc(int b, int& R, int& C) { const int st = b / 1024, sb = b % 1024, swz = sb ^ (((sb >> 9) & 1) << 5); R = (st >> 1) * 16 + swz / 64; C = (st & 1) * 32 + (swz % 64) / 2; }
__host__ __device__ __forceinline__ int perm32(int rho) { const int n = rho >> 4, i = rho & 15; return 8 * (i >> 2) + 4 * n + (i & 3); }
struct Unit { int pm, pn; };
struct Gemm { const bf16_t* A; const bf16_t* Bt; int M, N, K; };
struct StaticOrder {
    static constexpr bool GATHER = false; static constexpr int tile_lo = 0;
    __device__ __forceinline__ int row_token(int) const { return 0; }
    int nM, nN, nwg, G, c;
    __device__ void init(int M, int N, int G_, int c_) { nM = M / BM; nN = N / BM; nwg = nM * nN; G = G_; c = c_; }
    __device__ bool next(int i, Unit& u) const {
        const long L = (long)i * G + c; if (L >= nwg) return false;
        int wgid = (int)L; { const int q = nwg / NXCD, r = nwg % NXCD, xcd = wgid % NXCD, off = wgid / NXCD; wgid = (xcd < r ? xcd * (q + 1) : r * (q + 1) + (xcd - r) * q) + off; }
        const int nig = WGM * nN, gid = wgid / nig, fm = gid * WGM, gsz = (nM - fm) < WGM ? (nM - fm) : WGM;
        u.pm = fm + ((wgid % nig) % gsz); u.pn = (wgid % nig) / gsz; return true;
    }
};
template <class Epi, class Sched>
__device__ __forceinline__ void gemm_phase(ldsp_t lds, const Gemm g, const Sched& S, const Epi& E) {
    constexpr bool GA = Sched::GATHER;
    const int tid = my_tid(), wid = __builtin_amdgcn_readfirstlane(tid >> 6), lane = tid & 63, wr = wid >> 2, wc = wid & 3, fr = lane & 15, fq = lane >> 4;
    const int K = g.K, nt = K / BK;
    unsigned voffA[2], voffB[2]; int Rr[2]; unsigned Cc2[2];
#pragma unroll
    for (int i = 0; i < 2; ++i) { int R, C; stage_rc(tid * 16 + i * 8192, R, C); const int Rb = (R & ~31) + perm32(R & 31);
        voffA[i] = (unsigned)(R * K + C) * 2u; voffB[i] = (unsigned)(Rb * K + C) * 2u; Rr[i] = R; Cc2[i] = (unsigned)C * 2u; }
    LAS int* gtab = (LAS int*)(lds + STAGE_BYTES);
    if (GA) { Unit u_; for (int i = 0; S.next(i, u_); ++i) { if (tid < 256) gtab[i * 256 + tid] = S.row_token((S.tile_lo + u_.pm) * 256 + tid); }
        __syncthreads(); }
    unsigned vC[2][2], vN[2][2], vX[2][2];
#define PG8_LOADV(V, UI) do { _Pragma("unroll") for (int h_ = 0; h_ < 2; ++h_) _Pragma("unroll") for (int i_ = 0; i_ < 2; ++i_) \
        V[h_][i_] = (unsigned)gtab[(UI) * 256 + h_ * 128 + Rr[i_]] * (unsigned)(K * 2) + Cc2[i_]; } while (0)
    const size_t kstep = (size_t)(BK * 2);
    const size_t hstep = (size_t)HALF * K * 2;
    const size_t tstep = 2 * hstep;
    const unsigned ldsw = (unsigned)wid * 1024u;
    const int aoff = lds_byte(wr * 64 + fr, fq * 8), boff = lds_byte(wc * 32 + fr, fq * 8);
#define PG8_SA(b, h) (((b) * 2 + (h)) * HTB)
#define PG8_SB(b, h) ((4 + (b) * 2 + (h)) * HTB)
#define PG8_STAGE(bufoff, gbase, voff) do { _Pragma("unroll") for (int _i = 0; _i < 2; ++_i) \
        __builtin_amdgcn_global_load_lds((const unsigned*)((const char*)(gbase) + (voff)[_i]), (LAS unsigned*)(lds + (bufoff) + ldsw + _i * 8192), 16, 0, 0); } while (0)
#define PG8_STAGE_A(bufoff, gbase, H, V) do { _Pragma("unroll") for (int _i = 0; _i < 2; ++_i) \
        __builtin_amdgcn_global_load_lds((const unsigned*)((const char*)(gbase) + (GA ? (size_t)0 : (size_t)(H) * hstep) + (GA ? (V)[H][_i] : voffA[_i])), (LAS unsigned*)(lds + (bufoff) + ldsw + _i * 8192), 16, 0, 0); } while (0)
#define PG8_LDA(dst, b, h) do { _Pragma("unroll") for (int m = 0; m < 4; ++m) _Pragma("unroll") for (int k = 0; k < 2; ++k) dst[m][k] = *(const LAS bf16x8*)(lds + PG8_SA(b, h) + aoff + m * 2048 + k * 1024); } while (0)
#define PG8_LDB(dst, b, h) do { _Pragma("unroll") for (int n = 0; n < 2; ++n) _Pragma("unroll") for (int k = 0; k < 2; ++k) dst[n][k] = *(const LAS bf16x8*)(lds + PG8_SB(b, h) + boff + n * 2048 + k * 1024); } while (0)
#define PG8_MMA(ai, bj, At, Bt) do { __builtin_amdgcn_s_setprio(1); _Pragma("unroll") for (int m = 0; m < 4; ++m) _Pragma("unroll") for (int n = 0; n < 2; ++n) _Pragma("unroll") for (int k = 0; k < 2; ++k) \
        acc[ai][bj][m][n] = __builtin_amdgcn_mfma_f32_16x16x32_bf16(Bt[n][k], At[m][k], acc[ai][bj][m][n], 0, 0, 0); __builtin_amdgcn_s_setprio(0); } while (0)
#define PG8_WAIT_V(n) asm volatile("s_waitcnt vmcnt(" #n ")" ::: "memory")
#define PG8_WAIT_L(n) asm volatile("s_waitcnt lgkmcnt(" #n ")" ::: "memory")
#define PG8_BAR __builtin_amdgcn_s_barrier()
#define PG8_SCHED __builtin_amdgcn_sched_barrier(0)
    Unit cur, nxt; int ui = 0;
    if (!S.next(0, cur)) return;
    f32x4 acc[2][2][4][2];
#pragma unroll
    for (int a = 0; a < 2; ++a)
#pragma unroll
        for (int b = 0; b < 2; ++b)
#pragma unroll
            for (int m = 0; m < 4; ++m)
#pragma unroll
                for (int n = 0; n < 2; ++n) acc[a][b][m][n] = (f32x4){0.f, 0.f, 0.f, 0.f};
    bf16x8 At[4][2], B0[2][2], B1[2][2];
    const char* cA = (const char*)g.A + (GA ? (size_t)0 : (size_t)cur.pm * tstep); const char* cB = (const char*)g.Bt + (size_t)cur.pn * tstep;
    if (GA) { PG8_LOADV(vC, 0); }
    PG8_STAGE(PG8_SB(0, 0), cB, voffB); PG8_STAGE(PG8_SB(0, 1), cB + hstep, voffB); PG8_STAGE_A(PG8_SA(0, 0), cA, 0, vC); PG8_STAGE_A(PG8_SA(0, 1), cA, 1, vC);
    if (wr == 1) PG8_BAR;
    PG8_WAIT_V(2); PG8_BAR;
    PG8_STAGE(PG8_SB(1, 0), cB + kstep, voffB); PG8_STAGE_A(PG8_SA(1, 0), cA + kstep, 0, vC); PG8_STAGE(PG8_SB(1, 1), cB + hstep + kstep, voffB);
    PG8_WAIT_V(6); PG8_BAR;
    for (;;) {
        const bool has_next = S.next(ui + 1, nxt);
        const char* nA = (has_next && !GA) ? (const char*)g.A + (size_t)nxt.pm * tstep : cA; const char* nB = has_next ? (const char*)g.Bt + (size_t)nxt.pn * tstep : cB;
        if (GA) { if (has_next) { PG8_LOADV(vN, ui + 1); } else {
#pragma unroll
            for (int h_ = 0; h_ < 2; ++h_)
#pragma unroll
                for (int i_ = 0; i_ < 2; ++i_) vN[h_][i_] = vC[h_][i_]; } }
        for (int t = 0; t < nt; t += 2) {
            const bool last = (t == nt - 2);
            if (GA) {
#pragma unroll
                for (int h_ = 0; h_ < 2; ++h_)
#pragma unroll
                    for (int i_ = 0; i_ < 2; ++i_) vX[h_][i_] = last ? vN[h_][i_] : vC[h_][i_]; }
            const char* a1 = cA + (size_t)(t + 1) * kstep;
            const char* a2 = last ? nA : cA + (size_t)(t + 2) * kstep; const char* b2 = last ? nB : cB + (size_t)(t + 2) * kstep;
            const char* a3 = a2 + kstep; const char* b3 = b2 + kstep;
            PG8_LDB(B0, 0, 0); PG8_LDB(B1, 0, 1); PG8_SCHED; PG8_LDA(At, 0, 0); PG8_STAGE_A(PG8_SA(1, 1), a1, 1, vC);
            PG8_WAIT_V(8); PG8_WAIT_L(0); PG8_BAR; PG8_MMA(0, 0, At, B0); PG8_MMA(0, 1, At, B1); PG8_BAR; PG8_SCHED;
            PG8_LDA(At, 0, 1); PG8_STAGE(PG8_SB(0, 0), b2, voffB); PG8_STAGE(PG8_SB(0, 1), b2 + hstep, voffB); PG8_STAGE_A(PG8_SA(0, 0), a2, 0, vX);
            PG8_WAIT_V(8); PG8_WAIT_L(0); PG8_BAR; PG8_MMA(1, 0, At, B0); PG8_MMA(1, 1, At, B1); PG8_BAR; PG8_SCHED;
            PG8_LDB(B0, 1, 0); PG8_LDB(B1, 1, 1); PG8_SCHED; PG8_LDA(At, 1, 0); PG8_STAGE_A(PG8_SA(0, 1), a2, 1, vX);
            PG8_WAIT_V(8); PG8_WAIT_L(0); PG8_BAR; PG8_MMA(0, 0, At, B0); PG8_MMA(0, 1, At, B1); PG8_BAR; PG8_SCHED;
            PG8_LDA(At, 1, 1); PG8_STAGE(PG8_SB(1, 0), b3, voffB); PG8_STAGE(PG8_SB(1, 1), b3 + hstep, voffB); PG8_STAGE_A(PG8_SA(1, 0), a3, 0, vX);
            PG8_WAIT_V(8); PG8_WAIT_L(0); PG8_BAR; PG8_MMA(1, 0, At, B0); PG8_MMA(1, 1, At, B1); PG8_BAR; PG8_SCHED;
        }
        if (wr == 0) PG8_BAR;
        E(acc, cur, wr, wc, fr, fq);
        if (!has_next) break;
#pragma unroll
        for (int a = 0; a < 2; ++a)
#pragma unroll
            for (int b = 0; b < 2; ++b)
#pragma unroll
                for (int m = 0; m < 4; ++m)
#pragma unroll
                    for (int n = 0; n < 2; ++n) acc[a][b][m][n] = (f32x4){0.f, 0.f, 0.f, 0.f};
        cur = nxt; cA = nA; cB = nB; ++ui;
        if (GA) {
#pragma unroll
            for (int h_ = 0; h_ < 2; ++h_)
#pragma unroll
                for (int i_ = 0; i_ < 2; ++i_) vC[h_][i_] = vN[h_][i_]; }
        if (wr == 1) PG8_BAR;
    }
    PG8_WAIT_V(0);
    PG8_BAR;
#undef PG8_SA
#undef PG8_SB
#undef PG8_STAGE
#undef PG8_STAGE_A
#undef PG8_LOADV
#undef PG8_LDA
#undef PG8_LDB
#undef PG8_MMA
#undef PG8_WAIT_V
#undef PG8_WAIT_L
#undef PG8_BAR
#undef PG8_SCHED
}
}
using pg8::Unit;
typedef f32x4 acc_t[2][2][4][2];
#define EPI_BEGIN \
    _Pragma("unroll") for (int ai = 0; ai < 2; ++ai) _Pragma("unroll") for (int m = 0; m < 4; ++m) _Pragma("unroll") for (int bj = 0; bj < 2; ++bj) { \
        const int row = u.pm * 256 + ai * 128 + wr * 64 + m * 16 + fr; const int col = u.pn * 256 + bj * 128 + wc * 32 + 8 * fq; \
        const f32x4 v0 = acc[ai][bj][m][0], v1 = acc[ai][bj][m][1];
#define EPI_END if (bj == 1 && (m & 1)) asm volatile("" ::: "memory"); }

template <bool RES_F32>
struct EpiRes {
    const void* res; bf16_t* out;
    __device__ __forceinline__ void operator()(const acc_t& acc, const Unit& u, int wr, int wc, int fr, int fq) const {
        asm volatile("" : "+v"(fr), "+v"(fq));
        constexpr int MB = RES_F32 ? 2 : 4;
#pragma unroll
        for (int ai = 0; ai < 2; ++ai)
#pragma unroll
            for (int mp = 0; mp < 4 / MB; ++mp) {
                f32x4 rf[MB][2][2]; u32x4 rb[MB][2];
#pragma unroll
                for (int mm = 0; mm < MB; ++mm)
#pragma unroll
                    for (int bj = 0; bj < 2; ++bj) { const size_t o = (size_t)(u.pm * 256 + ai * 128 + wr * 64 + (MB * mp + mm) * 16 + fr) * DM + u.pn * 256 + bj * 128 + wc * 32 + 8 * fq;
                        if (RES_F32) { rf[mm][bj][0] = *(const f32x4*)((const float*)res + o); rf[mm][bj][1] = *(const f32x4*)((const float*)res + o + 4); }
                        else rb[mm][bj] = *(const u32x4*)((const bf16_t*)res + o); }
#pragma unroll
                for (int mm = 0; mm < MB; ++mm)
#pragma unroll
                    for (int bj = 0; bj < 2; ++bj) { const int m = MB * mp + mm; const size_t o = (size_t)(u.pm * 256 + ai * 128 + wr * 64 + m * 16 + fr) * DM + u.pn * 256 + bj * 128 + wc * 32 + 8 * fq;
                        f32x4 r0, r1;
                        if (RES_F32) { r0 = rf[mm][bj][0]; r1 = rf[mm][bj][1]; }
                        else { const u32x4 w = rb[mm][bj];
                            r0 = (f32x4){__uint_as_float(w[0] << 16), __uint_as_float(w[0] & 0xffff0000u), __uint_as_float(w[1] << 16), __uint_as_float(w[1] & 0xffff0000u)};
                            r1 = (f32x4){__uint_as_float(w[2] << 16), __uint_as_float(w[2] & 0xffff0000u), __uint_as_float(w[3] << 16), __uint_as_float(w[3] & 0xffff0000u)}; }
                        *(bf16x8*)(out + o) = pack8(r0 * ALPHA + acc[ai][bj][m][0], r1 * ALPHA + acc[ai][bj][m][1]); }
                asm volatile("" ::: "memory");
            }
    }
};
struct EpiHgIn {
    bf16_t* qs; bf16_t* vv; bf16_t* sg; float* lf; const float* lbv;
    __device__ __forceinline__ void operator()(const acc_t& acc, const Unit& u, int wr, int wc, int fr, int fq) const {
        asm volatile("" : "+v"(fr), "+v"(fq));
        const int typ = u.pn >> 2;
        EPI_BEGIN { const int c = col & 1023; const size_t o = (size_t)row * DM + c;
            if (typ == 0) { f32x4 a, b;
#pragma unroll
                for (int e = 0; e < 4; ++e) { a[e] = siluf_(v0[e]); b[e] = siluf_(v1[e]); }
                *(bf16x8*)(qs + o) = pack8(a, b); }
            else if (typ == 1) { const f32x4 l0 = *(const f32x4*)(lbv + c), l1 = *(const f32x4*)(lbv + c + 4); f32x4 a, b;
#pragma unroll
                for (int e = 0; e < 4; ++e) { a[e] = __logf(l0[e] + (1.f - l0[e]) * sigmoidf_(v0[e])); b[e] = __logf(l1[e] + (1.f - l1[e]) * sigmoidf_(v1[e])); }
                *(f32x4*)(lf + o) = a; *(f32x4*)(lf + o + 4) = b; }
            else if (typ == 2) { *(bf16x8*)(vv + o) = pack8(v0, v1); }
            else { f32x4 a, b;
#pragma unroll
                for (int e = 0; e < 4; ++e) { a[e] = sigmoidf_(v0[e]); b[e] = sigmoidf_(v1[e]); }
                *(bf16x8*)(sg + o) = pack8(a, b); } } EPI_END
    }
};
struct EpiSwiglu {
    bf16_t* act; int ldact; int ntile;
    __device__ __forceinline__ void operator()(const acc_t& acc, const Unit& u, int wr, int wc, int fr, int fq) const {
        asm volatile("" : "+v"(fr), "+v"(fq));
        const int pnl = u.pn % ntile;
        EPI_BEGIN { const int cl = (pnl * 256 + (col & 255)) >> 1;
            const unsigned w0 = cvtpk(siluf_(v0[0]) * v1[0], siluf_(v0[1]) * v1[1]), w1 = cvtpk(siluf_(v0[2]) * v1[2], siluf_(v0[3]) * v1[3]);
            *(u32x2*)(act + (size_t)row * ldact + cl) = (u32x2){w0, w1}; } EPI_END
    }
};
struct EpiMoeDown {
    bf16_t* y;
    __device__ __forceinline__ void operator()(const acc_t& acc, const Unit& u, int wr, int wc, int fr, int fq) const {
        asm volatile("" : "+v"(fr), "+v"(fq));
        const int pnl = u.pn & 3;
        EPI_BEGIN { *(bf16x8*)(y + (size_t)row * DM + pnl * 256 + (col & 255)) = pack8(v0, v1); } EPI_END
    }
};
struct EpiDaIn {
    bf16_t* q; bf16_t* k; bf16_t* v; const f32x2* rope;
    __device__ __forceinline__ void operator()(const acc_t& acc, const Unit& u, int wr, int wc, int fr, int fq) const {
        asm volatile("" : "+v"(fr), "+v"(fq));
        const bool isqk = (u.pn * 256 < 2048);
#pragma unroll
        for (int ai = 0; ai < 2; ++ai)
#pragma unroll
            for (int mp = 0; mp < 2; ++mp) {
                f32x4 t0[2][2], t1[2][2];
                if (isqk) {
#pragma unroll
                    for (int mm = 0; mm < 2; ++mm)
#pragma unroll
                        for (int bj = 0; bj < 2; ++bj) { const int row = u.pm * 256 + ai * 128 + wr * 64 + (2 * mp + mm) * 16 + fr, col = u.pn * 256 + bj * 128 + wc * 32 + 8 * fq;
                            const int pos = row & (SEQ - 1), j0 = ((col >> 3) & 7) * 4;
                            t0[mm][bj] = *(const f32x4*)(rope + (size_t)pos * 32 + j0); t1[mm][bj] = *(const f32x4*)(rope + (size_t)pos * 32 + j0 + 2); } }
#pragma unroll
                for (int mm = 0; mm < 2; ++mm)
#pragma unroll
                    for (int bj = 0; bj < 2; ++bj) { const int m = 2 * mp + mm; const int row = u.pm * 256 + ai * 128 + wr * 64 + m * 16 + fr, col = u.pn * 256 + bj * 128 + wc * 32 + 8 * fq;
                        const f32x4 v0 = acc[ai][bj][m][0], v1 = acc[ai][bj][m][1]; const int b = row >> 13, pos = row & (SEQ - 1);
                        if (isqk) { const int blk = col >> 6, which = blk >> 4, hb = blk & 15, j0 = ((col >> 3) & 7) * 4;
                            const f32x4 a0 = t0[mm][bj], a1 = t1[mm][bj];
                            const float cs[4] = {a0[0], a0[2], a1[0], a1[2]}, sn[4] = {a0[1], a0[3], a1[1], a1[3]};
                            float y1[4], y2[4];
#pragma unroll
                            for (int e = 0; e < 4; ++e) { y1[e] = v0[e] * cs[e] - v1[e] * sn[e]; y2[e] = v1[e] * cs[e] + v0[e] * sn[e]; }
                            bf16_t* dst = (which ? k : q) + (((size_t)b * 8 + (hb >> 1)) * SEQ + pos) * 128 + (hb & 1) * 64 + j0;
                            *(u32x2*)dst = (u32x2){cvtpk(y1[0], y1[1]), cvtpk(y1[2], y1[3])};
                            *(u32x2*)(dst + 32) = (u32x2){cvtpk(y2[0], y2[1]), cvtpk(y2[2], y2[3])}; }
                        else { const int h = (col - 2048) >> 7, d = col & 127;
                            *(bf16x8*)(v + (((size_t)b * 8 + h) * SEQ + pos) * 128 + d) = pack8(v0, v1); } }
                asm volatile("" ::: "memory");
            }
    }
};
struct EpiNsaIn {
    bf16_t* q; bf16_t* qr; bf16_t* kv; float* gates; const f32x2* rope;
    __device__ __forceinline__ void operator()(const acc_t& acc, const Unit& u, int wr, int wc, int fr, int fq) const {
        asm volatile("" : "+v"(fr), "+v"(fq));
        const bool isrope = (u.pn < 10);
#pragma unroll
        for (int ai = 0; ai < 2; ++ai)
#pragma unroll
            for (int mp = 0; mp < 2; ++mp) {
                f32x4 t0[2][2], t1[2][2];
                if (isrope) {
#pragma unroll
                    for (int mm = 0; mm < 2; ++mm)
#pragma unroll
                        for (int bj = 0; bj < 2; ++bj) { const int row = u.pm * 256 + ai * 128 + wr * 64 + (2 * mp + mm) * 16 + fr, col = u.pn * 256 + bj * 128 + wc * 32 + 8 * fq;
                            const int pos = row & (SEQ - 1), j0 = ((col >> 3) & 15) * 4;
                            t0[mm][bj] = *(const f32x4*)(rope + (size_t)pos * 64 + j0); t1[mm][bj] = *(const f32x4*)(rope + (size_t)pos * 64 + j0 + 2); } }
#pragma unroll
                for (int mm = 0; mm < 2; ++mm)
#pragma unroll
                    for (int bj = 0; bj < 2; ++bj) { const int m = 2 * mp + mm; const int row = u.pm * 256 + ai * 128 + wr * 64 + m * 16 + fr, col = u.pn * 256 + bj * 128 + wc * 32 + 8 * fq;
                        const f32x4 v0 = acc[ai][bj][m][0], v1 = acc[ai][bj][m][1]; const int b = row >> 13, pos = row & (SEQ - 1);
                        if (isrope) { const int blk = col >> 7, j0 = ((col >> 3) & 15) * 4;
                            const f32x4 a0 = t0[mm][bj], a1 = t1[mm][bj];
                            const float cs[4] = {a0[0], a0[2], a1[0], a1[2]}, sn[4] = {a0[1], a0[3], a1[1], a1[3]};
                            float y1[4], y2[4];
#pragma unroll
                            for (int e = 0; e < 4; ++e) { y1[e] = v0[e] * cs[e] - v1[e] * sn[e]; y2[e] = v1[e] * cs[e] + v0[e] * sn[e]; }
                            const u32x2 p1 = (u32x2){cvtpk(v0[0], v0[1]), cvtpk(v0[2], v0[3])}, p2 = (u32x2){cvtpk(v1[0], v1[1]), cvtpk(v1[2], v1[3])};
                            const u32x2 r1 = (u32x2){cvtpk(y1[0], y1[1]), cvtpk(y1[2], y1[3])}, r2 = (u32x2){cvtpk(y2[0], y2[1]), cvtpk(y2[2], y2[3])};
                            if (blk < 8) { const size_t o = (((size_t)b * 8 + blk) * SEQ + pos) * 128 + j0;
                                *(u32x2*)(q + o) = p1; *(u32x2*)(q + o + 64) = p2; *(u32x2*)(qr + o) = r1; *(u32x2*)(qr + o + 64) = r2; }
                            else { const int jj = (blk - 8) >> 1, g = (blk - 8) & 1; const bool rot = (jj == 2) || (jj == 4);
                                const size_t o = (((size_t)jj * 8 + b * 2 + g) * SEQ + pos) * 128 + j0;
                                *(u32x2*)(kv + o) = rot ? r1 : p1; *(u32x2*)(kv + o + 64) = rot ? r2 : p2; } }
                        else { const int gi = col - 2560;
                            if (gi < 24) { f32x4 a, bb;
#pragma unroll
                                for (int e = 0; e < 4; ++e) { a[e] = sigmoidf_(v0[e]); bb[e] = sigmoidf_(v1[e]); }
                                *(f32x4*)(gates + (size_t)row * 24 + gi) = a; *(f32x4*)(gates + (size_t)row * 24 + gi + 4) = bb; } } }
                asm volatile("" ::: "memory");
            }
    }
};
struct EpiSbIn {
    bf16_t* qkv;
    __device__ __forceinline__ void operator()(const acc_t& acc, const Unit& u, int wr, int wc, int fr, int fq) const {
        asm volatile("" : "+v"(fr), "+v"(fq));
        EPI_BEGIN { const int b = row >> 13, pos = row & (SEQ - 1), which = col >> 10, h = (col >> 7) & 7, d = col & 127;
            *(bf16x8*)(qkv + (size_t)which * NT * DM + (((size_t)b * 8 + h) * SEQ + pos) * 128 + d) = pack8(v0, v1); } EPI_END
    }
};
using pg8::NXCD; using pg8::WGM;
template <bool GATHER_>
struct MoeOrderT {
    static constexpr bool GATHER = GATHER_;
    int G, c, tile_lo, nT, nNt; int seg_tile[8]; const int* tok; int imax = 0x7fffffff;
    __device__ __forceinline__ int row_token(int r) const { return tok[r]; }
    __device__ __forceinline__ bool next(int i, Unit& u) const { return i < imax && at((long)i * G + c, u); }
    __device__ __forceinline__ bool at(long L, Unit& u) const {
        const int nwg = nT * nNt;
        if (nT <= 0 || L >= (long)nwg) return false;
        int wgid = (int)L; { const int q = nwg / NXCD, r = nwg % NXCD, xcd = wgid % NXCD, off = wgid / NXCD; wgid = (xcd < r ? xcd * (q + 1) : r * (q + 1) + (xcd - r) * q) + off; }
        const int nig = WGM * nNt, gid = wgid / nig, fm = gid * WGM, gsz = (nT - fm) < WGM ? (nT - fm) : WGM;
        const int pml = fm + ((wgid % nig) % gsz), pn = (wgid % nig) / gsz, tile = tile_lo + pml;
        int e = 0;
#pragma unroll
        for (int k = 1; k < 8; ++k) e += (tile >= seg_tile[k]) ? 1 : 0;
        u.pm = pml; u.pn = e * nNt + pn; return true;
    }
};

struct MapId { const float* src; int ld, nsrc; __device__ __forceinline__ const float* operator()(int n) const { return n < nsrc ? src + n : nullptr; }
    __device__ __forceinline__ MapId shifted(size_t off) const { return MapId{src + off, ld, nsrc}; } };
struct MapRope64 { const float* src; int ld; __device__ __forceinline__ const float* operator()(int n) const {
    if (n >= 2048) return src + n; const int p = n & 63, g = p >> 3, e = p & 7; return src + (n & ~63) + (e < 4 ? 4 * g + e : 32 + 4 * g + (e - 4)); }
    __device__ __forceinline__ MapRope64 shifted(size_t off) const { return MapRope64{src + off, ld}; } };
struct MapNsa { const float* src; int ld; __device__ __forceinline__ const float* operator()(int n) const {
    if (n >= 2584) return nullptr; if (n >= 2560) return src + n; const int p = n & 127, g = p >> 3, e = p & 7; return src + (n & ~127) + (e < 4 ? 4 * g + e : 64 + 4 * g + (e - 4)); }
    __device__ __forceinline__ MapNsa shifted(size_t off) const { return MapNsa{src + off, ld}; } };
struct MapGU { const float* gate; const float* up; int ld; __device__ __forceinline__ const float* operator()(int n) const {
    const int i = n >> 3, e = n & 7; return e < 4 ? gate + 4 * i + e : up + 4 * i + (e - 4); }
    __device__ __forceinline__ MapGU shifted(size_t off) const { return MapGU{gate + off, up + off, ld}; } };
template <class Map>
__device__ __forceinline__ void convert_T(ldsp_t lds, bf16_t* dst, int nb, size_t src_bstride, int Ndst, int K, const Map map0, int wg, int nwg) {
    const int tid = my_tid(), ntn = Ndst >> 6, per = ntn * (K >> 6), ntiles = per * nb;
    LAS bf16_t* tl = (LAS bf16_t*)lds;
    const int ln = tid & 63, lk = tid >> 6, sn = tid >> 3, skc = (tid & 7) * 8;
    float va[8], vb[8];
#define CT_LOAD(V, TILE) do { const int bi_ = (TILE) / per, tt_ = (TILE) % per, n0_ = (tt_ % ntn) << 6, k0_ = (tt_ / ntn) << 6; \
        const Map m_ = map0.shifted((size_t)bi_ * src_bstride); const float* cp_ = m_(n0_ + ln); \
        _Pragma("unroll") for (int it = 0; it < 8; ++it) V[it] = cp_ ? __builtin_nontemporal_load(cp_ + (size_t)(k0_ + lk + 8 * it) * m_.ld) : 0.f; } while (0)
    float vc[8], vd[8];
    int tile = wg, buf = 0;
    if (tile < ntiles) CT_LOAD(va, tile);
    if (tile + nwg < ntiles) CT_LOAD(vb, tile + nwg);
    if (tile + 2 * nwg < ntiles) CT_LOAD(vc, tile + 2 * nwg);
#define CT_STEP(VCUR, VNEW) do { if (tile < ntiles) { \
        if (tile + 3 * nwg < ntiles) CT_LOAD(VNEW, tile + 3 * nwg); \
        LAS bf16_t* tb = tl + buf * (64 * 66); \
        _Pragma("unroll") for (int it = 0; it < 8; ++it) tb[ln * 66 + lk + 8 * it] = f2bf(VCUR[it]); \
        __syncthreads(); \
        { const int bi = tile / per, tt = tile % per, n0 = (tt % ntn) << 6, k0 = (tt / ntn) << 6; \
          const LAS unsigned* rp = (const LAS unsigned*)(tb + sn * 66 + skc); \
          const u32x4 w = {rp[0], rp[1], rp[2], rp[3]}; \
          *(u32x4*)(dst + ((size_t)bi * Ndst + n0 + sn) * K + k0 + skc) = w; } \
        tile += nwg; buf ^= 1; } } while (0)
    while (tile < ntiles) { CT_STEP(va, vd); CT_STEP(vb, va); CT_STEP(vc, vb); CT_STEP(vd, vc); }
#undef CT_STEP
    __syncthreads();
#undef CT_LOAD
}

struct Route { int e0, e1, p0, p1; float g0, g1; int pad0, pad1; };
__device__ __forceinline__ void moe_segments_lds(const unsigned* cnt, LAS int* segL) {
    if (threadIdx.x == 0) { int s = 0;
        for (int e = 0; e < 8; ++e) { segL[e] = s; s += (int)((cnt[e] + 255u) & ~255u); }
        segL[8] = s; }
    __syncthreads();
}
__device__ __forceinline__ void ln_phase(ldsp_t lds, const bf16_t* src, float* dst_f32, bf16_t* dst_bf16, const float* lng, const float* lnb,
                                         const Route* route_in, const bf16_t* ybuf, const unsigned* cnt_in,
                                         const float* wrouter, Route* route_out, unsigned* cnt_out, int wg, int nwg) {
    const int tid = my_tid(), wid = tid >> 6, lane = tid & 63;
    LAS float* wl = (LAS float*)lds;
    LAS int* rinfo = (LAS int*)(lds + 32768);
    LAS unsigned* cntL = (LAS unsigned*)(lds + 32768 + 4096);
    LAS int* seg_start = (LAS int*)(lds + 32768 + 4096 + 256);
    if (route_in) moe_segments_lds(cnt_in, seg_start);
    if (wrouter) { for (int i = tid; i < 8192; i += 512) { const int d = i >> 3, e = i & 7; wl[e * 1024 + d] = wrouter[i]; } }
    f32x4 gv[4], bv[4];
#pragma unroll
    for (int q = 0; q < 4; ++q) { gv[q] = *(const f32x4*)(lng + 4 * lane + 256 * q); bv[q] = *(const f32x4*)(lnb + 4 * lane + 256 * q); }
    for (int chunk = wg; chunk < NT / 128; chunk += nwg) {
        if (wrouter) { if (tid < 8) cntL[tid] = 0u; }
        __syncthreads();
        u32x2 zn[4], yan[4], ybn[4]; Route rn; rn.e0 = 0; rn.e1 = 0; rn.p0 = 0; rn.p1 = 0; rn.g0 = 0.f; rn.g1 = 0.f; rn.pad0 = 0; rn.pad1 = 0;
#define LN_LOAD(ROW) do { _Pragma("unroll") for (int q = 0; q < 4; ++q) zn[q] = *(const u32x2*)(src + (size_t)(ROW) * DM + 4 * lane + 256 * q); \
            if (route_in) { rn = route_in[(ROW)]; const size_t s0_ = (size_t)(seg_start[rn.e0] + rn.p0) * DM, s1_ = (size_t)(seg_start[rn.e1] + rn.p1) * DM; \
                _Pragma("unroll") for (int q = 0; q < 4; ++q) { yan[q] = *(const u32x2*)(ybuf + s0_ + 4 * lane + 256 * q); ybn[q] = *(const u32x2*)(ybuf + s1_ + 4 * lane + 256 * q); } } } while (0)
        LN_LOAD(chunk * 128 + wid * 16);
        for (int i = 0; i < 16; ++i) {
            const int rl = wid * 16 + i, row = chunk * 128 + rl;
            f32x4 z[4]; u32x2 ya[4], yb[4]; const Route r = rn;
#pragma unroll
            for (int q = 0; q < 4; ++q) { const u32x2 w = zn[q]; ya[q] = yan[q]; yb[q] = ybn[q];
                z[q] = (f32x4){__uint_as_float(w[0] << 16), __uint_as_float(w[0] & 0xffff0000u), __uint_as_float(w[1] << 16), __uint_as_float(w[1] & 0xffff0000u)}; }
            if (i + 1 < 16) LN_LOAD(row + 1);
            if (route_in) {
#pragma unroll
                for (int q = 0; q < 4; ++q) { const u32x2 a = ya[q], b = yb[q];
                    z[q][0] = z[q][0] * ALPHA + r.g0 * __uint_as_float(a[0] << 16) + r.g1 * __uint_as_float(b[0] << 16);
                    z[q][1] = z[q][1] * ALPHA + r.g0 * __uint_as_float(a[0] & 0xffff0000u) + r.g1 * __uint_as_float(b[0] & 0xffff0000u);
                    z[q][2] = z[q][2] * ALPHA + r.g0 * __uint_as_float(a[1] << 16) + r.g1 * __uint_as_float(b[1] << 16);
                    z[q][3] = z[q][3] * ALPHA + r.g0 * __uint_as_float(a[1] & 0xffff0000u) + r.g1 * __uint_as_float(b[1] & 0xffff0000u); }
            }
            float s = 0.f;
#pragma unroll
            for (int q = 0; q < 4; ++q) s += (z[q][0] + z[q][1]) + (z[q][2] + z[q][3]);
            const float mean = wave_sum(s) * (1.f / DM);
            float v = 0.f;
#pragma unroll
            for (int q = 0; q < 4; ++q) { z[q] = z[q] - mean; v += (z[q][0] * z[q][0] + z[q][1] * z[q][1]) + (z[q][2] * z[q][2] + z[q][3] * z[q][3]); }
            const float rstd = rsqrtf(wave_sum(v) * (1.f / DM) + LN_EPS);
#pragma unroll
            for (int q = 0; q < 4; ++q) { z[q] = z[q] * rstd * gv[q] + bv[q]; if (dst_f32) *(f32x4*)(dst_f32 + (size_t)row * DM + 4 * lane + 256 * q) = z[q]; }
            if (dst_bf16) {
#pragma unroll
                for (int q = 0; q < 4; ++q) *(u32x2*)(dst_bf16 + (size_t)row * DM + 4 * lane + 256 * q) = (u32x2){cvtpk(z[q][0], z[q][1]), cvtpk(z[q][2], z[q][3])};
            }
            if (wrouter) {
                float lg[8];
#pragma unroll
                for (int e = 0; e < 8; ++e) { float a = 0.f;
#pragma unroll
                    for (int q = 0; q < 4; ++q) { const f32x4 w = *(const LAS f32x4*)(wl + e * 1024 + 4 * lane + 256 * q); a += z[q][0] * w[0] + z[q][1] * w[1] + z[q][2] * w[2] + z[q][3] * w[3]; }
                    lg[e] = wave_sum(a); }
                int e0 = 0; float v0 = lg[0];
#pragma unroll
                for (int e = 1; e < 8; ++e) if (lg[e] > v0) { v0 = lg[e]; e0 = e; }
                int e1 = -1; float v1 = -3.0e38f;
#pragma unroll
                for (int e = 0; e < 8; ++e) if (e != e0 && lg[e] > v1) { v1 = lg[e]; e1 = e; }
                if (e1 < 0) { e1 = (e0 + 1) & 7; v1 = v0; }
                if (lane == 0) {
                    const float g1 = 1.f / (1.f + __expf(v0 - v1)), g0 = 1.f - g1;
                    const int p0 = (int)atomicAdd((unsigned*)(cntL + e0), 1u), p1 = (int)atomicAdd((unsigned*)(cntL + e1), 1u);
                    rinfo[rl * 6 + 0] = e0; rinfo[rl * 6 + 1] = e1; rinfo[rl * 6 + 2] = p0; rinfo[rl * 6 + 3] = p1;
                    rinfo[rl * 6 + 4] = __float_as_int(g0); rinfo[rl * 6 + 5] = __float_as_int(g1);
                }
            }
        }
        if (wrouter) {
            __syncthreads();
            if (tid < 8) cntL[8 + tid] = atomicAdd(cnt_out + tid, cntL[tid]);
            __syncthreads();
            if (tid < 128) { Route r; r.e0 = rinfo[tid * 6 + 0]; r.e1 = rinfo[tid * 6 + 1];
                r.p0 = rinfo[tid * 6 + 2] + (int)cntL[8 + r.e0]; r.p1 = rinfo[tid * 6 + 3] + (int)cntL[8 + r.e1];
                r.g0 = __int_as_float(rinfo[tid * 6 + 4]); r.g1 = __int_as_float(rinfo[tid * 6 + 5]); r.pad0 = 0; r.pad1 = 0;
                route_out[chunk * 128 + tid] = r; }
            __syncthreads();
        }
    }
}
#undef LN_LOAD
__device__ __forceinline__ void moe_build_table(ldsp_t lds, int* tab, const Route* route, const unsigned* cnt, int wg, int nwg) {
    const int tid = my_tid();
    LAS int* seg_start = (LAS int*)lds; moe_segments_lds(cnt, seg_start);
    for (int t = wg * 512 + tid; t < NT; t += nwg * 512) { const Route r = route[t]; tab[seg_start[r.e0] + r.p0] = t; tab[seg_start[r.e1] + r.p1] = t; }
    for (int i = wg * 512 + tid; i < 8 * 256; i += nwg * 512) { const int e = i >> 8, k = i & 255; const int c = (int)cnt[e], pad = (c + 255) & ~255;
        if (c + k < pad) tab[seg_start[e] + c + k] = 0; }
    __syncthreads();
}

constexpr int HG_P144 = 144, HG_P272 = 272;
__device__ __forceinline__ void hgrn_passA(ldsp_t lds, const float* lf, const bf16_t* vv, bf16_t* ST, float* dec, int wg, int nwg) {
    const int tid = my_tid(), wid = tid >> 6, lane = tid & 63, r32 = lane & 31, hi = lane >> 5;
    const int d = tid & 127, sq = tid >> 7;
    ldsp_t KhT = lds, VT = lds + 128 * HG_P144; LAS float* tot = (LAS float*)(lds + 2 * 128 * HG_P144);
    float lfn[16]; bf16_t vnx[16];
#define HA_LOAD(IT) do { const int bh_ = (IT) >> 7, c_ = (IT) & 127, b_ = bh_ >> 3, h_ = bh_ & 7; const size_t t0_ = (size_t)b_ * SEQ + c_ * 64; \
        _Pragma("unroll") for (int tt = 0; tt < 16; ++tt) { const size_t o_ = (t0_ + 16 * sq + tt) * DM + h_ * 128 + d; lfn[tt] = lf[o_]; vnx[tt] = vv[o_]; } } while (0)
    if (wg < 4096) HA_LOAD(wg);
    for (int it = wg; it < 4096; it += nwg) {
        const int bh = it >> 7, c = it & 127, b = bh >> 3, h = bh & 7;
        const size_t tok0 = (size_t)b * SEQ + c * 64; (void)tok0; (void)b; (void)h;
        float lfv[16], cs[16]; bf16_t vraw[16];
#pragma unroll
        for (int tt = 0; tt < 16; ++tt) { lfv[tt] = lfn[tt]; vraw[tt] = vnx[tt]; }
        if (it + nwg < 4096) HA_LOAD(it + nwg);
        float run = 0.f;
#pragma unroll
        for (int tt = 0; tt < 16; ++tt) { run += lfv[tt]; cs[tt] = run; }
        tot[sq * 128 + d] = run;
        __syncthreads();
        float off = 0.f, cl = 0.f;
#pragma unroll
        for (int q = 0; q < 4; ++q) { const float t = tot[q * 128 + d]; cl += t; off += (q < sq) ? t : 0.f; }
        if (sq == 0) dec[(size_t)it * 128 + d] = __expf(cl);
        { unsigned w[8];
#pragma unroll
          for (int p = 0; p < 8; ++p) { const float c0 = off + cs[2 * p], c1 = off + cs[2 * p + 1];
              w[p] = cvtpk((1.f - __expf(lfv[2 * p])) * __expf(cl - c0), (1.f - __expf(lfv[2 * p + 1])) * __expf(cl - c1)); }
          *(LAS u32x4*)(KhT + d * HG_P144 + sq * 32) = (u32x4){w[0], w[1], w[2], w[3]};
          *(LAS u32x4*)(KhT + d * HG_P144 + sq * 32 + 16) = (u32x4){w[4], w[5], w[6], w[7]};
          unsigned x[8];
#pragma unroll
          for (int p = 0; p < 8; ++p) x[p] = (unsigned)vraw[2 * p] | ((unsigned)vraw[2 * p + 1] << 16);
          *(LAS u32x4*)(VT + d * HG_P144 + sq * 32) = (u32x4){x[0], x[1], x[2], x[3]};
          *(LAS u32x4*)(VT + d * HG_P144 + sq * 32 + 16) = (u32x4){x[4], x[5], x[6], x[7]}; }
        __syncthreads();
        const int mt = wid >> 1;
#pragma unroll
        for (int nn = 0; nn < 2; ++nn) { const int nt = (wid & 1) * 2 + nn; f32x16 acc = {};
#pragma unroll
            for (int ks = 0; ks < 4; ++ks) {
                const bf16x8 a = *(const LAS bf16x8*)(VT + (32 * mt + r32) * HG_P144 + (16 * ks + 8 * hi) * 2);
                const bf16x8 bb = *(const LAS bf16x8*)(KhT + (32 * nt + r32) * HG_P144 + (16 * ks + 8 * hi) * 2);
                acc = __builtin_amdgcn_mfma_f32_32x32x16_bf16(a, bb, acc, 0, 0, 0); }
#pragma unroll
            for (int r = 0; r < 16; ++r) { const int v = 32 * mt + (r & 3) + 8 * (r >> 2) + 4 * hi;
                ST[((size_t)it * 128 + v) * 128 + 32 * nt + r32] = f2bf(acc[r]); } }
        __syncthreads();
    }
}
#undef HA_LOAD
__device__ __forceinline__ void hgrn_passB(bf16_t* ST, const float* dec, int wg, int nwg) {
    for (int eg = wg * 512 + my_tid(); eg < 32 * 4096; eg += nwg * 512) {
        const int bh = eg >> 12, w = eg & 4095, v = w >> 5, d4 = (w & 31) * 4;
        float st[4] = {0.f, 0.f, 0.f, 0.f};
        for (int c0 = 0; c0 < 128; c0 += 8) {
            u32x2 kvr[8]; f32x4 dc[8];
#pragma unroll
            for (int j = 0; j < 8; ++j) { const size_t it = (size_t)bh * 128 + c0 + j;
                kvr[j] = *(const u32x2*)(ST + (it * 128 + v) * 128 + d4); dc[j] = *(const f32x4*)(dec + it * 128 + d4); }
#pragma unroll
            for (int j = 0; j < 8; ++j) { const size_t it = (size_t)bh * 128 + c0 + j;
                *(u32x2*)(ST + (it * 128 + v) * 128 + d4) = (u32x2){cvtpk(st[0], st[1]), cvtpk(st[2], st[3])};
                st[0] = dc[j][0] * st[0] + __uint_as_float(kvr[j][0] << 16); st[1] = dc[j][1] * st[1] + __uint_as_float(kvr[j][0] & 0xffff0000u);
                st[2] = dc[j][2] * st[2] + __uint_as_float(kvr[j][1] << 16); st[3] = dc[j][3] * st[3] + __uint_as_float(kvr[j][1] & 0xffff0000u); }
        }
    }
}
__device__ __forceinline__ void hgrn_passC(ldsp_t lds, const bf16_t* qs, const float* lf, const bf16_t* vv, const bf16_t* sg, const bf16_t* ST, const float* normg, bf16_t* ob, int wg, int nwg) {
    const int tid = my_tid(), wid = tid >> 6, lane = tid & 63, c16 = lane & 15, g = lane >> 4;
    const int d = tid & 127, sq = tid >> 7;
    ldsp_t Qi = lds, Qc = lds + 17408, Kt = lds + 2 * 17408, VT = lds + 2 * 17408 + 43520, STl = VT + 18432;
    LAS float* refs = (LAS float*)(STl + 34816); LAS float* tot = refs + 512; LAS float* ssq = tot + 512;
    float lfn[16]; bf16_t qn[16], vn[16]; u32x4 stn[4];
#define HC_LOAD(IT) do { const int bh_ = (IT) >> 7, c_ = (IT) & 127, b_ = bh_ >> 3, h_ = bh_ & 7; const size_t t0_ = (size_t)b_ * SEQ + c_ * 64; \
        _Pragma("unroll") for (int tt = 0; tt < 16; ++tt) { const size_t o_ = (t0_ + 16 * sq + tt) * DM + h_ * 128 + d; lfn[tt] = lf[o_]; qn[tt] = qs[o_]; vn[tt] = vv[o_]; } \
        _Pragma("unroll") for (int i4 = 0; i4 < 4; ++i4) { const int p = tid + 512 * i4, v = p >> 4, ch = p & 15; stn[i4] = *(const u32x4*)(ST + ((size_t)(IT) * 128 + v) * 128 + ch * 8); } } while (0)
    if (wg < 4096) HC_LOAD(wg);
    for (int it = wg; it < 4096; it += nwg) {
        const int bh = it >> 7, c = it & 127, b = bh >> 3, h = bh & 7;
        const size_t tok0 = (size_t)b * SEQ + c * 64;
        float lfv[16], cum[16]; bf16_t qraw[16], vraw[16];
#pragma unroll
        for (int tt = 0; tt < 16; ++tt) { lfv[tt] = lfn[tt]; qraw[tt] = qn[tt]; vraw[tt] = vn[tt]; }
        float run = 0.f;
#pragma unroll
        for (int tt = 0; tt < 16; ++tt) { run += lfv[tt]; cum[tt] = run; }
        tot[sq * 128 + d] = run;
#pragma unroll
        for (int i4 = 0; i4 < 4; ++i4) { const int p = tid + 512 * i4, v = p >> 4, ch = p & 15;
            *(LAS u32x4*)(STl + v * HG_P272 + ch * 16) = stn[i4]; }
        { unsigned x[8];
#pragma unroll
          for (int p = 0; p < 8; ++p) x[p] = (unsigned)vraw[2 * p] | ((unsigned)vraw[2 * p + 1] << 16);
          *(LAS u32x4*)(VT + d * HG_P144 + sq * 32) = (u32x4){x[0], x[1], x[2], x[3]};
          *(LAS u32x4*)(VT + d * HG_P144 + sq * 32 + 16) = (u32x4){x[4], x[5], x[6], x[7]}; }
        if (it + nwg < 4096) HC_LOAD(it + nwg);
        __syncthreads();
        float off = 0.f;
#pragma unroll
        for (int q = 0; q < 4; ++q) { const float t = tot[q * 128 + d]; off += (q < sq) ? t : 0.f; }
#pragma unroll
        for (int tt = 0; tt < 16; ++tt) cum[tt] += off;
        refs[sq * 128 + d] = cum[0];
        __syncthreads();
        float rf[4];
#pragma unroll
        for (int i = 0; i < 4; ++i) rf[i] = refs[i * 128 + d];
        float rme = rf[0];
#pragma unroll
        for (int i = 1; i < 4; ++i) rme = (sq == i) ? rf[i] : rme;
#pragma unroll
        for (int tt = 0; tt < 16; ++tt) { const int t = 16 * sq + tt; const float qv = bf2f(qraw[tt]);
            *(LAS bf16_t*)(Qi + t * HG_P272 + d * 2) = f2bf(qv * __expf(cum[tt] - rme));
            *(LAS bf16_t*)(Qc + t * HG_P272 + d * 2) = f2bf(qv * __expf(cum[tt]));
            const float kvv = 1.f - __expf(lfv[tt]);
#pragma unroll
            for (int i = 0; i < 4; ++i) { const int rb = (i == 0) ? 0 : (i == 1) ? 16 : (i == 2) ? 48 : 96;
                if (i >= sq) *(LAS bf16_t*)(Kt + (rb + t) * HG_P272 + d * 2) = f2bf(kvv * __expf(rf[i] - cum[tt])); } }
        __syncthreads();
        const int ib = wid >> 1, vh = wid & 1;
        const int rbI = (ib == 0) ? 0 : (ib == 1) ? 16 : (ib == 2) ? 48 : 96;
        f32x4 sc[4];
#pragma unroll
        for (int a = 0; a < 4; ++a) { sc[a] = (f32x4){0.f, 0.f, 0.f, 0.f};
            if (a <= ib) {
#pragma unroll
                for (int ks = 0; ks < 4; ++ks) {
                    const bf16x8 A = *(const LAS bf16x8*)(Kt + (rbI + 16 * a + c16) * HG_P272 + (32 * ks + 8 * g) * 2);
                    const bf16x8 B = *(const LAS bf16x8*)(Qi + (16 * ib + c16) * HG_P272 + (32 * ks + 8 * g) * 2);
                    sc[a] = __builtin_amdgcn_mfma_f32_16x16x32_bf16(A, B, sc[a], 0, 0, 0); }
                if (a == ib) {
#pragma unroll
                    for (int r = 0; r < 4; ++r) if (4 * g + r > c16) sc[a][r] = 0.f; } } }
        bf16x8 pb[2];
#pragma unroll
        for (int p = 0; p < 2; ++p) { const u32x4 w = {cvtpk(sc[2 * p][0], sc[2 * p][1]), cvtpk(sc[2 * p][2], sc[2 * p][3]), cvtpk(sc[2 * p + 1][0], sc[2 * p + 1][1]), cvtpk(sc[2 * p + 1][2], sc[2 * p + 1][3])};
            pb[p] = *reinterpret_cast<const bf16x8*>(&w); }
        f32x4 ao[4]; float ssl = 0.f;
#pragma unroll
        for (int vt = 0; vt < 4; ++vt) { ao[vt] = (f32x4){0.f, 0.f, 0.f, 0.f}; const int vrow = 16 * (4 * vh + vt) + c16;
#pragma unroll
            for (int p = 0; p < 2; ++p) if (2 * p <= ib) {
                const u32x2 lo = *(const LAS u32x2*)(VT + vrow * HG_P144 + (32 * p + 4 * g) * 2), hi2 = *(const LAS u32x2*)(VT + vrow * HG_P144 + (32 * p + 16 + 4 * g) * 2);
                const u32x4 w = {lo[0], lo[1], hi2[0], hi2[1]};
                ao[vt] = __builtin_amdgcn_mfma_f32_16x16x32_bf16(*reinterpret_cast<const bf16x8*>(&w), pb[p], ao[vt], 0, 0, 0); }
#pragma unroll
            for (int ks = 0; ks < 4; ++ks) {
                const bf16x8 A = *(const LAS bf16x8*)(STl + vrow * HG_P272 + (32 * ks + 8 * g) * 2);
                const bf16x8 B = *(const LAS bf16x8*)(Qc + (16 * ib + c16) * HG_P272 + (32 * ks + 8 * g) * 2);
                ao[vt] = __builtin_amdgcn_mfma_f32_16x16x32_bf16(A, B, ao[vt], 0, 0, 0); }
            ssl += ao[vt][0] * ao[vt][0] + ao[vt][1] * ao[vt][1] + ao[vt][2] * ao[vt][2] + ao[vt][3] * ao[vt][3]; }
        ssl += __shfl_xor(ssl, 16); ssl += __shfl_xor(ssl, 32);
        if (g == 0) ssq[vh * 64 + 16 * ib + c16] = ssl;
        __syncthreads();
        const float rs = rsqrtf((ssq[16 * ib + c16] + ssq[64 + 16 * ib + c16]) * (1.f / 128.f) + LN_EPS);
        const size_t trow = (tok0 + 16 * ib + c16) * DM + h * 128;
#pragma unroll
        for (int vt = 0; vt < 4; ++vt) { const int v0 = 16 * (4 * vh + vt) + 4 * g;
            const f32x4 ng = *(const f32x4*)(normg + v0); const u32x2 sgr = *(const u32x2*)(sg + trow + v0);
            const float o0 = ao[vt][0] * rs * ng[0] * __uint_as_float(sgr[0] << 16), o1 = ao[vt][1] * rs * ng[1] * __uint_as_float(sgr[0] & 0xffff0000u);
            const float o2 = ao[vt][2] * rs * ng[2] * __uint_as_float(sgr[1] << 16), o3 = ao[vt][3] * rs * ng[3] * __uint_as_float(sgr[1] & 0xffff0000u);
            *(u32x2*)(ob + trow + v0) = (u32x2){cvtpk(o0, o1), cvtpk(o2, o3)}; }
        __syncthreads();
    }
}

#undef HC_LOAD
#define KSWZ(row, colB) ((row) * 256 + ((colB) ^ (((row) & 7) << 4)))
__device__ __forceinline__ int q_park(int wid) { return wid < 4 ? 2 * 32768 + wid * 8192 : 3 * 32768 + 2048 + (wid - 4) * 8192; }
constexpr int AT_V = 0, AT_K = 16384, AT_BUF = 32768, AT_WS = 3 * 32768, AT_END = 3 * 32768 + 8 * 64 * 4;
__device__ __forceinline__ int v_st(int k, int c) { const int kk = (k & ~0xC) | ((k & 4) << 1) | ((k & 8) >> 1); return ((kk >> 3) * 4 + (c >> 5)) * 512 + ((kk & 7) * 32 + (c & 31)) * 2; }
__device__ __forceinline__ int v_rd_base(int lane) { return ((lane & 3) << 3) | (((lane >> 2) & 3) << 6) | (((lane >> 4) & 1) << 5) | (((lane >> 5) & 1) << 8); }
constexpr int v_rd_off(int d0, int ks, int half) { return d0 * 512 + ks * 4096 + half * 2048; }
__device__ __forceinline__ int crow(int r, int hi) { return (r & 3) + 8 * (r >> 2) + 4 * hi; }
template <int D0_LO, int D0_HI>
__device__ __forceinline__ void qkt_range(f32x16& p0, f32x16& p1, ldsp_t Kt, int r32, int hi, const bf16x8* qr) {
    p0 = f32x16{}; p1 = f32x16{};
    ldsp_t kb[4];
#pragma unroll
    for (int dd = 0; dd < 4; ++dd) kb[dd] = Kt + KSWZ(r32, (dd * 16 + hi * 8) * 2);
#pragma unroll
    for (int d0 = D0_LO; d0 < D0_HI; ++d0) {
        ldsp_t a = kb[d0 & 3] + (d0 >> 2) * 128;
        const bf16x8 b0 = *(const LAS bf16x8*)(a);
        const bf16x8 b1 = *(const LAS bf16x8*)(a + 32 * 256);
        p0 = __builtin_amdgcn_mfma_f32_32x32x16_bf16(b0, qr[d0], p0, 0, 0, 0);
        p1 = __builtin_amdgcn_mfma_f32_32x32x16_bf16(b1, qr[d0], p1, 0, 0, 0); }
}
template <int D0_LO, int D0_HI>
__device__ __forceinline__ void qkt_range_lq(f32x16& p0, f32x16& p1, ldsp_t Kt, ldsp_t Qw, int r32, int hi) {
    p0 = f32x16{}; p1 = f32x16{};
    int ko[4];
#pragma unroll
    for (int dd = 0; dd < 4; ++dd) ko[dd] = KSWZ(r32, (dd * 16 + hi * 8) * 2);
#pragma unroll
    for (int d0 = D0_LO; d0 < D0_HI; ++d0) {
        const int off = ko[d0 & 3] + (d0 >> 2) * 128;
        const bf16x8 b0 = *(const LAS bf16x8*)(Kt + off);
        const bf16x8 b1 = *(const LAS bf16x8*)(Kt + off + 32 * 256);
        const bf16x8 q = *(const LAS bf16x8*)(Qw + off);
        p0 = __builtin_amdgcn_mfma_f32_32x32x16_bf16(b0, q, p0, 0, 0, 0);
        p1 = __builtin_amdgcn_mfma_f32_32x32x16_bf16(b1, q, p1, 0, 0, 0); }
}
template <int ND>
__device__ __forceinline__ void qkt(f32x16& p0, f32x16& p1, ldsp_t Kt, int r32, int hi, const bf16x8* qr) {
    p0 = f32x16{}; p1 = f32x16{};
    ldsp_t kb[4];
#pragma unroll
    for (int dd = 0; dd < 4; ++dd) kb[dd] = Kt + KSWZ(r32, (dd * 16 + hi * 8) * 2);
#pragma unroll
    for (int d0 = 0; d0 < ND; ++d0) {
        ldsp_t a = kb[d0 & 3] + (d0 >> 2) * 128;
        const bf16x8 b0 = *(const LAS bf16x8*)(a);
        const bf16x8 b1 = *(const LAS bf16x8*)(a + 32 * 256);
        p0 = __builtin_amdgcn_mfma_f32_32x32x16_bf16(b0, qr[d0], p0, 0, 0, 0);
        p1 = __builtin_amdgcn_mfma_f32_32x32x16_bf16(b1, qr[d0], p1, 0, 0, 0); }
}
__device__ __forceinline__ void pv_tile(f32x16* o, unsigned vb0, bf16x8 pa0, bf16x8 pa1, bf16x8 pa2, bf16x8 pa3) {
#define TRRD(dst, off) asm volatile("ds_read_b64_tr_b16 %0, %1 offset:%2" : "=&v"(dst) : "v"(vb0), "i"(off) : "memory")
#define PV_D0(d0) do { s16x4 l0, l1, l2, l3, h0, h1, h2, h3; constexpr int b_ = v_rd_off(d0, 0, 0); \
        TRRD(l0, b_); TRRD(h0, b_ + 2048); TRRD(l1, b_ + 4096); TRRD(h1, b_ + 6144); TRRD(l2, b_ + 8192); TRRD(h2, b_ + 10240); TRRD(l3, b_ + 12288); TRRD(h3, b_ + 14336); \
        asm volatile("s_waitcnt lgkmcnt(0)" ::: "memory"); __builtin_amdgcn_sched_barrier(0); \
        o[d0] = __builtin_amdgcn_mfma_f32_32x32x16_bf16(pa0, (bf16x8){l0[0], l0[1], l0[2], l0[3], h0[0], h0[1], h0[2], h0[3]}, o[d0], 0, 0, 0);   \
        o[d0] = __builtin_amdgcn_mfma_f32_32x32x16_bf16(pa1, (bf16x8){l1[0], l1[1], l1[2], l1[3], h1[0], h1[1], h1[2], h1[3]}, o[d0], 0, 0, 0);   \
        o[d0] = __builtin_amdgcn_mfma_f32_32x32x16_bf16(pa2, (bf16x8){l2[0], l2[1], l2[2], l2[3], h2[0], h2[1], h2[2], h2[3]}, o[d0], 0, 0, 0);   \
        o[d0] = __builtin_amdgcn_mfma_f32_32x32x16_bf16(pa3, (bf16x8){l3[0], l3[1], l3[2], l3[3], h3[0], h3[1], h3[2], h3[3]}, o[d0], 0, 0, 0); } while (0)
    PV_D0(0); PV_D0(1); PV_D0(2); PV_D0(3);
#undef PV_D0
#undef TRRD
}
__device__ __forceinline__ void pv_tile_h(f32x16* o, unsigned vb0, bf16x8 pa0, bf16x8 pa1, bf16x8 pa2, bf16x8 pa3) {
#define TRRD(dst, off) asm volatile("ds_read_b64_tr_b16 %0, %1 offset:%2" : "=&v"(dst) : "v"(vb0), "i"(off) : "memory")
#define PV_D0(d0) do { constexpr int b_ = v_rd_off(d0, 0, 0); \
        { s16x4 l0, l1, h0, h1; TRRD(l0, b_); TRRD(h0, b_ + 2048); TRRD(l1, b_ + 4096); TRRD(h1, b_ + 6144); \
          asm volatile("s_waitcnt lgkmcnt(0)" ::: "memory"); __builtin_amdgcn_sched_barrier(0); \
          o[d0] = __builtin_amdgcn_mfma_f32_32x32x16_bf16(pa0, (bf16x8){l0[0], l0[1], l0[2], l0[3], h0[0], h0[1], h0[2], h0[3]}, o[d0], 0, 0, 0);   \
          o[d0] = __builtin_amdgcn_mfma_f32_32x32x16_bf16(pa1, (bf16x8){l1[0], l1[1], l1[2], l1[3], h1[0], h1[1], h1[2], h1[3]}, o[d0], 0, 0, 0); } \
        { s16x4 l2, l3, h2, h3; TRRD(l2, b_ + 8192); TRRD(h2, b_ + 10240); TRRD(l3, b_ + 12288); TRRD(h3, b_ + 14336); \
          asm volatile("s_waitcnt lgkmcnt(0)" ::: "memory"); __builtin_amdgcn_sched_barrier(0); \
          o[d0] = __builtin_amdgcn_mfma_f32_32x32x16_bf16(pa2, (bf16x8){l2[0], l2[1], l2[2], l2[3], h2[0], h2[1], h2[2], h2[3]}, o[d0], 0, 0, 0);   \
          o[d0] = __builtin_amdgcn_mfma_f32_32x32x16_bf16(pa3, (bf16x8){l3[0], l3[1], l3[2], l3[3], h3[0], h3[1], h3[2], h3[3]}, o[d0], 0, 0, 0); } } while (0)
    PV_D0(0); PV_D0(1); PV_D0(2); PV_D0(3);
#undef PV_D0
#undef TRRD
}
__device__ __forceinline__ void pv_tile2(f32x16* oa, f32x16* ob_, unsigned vb0, const bf16x8* pa, const bf16x8* pb) {
#define TRRD(dst, off) asm volatile("ds_read_b64_tr_b16 %0, %1 offset:%2" : "=&v"(dst) : "v"(vb0), "i"(off) : "memory")
#define PV_D0(d0) do { s16x4 l0, l1, l2, l3, h0, h1, h2, h3; constexpr int b_ = v_rd_off(d0, 0, 0); \
        TRRD(l0, b_); TRRD(h0, b_ + 2048); TRRD(l1, b_ + 4096); TRRD(h1, b_ + 6144); TRRD(l2, b_ + 8192); TRRD(h2, b_ + 10240); TRRD(l3, b_ + 12288); TRRD(h3, b_ + 14336); \
        asm volatile("s_waitcnt lgkmcnt(0)" ::: "memory"); __builtin_amdgcn_sched_barrier(0); \
        const bf16x8 v0_ = (bf16x8){l0[0], l0[1], l0[2], l0[3], h0[0], h0[1], h0[2], h0[3]}, v1_ = (bf16x8){l1[0], l1[1], l1[2], l1[3], h1[0], h1[1], h1[2], h1[3]}; \
        const bf16x8 v2_ = (bf16x8){l2[0], l2[1], l2[2], l2[3], h2[0], h2[1], h2[2], h2[3]}, v3_ = (bf16x8){l3[0], l3[1], l3[2], l3[3], h3[0], h3[1], h3[2], h3[3]}; \
        oa[d0] = __builtin_amdgcn_mfma_f32_32x32x16_bf16(pa[0], v0_, oa[d0], 0, 0, 0); ob_[d0] = __builtin_amdgcn_mfma_f32_32x32x16_bf16(pb[0], v0_, ob_[d0], 0, 0, 0); \
        oa[d0] = __builtin_amdgcn_mfma_f32_32x32x16_bf16(pa[1], v1_, oa[d0], 0, 0, 0); ob_[d0] = __builtin_amdgcn_mfma_f32_32x32x16_bf16(pb[1], v1_, ob_[d0], 0, 0, 0); \
        oa[d0] = __builtin_amdgcn_mfma_f32_32x32x16_bf16(pa[2], v2_, oa[d0], 0, 0, 0); ob_[d0] = __builtin_amdgcn_mfma_f32_32x32x16_bf16(pb[2], v2_, ob_[d0], 0, 0, 0); \
        oa[d0] = __builtin_amdgcn_mfma_f32_32x32x16_bf16(pa[3], v3_, oa[d0], 0, 0, 0); ob_[d0] = __builtin_amdgcn_mfma_f32_32x32x16_bf16(pb[3], v3_, ob_[d0], 0, 0, 0); } while (0)
    PV_D0(0); PV_D0(1); PV_D0(2); PV_D0(3);
#undef PV_D0
#undef TRRD
}
__device__ __forceinline__ void partialSM(f32x16& p0, f32x16& p1, float& m_reg, float& alpha, float scale, float C2) {
    float pmax = p0[0];
#pragma unroll
    for (int r = 1; r < 16; ++r) pmax = fmaxf(pmax, p0[r]);
#pragma unroll
    for (int r = 0; r < 16; ++r) pmax = fmaxf(pmax, p1[r]);
    { auto rr = __builtin_amdgcn_permlane32_swap(__float_as_uint(pmax), __float_as_uint(pmax), false, false);
      pmax = fmaxf(__uint_as_float(rr[0]), __uint_as_float(rr[1])); }
    float mn;
    if (__all((pmax - m_reg) * scale <= 8.f)) { mn = m_reg; alpha = 1.f; }
    else { mn = fmaxf(m_reg, pmax); alpha = __builtin_amdgcn_exp2f((m_reg - mn) * C2); m_reg = mn; }
    const float mnL = -mn * C2;
#pragma unroll
    for (int r = 0; r < 16; ++r) { p0[r] = __builtin_amdgcn_exp2f(fmaf(p0[r], C2, mnL)); p1[r] = __builtin_amdgcn_exp2f(fmaf(p1[r], C2, mnL)); }
}
__device__ __forceinline__ float rowsum32(const f32x16& p0, const f32x16& p1) {
    float ps = 0.f;
#pragma unroll
    for (int r = 0; r < 16; ++r) ps += p0[r];
#pragma unroll
    for (int r = 0; r < 16; ++r) ps += p1[r];
    auto rr = __builtin_amdgcn_permlane32_swap(__float_as_uint(ps), __float_as_uint(ps), false, false);
    return __uint_as_float(rr[0]) + __uint_as_float(rr[1]);
}
__device__ __forceinline__ void packP(const f32x16& p0, const f32x16& p1, bf16x8& pa0, bf16x8& pa1, bf16x8& pa2, bf16x8& pa3) {
#define PK4(P, B_, OUT) do { unsigned a0 = cvtpk(P[B_+0], P[B_+1]), a1 = cvtpk(P[B_+2], P[B_+3]);                          \
        unsigned b0 = cvtpk(P[B_+4], P[B_+5]), b1 = cvtpk(P[B_+6], P[B_+7]);                                             \
        auto r0 = __builtin_amdgcn_permlane32_swap(a0, b0, false, false); auto r1 = __builtin_amdgcn_permlane32_swap(a1, b1, false, false); \
        u32x4 w = {r0[0], r1[0], r0[1], r1[1]}; OUT = *reinterpret_cast<bf16x8*>(&w); } while (0)
    PK4(p0, 0, pa0); PK4(p0, 8, pa1); PK4(p1, 0, pa2); PK4(p1, 8, pa3);
#undef PK4
}
__device__ __forceinline__ void rescaleO(f32x16* o, float alpha, LAS float* al_l, int r32, int hi) {
    if (__any(alpha < 1.f)) {
        if (hi == 0) al_l[r32] = alpha;
        asm volatile("s_waitcnt lgkmcnt(0)" ::: "memory");
#pragma unroll
        for (int q = 0; q < 4; ++q) { const f32x4 a = *(const LAS f32x4*)(al_l + 8 * q + 4 * hi);
#pragma unroll
            for (int d_ = 0; d_ < 4; ++d_)
#pragma unroll
                for (int i = 0; i < 4; ++i) o[d_][4 * q + i] *= a[i]; }
    }
}
__device__ __forceinline__ void row_scalars(float x, float* out16, LAS float* li_l, int r32, int hi) {
    if (hi == 0) li_l[r32] = x;
    asm volatile("s_waitcnt lgkmcnt(0)" ::: "memory");
#pragma unroll
    for (int r = 0; r < 16; ++r) out16[r] = li_l[crow(r, hi)];
    asm volatile("s_waitcnt lgkmcnt(0)" ::: "memory");
}
struct KVStage { bf16x8 k0, k1, v0, v1; };
template <int ND, bool WITH_V>
__device__ __forceinline__ void stage_load(KVStage& s, const bf16_t* Kg, const bf16_t* Vg, int tid) {
    if (ND == 8) { const int sr = tid >> 4, sc = (tid & 15) * 8;
        s.k0 = *(const bf16x8*)(Kg + (size_t)sr * 128 + sc); s.k1 = *(const bf16x8*)(Kg + (size_t)(32 + sr) * 128 + sc); }
    else { const int key = tid >> 3, c8 = (tid & 7) * 8; s.k0 = *(const bf16x8*)(Kg + (size_t)key * 64 + c8); }
    if (WITH_V) { const int sr = tid >> 4, sc = (tid & 15) * 8;
        s.v0 = *(const bf16x8*)(Vg + (size_t)sr * 128 + sc); s.v1 = *(const bf16x8*)(Vg + (size_t)(32 + sr) * 128 + sc); }
}
template <int ND, bool WITH_V>
__device__ __forceinline__ void stage_write(const KVStage& s, ldsp_t lds, int tid) {
    if (ND == 8) { const int sr = tid >> 4, sc = (tid & 15) * 8, kws = KSWZ(sr, sc * 2);
        *(LAS bf16x8*)(lds + AT_K + kws) = s.k0; *(LAS bf16x8*)(lds + AT_K + kws + 32 * 256) = s.k1; }
    else { const int key = tid >> 3, c8 = (tid & 7) * 8; *(LAS bf16x8*)(lds + AT_K + KSWZ(key, c8 * 2)) = s.k0; }
    if (WITH_V) { const int sr = tid >> 4, sc = (tid & 15) * 8;
        *(LAS bf16x8*)(lds + AT_V + v_st(sr, sc)) = s.v0; *(LAS bf16x8*)(lds + AT_V + v_st(32 + sr, sc)) = s.v1; }
}
__device__ __forceinline__ void stage_dma(ldsp_t buf, const bf16_t* Kg, const bf16_t* Vg, int wid_u, int lane) {
#pragma unroll
    for (int i = 0; i < 2; ++i) { const int q = (i * 8 + wid_u) * 64 + lane, row = q >> 4, cpos = q & 15;
        __builtin_amdgcn_global_load_lds((const unsigned*)(Kg + (size_t)row * 128 + ((cpos ^ (row & 7)) * 8)), (LAS unsigned*)(buf + AT_K + (i * 8 + wid_u) * 1024), 16, 0, 0); }
#pragma unroll
    for (int i = 0; i < 2; ++i) { const int q = (i * 8 + wid_u) * 64 + lane, sub = q >> 5, w5 = q & 31;
        const int kk = (sub >> 2) * 8 + (w5 >> 2), c = (sub & 3) * 32 + (w5 & 3) * 8, k = (kk & ~0xC) | ((kk & 4) << 1) | ((kk & 8) >> 1);
        __builtin_amdgcn_global_load_lds((const unsigned*)(Vg + (size_t)k * 128 + c), (LAS unsigned*)(buf + AT_V + (i * 8 + wid_u) * 1024), 16, 0, 0); }
}
enum { MK_CAUSAL = 0, MK_WINDOW = 1, MK_SLC = 2 };
template <int MK>
__device__ __forceinline__ int sweep_next(int j, int j_hi, unsigned un0, unsigned un1, unsigned un2, unsigned un3) {
    if (MK == MK_SLC) { while (j < j_hi) { const unsigned uw = (j < 32) ? un0 : (j < 64) ? un1 : (j < 96) ? un2 : un3; if ((uw >> (j & 31)) & 1u) break; ++j; } }
    return j;
}
template <int MK, int ND>
__device__ __forceinline__ void attn_sweep(ldsp_t lds, const bf16x8* qr, const bf16_t* Kg, const bf16_t* Vg, int j_lo, int j_hi, int pos,
                                           unsigned sel0, unsigned sel1, unsigned sel2, unsigned sel3, unsigned un0, unsigned un1, unsigned un2, unsigned un3,
                                           f32x16* o, float& m_reg, float& l_reg, float scale, int wspan) {
    const int tid = my_tid(), wid = tid >> 6, lane = tid & 63, r32 = lane & 31, hi = lane >> 5;
    const float C2 = scale * 1.4426950408889634f;
    LAS float* al_l = (LAS float*)(lds + AT_WS) + wid * 64;
    const unsigned vb0 = (unsigned)(size_t)(lds + AT_V) + v_rd_base(lane);
    const float NEG = -__builtin_inff();
    const int wpos0 = __builtin_amdgcn_readfirstlane(pos);
    static_assert(ND == 8, "LDS-DMA staging is written for 128-wide K rows");
    const int wid_u = __builtin_amdgcn_readfirstlane(wid);
    int j = sweep_next<MK>(j_lo, j_hi, un0, un1, un2, un3);
    if (j >= j_hi) { __syncthreads(); return; }
    int j1 = sweep_next<MK>(j + 1, j_hi, un0, un1, un2, un3);
    stage_dma(lds, Kg + (size_t)j * 64 * 128, Vg + (size_t)j * 64 * 128, wid_u, lane);
    if (j1 < j_hi) stage_dma(lds + AT_BUF, Kg + (size_t)j1 * 64 * 128, Vg + (size_t)j1 * 64 * 128, wid_u, lane);
    if (j1 < j_hi) asm volatile("s_waitcnt vmcnt(4)" ::: "memory"); else asm volatile("s_waitcnt vmcnt(0)" ::: "memory");
    __builtin_amdgcn_s_barrier(); asm volatile("" ::: "memory");
    int cur = 0;
    for (;;) {
        const int j2 = (j1 < j_hi) ? sweep_next<MK>(j1 + 1, j_hi, un0, un1, un2, un3) : j_hi;
        const int nb2 = cur >= 1 ? cur - 1 : 2;
        if (j2 < j_hi) stage_dma(lds + nb2 * AT_BUF, Kg + (size_t)j2 * 64 * 128, Vg + (size_t)j2 * 64 * 128, wid_u, lane);
        bool tsel = true;
        if (MK == MK_SLC) { const unsigned sw = (j < 32) ? sel0 : (j < 64) ? sel1 : (j < 96) ? sel2 : sel3; tsel = (sw >> (j & 31)) & 1u; }
        if (MK != MK_SLC || __any(tsel)) {
        f32x16 p0, p1; qkt<ND>(p0, p1, lds + cur * AT_BUF + AT_K, r32, hi, qr);
        bool need = (j * 64 + 63 > wpos0);
        if (MK == MK_WINDOW) need = need || (j * 64 <= wpos0 + wspan - 512);
        if (need) { const int kb = j * 64 + 4 * hi;
#pragma unroll
            for (int r = 0; r < 16; ++r) { const int k0 = kb + (r & 3) + 8 * (r >> 2), k1 = k0 + 32;
                bool ok0 = k0 <= pos, ok1 = k1 <= pos;
                if (MK == MK_WINDOW) { ok0 = ok0 && (k0 > pos - 512); ok1 = ok1 && (k1 > pos - 512); }
                if (!ok0) p0[r] = NEG; if (!ok1) p1[r] = NEG; } }
        if (MK == MK_SLC) { if (!__all(tsel)) {
#pragma unroll
            for (int r = 0; r < 16; ++r) { p0[r] = tsel ? p0[r] : NEG; p1[r] = tsel ? p1[r] : NEG; } } }
        float alpha; partialSM(p0, p1, m_reg, alpha, scale, C2);
        rescaleO(o, alpha, al_l, r32, hi);
        l_reg = l_reg * alpha + rowsum32(p0, p1);
        bf16x8 pa0, pa1, pa2, pa3; packP(p0, p1, pa0, pa1, pa2, pa3);
        pv_tile(o, vb0 + cur * AT_BUF, pa0, pa1, pa2, pa3);
        }
        if (j2 < j_hi) asm volatile("s_waitcnt vmcnt(4) lgkmcnt(0)" ::: "memory"); else asm volatile("s_waitcnt vmcnt(0) lgkmcnt(0)" ::: "memory");
        __builtin_amdgcn_s_barrier(); asm volatile("" ::: "memory");
        if (j1 >= j_hi) break;
        j = j1; j1 = j2; cur = cur == 2 ? 0 : cur + 1;
    }
}
constexpr int OT_LD = 136;
__device__ __forceinline__ LAS bf16_t* ot_tile(ldsp_t lds, int wid) { return (LAS bf16_t*)(lds + wid * (32 * OT_LD * 2)); }
__device__ __forceinline__ void ot_flush(LAS bf16_t* t, bf16_t* dst, size_t ld, int lane) {
    asm volatile("s_waitcnt lgkmcnt(0)" ::: "memory");
#pragma unroll
    for (int i = 0; i < 8; ++i) { const int row = 4 * i + (lane >> 4), c = (lane & 15) * 8;
        const u32x4 w = *(const LAS u32x4*)(t + row * OT_LD + c);
        *(u32x4*)(dst + (size_t)row * ld + c) = w; }
}
__device__ __forceinline__ void store_O_bf16(ldsp_t lds, int wid, const f32x16* o, const float* rs16, bf16_t* base  , size_t ld, int r32, int hi) {
    LAS bf16_t* t = ot_tile(lds, wid);
#pragma unroll
    for (int r = 0; r < 16; ++r) { const int orow = crow(r, hi);
#pragma unroll
        for (int d0 = 0; d0 < 4; ++d0) t[orow * OT_LD + d0 * 32 + r32] = f2bf(o[d0][r] * rs16[r]); }
    ot_flush(t, base, ld, hi * 32 + r32);
}
__device__ __forceinline__ void da_sweep(ldsp_t lds, const bf16_t* Q, const bf16_t* K, const bf16_t* V, int bh, int qb, f32x16* o0, f32x16* o1, float& l0, float& l1) {
    const float SCALE = 0.125f, C2 = SCALE * 1.4426950408889634f, NEG = -__builtin_inff();
    const int tid = my_tid(), wid = tid >> 6, lane = tid & 63, r32 = lane & 31, hi = lane >> 5;
    LAS float* al_l = (LAS float*)(lds + AT_WS) + wid * 64;
    const unsigned vb0 = (unsigned)(size_t)(lds + AT_V) + v_rd_base(lane);
    const bf16_t* Kg = K + (size_t)bh * SEQ * 128; const bf16_t* Vg = V + (size_t)bh * SEQ * 128;
    ldsp_t Qw = lds + q_park(wid);
    { const bf16_t* Qb = Q + ((size_t)bh * SEQ + qb * 256 + wid * 32 + r32) * 128;
#pragma unroll
      for (int d0 = 0; d0 < 8; ++d0) *(LAS bf16x8*)(Qw + KSWZ(r32, (d0 * 16 + hi * 8) * 2)) = *(const bf16x8*)(Qb + d0 * 16 + hi * 8); }
    float m0 = -1e30f, m1 = -1e30f;
    const int wpos0 = qb * 256 + wid * 32, pos = wpos0 + r32, j_hi = 4 * (qb + 1);
    const int wid_u = __builtin_amdgcn_readfirstlane(wid);
    __syncthreads();
    stage_dma(lds, Kg, Vg, wid_u, lane);
    __syncthreads();
    int cur = 0;
    for (int j = 0; j < j_hi; ++j) {
        const bool has = j + 1 < j_hi;
        if (has) stage_dma(lds + (cur ^ 1) * AT_BUF, Kg + (size_t)(j + 1) * 64 * 128, Vg + (size_t)(j + 1) * 64 * 128, wid_u, lane);
        const bool need = (j * 64 + 63 > wpos0);
        const int kb = j * 64 + 4 * hi;
        if (j * 64 <= wpos0 + 31) {
        { f32x16 p0, p1; qkt_range_lq<0, 4>(p0, p1, lds + cur * AT_BUF + AT_K, Qw, r32, hi);
          if (need) {
#pragma unroll
              for (int r = 0; r < 16; ++r) { const int k0 = kb + (r & 3) + 8 * (r >> 2); if (k0 > pos) p0[r] = NEG; if (k0 + 32 > pos) p1[r] = NEG; } }
          float a0; partialSM(p0, p1, m0, a0, SCALE, C2); l0 = l0 * a0 + rowsum32(p0, p1);
          bf16x8 pa0, pa1, pa2, pa3; packP(p0, p1, pa0, pa1, pa2, pa3);
          rescaleO(o0, a0, al_l, r32, hi); pv_tile_h(o0, vb0 + cur * AT_BUF, pa0, pa1, pa2, pa3); }
        { f32x16 p0, p1; qkt_range_lq<4, 8>(p0, p1, lds + cur * AT_BUF + AT_K, Qw, r32, hi);
          if (need) {
#pragma unroll
              for (int r = 0; r < 16; ++r) { const int k0 = kb + (r & 3) + 8 * (r >> 2); if (k0 > pos) p0[r] = NEG; if (k0 + 32 > pos) p1[r] = NEG; } }
          float a1; partialSM(p0, p1, m1, a1, SCALE, C2); l1 = l1 * a1 + rowsum32(p0, p1);
          bf16x8 pa0, pa1, pa2, pa3; packP(p0, p1, pa0, pa1, pa2, pa3);
          rescaleO(o1, a1, al_l, r32, hi); pv_tile_h(o1, vb0 + cur * AT_BUF, pa0, pa1, pa2, pa3); }
        }
        __syncthreads();
        cur ^= 1;
    }
}
__device__ __forceinline__ void da_epilogue(ldsp_t lds, const f32x16* o0, const f32x16* o1, float l0, float l1, const float* lam, const float* normg, bf16_t* ob, int b, int h, int qb) {
    const float LAM_INIT = 0.35550906759096934f;
    const int tid = my_tid(), wid = tid >> 6, lane = tid & 63, r32 = lane & 31, hi = lane >> 5;
    LAS float* li_l = (LAS float*)(lds + AT_WS) + wid * 64 + 32;
    const float s1 = wave_sum(lam[lane] * lam[64 + lane]), s2 = wave_sum(lam[128 + lane] * lam[192 + lane]);
    const float lmb = __expf(s1) - __expf(s2) + LAM_INIT;
    float i0[16], i1[16]; row_scalars(1.f / l0, i0, li_l, r32, hi); row_scalars(lmb / l1, i1, li_l, r32, hi);
    float ng[4];
#pragma unroll
    for (int d0 = 0; d0 < 4; ++d0) ng[d0] = normg[d0 * 32 + r32] * (1.f - LAM_INIT);
    bf16_t* Ob = ob + ((size_t)b * SEQ + qb * 256 + wid * 32) * DM + h * 128;
    LAS bf16_t* ot = ot_tile(lds, wid);
#pragma unroll
    for (int r = 0; r < 16; ++r) {
        float x[4], ss = 0.f;
#pragma unroll
        for (int d0 = 0; d0 < 4; ++d0) { x[d0] = o0[d0][r] * i0[r] - o1[d0][r] * i1[r]; ss += x[d0] * x[d0]; }
        ss += __shfl_xor(ss, 1); ss += __shfl_xor(ss, 2); ss += __shfl_xor(ss, 4); ss += __shfl_xor(ss, 8); ss += __shfl_xor(ss, 16);
        const float rs = rsqrtf(ss * (1.f / 128.f) + LN_EPS);
        const int orow = crow(r, hi);
#pragma unroll
        for (int d0 = 0; d0 < 4; ++d0) ot[orow * OT_LD + d0 * 32 + r32] = f2bf(x[d0] * rs * ng[d0]); }
    ot_flush(ot, Ob, DM, lane);
}
__device__ __forceinline__ void da_attn_phase(ldsp_t lds, const bf16_t* Q, const bf16_t* K, const bf16_t* V, const float* lam, const float* normg, bf16_t* ob, int wg, int nwg) {
    const int nround = (1024 + nwg - 1) / nwg;
    for (int n = 0; n < nround; ++n) {
        const int idx = n * nwg + ((n & 1) ? (nwg - 1 - wg) : wg);
        if (idx >= 1024) continue;
        const int qb = 31 - (idx >> 5), bh = idx & 31, b = bh >> 3, h = bh & 7;
        f32x16 o0[4] = {}, o1[4] = {}; float l0 = 0.f, l1 = 0.f;
        da_sweep(lds, Q, K, V, bh, qb, o0, o1, l0, l1);
        da_epilogue(lds, o0, o1, l0, l1, lam, normg, ob, b, h, qb);
        __syncthreads();
    }
}
__device__ __forceinline__ void sb_attn_phase(ldsp_t lds, const bf16_t* Q, const bf16_t* K, const bf16_t* V, bf16_t* ob, int wg, int nwg) {
    const int tid = my_tid(), wid = tid >> 6, lane = tid & 63, r32 = lane & 31, hi = lane >> 5;
    const float SCALE = 0.08838834764831845f;
    LAS int* flags = (LAS int*)(lds + LDS_MISC - 64);
    const unsigned vb0 = (unsigned)(size_t)(lds + AT_V) + v_rd_base(lane);
    for (int idx = wg; idx < 1024; idx += nwg) {
        const int qb = idx >> 5, bh = idx & 31, b = bh >> 3, h = bh & 7;
        const bf16_t* Qb = Q + ((size_t)bh * SEQ + qb * 256 + wid * 32 + r32) * 128;
        const bf16_t* Kb = K + (size_t)bh * SEQ * 128; const bf16_t* Vb = V + (size_t)bh * SEQ * 128;
        ldsp_t Qw = lds + q_park(wid);
#pragma unroll
        for (int d0 = 0; d0 < 8; ++d0) *(LAS bf16x8*)(Qw + KSWZ(r32, (d0 * 16 + hi * 8) * 2)) = *(const bf16x8*)(Qb + d0 * 16 + hi * 8);
        f32x16 o[4] = {}; float R = 0.f; bool done = false;
        const int wpos0 = qb * 256 + wid * 32, pos = wpos0 + r32;
        const int wid_u = __builtin_amdgcn_readfirstlane(wid);
        stage_dma(lds, Kb + (size_t)(4 * qb + 3) * 64 * 128, Vb + (size_t)(4 * qb + 3) * 64 * 128, wid_u, lane);
        int cur = 0;
        for (int j = 4 * qb + 3; j >= 0; --j) {
            if (lane == 0) flags[wid] = done ? 1 : 0;
            __syncthreads();
            int alld = 1;
#pragma unroll
            for (int k = 0; k < 8; ++k) alld &= flags[k];
            if (alld) break;
            if (j > 0) stage_dma(lds + (cur ^ 1) * AT_BUF, Kb + (size_t)(j - 1) * 64 * 128, Vb + (size_t)(j - 1) * 64 * 128, wid_u, lane);
            const unsigned vbc = vb0 + cur * AT_BUF; ldsp_t Kt = lds + cur * AT_BUF + AT_K;
            cur ^= 1;
            if (!done && 64 * j < wpos0 + 31) {
                f32x16 p0, p1; qkt_range_lq<0, 8>(p0, p1, Kt, Qw, r32, hi);
                float l0[16], l1[16];
                const int kb = j * 64 + 4 * hi;
#pragma unroll
                for (int r = 0; r < 16; ++r) { const int k0 = kb + (r & 3) + 8 * (r >> 2), k1 = k0 + 32;
                    const float z0 = p0[r] * SCALE, z1 = p1[r] * SCALE;
                    const float sp0 = fmaxf(z0, 0.f) + __logf(1.f + __expf(-fabsf(z0))), sp1 = fmaxf(z1, 0.f) + __logf(1.f + __expf(-fabsf(z1)));
                    l0[r] = (k0 < pos) ? -sp0 : 0.f; l1[r] = (k1 < pos) ? -sp1 : 0.f; p0[r] = z0; p1[r] = z1; }
                float gs0[4], gs1[4], pg0[4], pg1[4], A0[4], A1[4];
#pragma unroll
                for (int q = 0; q < 4; ++q) { gs0[q] = (l0[4 * q] + l0[4 * q + 1]) + (l0[4 * q + 2] + l0[4 * q + 3]); gs1[q] = (l1[4 * q] + l1[4 * q + 1]) + (l1[4 * q + 2] + l1[4 * q + 3]); }
#pragma unroll
                for (int q = 0; q < 4; ++q) { pg0[q] = __shfl_xor(gs0[q], 32); pg1[q] = __shfl_xor(gs1[q], 32); }
                const float t00 = gs0[0] + pg0[0], t01 = gs0[1] + pg0[1], t02 = gs0[2] + pg0[2], t03 = gs0[3] + pg0[3];
                const float t10 = gs1[0] + pg1[0], t11 = gs1[1] + pg1[1], t12 = gs1[2] + pg1[2], t13 = gs1[3] + pg1[3];
                const float T1 = (t10 + t11) + (t12 + t13), T0 = (t00 + t01) + (t02 + t03);
                A0[3] = T1; A0[2] = A0[3] + t03; A0[1] = A0[2] + t02; A0[0] = A0[1] + t01;
                A1[3] = 0.f; A1[2] = t13; A1[1] = A1[2] + t12; A1[0] = A1[1] + t11;
                if (hi == 0) {
#pragma unroll
                    for (int q = 0; q < 4; ++q) { A0[q] += pg0[q]; A1[q] += pg1[q]; } }
#pragma unroll
                for (int q = 0; q < 4; ++q) {
                    float af0 = A0[q] + R, af1 = A1[q] + R;
#pragma unroll
                    for (int i = 3; i >= 0; --i) { const int r = 4 * q + i; const int k0 = kb + i + 8 * q, k1 = k0 + 32;
                        const float a0 = (k0 < pos) ? __expf(p0[r] + l0[r] + af0) : 0.f, a1 = (k1 < pos) ? __expf(p1[r] + l1[r] + af1) : 0.f;
                        af0 += l0[r]; af1 += l1[r]; p0[r] = a0; p1[r] = a1; } }
                R += T0 + T1;
                bf16x8 pa0, pa1, pa2, pa3; packP(p0, p1, pa0, pa1, pa2, pa3);
                pv_tile(o, vbc, pa0, pa1, pa2, pa3);
                done = __all(R < -104.f);
            }
        }
        __syncthreads();
        float one[16];
#pragma unroll
        for (int r = 0; r < 16; ++r) one[r] = 1.f;
        store_O_bf16(lds, wid, o, one, ob + ((size_t)b * SEQ + qb * 256 + wid * 32) * DM + h * 128, DM, r32, hi);
        __syncthreads();
    }
}

__device__ __forceinline__ float gelu_tanh(float x) { const float u = 0.7978845608028654f * (x + 0.044715f * x * x * x); const float e = __expf(2.f * u); const float th = 1.f - 2.f / (e + 1.f); return 0.5f * x * (1.f + th); }
__device__ __forceinline__ void nsa_compress_phase(ldsp_t lds, const bf16_t* kv, const bf16_t* W1t, const bf16_t* W2t, const float* biasp, bf16_t* KC, int wg, int nwg) {
    const int tid = my_tid(), wid = tid >> 6, lane = tid & 63, c16 = lane & 15, g = lane >> 4;
    const int rg = wid & 1, ch = wid >> 1;
    ldsp_t H1 = lds;
    LAS float* biasL = (LAS float*)(lds + 32 * HG_P272);
    if (tid < 256) { float sacc = 0.f; for (int p = 0; p < 32; ++p) sacc += biasp[((tid >> 7) * 32 + p) * 128 + (tid & 127)]; biasL[tid] = sacc; }
    __syncthreads();
    for (int it = wg; it < 256; it += nwg) {
        const int jj = it >> 7, bg = (it >> 4) & 7, ct = it & 15;
        const bf16_t* X = kv + ((size_t)(jj * 8 + bg) * SEQ) * 128;
        const bf16_t* W1 = W1t + (size_t)jj * 128 * 4096; const bf16_t* W2 = W2t + (size_t)jj * 128 * 128;
        int crow_ = ct * 32 + rg * 16 + c16; if (crow_ > 510) crow_ = 510;
        const bf16_t* Ar = X + (size_t)crow_ * 16 * 128 + 8 * g;
        const bf16_t* Br = W1 + (size_t)(32 * ch + c16) * 4096 + 8 * g;
        f32x4 acc[2];
#pragma unroll
        for (int nt = 0; nt < 2; ++nt) acc[nt] = (f32x4){0.f, 0.f, 0.f, 0.f};
        for (int ks = 0; ks < 128; ks += 4) {
            bf16x8 A[4], B[4][2];
#pragma unroll
            for (int u = 0; u < 4; ++u) { A[u] = *(const bf16x8*)(Ar + (ks + u) * 32);
#pragma unroll
                for (int nt = 0; nt < 2; ++nt) B[u][nt] = *(const bf16x8*)(Br + (size_t)(16 * nt) * 4096 + (ks + u) * 32); }
#pragma unroll
            for (int u = 0; u < 4; ++u)
#pragma unroll
                for (int nt = 0; nt < 2; ++nt) acc[nt] = __builtin_amdgcn_mfma_f32_16x16x32_bf16(A[u], B[u][nt], acc[nt], 0, 0, 0); }
#pragma unroll
        for (int nt = 0; nt < 2; ++nt) { const int n = 32 * ch + 16 * nt + c16; const float bs = biasL[jj * 128 + n];
#pragma unroll
            for (int r = 0; r < 4; ++r) *(LAS bf16_t*)(H1 + (16 * rg + 4 * g + r) * HG_P272 + n * 2) = f2bf(gelu_tanh(acc[nt][r] + bs)); }
        __syncthreads();
        f32x4 ac2[2];
#pragma unroll
        for (int nt = 0; nt < 2; ++nt) { ac2[nt] = (f32x4){0.f, 0.f, 0.f, 0.f};
#pragma unroll
            for (int ks = 0; ks < 4; ++ks) { const bf16x8 A = *(const LAS bf16x8*)(H1 + (16 * rg + c16) * HG_P272 + (32 * ks + 8 * g) * 2);
                const bf16x8 B = *(const bf16x8*)(W2 + (size_t)(32 * ch + 16 * nt + c16) * 128 + 32 * ks + 8 * g);
                ac2[nt] = __builtin_amdgcn_mfma_f32_16x16x32_bf16(A, B, ac2[nt], 0, 0, 0); } }
#pragma unroll
        for (int nt = 0; nt < 2; ++nt)
#pragma unroll
            for (int r = 0; r < 4; ++r) { const int c = ct * 32 + rg * 16 + 4 * g + r; const int n = 32 * ch + 16 * nt + c16;
                KC[((size_t)(jj * 8 + bg) * NCMP_P + c) * 128 + n] = (c <= 510) ? f2bf(ac2[nt][r]) : (bf16_t)0; }
        __syncthreads();
    }
}
constexpr int NS_IMPP = AT_END, NS_IMPS = NS_IMPP + 4096, NS_IMP = NS_IMPS + 4096, NS_CARRY = NS_IMP + 33792, NS_SEL = NS_CARRY + 512, NS_UN = NS_SEL + 1024, NS_END = NS_UN + 16;
static_assert(NS_END <= LDS_MISC, "NSA LDS");
__device__ __forceinline__ void nsa_cmp_sweep1(ldsp_t lds, const bf16x8* qr, const bf16_t* kcb, const bf16_t* vcb, int ntile, int pos, float& m_reg, float& l_reg) {
    const int tid = my_tid(), wid_u = __builtin_amdgcn_readfirstlane(tid >> 6), lane = tid & 63, r32 = lane & 31, hi = lane >> 5;
    const float SCALE = 0.08838834764831845f, C2 = SCALE * 1.4426950408889634f, NEG = -__builtin_inff();
    stage_dma(lds, kcb, vcb, wid_u, lane);
    int cur = 0;
    for (int jt = 0; jt < ntile; ++jt) {
        __syncthreads();
        if (jt + 1 < ntile) stage_dma(lds + (cur ^ 1) * AT_BUF, kcb + (size_t)(jt + 1) * 64 * 128, vcb + (size_t)(jt + 1) * 64 * 128, wid_u, lane);
        f32x16 p0, p1; qkt<8>(p0, p1, lds + cur * AT_BUF + AT_K, r32, hi, qr);
        const int kb = jt * 64 + 4 * hi;
#pragma unroll
        for (int r = 0; r < 16; ++r) { const int c0 = kb + (r & 3) + 8 * (r >> 2), c1 = c0 + 32;
            if (!(c0 < NCMP && 16 * c0 + 31 <= pos)) p0[r] = NEG; if (!(c1 < NCMP && 16 * c1 + 31 <= pos)) p1[r] = NEG; }
        float alpha; partialSM(p0, p1, m_reg, alpha, SCALE, C2);
        l_reg = l_reg * alpha + rowsum32(p0, p1);
        cur ^= 1;
    }
    __syncthreads();
}
__device__ __forceinline__ void nsa_cmp_sweep2(ldsp_t lds, const bf16x8* qr, const bf16_t* kcb, const bf16_t* vcb, int ntile, int pos, int tokl, float m_reg, float l_reg, f32x16* o) {
    const int tid = my_tid(), lane = tid & 63, r32 = lane & 31, hi = lane >> 5;
    const float SCALE = 0.08838834764831845f, C2 = SCALE * 1.4426950408889634f;
    LAS float* impP = (LAS float*)(lds + NS_IMPP); LAS float* impS = (LAS float*)(lds + NS_IMPS);
    LAS float* imp = (LAS float*)(lds + NS_IMP); LAS float* carry = (LAS float*)(lds + NS_CARRY);
    const unsigned vb0 = (unsigned)(size_t)(lds + AT_V) + v_rd_base(lane);
    const float inv_l = l_reg > 0.f ? 1.f / l_reg : 0.f;
    const float mL = -m_reg * C2;
    const int wid_u = __builtin_amdgcn_readfirstlane(tid >> 6);
    stage_dma(lds, kcb, vcb, wid_u, lane);
    int cur = 0;
    for (int jt = 0; jt < ntile; ++jt) {
        __syncthreads();
        if (jt + 1 < ntile) stage_dma(lds + (cur ^ 1) * AT_BUF, kcb + (size_t)(jt + 1) * 64 * 128, vcb + (size_t)(jt + 1) * 64 * 128, wid_u, lane);
        f32x16 p0, p1; qkt<8>(p0, p1, lds + cur * AT_BUF + AT_K, r32, hi, qr);
        const int kb = jt * 64 + 4 * hi;
#pragma unroll
        for (int r = 0; r < 16; ++r) { const int c0 = kb + (r & 3) + 8 * (r >> 2), c1 = c0 + 32;
            const bool ok0 = (c0 < NCMP && 16 * c0 + 31 <= pos), ok1 = (c1 < NCMP && 16 * c1 + 31 <= pos);
            p0[r] = ok0 ? __builtin_amdgcn_exp2f(fmaf(p0[r], C2, mL)) * inv_l : 0.f; p1[r] = ok1 ? __builtin_amdgcn_exp2f(fmaf(p1[r], C2, mL)) * inv_l : 0.f; }
#pragma unroll
        for (int q = 0; q < 4; ++q) {
            float sp0 = 0.5f * p0[4 * q + 3], sp1 = 0.5f * p1[4 * q + 3];
            float mn0 = (p0[4 * q] + p0[4 * q + 1]) + (p0[4 * q + 2] + sp0), mn1 = (p1[4 * q] + p1[4 * q + 1]) + (p1[4 * q + 2] + sp1);
            mn0 += __shfl_xor(mn0, 1); mn0 += __shfl_xor(mn0, 2); mn1 += __shfl_xor(mn1, 1); mn1 += __shfl_xor(mn1, 2);
            sp0 += __shfl_xor(sp0, 1); sp0 += __shfl_xor(sp0, 2); sp1 += __shfl_xor(sp1, 1); sp1 += __shfl_xor(sp1, 2);
            if ((r32 & 3) == 0) { const int i0 = tokl * 16 + 2 * q + hi; impP[i0] = mn0; impS[i0] = sp0; impP[i0 + 8] = mn1; impS[i0 + 8] = sp1; } }
        bf16x8 pa0, pa1, pa2, pa3; packP(p0, p1, pa0, pa1, pa2, pa3);
        pv_tile(o, vb0 + cur * AT_BUF, pa0, pa1, pa2, pa3);
        cur ^= 1;
        __syncthreads();
        { const int tk = tid >> 3, part = tid & 7;
#pragma unroll
          for (int e = 0; e < 2; ++e) { const int nb = 2 * part + e; float mm = impP[tk * 16 + nb];
              if (nb > 0) mm += impS[tk * 16 + nb - 1];
              if (nb == 0 && jt > 0) mm += carry[((jt - 1) & 1) * 64 + tk];
              imp[tk * 132 + 16 * jt + nb] = mm; }
          if (part == 7) carry[(jt & 1) * 64 + tk] = impS[tk * 16 + 15]; }
    }
    __syncthreads();
}
template <int CTRL> __device__ __forceinline__ int dpp_i(int v) { return __builtin_amdgcn_update_dpp(v, v, CTRL, 0xf, 0xf, false); }
template <int CTRL> __device__ __forceinline__ float dpp_f(float v) { return __int_as_float(__builtin_amdgcn_update_dpp(__float_as_int(v), __float_as_int(v), CTRL, 0xf, 0xf, false)); }
__device__ __forceinline__ void nsa_topk(ldsp_t lds, int cur) {
    const int tid = my_tid(), tk = tid >> 3, part = tid & 7;
    const float NEG = -__builtin_inff();
    LAS float* imp = (LAS float*)(lds + NS_IMP);
    LAS unsigned* selm = (LAS unsigned*)(lds + NS_SEL); LAS unsigned* unm = (LAS unsigned*)(lds + NS_UN);
    float vals[16]; unsigned mym = 0u;
#pragma unroll
    for (int q = 0; q < 4; ++q) { const f32x4 t = *(const LAS f32x4*)(imp + tk * 132 + part * 16 + 4 * q);
#pragma unroll
        for (int e = 0; e < 4; ++e) vals[4 * q + e] = t[e]; }
#pragma unroll
    for (int k = 0; k < 16; ++k) { const int nn = part * 16 + k; const bool forced = (nn == 0 || nn == cur || nn == cur - 1);
        mym |= forced ? (1u << k) : 0u; vals[k] = (nn > cur || forced) ? NEG : vals[k]; }
    const int nforced = cur >= 2 ? 3 : cur + 1;
    for (int rnd = nforced; rnd < 16; ++rnd) {
        float best = vals[0]; int bi = 0;
#pragma unroll
        for (int k = 1; k < 16; ++k) if (vals[k] > best) { best = vals[k]; bi = k; }
        int gi = part * 16 + bi;
        { const float ov = dpp_f<0xB1>(best); const int oi = dpp_i<0xB1>(gi); const bool t = (ov > best) || (ov == best && oi < gi); best = t ? ov : best; gi = t ? oi : gi; }
        { const float ov = dpp_f<0x4E>(best); const int oi = dpp_i<0x4E>(gi); const bool t = (ov > best) || (ov == best && oi < gi); best = t ? ov : best; gi = t ? oi : gi; }
        { const float ov = dpp_f<0x141>(best); const int oi = dpp_i<0x141>(gi); const bool t = (ov > best) || (ov == best && oi < gi); best = t ? ov : best; gi = t ? oi : gi; }
        const bool win = (best > -5e29f) && ((gi >> 4) == part);
        const int kk = win ? (gi & 15) : 16;
        mym |= win ? (1u << (gi & 15)) : 0u;
#pragma unroll
        for (int k = 0; k < 16; ++k) vals[k] = (k == kk) ? NEG : vals[k];
    }
    unsigned mw = mym << (16 * (part & 1));
    mw |= (unsigned)dpp_i<0xB1>((int)mw);
    if ((part & 1) == 0) { selm[tk * 4 + (part >> 1)] = mw; atomicOr((unsigned*)(unm + (part >> 1)), mw); }
}
__device__ __forceinline__ void nsa_load_q(bf16x8* qr, const bf16_t* Q, int b, int g, int s0) {
    const int tid = my_tid(), wid = tid >> 6, lane = tid & 63, r32 = lane & 31, hi = lane >> 5, hh = r32 & 3, tokl = 8 * wid + (r32 >> 2);
    const bf16_t* p = Q + (((size_t)b * 8 + g * 4 + hh) * SEQ + s0 + tokl) * 128 + hi * 8;
#pragma unroll
    for (int d0 = 0; d0 < 8; ++d0) qr[d0] = *(const bf16x8*)(p + d0 * 16);
}
template <int MODE>
__device__ __forceinline__ void nsa_branch_out(ldsp_t lds, f32x16* o, float l_reg, bool normalise, int which, const float* gates, float* OACC, bf16_t* ob, int b, int g, int s0) {
    const int tid = my_tid(), wid = tid >> 6, lane = tid & 63, r32 = lane & 31, hi = lane >> 5, hh = r32 & 3, tokl = 8 * wid + (r32 >> 2);
    LAS float* li_l = (LAS float*)(lds + AT_WS) + wid * 64 + 32;
    const float gt = gates[((size_t)b * SEQ + s0 + tokl) * 24 + (g * 4 + hh) * 3 + which];
    float gsc[16]; row_scalars(normalise ? gt * (l_reg > 0.f ? 1.f / l_reg : 0.f) : gt, gsc, li_l, r32, hi);
    f32x4* op = (f32x4*)(OACC + ((size_t)b * SEQ + s0) * DM + (size_t)g * (64 * 512)) + tid;
    LAS bf16_t* ot = ot_tile(lds, wid);
    const size_t base = ((size_t)b * SEQ + s0 + 8 * wid) * DM + (size_t)g * 512;
#pragma unroll
    for (int d0 = 0; d0 < 4; ++d0)
#pragma unroll
        for (int k = 0; k < 4; ++k) {
            f32x4 v = {o[d0][4 * k] * gsc[4 * k], o[d0][4 * k + 1] * gsc[4 * k + 1], o[d0][4 * k + 2] * gsc[4 * k + 2], o[d0][4 * k + 3] * gsc[4 * k + 3]};
            if (MODE == 0) op[(d0 * 4 + k) * 512] = v;
            else if (MODE == 1) op[(d0 * 4 + k) * 512] += v;
            else { v += op[(d0 * 4 + k) * 512];
#pragma unroll
                for (int e = 0; e < 4; ++e) { const int r = 4 * k + e; ot[crow(r, hi) * OT_LD + d0 * 32 + r32] = f2bf(v[e]); } } }
    if (MODE == 2) {
        asm volatile("s_waitcnt lgkmcnt(0)" ::: "memory");
#pragma unroll
        for (int i = 0; i < 8; ++i) { const int qi = 4 * i + (lane >> 4), c = (lane & 15) * 8;
            const u32x4 w = *(const LAS u32x4*)(ot + qi * OT_LD + c);
            *(u32x4*)(ob + base + (size_t)(qi >> 2) * DM + (qi & 3) * 128 + c) = w; } }
}
__device__ __forceinline__ void nsa_attn_phase(ldsp_t lds, const bf16_t* Qp, const bf16_t* Qr, const bf16_t* kv, const bf16_t* KC, const float* gates, float* OACC, bf16_t* ob, int wg, int nwg) {
    const float SCALE = 0.08838834764831845f;
    LAS float* imp = (LAS float*)(lds + NS_IMP);
    LAS unsigned* selm = (LAS unsigned*)(lds + NS_SEL); LAS unsigned* unm = (LAS unsigned*)(lds + NS_UN);
    const int nround = (1024 + nwg - 1) / nwg;
    for (int n = 0; n < nround; ++n) {
        const int idx = n * nwg + ((n & 1) ? (nwg - 1 - wg) : wg);
        if (idx >= 1024) continue;
        const int blk = 127 - (idx >> 3), bg = idx & 7, b = bg >> 1, g = bg & 1;
        const int s0 = blk * 64;
        const int tid = my_tid(), wid = tid >> 6, lane = tid & 63, tokl = 8 * wid + ((lane & 31) >> 2), pos = s0 + tokl;
        const bf16_t* kcb = KC + (size_t)bg * NCMP_P * 128; const bf16_t* vcb = KC + (size_t)(8 + bg) * NCMP_P * 128;
        for (int i = tid; i < 64 * 132; i += 512) imp[i] = 0.f;
        if (tid < 4) unm[tid] = 0u;
        bf16x8 qr[8];
        nsa_load_q(qr, Qp, b, g, s0);
        int nvalid = 4 * blk + 3; if (nvalid > NCMP) nvalid = NCMP;
        const int ntile = (nvalid + 63) >> 6;
        float m_reg = -1e30f, l_reg = 0.f;
        nsa_cmp_sweep1(lds, qr, kcb, vcb, ntile, pos, m_reg, l_reg);
        f32x16 o[4] = {};
        nsa_cmp_sweep2(lds, qr, kcb, vcb, ntile, pos, tokl, m_reg, l_reg, o);
        nsa_topk(lds, blk);
        nsa_branch_out<0>(lds, o, 1.f, false, 0, gates, OACC, ob, b, g, s0);
        __syncthreads();
        nsa_load_q(qr, Qr, b, g, s0);
        {
            const unsigned sel0 = selm[tokl * 4 + 0], sel1 = selm[tokl * 4 + 1], sel2 = selm[tokl * 4 + 2], sel3 = selm[tokl * 4 + 3];
            const unsigned un0 = unm[0], un1 = unm[1], un2 = unm[2], un3 = unm[3];
#pragma unroll
            for (int d0 = 0; d0 < 4; ++d0) o[d0] = f32x16{};
            m_reg = -1e30f; l_reg = 0.f;
            attn_sweep<MK_SLC, 8>(lds, qr, kv + (size_t)(2 * 8 + bg) * SEQ * 128, kv + (size_t)(3 * 8 + bg) * SEQ * 128, 0, blk + 1, pos, sel0, sel1, sel2, sel3, un0, un1, un2, un3, o, m_reg, l_reg, SCALE, 7);
            nsa_branch_out<1>(lds, o, l_reg, true, 1, gates, OACC, ob, b, g, s0);
        }
        {
#pragma unroll
            for (int d0 = 0; d0 < 4; ++d0) o[d0] = f32x16{};
            m_reg = -1e30f; l_reg = 0.f;
            attn_sweep<MK_WINDOW, 8>(lds, qr, kv + (size_t)(4 * 8 + bg) * SEQ * 128, kv + (size_t)(5 * 8 + bg) * SEQ * 128, blk > 8 ? blk - 8 : 0, blk + 1, pos, 0, 0, 0, 0, 0, 0, 0, 0, o, m_reg, l_reg, SCALE, 7);
            nsa_branch_out<2>(lds, o, l_reg, true, 2, gates, OACC, ob, b, g, s0);
        }
        __syncthreads();
    }
}

struct Args { const float* in[25]; float* out; unsigned char* ws; int ph_lo, ph_hi; };
enum { I_X = 0, I_HG_WIN, I_HG_LB, I_HG_NG, I_HG_WOUT, I_DA_WIN, I_DA_LAM, I_DA_NG, I_DA_WOUT, I_NSA_WIN, I_NSA_PE, I_NSA_W1, I_NSA_W2, I_NSA_WOUT,
       I_SB_WIN, I_SB_WOUT, I_FFN_WG, I_FFN_WU, I_FFN_WD, I_MOE_WR, I_MOE_WG, I_MOE_WU, I_MOE_WD, I_LN_G, I_LN_B };
__device__ __forceinline__ void rope_table(f32x2* tab, int half, double ratio, int wg, int nwg) {
    for (int i = wg * 512 + my_tid(); i < SEQ * half; i += nwg * 512) {
        const int s = i / half, j = i % half;
        double inv = 1.0; for (int k = 0; k < j; ++k) inv *= ratio;
        const float ang = (float)s * (float)inv;
        const double rev = (double)ang * 0.15915494309189535; const float fr = (float)(rev - floor(rev));
        tab[i] = (f32x2){__builtin_amdgcn_cosf(fr), __builtin_amdgcn_sinf(fr)};
    }
}
__device__ __forceinline__ void prologue_phase(ldsp_t lds, const Args& a, int wg, int nwg) {
    unsigned char* ws = a.ws; const int tid = my_tid();
    { const float* x = a.in[I_X]; bf16_t* hb = (bf16_t*)(ws + WS_HB);
      for (size_t i = ((size_t)wg * 512 + tid) * 8; i < (size_t)NT * DM; i += (size_t)nwg * 512 * 8)
          *(bf16x8*)(hb + i) = pack8(*(const f32x4*)(x + i), *(const f32x4*)(x + i + 4)); }
    if (wg == 0) { float* lbv = (float*)(ws + WS_LBV); const float* L = a.in[I_HG_LB];
        for (int d = tid; d < DM; d += 512) { float mx = L[d];
            for (int r = 1; r < 5; ++r) mx = fmaxf(mx, L[r * DM + d]);
            float s = 0.f; for (int r = 0; r < 5; ++r) s += __expf(L[r * DM + d] - mx);
            lbv[d] = __expf(L[d] - mx) / s; } }
    for (int u = wg; u < 64; u += nwg) { const int jj = u >> 5, p = u & 31; LAS float* red = (LAS float*)lds;
        const float* pe = a.in[I_NSA_PE] + (size_t)jj * 4096 + p * 128; const float* w1 = a.in[I_NSA_W1] + ((size_t)jj * 4096 + p * 128) * 128;
        const int nn = tid & 127, sub = tid >> 7; float sacc = 0.f;
#pragma unroll 8
        for (int k = sub * 32; k < sub * 32 + 32; ++k) sacc += pe[k] * w1[(size_t)k * 128 + nn];
        red[sub * 128 + nn] = sacc; __syncthreads();
        if (tid < 128) ((float*)(ws + WS_CMPBIAS))[(jj * 32 + p) * 128 + tid] = (red[tid] + red[128 + tid]) + (red[256 + tid] + red[384 + tid]);
        __syncthreads(); }
    rope_table((f32x2*)(ws + WS_ROPE_DA), 32, 0.7498942093324559, wg, nwg);
    rope_table((f32x2*)(ws + WS_ROPE_NSA), 64, 0.8659643233600653, wg, nwg);
    __syncthreads();
    convert_T(lds, (bf16_t*)(ws + WS_W_HGIN), 1, 0, 4096, 1024, MapId{a.in[I_HG_WIN], 4096, 4096}, wg, nwg);
    convert_T(lds, (bf16_t*)(ws + WS_W_HGOUT), 1, 0, 1024, 1024, MapId{a.in[I_HG_WOUT], 1024, 1024}, wg, nwg);
    convert_T(lds, (bf16_t*)(ws + WS_W_DAIN), 1, 0, 3072, 1024, MapRope64{a.in[I_DA_WIN], 3072}, wg, nwg);
    convert_T(lds, (bf16_t*)(ws + WS_W_DAOUT), 1, 0, 1024, 1024, MapId{a.in[I_DA_WOUT], 1024, 1024}, wg, nwg);
    convert_T(lds, (bf16_t*)(ws + WS_W_NSAIN), 1, 0, NSA_NPAD, 1024, MapNsa{a.in[I_NSA_WIN], 2584}, wg, nwg);
    convert_T(lds, (bf16_t*)(ws + WS_W_NSAOUT), 1, 0, 1024, 1024, MapId{a.in[I_NSA_WOUT], 1024, 1024}, wg, nwg);
    convert_T(lds, (bf16_t*)(ws + WS_W_SBIN), 1, 0, 3072, 1024, MapId{a.in[I_SB_WIN], 3072, 3072}, wg, nwg);
    convert_T(lds, (bf16_t*)(ws + WS_W_SBOUT), 1, 0, 1024, 1024, MapId{a.in[I_SB_WOUT], 1024, 1024}, wg, nwg);
    for (int j = 0; j < 2; ++j) {
        convert_T(lds, (bf16_t*)(ws + WS_W_FFNGU) + (size_t)j * 5632 * 1024, 1, 0, 5632, 1024, MapGU{a.in[I_FFN_WG] + (size_t)j * 1024 * DFF, a.in[I_FFN_WU] + (size_t)j * 1024 * DFF, DFF}, wg, nwg);
        convert_T(lds, (bf16_t*)(ws + WS_W_FFND) + (size_t)j * 1024 * DFF, 1, 0, 1024, DFF, MapId{a.in[I_FFN_WD] + (size_t)j * DFF * 1024, 1024, 1024}, wg, nwg);
        convert_T(lds, (bf16_t*)(ws + WS_W_CMP1) + (size_t)j * 128 * 4096, 1, 0, 128, 4096, MapId{a.in[I_NSA_W1] + (size_t)j * 4096 * 128, 128, 128}, wg, nwg);
        convert_T(lds, (bf16_t*)(ws + WS_W_CMP2) + (size_t)j * 128 * 128, 1, 0, 128, 128, MapId{a.in[I_NSA_W2] + (size_t)j * 128 * 128, 128, 128}, wg, nwg);
    }
}
__device__ __forceinline__ void moe_down_sub(ldsp_t lds, const bf16_t* A, const bf16_t* Bt, const pg8::Unit u, int rq, int cq, bf16_t* y) {
    using namespace pg8;
    constexpr int K = DFFE, nt = K / BK, STG = 16384, NST = 8;
    const int tid = my_tid(), wid = __builtin_amdgcn_readfirstlane(tid >> 6), lane = tid & 63, wm = wid >> 1, wc2 = wid & 1, fr = lane & 15, fq = lane >> 4;
    unsigned voffA, voffB;
    { int R, C; stage_rc(tid * 16, R, C); voffA = (unsigned)(R * K + C) * 2u; const int Rb = (R & ~31) + perm32(R & 31); voffB = (unsigned)(Rb * K + C) * 2u; }
    const char* cA = (const char*)A + ((size_t)u.pm * 256 + (size_t)rq * 64) * K * 2;
    const char* cB = (const char*)Bt + ((size_t)u.pn * 256 + (size_t)cq * 64) * K * 2;
    const unsigned ldsw = (unsigned)wid * 1024u;
    const int aoff = lds_byte(wm * 16 + fr, fq * 8), boff = 8192 + lds_byte(wc2 * 32 + fr, fq * 8);
#define MS_STAGE(s, t) do { const size_t ko_ = (size_t)(t) * (BK * 2); \
        __builtin_amdgcn_global_load_lds((const unsigned*)(cA + ko_ + voffA), (LAS unsigned*)(lds + (s) * STG + ldsw), 16, 0, 0); \
        __builtin_amdgcn_global_load_lds((const unsigned*)(cB + ko_ + voffB), (LAS unsigned*)(lds + (s) * STG + 8192 + ldsw), 16, 0, 0); } while (0)
    f32x4 acc[2] = {(f32x4){0.f, 0.f, 0.f, 0.f}, (f32x4){0.f, 0.f, 0.f, 0.f}};
#pragma unroll
    for (int t = 0; t < NST - 1; ++t) MS_STAGE(t, t);
    for (int t = 0; t < nt; ++t) {
        asm volatile("s_waitcnt vmcnt(12)" ::: "memory");
        __builtin_amdgcn_s_barrier();
        asm volatile("" ::: "memory");
        { const int tn = (t + NST - 1 < nt) ? t + NST - 1 : nt - 1;
          MS_STAGE((t + NST - 1) & (NST - 1), tn); }
        const int s = t & (NST - 1);
        bf16x8 At[2], Bf[2][2];
#pragma unroll
        for (int k = 0; k < 2; ++k) At[k] = *(const LAS bf16x8*)(lds + s * STG + aoff + k * 1024);
#pragma unroll
        for (int n = 0; n < 2; ++n)
#pragma unroll
            for (int k = 0; k < 2; ++k) Bf[n][k] = *(const LAS bf16x8*)(lds + s * STG + boff + n * 2048 + k * 1024);
#pragma unroll
        for (int n = 0; n < 2; ++n)
#pragma unroll
            for (int k = 0; k < 2; ++k) acc[n] = __builtin_amdgcn_mfma_f32_16x16x32_bf16(Bf[n][k], At[k], acc[n], 0, 0, 0);
        asm volatile("" ::: "memory");
    }
#undef MS_STAGE
    asm volatile("s_waitcnt vmcnt(0)" ::: "memory");
    { const int row = u.pm * 256 + rq * 64 + wm * 16 + fr, colL = (u.pn & 3) * 256 + cq * 64 + wc2 * 32 + 8 * fq;
      *(bf16x8*)(y + (size_t)row * DM + colL) = pack8(acc[0], acc[1]); }
    __syncthreads();
}
__device__ __forceinline__ void moe_convert_phase(ldsp_t lds, const Args& a, int j, int wg, int nwg) {
    unsigned char* ws = a.ws;
    const size_t eo = (size_t)(j * 8) * 1024 * DFFE;
    convert_T(lds, (bf16_t*)(ws + WS_W_MOEGU), 8, (size_t)1024 * DFFE, 7168, 1024, MapGU{a.in[I_MOE_WG] + eo, a.in[I_MOE_WU] + eo, DFFE}, wg, nwg);
    convert_T(lds, (bf16_t*)(ws + WS_W_MOED), 8, (size_t)1024 * DFFE, 1024, DFFE, MapId{a.in[I_MOE_WD] + eo, 1024, 1024}, wg, nwg);
}

__global__ void __launch_bounds__(512, 2) mega(Args a) {
    extern __shared__ __attribute__((aligned(16))) unsigned char lds_raw[];
    ldsp_t lds = (ldsp_t)lds_raw;
    const int tid = my_tid(), wg = blockIdx.x, nwg = gridDim.x;
    const int lo = a.ph_lo, hi = a.ph_hi;
    unsigned char* ws = a.ws;
    volatile LAS unsigned* misc = (volatile LAS unsigned*)(lds + LDS_MISC);
    XcdBarrier bar; bar.bar = (unsigned*)(ws + WS_BAR); bar.x = 0; bar.st = misc;
    if (hi - lo > 1) { if (tid == 0) { misc[0] = 0u; misc[1] = 0u; misc[2] = 0u; misc[3] = 0u; } __syncthreads(); bar = xcd_barrier_post((unsigned*)(ws + WS_BAR), misc); }
    int ph = 0;
#ifndef PH_MASK
#define PH_MASK 0xffffffffu
#endif
#ifndef REPEAT_ID
#define REPEAT_ID (-1)
#define REPEAT_N 1
#endif
#define PH_BEGIN(ID) if (((PH_MASK >> (ID)) & 1u) && ph >= lo && ph < hi) { for (int rep_ = 0; rep_ < ((ID) == REPEAT_ID ? REPEAT_N : 1); ++rep_) {
#define PH_END   } if (ph + 1 < hi) xcd_barrier(bar); } ++ph;
    bf16_t* hb = (bf16_t*)(ws + WS_HB); bf16_t* ob = (bf16_t*)(ws + WS_OB);
    unsigned* ctl = (unsigned*)(ws + WS_CTL);

    PH_BEGIN(0) prologue_phase(lds, a, wg, nwg); PH_END

    for (int layer = 0; layer < 4; ++layer) {
        if (layer == 0) {
            PH_BEGIN(1) { pg8::Gemm g{hb, (const bf16_t*)(ws + WS_W_HGIN), NT, 4096, 1024}; pg8::StaticOrder S; S.init(NT, 4096, nwg, wg);
                EpiHgIn E{(bf16_t*)(ws + SC_HG_QS), (bf16_t*)(ws + SC_HG_VV), (bf16_t*)(ws + SC_HG_SG), (float*)(ws + SC_HG_LF), (const float*)(ws + WS_LBV)};
                pg8::gemm_phase(lds, g, S, E); } PH_END
            PH_BEGIN(2) hgrn_passA(lds, (const float*)(ws + SC_HG_LF), (const bf16_t*)(ws + SC_HG_VV), (bf16_t*)(ws + SC_HG_ST), (float*)(ws + SC_HG_DEC), wg, nwg); PH_END
            PH_BEGIN(3) hgrn_passB((bf16_t*)(ws + SC_HG_ST), (const float*)(ws + SC_HG_DEC), wg, nwg); PH_END
            PH_BEGIN(4) hgrn_passC(lds, (const bf16_t*)(ws + SC_HG_QS), (const float*)(ws + SC_HG_LF), (const bf16_t*)(ws + SC_HG_VV), (const bf16_t*)(ws + SC_HG_SG),
                                (const bf16_t*)(ws + SC_HG_ST), a.in[I_HG_NG], ob, wg, nwg); PH_END
        } else if (layer == 1) {
            PH_BEGIN(5) { pg8::Gemm g{hb, (const bf16_t*)(ws + WS_W_DAIN), NT, 3072, 1024}; pg8::StaticOrder S; S.init(NT, 3072, nwg, wg);
                EpiDaIn E{(bf16_t*)(ws + SC_DA_Q), (bf16_t*)(ws + SC_DA_K), (bf16_t*)(ws + SC_DA_V), (const f32x2*)(ws + WS_ROPE_DA)};
                pg8::gemm_phase(lds, g, S, E); } PH_END
            PH_BEGIN(6) da_attn_phase(lds, (const bf16_t*)(ws + SC_DA_Q), (const bf16_t*)(ws + SC_DA_K), (const bf16_t*)(ws + SC_DA_V), a.in[I_DA_LAM], a.in[I_DA_NG], ob, wg, nwg); PH_END
        } else if (layer == 2) {
            PH_BEGIN(8) { pg8::Gemm g{hb, (const bf16_t*)(ws + WS_W_NSAIN), NT, NSA_NPAD, 1024}; pg8::StaticOrder S; S.init(NT, NSA_NPAD, nwg, wg);
                EpiNsaIn E{(bf16_t*)(ws + SC_NSA_Q), (bf16_t*)(ws + SC_NSA_QR), (bf16_t*)(ws + SC_NSA_KV), (float*)(ws + SC_NSA_GATE), (const f32x2*)(ws + WS_ROPE_NSA)};
                pg8::gemm_phase(lds, g, S, E); } PH_END
            PH_BEGIN(9) nsa_compress_phase(lds, (const bf16_t*)(ws + SC_NSA_KV), (const bf16_t*)(ws + WS_W_CMP1), (const bf16_t*)(ws + WS_W_CMP2), (const float*)(ws + WS_CMPBIAS), (bf16_t*)(ws + SC_NSA_KC), wg, nwg); PH_END
            PH_BEGIN(10) nsa_attn_phase(lds, (const bf16_t*)(ws + SC_NSA_Q), (const bf16_t*)(ws + SC_NSA_QR), (const bf16_t*)(ws + SC_NSA_KV), (const bf16_t*)(ws + SC_NSA_KC),
                                    (const float*)(ws + SC_NSA_GATE), (float*)(ws + SC_NSA_OACC), ob, wg, nwg); PH_END
        } else {
            PH_BEGIN(11) { pg8::Gemm g{hb, (const bf16_t*)(ws + WS_W_SBIN), NT, 3072, 1024}; pg8::StaticOrder S; S.init(NT, 3072, nwg, wg);
                EpiSbIn E{(bf16_t*)(ws + SC_SB_Q)};
                pg8::gemm_phase(lds, g, S, E); } PH_END
            PH_BEGIN(12) sb_attn_phase(lds, (const bf16_t*)(ws + SC_SB_Q), (const bf16_t*)(ws + SC_SB_K), (const bf16_t*)(ws + SC_SB_V), ob, wg, nwg); PH_END
        }
        const size_t wout_off = (layer == 0) ? WS_W_HGOUT : (layer == 1) ? WS_W_DAOUT : (layer == 2) ? WS_W_NSAOUT : WS_W_SBOUT;
        PH_BEGIN(13) { pg8::Gemm g{ob, (const bf16_t*)(ws + wout_off), NT, 1024, 1024}; pg8::StaticOrder S; S.init(NT, 1024, nwg, wg);
            bf16_t* zdst = rep_ ? (bf16_t*)a.out : hb;
            if (layer == 0) { EpiRes<true> E{a.in[I_X], zdst}; pg8::gemm_phase(lds, g, S, E); }
            else { EpiRes<false> E{hb, zdst}; pg8::gemm_phase(lds, g, S, E); } } PH_END
        const int j = layer >> 1;
        unsigned* cnt = ctl + 64 * j;
        const Route* route = (const Route*)(ws + SC_MOE_ROUTE);
        PH_BEGIN(14) ln_phase(lds, hb, rep_ ? a.out : nullptr, rep_ ? nullptr : hb, a.in[I_LN_G] + (size_t)(layer * 2) * DM, a.in[I_LN_B] + (size_t)(layer * 2) * DM, nullptr, nullptr, nullptr,
                          ((layer & 1) && !rep_) ? a.in[I_MOE_WR] + (size_t)j * DM * 8 : nullptr, (Route*)(ws + SC_MOE_ROUTE), cnt, wg, nwg); PH_END
        if ((layer & 1) == 0) {
            PH_BEGIN(15) { pg8::Gemm g{hb, (const bf16_t*)(ws + WS_W_FFNGU) + (size_t)j * 5632 * 1024, NT, 5632, 1024}; pg8::StaticOrder S; S.init(NT, 5632, nwg, wg);
                EpiSwiglu E{(bf16_t*)(ws + SC_FF_ACT), DFF, 22};
                pg8::gemm_phase(lds, g, S, E); } PH_END
            PH_BEGIN(16) { pg8::Gemm g{(const bf16_t*)(ws + SC_FF_ACT), (const bf16_t*)(ws + WS_W_FFND) + (size_t)j * 1024 * DFF, NT, 1024, DFF}; pg8::StaticOrder S; S.init(NT, 1024, nwg, wg);
                EpiRes<false> E{hb, rep_ ? (bf16_t*)a.out : hb};
                pg8::gemm_phase(lds, g, S, E); } PH_END
            PH_BEGIN(17) ln_phase(lds, hb, (layer == 3 || rep_) ? a.out : nullptr, rep_ ? nullptr : hb, a.in[I_LN_G] + (size_t)(layer * 2 + 1) * DM, a.in[I_LN_B] + (size_t)(layer * 2 + 1) * DM, nullptr, nullptr, nullptr,
                              nullptr, nullptr, nullptr, wg, nwg); PH_END
        } else {
            PH_BEGIN(18) moe_convert_phase(lds, a, j, wg, nwg);
                         moe_build_table(lds, (int*)(ws + SC_MOE_XS), route, cnt, wg, nwg); PH_END
            for (int ck = 0; ck < 2; ++ck) {
                int seg_tile[8], nT_, tile_lo_ = ck * MOE_CHUNK_TILES;
                { int s_ = 0;
#pragma unroll
                  for (int e = 0; e < 8; ++e) { seg_tile[e] = s_ >> 8; s_ += (int)((cnt[e] + 255u) & ~255u); }
                  int nt_all = s_ >> 8; int t_hi = tile_lo_ + MOE_CHUNK_TILES; if (t_hi > nt_all) t_hi = nt_all; nT_ = t_hi - tile_lo_; }
                PH_BEGIN(19) { MoeOrderT<true> MO; MO.G = nwg; MO.c = wg; MO.tile_lo = tile_lo_; MO.nT = nT_; MO.nNt = 28; MO.tok = (const int*)(ws + SC_MOE_XS);
#pragma unroll
                    for (int e = 0; e < 8; ++e) MO.seg_tile[e] = seg_tile[e];
                    pg8::Gemm g{hb, (const bf16_t*)(ws + WS_W_MOEGU), MOE_CHUNK_ROWS, 7168, 1024};
                    EpiSwiglu E{(bf16_t*)(ws + SC_MOE_ACT), DFFE, 28};
                    pg8::gemm_phase(lds, g, MO, E); } PH_END
                PH_BEGIN(20) { MoeOrderT<false> MO; MO.G = nwg; MO.c = wg; MO.tile_lo = tile_lo_; MO.nT = nT_; MO.nNt = 4; MO.tok = nullptr;
#pragma unroll
                    for (int e = 0; e < 8; ++e) MO.seg_tile[e] = seg_tile[e];
                    pg8::Gemm g{(const bf16_t*)(ws + SC_MOE_ACT), (const bf16_t*)(ws + WS_W_MOED), MOE_CHUNK_ROWS, 1024, DFFE};
                    EpiMoeDown E{(bf16_t*)(ws + SC_MOE_Y) + (size_t)ck * MOE_CHUNK_ROWS * DM};
                    const int nu_ = nT_ > 0 ? nT_ * 4 : 0, nfull_ = nu_ / nwg, ntail_ = nu_ - nfull_ * nwg;
                    const bool stail_ = (ntail_ > 0 && ntail_ <= 16 && nwg == 256);
                    if (stail_) MO.imax = nfull_;
                    pg8::gemm_phase(lds, g, MO, E);
                    if (stail_) { __syncthreads();
                        const int j_ = wg >> 3, uidx_ = (wg & 7) + 8 * (j_ >> 4), sub_ = j_ & 15;
                        if (uidx_ < ntail_) { pg8::Unit u_; MO.at((long)nfull_ * nwg + uidx_, u_); moe_down_sub(lds, g.A, g.Bt, u_, sub_ >> 2, sub_ & 3, E.y); } } } PH_END
            }
            PH_BEGIN(21) ln_phase(lds, hb, (layer == 3 || rep_) ? a.out : nullptr, rep_ ? nullptr : hb, a.in[I_LN_G] + (size_t)(layer * 2 + 1) * DM, a.in[I_LN_B] + (size_t)(layer * 2 + 1) * DM,
                              route, (const bf16_t*)(ws + SC_MOE_Y), cnt, nullptr, nullptr, nullptr, wg, nwg); PH_END
        }
    }
#undef PH_BEGIN
#undef PH_END
}
constexpr int NPHASES = 38;

#ifdef DBG_REPORT
__global__ void dbg_stats(const void* buf, size_t n, int isbf, float* acc, int slot) {
    float bad = 0.f, ss = 0.f;
    for (size_t i = (size_t)blockIdx.x * blockDim.x + threadIdx.x; i < n; i += (size_t)gridDim.x * blockDim.x) {
        const float v = isbf ? bf2f(((const bf16_t*)buf)[i]) : ((const float*)buf)[i];
        if (!(fabsf(v) < 3e38f)) bad += 1.f; else ss += v * v; }
    bad = wave_sum(bad); ss = wave_sum(ss);
    if ((threadIdx.x & 63) == 0) { atomicAdd(acc + 2 * slot, bad); atomicAdd(acc + 2 * slot + 1, ss); }
}
__global__ void dbg_write(const float* acc, int nslot, float* out, size_t nout) {
    float code = 1.f;
    for (int k = 0; k < nslot; ++k) if (acc[2 * k] > 0.f) code += (float)(1 << k);
    const float c = 10.f * code;
    for (size_t i = (size_t)blockIdx.x * blockDim.x + threadIdx.x; i < nout; i += (size_t)gridDim.x * blockDim.x) out[i] = c;
}
#endif
extern "C" void kernel_launch(void* const* d_in, const int* in_sizes, int n_in, void* d_out, int out_size, void* d_ws, size_t ws_size, hipStream_t stream) {
    static int grid = 0;
    if (grid == 0) {
        if (n_in != 25 || out_size != NT * DM || ws_size < WS_END) { fprintf(stderr, "kernel_launch: unexpected shapes / workspace (%d inputs, out %d, ws %zu < %zu)\n", n_in, out_size, ws_size, (size_t)WS_END); grid = -1; return; }
        int dev = 0, cus = 0;
        if (hipGetDevice(&dev) != hipSuccess || hipDeviceGetAttribute(&cus, hipDeviceAttributeMultiprocessorCount, dev) != hipSuccess) { grid = -1; return; }
        if (hipFuncSetAttribute((const void*)mega, hipFuncAttributeMaxDynamicSharedMemorySize, LDS_BYTES) != hipSuccess) { fprintf(stderr, "kernel_launch: hipFuncSetAttribute failed\n"); grid = -1; return; }
        int per_cu = 0;
        if (hipOccupancyMaxActiveBlocksPerMultiprocessor(&per_cu, (const void*)mega, 512, LDS_BYTES) != hipSuccess || per_cu < 1) { fprintf(stderr, "kernel_launch: occupancy query says %d blocks per CU\n", per_cu); }
        (void)hipGetLastError();
        grid = cus;
    }
    if (grid < 0) return;
    (void)hipMemsetAsync((char*)d_ws, 0, WS_ZERO_BYTES, stream);
    Args a{};
    for (int i = 0; i < 25; ++i) a.in[i] = (const float*)d_in[i];
    a.out = (float*)d_out; a.ws = (unsigned char*)d_ws;
#if MK_FUSED
    a.ph_lo = 0; a.ph_hi = NPHASES;
    hipLaunchKernelGGL(mega, dim3(grid), dim3(512), LDS_BYTES, stream, a);
#else
#ifndef DBG_NPH
#define DBG_NPH NPHASES
#endif
    for (int p = 0; p < DBG_NPH; ++p) { a.ph_lo = p; a.ph_hi = p + 1; hipLaunchKernelGGL(mega, dim3(grid), dim3(512), LDS_BYTES, stream, a); }
#ifdef DBG_REPORT
    { float* acc = (float*)((char*)d_ws + WS_CTL + 2048); char* w = (char*)d_ws;
      hipLaunchKernelGGL(dbg_stats, dim3(1024), dim3(256), 0, stream, (const void*)(w + SC_HG_VV), (size_t)NT * DM, 1, acc, 0);
      hipLaunchKernelGGL(dbg_stats, dim3(1024), dim3(256), 0, stream, (const void*)(w + SC_HG_ST), (size_t)4096 * 128 * 128, 1, acc, 1);
      hipLaunchKernelGGL(dbg_stats, dim3(1024), dim3(256), 0, stream, (const void*)(w + SC_HG_SG), (size_t)NT * DM, 1, acc, 2);
      hipLaunchKernelGGL(dbg_stats, dim3(1024), dim3(256), 0, stream, (const void*)(w + SC_HG_LF), (size_t)NT * DM, 0, acc, 3);
      hipLaunchKernelGGL(dbg_write, dim3(1024), dim3(256), 0, stream, (const float*)acc, 4, (float*)d_out, (size_t)NT * DM); }
#endif
#endif
}
```

```cpp
#include <hip/hip_runtime.h>
#include <stdint.h>
#include <stdio.h>

#ifndef MK_FUSED
#define MK_FUSED 1
#endif


#define LAS __attribute__((address_space(3)))
typedef unsigned short bf16_t;
typedef short bf16x8 __attribute__((ext_vector_type(8)));
typedef short s16x4 __attribute__((ext_vector_type(4)));
typedef float f32x2 __attribute__((ext_vector_type(2)));
typedef float f32x4 __attribute__((ext_vector_type(4)));
typedef float f32x16 __attribute__((ext_vector_type(16)));
typedef unsigned u32x2 __attribute__((ext_vector_type(2)));
typedef unsigned u32x4 __attribute__((ext_vector_type(4)));
typedef LAS unsigned char* ldsp_t;

constexpr int DM = 1024, NB = 4, SEQ = 8192, NT = NB * SEQ, NHEAD = 8, HDIM = 128;
constexpr int DFF = 2816, NEXP = 8, DFFE = 3584;
constexpr float ALPHA = 1.681792830507429f;
constexpr float LN_EPS = 1e-5f;
constexpr int NSA_NPAD = 2816;
constexpr int NCMP = 511, NCMP_P = 512;
constexpr int MOE_TILES_MAX = 264, MOE_CHUNK_TILES = 132, MOE_ROWS_MAX = MOE_TILES_MAX * 256, MOE_CHUNK_ROWS = MOE_CHUNK_TILES * 256;

constexpr size_t al256(size_t x) { return (x + 255) & ~(size_t)255; }
constexpr size_t WS_BAR = 0;
constexpr size_t WS_CTL = 16384;
constexpr size_t WS_ZERO_BYTES = 16384 + 4096;
constexpr size_t WS_SMALL = WS_ZERO_BYTES;
constexpr size_t WS_LBV = WS_SMALL;
constexpr size_t WS_CMPBIAS = WS_LBV + 4096;
constexpr size_t WS_ROPE_DA = WS_CMPBIAS + 32768;
constexpr size_t WS_ROPE_NSA = WS_ROPE_DA + (size_t)SEQ * 32 * 8;
constexpr size_t WS_HB = al256(WS_ROPE_NSA + (size_t)SEQ * 64 * 8);
constexpr size_t WS_OB = WS_HB + (size_t)NT * DM * 2;
constexpr size_t WS_W_HGIN = WS_OB + (size_t)NT * DM * 2;
constexpr size_t WS_W_HGOUT = WS_W_HGIN + (size_t)4096 * 1024 * 2;
constexpr size_t WS_W_DAIN = WS_W_HGOUT + (size_t)1024 * 1024 * 2;
constexpr size_t WS_W_DAOUT = WS_W_DAIN + (size_t)3072 * 1024 * 2;
constexpr size_t WS_W_NSAIN = WS_W_DAOUT + (size_t)1024 * 1024 * 2;
constexpr size_t WS_W_NSAOUT = WS_W_NSAIN + (size_t)NSA_NPAD * 1024 * 2;
constexpr size_t WS_W_SBIN = WS_W_NSAOUT + (size_t)1024 * 1024 * 2;
constexpr size_t WS_W_SBOUT = WS_W_SBIN + (size_t)3072 * 1024 * 2;
constexpr size_t WS_W_FFNGU = WS_W_SBOUT + (size_t)1024 * 1024 * 2;
constexpr size_t WS_W_FFND = WS_W_FFNGU + (size_t)2 * 5632 * 1024 * 2;
constexpr size_t WS_W_CMP1 = WS_W_FFND + (size_t)2 * 1024 * 2816 * 2;
constexpr size_t WS_W_CMP2 = WS_W_CMP1 + (size_t)2 * 128 * 4096 * 2;
constexpr size_t WS_W_MOEGU = WS_W_CMP2 + (size_t)2 * 128 * 128 * 2;
constexpr size_t WS_W_MOED = WS_W_MOEGU + (size_t)8 * 7168 * 1024 * 2;
constexpr size_t WS_SCR = al256(WS_W_MOED + (size_t)8 * 1024 * 3584 * 2);
constexpr size_t SC_HG_QS = WS_SCR;
constexpr size_t SC_HG_VV = SC_HG_QS + (size_t)NT * DM * 2;
constexpr size_t SC_HG_SG = SC_HG_VV + (size_t)NT * DM * 2;
constexpr size_t SC_HG_LF = SC_HG_SG + (size_t)NT * DM * 2;
constexpr size_t SC_HG_ST = SC_HG_LF + (size_t)NT * DM * 4;
constexpr size_t SC_HG_DEC = SC_HG_ST + (size_t)4096 * 128 * 128 * 2;
constexpr size_t SC_HG_END = SC_HG_DEC + (size_t)4096 * 128 * 4;
constexpr size_t SC_FF_ACT = WS_SCR;
constexpr size_t SC_FF_END = SC_FF_ACT + (size_t)NT * DFF * 2;
constexpr size_t SC_DA_Q = WS_SCR;
constexpr size_t SC_DA_K = SC_DA_Q + (size_t)NT * DM * 2;
constexpr size_t SC_DA_V = SC_DA_K + (size_t)NT * DM * 2;
constexpr size_t SC_DA_END = SC_DA_V + (size_t)NT * DM * 2;
constexpr size_t SC_MOE_ROUTE = WS_SCR;
constexpr size_t SC_MOE_XS = SC_MOE_ROUTE + (size_t)NT * 32;
constexpr size_t SC_MOE_ACT = SC_MOE_XS + al256((size_t)MOE_ROWS_MAX * 4);
constexpr size_t SC_MOE_Y = SC_MOE_ACT + (size_t)MOE_CHUNK_ROWS * DFFE * 2;
constexpr size_t SC_MOE_END = SC_MOE_Y + (size_t)MOE_ROWS_MAX * DM * 2;
constexpr size_t SC_NSA_Q = WS_SCR;
constexpr size_t SC_NSA_QR = SC_NSA_Q + (size_t)NT * DM * 2;
constexpr size_t SC_NSA_KV = SC_NSA_QR + (size_t)NT * DM * 2;
constexpr size_t SC_NSA_GATE = SC_NSA_KV + (size_t)6 * NT * 256 * 2;
constexpr size_t SC_NSA_KC = SC_NSA_GATE + (size_t)NT * 24 * 4;
constexpr size_t SC_NSA_OACC = SC_NSA_KC + (size_t)2 * 8 * NCMP_P * 128 * 2;
constexpr size_t SC_NSA_END = SC_NSA_OACC + (size_t)NT * DM * 4;
constexpr size_t SC_SB_Q = WS_SCR;
constexpr size_t SC_SB_K = SC_SB_Q + (size_t)NT * DM * 2;
constexpr size_t SC_SB_V = SC_SB_K + (size_t)NT * DM * 2;
constexpr size_t SC_SB_END = SC_SB_V + (size_t)NT * DM * 2;
constexpr size_t cmax(size_t a, size_t b) { return a > b ? a : b; }
constexpr size_t WS_END = cmax(cmax(cmax(SC_HG_END, SC_FF_END), cmax(SC_DA_END, SC_MOE_END)), cmax(SC_NSA_END, SC_SB_END));
static_assert(WS_END <= (size_t)981882880, "workspace budget (sum of the inputs)");

constexpr int LDS_BYTES = 152 * 1024;
constexpr int LDS_MISC = 150 * 1024;

__device__ __forceinline__ unsigned bf16_rne_bits(float f) { const unsigned u = __float_as_uint(f); return (u + 0x7fffu + ((u >> 16) & 1u)) >> 16; }
__device__ __forceinline__ unsigned cvtpk(float lo, float hi) {
    typedef __bf16 bf2_t __attribute__((ext_vector_type(2)));
    typedef float f2_t __attribute__((ext_vector_type(2)));
    const bf2_t r = __builtin_convertvector((f2_t){lo, hi}, bf2_t);
    return __builtin_bit_cast(unsigned, r);
}
__device__ __forceinline__ float bf2f(bf16_t b) { return __uint_as_float(((unsigned)b) << 16); }
__device__ __forceinline__ bf16_t f2bf(float f) { return (bf16_t)(cvtpk(f, 0.f) & 0xffffu); }
__device__ __forceinline__ bf16x8 pack8(f32x4 a, f32x4 b) { u32x4 w = {cvtpk(a[0], a[1]), cvtpk(a[2], a[3]), cvtpk(b[0], b[1]), cvtpk(b[2], b[3])}; return *reinterpret_cast<bf16x8*>(&w); }
__device__ __forceinline__ float sigmoidf_(float x) { return __builtin_amdgcn_rcpf(1.f + __expf(-x)); }
__device__ __forceinline__ float siluf_(float x) { return x * __builtin_amdgcn_rcpf(1.f + __expf(-x)); }
__device__ __forceinline__ int my_tid() { int t = threadIdx.x; asm volatile("" : "+v"(t)); return t; }
__device__ __forceinline__ float wave_sum(float v) {
#pragma unroll
    for (int o = 32; o > 0; o >>= 1) v += __shfl_xor(v, o);
    return v;
}

#define XB_TMO      128
#define XB_XCNT(j)  (256  + 64 * (j))
#define XB_XSUB(j)  (1280 + 64 * (j))
#define XB_XGEN(j)  (2304 + 64 * (j))
#define XB_TOP      3328
#define XB_TOPGEN   3392
#define XCD_BAR_WORDS 3456
#define XB_SPIN_CAP (1u << 18)
__device__ __forceinline__ unsigned xb_ld(unsigned* p)              { return __hip_atomic_load(p, __ATOMIC_RELAXED, __HIP_MEMORY_SCOPE_AGENT); }
__device__ __forceinline__ unsigned xb_add(unsigned* p, unsigned v) { return __hip_atomic_fetch_add(p, v, __ATOMIC_RELAXED, __HIP_MEMORY_SCOPE_AGENT); }
__device__ __forceinline__ unsigned xb_xcc_id() { return (unsigned)__builtin_amdgcn_s_getreg((3 << 11) | 20) & 0xFu; }
#define XB_SPIN(cond, bar) do { unsigned _sp = 0; while (cond) { __builtin_amdgcn_s_sleep(1); \
    if ((++_sp & 255u) == 0u) { if (xb_ld(&(bar)[XB_TMO])) break; if (_sp > XB_SPIN_CAP) { atomicAdd(&(bar)[XB_TMO], 1u); break; } } } } while (0)
struct XcdBarrier { unsigned* bar; unsigned x; volatile LAS unsigned* st; };
__device__ __forceinline__ XcdBarrier xcd_barrier_post(unsigned* bar, volatile LAS unsigned* st) {
    XcdBarrier b; b.bar = bar; b.x = xb_xcc_id(); b.st = st;
    if (threadIdx.x == 0) (void)xb_add(&bar[XB_XCNT(b.x)], 1u);
    return b;
}
__device__ __forceinline__ void xcd_barrier_complete(unsigned* bar, unsigned x, unsigned& nloc, unsigned& nx) {
    const unsigned G = gridDim.x * gridDim.y * gridDim.z;
    unsigned sum, cnt, mine, sp = 0u;
    for (;;) {
        sum = 0u; cnt = 0u; mine = 0u;
#pragma unroll
        for (unsigned j = 0; j < 16; ++j) { const unsigned c = xb_ld(&bar[XB_XCNT(j)]); sum += c; cnt += (c > 0u) ? 1u : 0u; mine = (j == x) ? c : mine; }
        if (sum == G) break;
        __builtin_amdgcn_s_sleep(1);
        if ((++sp & 255u) == 0u) { if (xb_ld(&bar[XB_TMO])) break; if (sp > XB_SPIN_CAP) { atomicAdd(&bar[XB_TMO], 1u); break; } }
    }
    nloc = mine > 0u ? mine : 1u; nx = cnt > 0u ? cnt : 1u;
}
__device__ __forceinline__ void xcd_barrier(const XcdBarrier& b) {
    asm volatile("s_waitcnt vmcnt(0)" ::: "memory");
    __syncthreads();
    if (threadIdx.x == 0) {
        unsigned* bar = b.bar;
        __builtin_amdgcn_s_waitcnt(0);
        unsigned nloc = b.st[0], nx = b.st[1];
        if (nloc == 0u) { xcd_barrier_complete(bar, b.x, nloc, nx); b.st[0] = nloc; b.st[1] = nx; }
        const unsigned old = xb_add(&bar[XB_XSUB(b.x)], 1u);
        const unsigned gen = old / nloc;
        if (old + 1u == (gen + 1u) * nloc) {
            __builtin_amdgcn_fence(__ATOMIC_RELEASE, "agent");
            asm volatile("s_waitcnt vmcnt(0)" ::: "memory");
            const unsigned og = xb_add(&bar[XB_TOP], 1u);
            const unsigned tg = og / nx;
            if (og + 1u == (tg + 1u) * nx) xb_add(&bar[XB_TOPGEN], 1u);
            else XB_SPIN(xb_ld(&bar[XB_TOPGEN]) == tg, bar);
            __builtin_amdgcn_fence(__ATOMIC_ACQUIRE, "agent");
            xb_add(&bar[XB_XGEN(b.x)], 1u);
            asm volatile("s_waitcnt vmcnt(0)" ::: "memory");
        } else {
            XB_SPIN(xb_ld(&bar[XB_XGEN(b.x)]) == gen, bar);
            __builtin_amdgcn_fence(__ATOMIC_ACQUIRE, "agent");
            asm volatile("s_waitcnt vmcnt(0)" ::: "memory");
        }
    }
    __syncthreads();
}

namespace pg8 {
constexpr int BM = 256, BK = 64, HALF = 128, HTB = HALF * BK * 2, STAGE_BYTES = 8 * HTB, NXCD = 8, WGM = 8;
__host__ __device__ __forceinline__ int lds_byte(int r, int c) { const int st = (r >> 4) * 2 + (c >> 5), rr = r & 15, cc = c & 31, ob = rr * 64 + cc * 2; return st * 1024 + (ob ^ (((ob >> 9) & 1) << 5)); }
__host__ __device__ __forceinline__ void stage_rc(int b, int& R, int& C) { const int st = b / 1024, sb = b % 1024, swz = sb ^ (((sb >> 9) & 1) << 5); R = (st >> 1) * 16 + swz / 64; C = (st & 1) * 32 + (swz % 64) / 2; }
__host__ __device__ __forceinline__ int perm32(int rho) { const int n = rho >> 4, i = rho & 15; return 8 * (i >> 2) + 4 * n + (i & 3); }
struct Unit { int pm, pn; };
struct Gemm { const bf16_t* A; const bf16_t* Bt; int M, N, K; };
struct StaticOrder {
    static constexpr bool GATHER = false; static constexpr int tile_lo = 0;
    __device__ __forceinline__ int row_token(int) const { return 0; }
    int nM, nN, nwg, G, c;
    __device__ void init(int M, int N, int G_, int c_) { nM = M / BM; nN = N / BM; nwg = nM * nN; G = G_; c = c_; }
    __device__ bool next(int i, Unit& u) const {
        const long L = (long)i * G + c; if (L >= nwg) return false;
        int wgid = (int)L; { const int q = nwg / NXCD, r = nwg % NXCD, xcd = wgid % NXCD, off = wgid / NXCD; wgid = (xcd < r ? xcd * (q + 1) : r * (q + 1) + (xcd - r) * q) + off; }
        const int nig = WGM * nN, gid = wgid / nig, fm = gid * WGM, gsz = (nM - fm) < WGM ? (nM - fm) : WGM;
        u.pm = fm + ((wgid % nig) % gsz); u.pn = (wgid % nig) / gsz; return true;
    }
};
template <class Epi, class Sched>
__device__ __forceinline__ void gemm_phase(ldsp_t lds, const Gemm g, const Sched& S, const Epi& E) {
    constexpr bool GA = Sched::GATHER;
    const int tid = my_tid(), wid = __builtin_amdgcn_readfirstlane(tid >> 6), lane = tid & 63, wr = wid >> 2, wc = wid & 3, fr = lane & 15, fq = lane >> 4;
    const int K = g.K, nt = K / BK;
    unsigned voffA[2], voffB[2]; int Rr[2]; unsigned Cc2[2];
#pragma unroll
    for (int i = 0; i < 2; ++i) { int R, C; stage_rc(tid * 16 + i * 8192, R, C); const int Rb = (R & ~31) + perm32(R & 31);
        voffA[i] = (unsigned)(R * K + C) * 2u; voffB[i] = (unsigned)(Rb * K + C) * 2u; Rr[i] = R; Cc2[i] = (unsigned)C * 2u; }
    LAS int* gtab = (LAS int*)(lds + STAGE_BYTES);
    if (GA) { Unit u_; for (int i = 0; S.next(i, u_); ++i) { if (tid < 256) gtab[i * 256 + tid] = S.row_token((S.tile_lo + u_.pm) * 256 + tid); }
        __syncthreads(); }
    unsigned vC[2][2], vN[2][2], vX[2][2];
#define PG8_LOADV(V, UI) do { _Pragma("unroll") for (int h_ = 0; h_ < 2; ++h_) _Pragma("unroll") for (int i_ = 0; i_ < 2; ++i_) \
        V[h_][i_] = (unsigned)gtab[(UI) * 256 + h_ * 128 + Rr[i_]] * (unsigned)(K * 2) + Cc2[i_]; } while (0)
    const size_t kstep = (size_t)(BK * 2);
    const size_t hstep = (size_t)HALF * K * 2;
    const size_t tstep = 2 * hstep;
    const unsigned ldsw = (unsigned)wid * 1024u;
    const int aoff = lds_byte(wr * 64 + fr, fq * 8), boff = lds_byte(wc * 32 + fr, fq * 8);
#define PG8_SA(b, h) (((b) * 2 + (h)) * HTB)
#define PG8_SB(b, h) ((4 + (b) * 2 + (h)) * HTB)
#define PG8_STAGE(bufoff, gbase, voff) do { _Pragma("unroll") for (int _i = 0; _i < 2; ++_i) \
        __builtin_amdgcn_global_load_lds((const unsigned*)((const char*)(gbase) + (voff)[_i]), (LAS unsigned*)(lds + (bufoff) + ldsw + _i * 8192), 16, 0, 0); } while (0)
#define PG8_STAGE_A(bufoff, gbase, H, V) do { _Pragma("unroll") for (int _i = 0; _i < 2; ++_i) \
        __builtin_amdgcn_global_load_lds((const unsigned*)((const char*)(gbase) + (GA ? (size_t)0 : (size_t)(H) * hstep) + (GA ? (V)[H][_i] : voffA[_i])), (LAS unsigned*)(lds + (bufoff) + ldsw + _i * 8192), 16, 0, 0); } while (0)
#define PG8_LDA(dst, b, h) do { _Pragma("unroll") for (int m = 0; m < 4; ++m) _Pragma("unroll") for (int k = 0; k < 2; ++k) dst[m][k] = *(const LAS bf16x8*)(lds + PG8_SA(b, h) + aoff + m * 2048 + k * 1024); } while (0)
#define PG8_LDB(dst, b, h) do { _Pragma("unroll") for (int n = 0; n < 2; ++n) _Pragma("unroll") for (int k = 0; k < 2; ++k) dst[n][k] = *(const LAS bf16x8*)(lds + PG8_SB(b, h) + boff + n * 2048 + k * 1024); } while (0)
#define PG8_MMA(ai, bj, At, Bt) do { __builtin_amdgcn_s_setprio(1); _Pragma("unroll") for (int m = 0; m < 4; ++m) _Pragma("unroll") for (int n = 0; n < 2; ++n) _Pragma("unroll") for (int k = 0; k < 2; ++k) \
        acc[ai][bj][m][n] = __builtin_amdgcn_mfma_f32_16x16x32_bf16(Bt[n][k], At[m][k], acc[ai][bj][m][n], 0, 0, 0); __builtin_amdgcn_s_setprio(0); } while (0)
#define PG8_WAIT_V(n) asm volatile("s_waitcnt vmcnt(" #n ")" ::: "memory")
#define PG8_WAIT_L(n) asm volatile("s_waitcnt lgkmcnt(" #n ")" ::: "memory")
#define PG8_BAR __builtin_amdgcn_s_barrier()
#define PG8_SCHED __builtin_amdgcn_sched_barrier(0)
    Unit cur, nxt; int ui = 0;
    if (!S.next(0, cur)) return;
    f32x4 acc[2][2][4][2];
#pragma unroll
    for (int a = 0; a < 2; ++a)
#pragma unroll
        for (int b = 0; b < 2; ++b)
#pragma unroll
            for (int m = 0; m < 4; ++m)
#pragma unroll
                for (int n = 0; n < 2; ++n) acc[a][b][m][n] = (f32x4){0.f, 0.f, 0.f, 0.f};
    bf16x8 At[4][2], B0[2][2], B1[2][2];
    const char* cA = (const char*)g.A + (GA ? (size_t)0 : (size_t)cur.pm * tstep); const char* cB = (const char*)g.Bt + (size_t)cur.pn * tstep;
    if (GA) { PG8_LOADV(vC, 0); }
    PG8_STAGE(PG8_SB(0, 0), cB, voffB); PG8_STAGE(PG8_SB(0, 1), cB + hstep, voffB); PG8_STAGE_A(PG8_SA(0, 0), cA, 0, vC); PG8_STAGE_A(PG8_SA(0, 1), cA, 1, vC);
    if (wr == 1) PG8_BAR;
    PG8_WAIT_V(2); PG8_BAR;
    PG8_STAGE(PG8_SB(1, 0), cB + kstep, voffB); PG8_STAGE_A(PG8_SA(1, 0), cA + kstep, 0, vC); PG8_STAGE(PG8_SB(1, 1), cB + hstep + kstep, voffB);
    PG8_WAIT_V(6); PG8_BAR;
    for (;;) {
        const bool has_next = S.next(ui + 1, nxt);
        const char* nA = (has_next && !GA) ? (const char*)g.A + (size_t)nxt.pm * tstep : cA; const char* nB = has_next ? (const char*)g.Bt + (size_t)nxt.pn * tstep : cB;
        if (GA) { if (has_next) { PG8_LOADV(vN, ui + 1); } else {
#pragma unroll
            for (int h_ = 0; h_ < 2; ++h_)
#pragma unroll
                for (int i_ = 0; i_ < 2; ++i_) vN[h_][i_] = vC[h_][i_]; } }
        for (int t = 0; t < nt; t += 2) {
            const bool last = (t == nt - 2);
            if (GA) {
#pragma unroll
                for (int h_ = 0; h_ < 2; ++h_)
#pragma unroll
                    for (int i_ = 0; i_ < 2; ++i_) vX[h_][i_] = last ? vN[h_][i_] : vC[h_][i_]; }
            const char* a1 = cA + (size_t)(t + 1) * kstep;
            const char* a2 = last ? nA : cA + (size_t)(t + 2) * kstep; const char* b2 = last ? nB : cB + (size_t)(t + 2) * kstep;
            const char* a3 = a2 + kstep; const char* b3 = b2 + kstep;
            PG8_LDB(B0, 0, 0); PG8_LDB(B1, 0, 1); PG8_SCHED; PG8_LDA(At, 0, 0); PG8_STAGE_A(PG8_SA(1, 1), a1, 1, vC);
            PG8_WAIT_V(8); PG8_WAIT_L(0); PG8_BAR; PG8_MMA(0, 0, At, B0); PG8_MMA(0, 1, At, B1); PG8_BAR; PG8_SCHED;
            PG8_LDA(At, 0, 1); PG8_STAGE(PG8_SB(0, 0), b2, voffB); PG8_STAGE(PG8_SB(0, 1), b2 + hstep, voffB); PG8_STAGE_A(PG8_SA(0, 0), a2, 0, vX);
            PG8_WAIT_V(8); PG8_WAIT_L(0); PG8_BAR; PG8_MMA(1, 0, At, B0); PG8_MMA(1, 1, At, B1); PG8_BAR; PG8_SCHED;
            PG8_LDB(B0, 1, 0); PG8_LDB(B1, 1, 1); PG8_SCHED; PG8_LDA(At, 1, 0); PG8_STAGE_A(PG8_SA(0, 1), a2, 1, vX);
            PG8_WAIT_V(8); PG8_WAIT_L(0); PG8_BAR; PG8_MMA(0, 0, At, B0); PG8_MMA(0, 1, At, B1); PG8_BAR; PG8_SCHED;
            PG8_LDA(At, 1, 1); PG8_STAGE(PG8_SB(1, 0), b3, voffB); PG8_STAGE(PG8_SB(1, 1), b3 + hstep, voffB); PG8_STAGE_A(PG8_SA(1, 0), a3, 0, vX);
            PG8_WAIT_V(8); PG8_WAIT_L(0); PG8_BAR; PG8_MMA(1, 0, At, B0); PG8_MMA(1, 1, At, B1); PG8_BAR; PG8_SCHED;
        }
        if (wr == 0) PG8_BAR;
        E(acc, cur, wr, wc, fr, fq);
        if (!has_next) break;
#pragma unroll
        for (int a = 0; a < 2; ++a)
#pragma unroll
            for (int b = 0; b < 2; ++b)
#pragma unroll
                for (int m = 0; m < 4; ++m)
#pragma unroll
                    for (int n = 0; n < 2; ++n) acc[a][b][m][n] = (f32x4){0.f, 0.f, 0.f, 0.f};
        cur = nxt; cA = nA; cB = nB; ++ui;
        if (GA) {
#pragma unroll
            for (int h_ = 0; h_ < 2; ++h_)
#pragma unroll
                for (int i_ = 0; i_ < 2; ++i_) vC[h_][i_] = vN[h_][i_]; }
        if (wr == 1) PG8_BAR;
    }
    PG8_WAIT_V(0);
    PG8_BAR;
#undef PG8_SA
#undef PG8_SB
#undef PG8_STAGE
#undef PG8_STAGE_A
#undef PG8_LOADV
#undef PG8_LDA
#undef PG8_LDB
#undef PG8_MMA
#undef PG8_WAIT_V
#undef PG8_WAIT_L
#undef PG8_BAR
#undef PG8_SCHED
}
}
using pg8::Unit;
typedef f32x4 acc_t[2][2][4][2];
#define EPI_BEGIN \
    _Pragma("unroll") for (int ai = 0; ai < 2; ++ai) _Pragma("unroll") for (int m = 0; m < 4; ++m) _Pragma("unroll") for (int bj = 0; bj < 2; ++bj) { \
        const int row = u.pm * 256 + ai * 128 + wr * 64 + m * 16 + fr; const int col = u.pn * 256 + bj * 128 + wc * 32 + 8 * fq; \
        const f32x4 v0 = acc[ai][bj][m][0], v1 = acc[ai][bj][m][1];
#define EPI_END if (bj == 1 && (m & 1)) asm volatile("" ::: "memory"); }

template <bool RES_F32>
struct EpiRes {
    const void* res; bf16_t* out;
    __device__ __forceinline__ void operator()(const acc_t& acc, const Unit& u, int wr, int wc, int fr, int fq) const {
        asm volatile("" : "+v"(fr), "+v"(fq));
        constexpr int MB = RES_F32 ? 2 : 4;
#pragma unroll
        for (int ai = 0; ai < 2; ++ai)
#pragma unroll
            for (int mp = 0; mp < 4 / MB; ++mp) {
                f32x4 rf[MB][2][2]; u32x4 rb[MB][2];
#pragma unroll
                for (int mm = 0; mm < MB; ++mm)
#pragma unroll
                    for (int bj = 0; bj < 2; ++bj) { const size_t o = (size_t)(u.pm * 256 + ai * 128 + wr * 64 + (MB * mp + mm) * 16 + fr) * DM + u.pn * 256 + bj * 128 + wc * 32 + 8 * fq;
                        if (RES_F32) { rf[mm][bj][0] = *(const f32x4*)((const float*)res + o); rf[mm][bj][1] = *(const f32x4*)((const float*)res + o + 4); }
                        else rb[mm][bj] = *(const u32x4*)((const bf16_t*)res + o); }
#pragma unroll
                for (int mm = 0; mm < MB; ++mm)
#pragma unroll
                    for (int bj = 0; bj < 2; ++bj) { const int m = MB * mp + mm; const size_t o = (size_t)(u.pm * 256 + ai * 128 + wr * 64 + m * 16 + fr) * DM + u.pn * 256 + bj * 128 + wc * 32 + 8 * fq;
                        f32x4 r0, r1;
                        if (RES_F32) { r0 = rf[mm][bj][0]; r1 = rf[mm][bj][1]; }
                        else { const u32x4 w = rb[mm][bj];
                            r0 = (f32x4){__uint_as_float(w[0] << 16), __uint_as_float(w[0] & 0xffff0000u), __uint_as_float(w[1] << 16), __uint_as_float(w[1] & 0xffff0000u)};
                            r1 = (f32x4){__uint_as_float(w[2] << 16), __uint_as_float(w[2] & 0xffff0000u), __uint_as_float(w[3] << 16), __uint_as_float(w[3] & 0xffff0000u)}; }
                        *(bf16x8*)(out + o) = pack8(r0 * ALPHA + acc[ai][bj][m][0], r1 * ALPHA + acc[ai][bj][m][1]); }
                asm volatile("" ::: "memory");
            }
    }
};
struct EpiHgIn {
    bf16_t* qs; bf16_t* vv; bf16_t* sg; float* lf; const float* lbv;
    __device__ __forceinline__ void operator()(const acc_t& acc, const Unit& u, int wr, int wc, int fr, int fq) const {
        asm volatile("" : "+v"(fr), "+v"(fq));
        const int typ = u.pn >> 2;
        EPI_BEGIN { const int c = col & 1023; const size_t o = (size_t)row * DM + c;
            if (typ == 0) { f32x4 a, b;
#pragma unroll
                for (int e = 0; e < 4; ++e) { a[e] = siluf_(v0[e]); b[e] = siluf_(v1[e]); }
                *(bf16x8*)(qs + o) = pack8(a, b); }
            else if (typ == 1) { const f32x4 l0 = *(const f32x4*)(lbv + c), l1 = *(const f32x4*)(lbv + c + 4); f32x4 a, b;
#pragma unroll
                for (int e = 0; e < 4; ++e) { a[e] = __logf(l0[e] + (1.f - l0[e]) * sigmoidf_(v0[e])); b[e] = __logf(l1[e] + (1.f - l1[e]) * sigmoidf_(v1[e])); }
                *(f32x4*)(lf + o) = a; *(f32x4*)(lf + o + 4) = b; }
            else if (typ == 2) { *(bf16x8*)(vv + o) = pack8(v0, v1); }
            else { f32x4 a, b;
#pragma unroll
                for (int e = 0; e < 4; ++e) { a[e] = sigmoidf_(v0[e]); b[e] = sigmoidf_(v1[e]); }
                *(bf16x8*)(sg + o) = pack8(a, b); } } EPI_END
    }
};
struct EpiSwiglu {
    bf16_t* act; int ldact; int ntile;
    __device__ __forceinline__ void operator()(const acc_t& acc, const Unit& u, int wr, int wc, int fr, int fq) const {
        asm volatile("" : "+v"(fr), "+v"(fq));
        const int pnl = u.pn % ntile;
#pragma unroll
        for (int ai = 0; ai < 2; ++ai)
#pragma unroll
            for (int m = 0; m < 4; ++m) { const int row = u.pm * 256 + ai * 128 + wr * 64 + m * 16 + fr, cl = pnl * 128 + wc * 32 + 8 * fq;
                const f32x4 g0 = acc[ai][0][m][0], g1 = acc[ai][0][m][1], u0 = acc[ai][1][m][0], u1 = acc[ai][1][m][1];
                f32x4 a, b;
#pragma unroll
                for (int e = 0; e < 4; ++e) { a[e] = siluf_(g0[e]) * u0[e]; b[e] = siluf_(g1[e]) * u1[e]; }
                *(bf16x8*)(act + (size_t)row * ldact + cl) = pack8(a, b);
                if (m & 1) asm volatile("" ::: "memory"); }
    }
};
struct EpiMoeDown {
    bf16_t* y;
    __device__ __forceinline__ void operator()(const acc_t& acc, const Unit& u, int wr, int wc, int fr, int fq) const {
        asm volatile("" : "+v"(fr), "+v"(fq));
        const int pnl = u.pn & 3;
        EPI_BEGIN { *(bf16x8*)(y + (size_t)row * DM + pnl * 256 + (col & 255)) = pack8(v0, v1); } EPI_END
    }
};
struct EpiDaIn {
    bf16_t* q; bf16_t* k; bf16_t* v; const f32x2* rope;
    __device__ __forceinline__ void operator()(const acc_t& acc, const Unit& u, int wr, int wc, int fr, int fq) const {
        asm volatile("" : "+v"(fr), "+v"(fq));
        const bool isqk = (u.pn * 256 < 2048);
#pragma unroll
        for (int ai = 0; ai < 2; ++ai)
#pragma unroll
            for (int mp = 0; mp < 2; ++mp) {
                f32x4 t0[2][2], t1[2][2];
                if (isqk) {
#pragma unroll
                    for (int mm = 0; mm < 2; ++mm)
#pragma unroll
                        for (int bj = 0; bj < 2; ++bj) { const int row = u.pm * 256 + ai * 128 + wr * 64 + (2 * mp + mm) * 16 + fr, col = u.pn * 256 + bj * 128 + wc * 32 + 8 * fq;
                            const int pos = row & (SEQ - 1), j0 = ((col >> 3) & 7) * 4;
                            t0[mm][bj] = *(const f32x4*)(rope + (size_t)pos * 32 + j0); t1[mm][bj] = *(const f32x4*)(rope + (size_t)pos * 32 + j0 + 2); } }
#pragma unroll
                for (int mm = 0; mm < 2; ++mm)
#pragma unroll
                    for (int bj = 0; bj < 2; ++bj) { const int m = 2 * mp + mm; const int row = u.pm * 256 + ai * 128 + wr * 64 + m * 16 + fr, col = u.pn * 256 + bj * 128 + wc * 32 + 8 * fq;
                        const f32x4 v0 = acc[ai][bj][m][0], v1 = acc[ai][bj][m][1]; const int b = row >> 13, pos = row & (SEQ - 1);
                        if (isqk) { const int blk = col >> 6, which = blk >> 4, hb = blk & 15, j0 = ((col >> 3) & 7) * 4;
                            const f32x4 a0 = t0[mm][bj], a1 = t1[mm][bj];
                            const float cs[4] = {a0[0], a0[2], a1[0], a1[2]}, sn[4] = {a0[1], a0[3], a1[1], a1[3]};
                            float y1[4], y2[4];
#pragma unroll
                            for (int e = 0; e < 4; ++e) { y1[e] = v0[e] * cs[e] - v1[e] * sn[e]; y2[e] = v1[e] * cs[e] + v0[e] * sn[e]; }
                            bf16_t* dst = (which ? k : q) + (((size_t)b * 8 + (hb >> 1)) * SEQ + pos) * 128 + (hb & 1) * 64 + j0;
                            *(u32x2*)dst = (u32x2){cvtpk(y1[0], y1[1]), cvtpk(y1[2], y1[3])};
                            *(u32x2*)(dst + 32) = (u32x2){cvtpk(y2[0], y2[1]), cvtpk(y2[2], y2[3])}; }
                        else { const int h = (col - 2048) >> 7, d = col & 127;
                            *(bf16x8*)(v + (((size_t)b * 8 + h) * SEQ + pos) * 128 + d) = pack8(v0, v1); } }
                asm volatile("" ::: "memory");
            }
    }
};
struct EpiNsaIn {
    bf16_t* q; bf16_t* qr; bf16_t* kv; float* gates; const f32x2* rope;
    __device__ __forceinline__ void operator()(const acc_t& acc, const Unit& u, int wr, int wc, int fr, int fq) const {
        asm volatile("" : "+v"(fr), "+v"(fq));
        const bool isrope = (u.pn < 10);
#pragma unroll
        for (int ai = 0; ai < 2; ++ai)
#pragma unroll
            for (int mp = 0; mp < 2; ++mp) {
                f32x4 t0[2][2], t1[2][2];
                if (isrope) {
#pragma unroll
                    for (int mm = 0; mm < 2; ++mm)
#pragma unroll
                        for (int bj = 0; bj < 2; ++bj) { const int row = u.pm * 256 + ai * 128 + wr * 64 + (2 * mp + mm) * 16 + fr, col = u.pn * 256 + bj * 128 + wc * 32 + 8 * fq;
                            const int pos = row & (SEQ - 1), j0 = ((col >> 3) & 15) * 4;
                            t0[mm][bj] = *(const f32x4*)(rope + (size_t)pos * 64 + j0); t1[mm][bj] = *(const f32x4*)(rope + (size_t)pos * 64 + j0 + 2); } }
#pragma unroll
                for (int mm = 0; mm < 2; ++mm)
#pragma unroll
                    for (int bj = 0; bj < 2; ++bj) { const int m = 2 * mp + mm; const int row = u.pm * 256 + ai * 128 + wr * 64 + m * 16 + fr, col = u.pn * 256 + bj * 128 + wc * 32 + 8 * fq;
                        const f32x4 v0 = acc[ai][bj][m][0], v1 = acc[ai][bj][m][1]; const int b = row >> 13, pos = row & (SEQ - 1);
                        if (isrope) { const int blk = col >> 7, j0 = ((col >> 3) & 15) * 4;
                            const f32x4 a0 = t0[mm][bj], a1 = t1[mm][bj];
                            const float cs[4] = {a0[0], a0[2], a1[0], a1[2]}, sn[4] = {a0[1], a0[3], a1[1], a1[3]};
                            float y1[4], y2[4];
#pragma unroll
                            for (int e = 0; e < 4; ++e) { y1[e] = v0[e] * cs[e] - v1[e] * sn[e]; y2[e] = v1[e] * cs[e] + v0[e] * sn[e]; }
                            const u32x2 p1 = (u32x2){cvtpk(v0[0], v0[1]), cvtpk(v0[2], v0[3])}, p2 = (u32x2){cvtpk(v1[0], v1[1]), cvtpk(v1[2], v1[3])};
                            const u32x2 r1 = (u32x2){cvtpk(y1[0], y1[1]), cvtpk(y1[2], y1[3])}, r2 = (u32x2){cvtpk(y2[0], y2[1]), cvtpk(y2[2], y2[3])};
                            if (blk < 8) { const size_t o = (((size_t)b * 8 + blk) * SEQ + pos) * 128 + j0;
                                *(u32x2*)(q + o) = p1; *(u32x2*)(q + o + 64) = p2; *(u32x2*)(qr + o) = r1; *(u32x2*)(qr + o + 64) = r2; }
                            else { const int jj = (blk - 8) >> 1, g = (blk - 8) & 1; const bool rot = (jj == 2) || (jj == 4);
                                const size_t o = (((size_t)jj * 8 + b * 2 + g) * SEQ + pos) * 128 + j0;
                                *(u32x2*)(kv + o) = rot ? r1 : p1; *(u32x2*)(kv + o + 64) = rot ? r2 : p2; } }
                        else { const int gi = col - 2560;
                            if (gi < 24) { f32x4 a, bb;
#pragma unroll
                                for (int e = 0; e < 4; ++e) { a[e] = sigmoidf_(v0[e]); bb[e] = sigmoidf_(v1[e]); }
                                *(f32x4*)(gates + (size_t)row * 24 + gi) = a; *(f32x4*)(gates + (size_t)row * 24 + gi + 4) = bb; } } }
                asm volatile("" ::: "memory");
            }
    }
};
struct EpiSbIn {
    bf16_t* qkv;
    __device__ __forceinline__ void operator()(const acc_t& acc, const Unit& u, int wr, int wc, int fr, int fq) const {
        asm volatile("" : "+v"(fr), "+v"(fq));
        EPI_BEGIN { const int b = row >> 13, pos = row & (SEQ - 1), which = col >> 10, h = (col >> 7) & 7, d = col & 127;
            *(bf16x8*)(qkv + (size_t)which * NT * DM + (((size_t)b * 8 + h) * SEQ + pos) * 128 + d) = pack8(v0, v1); } EPI_END
    }
};
using pg8::NXCD; using pg8::WGM;
template <bool GATHER_>
struct MoeOrderT {
    static constexpr bool GATHER = GATHER_;
    int G, c, tile_lo, nT, nNt; int seg_tile[8]; const int* tok; int imax = 0x7fffffff;
    __device__ __forceinline__ int row_token(int r) const { return tok[r]; }
    __device__ __forceinline__ bool next(int i, Unit& u) const { return i < imax && at((long)i * G + c, u); }
    __device__ __forceinline__ bool at(long L, Unit& u) const {
        const int nwg = nT * nNt;
        if (nT <= 0 || L >= (long)nwg) return false;
        int wgid = (int)L; { const int q = nwg / NXCD, r = nwg % NXCD, xcd = wgid % NXCD, off = wgid / NXCD; wgid = (xcd < r ? xcd * (q + 1) : r * (q + 1) + (xcd - r) * q) + off; }
        const int nig = WGM * nNt, gid = wgid / nig, fm = gid * WGM, gsz = (nT - fm) < WGM ? (nT - fm) : WGM;
        const int pml = fm + ((wgid % nig) % gsz), pn = (wgid % nig) / gsz, tile = tile_lo + pml;
        int e = 0;
#pragma unroll
        for (int k = 1; k < 8; ++k) e += (tile >= seg_tile[k]) ? 1 : 0;
        u.pm = pml; u.pn = e * nNt + pn; return true;
    }
};

struct MapId { const float* src; int ld, nsrc; __device__ __forceinline__ const float* operator()(int n) const { return n < nsrc ? src + n : nullptr; }
    __device__ __forceinline__ MapId shifted(size_t off) const { return MapId{src + off, ld, nsrc}; } };
struct MapRope64 { const float* src; int ld; __device__ __forceinline__ const float* operator()(int n) const {
    if (n >= 2048) return src + n; const int p = n & 63, g = p >> 3, e = p & 7; return src + (n & ~63) + (e < 4 ? 4 * g + e : 32 + 4 * g + (e - 4)); }
    __device__ __forceinline__ MapRope64 shifted(size_t off) const { return MapRope64{src + off, ld}; } };
struct MapNsa { const float* src; int ld; __device__ __forceinline__ const float* operator()(int n) const {
    if (n >= 2584) return nullptr; if (n >= 2560) return src + n; const int p = n & 127, g = p >> 3, e = p & 7; return src + (n & ~127) + (e < 4 ? 4 * g + e : 64 + 4 * g + (e - 4)); }
    __device__ __forceinline__ MapNsa shifted(size_t off) const { return MapNsa{src + off, ld}; } };
struct MapGU { const float* gate; const float* up; int ld; __device__ __forceinline__ const float* operator()(int n) const {
    const int u = n >> 8, c = n & 255; return c < 128 ? gate + 128 * u + c : up + 128 * u + (c - 128); }
    __device__ __forceinline__ MapGU shifted(size_t off) const { return MapGU{gate + off, up + off, ld}; } };
template <class Map>
__device__ __forceinline__ void convert_T(ldsp_t lds, bf16_t* dst, int nb, size_t src_bstride, int Ndst, int K, const Map map0, int wg, int nwg) {
    const int tid = my_tid(), ntn = Ndst >> 6, per = ntn * (K >> 6), ntiles = per * nb;
    LAS bf16_t* tl = (LAS bf16_t*)lds;
    const int ln = tid & 63, lk = tid >> 6, sn = tid >> 3, skc = (tid & 7) * 8;
    float va[8], vb[8];
#define CT_LOAD(V, TILE) do { const int bi_ = (TILE) / per, tt_ = (TILE) % per, n0_ = (tt_ % ntn) << 6, k0_ = (tt_ / ntn) << 6; \
        const Map m_ = map0.shifted((size_t)bi_ * src_bstride); const float* cp_ = m_(n0_ + ln); \
        _Pragma("unroll") for (int it = 0; it < 8; ++it) V[it] = cp_ ? __builtin_nontemporal_load(cp_ + (size_t)(k0_ + lk + 8 * it) * m_.ld) : 0.f; } while (0)
    float vc[8], vd[8];
    int tile = wg, buf = 0;
    if (tile < ntiles) CT_LOAD(va, tile);
    if (tile + nwg < ntiles) CT_LOAD(vb, tile + nwg);
    if (tile + 2 * nwg < ntiles) CT_LOAD(vc, tile + 2 * nwg);
#define CT_STEP(VCUR, VNEW) do { if (tile < ntiles) { \
        if (tile + 3 * nwg < ntiles) CT_LOAD(VNEW, tile + 3 * nwg); \
        LAS bf16_t* tb = tl + buf * (64 * 66); \
        _Pragma("unroll") for (int it = 0; it < 8; ++it) tb[ln * 66 + lk + 8 * it] = f2bf(VCUR[it]); \
        __syncthreads(); \
        { const int bi = tile / per, tt = tile % per, n0 = (tt % ntn) << 6, k0 = (tt / ntn) << 6; \
          const LAS unsigned* rp = (const LAS unsigned*)(tb + sn * 66 + skc); \
          const u32x4 w = {rp[0], rp[1], rp[2], rp[3]}; \
          *(u32x4*)(dst + ((size_t)bi * Ndst + n0 + sn) * K + k0 + skc) = w; } \
        tile += nwg; buf ^= 1; } } while (0)
    while (tile < ntiles) { CT_STEP(va, vd); CT_STEP(vb, va); CT_STEP(vc, vb); CT_STEP(vd, vc); }
#undef CT_STEP
    __syncthreads();
#undef CT_LOAD
}

struct Route { int e0, e1, p0, p1; float g0, g1; int pad0, pad1; };
__device__ __forceinline__ void moe_segments_lds(const unsigned* cnt, LAS int* segL) {
    if (threadIdx.x == 0) { int s = 0;
        for (int e = 0; e < 8; ++e) { segL[e] = s; s += (int)((cnt[e] + 255u) & ~255u); }
        segL[8] = s; }
    __syncthreads();
}
__device__ __forceinline__ void ln_phase(ldsp_t lds, const bf16_t* src, float* dst_f32, bf16_t* dst_bf16, const float* lng, const float* lnb,
                                         const Route* route_in, const bf16_t* ybuf, const unsigned* cnt_in,
                                         const float* wrouter, Route* route_out, unsigned* cnt_out, int wg, int nwg) {
    const int tid = my_tid(), wid = tid >> 6, lane = tid & 63;
    LAS float* wl = (LAS float*)lds;
    LAS int* rinfo = (LAS int*)(lds + 32768);
    LAS unsigned* cntL = (LAS unsigned*)(lds + 32768 + 4096);
    LAS int* seg_start = (LAS int*)(lds + 32768 + 4096 + 256);
    if (route_in) moe_segments_lds(cnt_in, seg_start);
    if (wrouter) { for (int i = tid; i < 8192; i += 512) { const int d = i >> 3, e = i & 7; wl[e * 1024 + d] = wrouter[i]; } }
    f32x4 gv[4], bv[4];
#pragma unroll
    for (int q = 0; q < 4; ++q) { gv[q] = *(const f32x4*)(lng + 4 * lane + 256 * q); bv[q] = *(const f32x4*)(lnb + 4 * lane + 256 * q); }
    for (int chunk = wg; chunk < NT / 128; chunk += nwg) {
        if (wrouter) { if (tid < 8) cntL[tid] = 0u; }
        __syncthreads();
        u32x2 zn[4], yan[4], ybn[4]; Route rn; rn.e0 = 0; rn.e1 = 0; rn.p0 = 0; rn.p1 = 0; rn.g0 = 0.f; rn.g1 = 0.f; rn.pad0 = 0; rn.pad1 = 0;
#define LN_LOAD(ROW) do { _Pragma("unroll") for (int q = 0; q < 4; ++q) zn[q] = *(const u32x2*)(src + (size_t)(ROW) * DM + 4 * lane + 256 * q); \
            if (route_in) { rn = route_in[(ROW)]; const size_t s0_ = (size_t)(seg_start[rn.e0] + rn.p0) * DM, s1_ = (size_t)(seg_start[rn.e1] + rn.p1) * DM; \
                _Pragma("unroll") for (int q = 0; q < 4; ++q) { yan[q] = *(const u32x2*)(ybuf + s0_ + 4 * lane + 256 * q); ybn[q] = *(const u32x2*)(ybuf + s1_ + 4 * lane + 256 * q); } } } while (0)
        LN_LOAD(chunk * 128 + wid * 16);
        for (int i = 0; i < 16; ++i) {
            const int rl = wid * 16 + i, row = chunk * 128 + rl;
            f32x4 z[4]; u32x2 ya[4], yb[4]; const Route r = rn;
#pragma unroll
            for (int q = 0; q < 4; ++q) { const u32x2 w = zn[q]; ya[q] = yan[q]; yb[q] = ybn[q];
                z[q] = (f32x4){__uint_as_float(w[0] << 16), __uint_as_float(w[0] & 0xffff0000u), __uint_as_float(w[1] << 16), __uint_as_float(w[1] & 0xffff0000u)}; }
            if (i + 1 < 16) LN_LOAD(row + 1);
            if (route_in) {
#pragma unroll
                for (int q = 0; q < 4; ++q) { const u32x2 a = ya[q], b = yb[q];
                    z[q][0] = z[q][0] * ALPHA + r.g0 * __uint_as_float(a[0] << 16) + r.g1 * __uint_as_float(b[0] << 16);
                    z[q][1] = z[q][1] * ALPHA + r.g0 * __uint_as_float(a[0] & 0xffff0000u) + r.g1 * __uint_as_float(b[0] & 0xffff0000u);
                    z[q][2] = z[q][2] * ALPHA + r.g0 * __uint_as_float(a[1] << 16) + r.g1 * __uint_as_float(b[1] << 16);
                    z[q][3] = z[q][3] * ALPHA + r.g0 * __uint_as_float(a[1] & 0xffff0000u) + r.g1 * __uint_as_float(b[1] & 0xffff0000u); }
            }
            float s = 0.f;
#pragma unroll
            for (int q = 0; q < 4; ++q) s += (z[q][0] + z[q][1]) + (z[q][2] + z[q][3]);
            const float mean = wave_sum(s) * (1.f / DM);
            float v = 0.f;
#pragma unroll
            for (int q = 0; q < 4; ++q) { z[q] = z[q] - mean; v += (z[q][0] * z[q][0] + z[q][1] * z[q][1]) + (z[q][2] * z[q][2] + z[q][3] * z[q][3]); }
            const float rstd = rsqrtf(wave_sum(v) * (1.f / DM) + LN_EPS);
#pragma unroll
            for (int q = 0; q < 4; ++q) { z[q] = z[q] * rstd * gv[q] + bv[q]; if (dst_f32) *(f32x4*)(dst_f32 + (size_t)row * DM + 4 * lane + 256 * q) = z[q]; }
            if (dst_bf16) {
#pragma unroll
                for (int q = 0; q < 4; ++q) *(u32x2*)(dst_bf16 + (size_t)row * DM + 4 * lane + 256 * q) = (u32x2){cvtpk(z[q][0], z[q][1]), cvtpk(z[q][2], z[q][3])};
            }
            if (wrouter) {
                float lg[8];
#pragma unroll
                for (int e = 0; e < 8; ++e) { float a = 0.f;
#pragma unroll
                    for (int q = 0; q < 4; ++q) { const f32x4 w = *(const LAS f32x4*)(wl + e * 1024 + 4 * lane + 256 * q); a += z[q][0] * w[0] + z[q][1] * w[1] + z[q][2] * w[2] + z[q][3] * w[3]; }
                    lg[e] = wave_sum(a); }
                int e0 = 0; float v0 = lg[0];
#pragma unroll
                for (int e = 1; e < 8; ++e) if (lg[e] > v0) { v0 = lg[e]; e0 = e; }
                int e1 = -1; float v1 = -3.0e38f;
#pragma unroll
                for (int e = 0; e < 8; ++e) if (e != e0 && lg[e] > v1) { v1 = lg[e]; e1 = e; }
                if (e1 < 0) { e1 = (e0 + 1) & 7; v1 = v0; }
                if (lane == 0) {
                    const float g1 = 1.f / (1.f + __expf(v0 - v1)), g0 = 1.f - g1;
                    const int p0 = (int)atomicAdd((unsigned*)(cntL + e0), 1u), p1 = (int)atomicAdd((unsigned*)(cntL + e1), 1u);
                    rinfo[rl * 6 + 0] = e0; rinfo[rl * 6 + 1] = e1; rinfo[rl * 6 + 2] = p0; rinfo[rl * 6 + 3] = p1;
                    rinfo[rl * 6 + 4] = __float_as_int(g0); rinfo[rl * 6 + 5] = __float_as_int(g1);
                }
            }
        }
        if (wrouter) {
            __syncthreads();
            if (tid < 8) cntL[8 + tid] = atomicAdd(cnt_out + tid, cntL[tid]);
            __syncthreads();
            if (tid < 128) { Route r; r.e0 = rinfo[tid * 6 + 0]; r.e1 = rinfo[tid * 6 + 1];
                r.p0 = rinfo[tid * 6 + 2] + (int)cntL[8 + r.e0]; r.p1 = rinfo[tid * 6 + 3] + (int)cntL[8 + r.e1];
                r.g0 = __int_as_float(rinfo[tid * 6 + 4]); r.g1 = __int_as_float(rinfo[tid * 6 + 5]); r.pad0 = 0; r.pad1 = 0;
                route_out[chunk * 128 + tid] = r; }
            __syncthreads();
        }
    }
}
#undef LN_LOAD
__device__ __forceinline__ void moe_build_table(ldsp_t lds, int* tab, const Route* route, const unsigned* cnt, int wg, int nwg) {
    const int tid = my_tid();
    LAS int* seg_start = (LAS int*)lds; moe_segments_lds(cnt, seg_start);
    for (int t = wg * 512 + tid; t < NT; t += nwg * 512) { const Route r = route[t]; tab[seg_start[r.e0] + r.p0] = t; tab[seg_start[r.e1] + r.p1] = t; }
    for (int i = wg * 512 + tid; i < 8 * 256; i += nwg * 512) { const int e = i >> 8, k = i & 255; const int c = (int)cnt[e], pad = (c + 255) & ~255;
        if (c + k < pad) tab[seg_start[e] + c + k] = 0; }
    __syncthreads();
}

constexpr int HG_P144 = 144, HG_P272 = 272;
__device__ __forceinline__ void hgrn_passA(ldsp_t lds, const float* lf, const bf16_t* vv, bf16_t* ST, float* dec, int wg, int nwg) {
    const int tid = my_tid(), wid = tid >> 6, lane = tid & 63, r32 = lane & 31, hi = lane >> 5;
    const int d = tid & 127, sq = tid >> 7;
    ldsp_t KhT = lds, VT = lds + 128 * HG_P144; LAS float* tot = (LAS float*)(lds + 2 * 128 * HG_P144);
    float lfn[16]; bf16_t vnx[16];
#define HA_LOAD(IT) do { const int bh_ = (IT) >> 7, c_ = (IT) & 127, b_ = bh_ >> 3, h_ = bh_ & 7; const size_t t0_ = (size_t)b_ * SEQ + c_ * 64; \
        _Pragma("unroll") for (int tt = 0; tt < 16; ++tt) { const size_t o_ = (t0_ + 16 * sq + tt) * DM + h_ * 128 + d; lfn[tt] = lf[o_]; vnx[tt] = vv[o_]; } } while (0)
    if (wg < 4096) HA_LOAD(wg);
    for (int it = wg; it < 4096; it += nwg) {
        const int bh = it >> 7, c = it & 127, b = bh >> 3, h = bh & 7;
        const size_t tok0 = (size_t)b * SEQ + c * 64; (void)tok0; (void)b; (void)h;
        float lfv[16], cs[16]; bf16_t vraw[16];
#pragma unroll
        for (int tt = 0; tt < 16; ++tt) { lfv[tt] = lfn[tt]; vraw[tt] = vnx[tt]; }
        if (it + nwg < 4096) HA_LOAD(it + nwg);
        float run = 0.f;
#pragma unroll
        for (int tt = 0; tt < 16; ++tt) { run += lfv[tt]; cs[tt] = run; }
        tot[sq * 128 + d] = run;
        __syncthreads();
        float off = 0.f, cl = 0.f;
#pragma unroll
        for (int q = 0; q < 4; ++q) { const float t = tot[q * 128 + d]; cl += t; off += (q < sq) ? t : 0.f; }
        if (sq == 0) dec[(size_t)it * 128 + d] = __expf(cl);
        { unsigned w[8];
#pragma unroll
          for (int p = 0; p < 8; ++p) { const float c0 = off + cs[2 * p], c1 = off + cs[2 * p + 1];
              w[p] = cvtpk((1.f - __expf(lfv[2 * p])) * __expf(cl - c0), (1.f - __expf(lfv[2 * p + 1])) * __expf(cl - c1)); }
          *(LAS u32x4*)(KhT + d * HG_P144 + sq * 32) = (u32x4){w[0], w[1], w[2], w[3]};
          *(LAS u32x4*)(KhT + d * HG_P144 + sq * 32 + 16) = (u32x4){w[4], w[5], w[6], w[7]};
          unsigned x[8];
#pragma unroll
          for (int p = 0; p < 8; ++p) x[p] = (unsigned)vraw[2 * p] | ((unsigned)vraw[2 * p + 1] << 16);
          *(LAS u32x4*)(VT + d * HG_P144 + sq * 32) = (u32x4){x[0], x[1], x[2], x[3]};
          *(LAS u32x4*)(VT + d * HG_P144 + sq * 32 + 16) = (u32x4){x[4], x[5], x[6], x[7]}; }
        __syncthreads();
        const int mt = wid >> 1;
#pragma unroll
        for (int nn = 0; nn < 2; ++nn) { const int nt = (wid & 1) * 2 + nn; f32x16 acc = {};
#pragma unroll
            for (int ks = 0; ks < 4; ++ks) {
                const bf16x8 a = *(const LAS bf16x8*)(VT + (32 * mt + r32) * HG_P144 + (16 * ks + 8 * hi) * 2);
                const bf16x8 bb = *(const LAS bf16x8*)(KhT + (32 * nt + r32) * HG_P144 + (16 * ks + 8 * hi) * 2);
                acc = __builtin_amdgcn_mfma_f32_32x32x16_bf16(a, bb, acc, 0, 0, 0); }
#pragma unroll
            for (int r = 0; r < 16; ++r) { const int v = 32 * mt + (r & 3) + 8 * (r >> 2) + 4 * hi;
                ST[((size_t)it * 128 + v) * 128 + 32 * nt + r32] = f2bf(acc[r]); } }
        __syncthreads();
    }
}
#undef HA_LOAD
__device__ __forceinline__ void hgrn_passB(bf16_t* ST, const float* dec, int wg, int nwg) {
    for (int eg = wg * 512 + my_tid(); eg < 32 * 4096; eg += nwg * 512) {
        const int bh = eg >> 12, w = eg & 4095, v = w >> 5, d4 = (w & 31) * 4;
        float st[4] = {0.f, 0.f, 0.f, 0.f};
        for (int c0 = 0; c0 < 128; c0 += 8) {
            u32x2 kvr[8]; f32x4 dc[8];
#pragma unroll
            for (int j = 0; j < 8; ++j) { const size_t it = (size_t)bh * 128 + c0 + j;
                kvr[j] = *(const u32x2*)(ST + (it * 128 + v) * 128 + d4); dc[j] = *(const f32x4*)(dec + it * 128 + d4); }
#pragma unroll
            for (int j = 0; j < 8; ++j) { const size_t it = (size_t)bh * 128 + c0 + j;
                *(u32x2*)(ST + (it * 128 + v) * 128 + d4) = (u32x2){cvtpk(st[0], st[1]), cvtpk(st[2], st[3])};
                st[0] = dc[j][0] * st[0] + __uint_as_float(kvr[j][0] << 16); st[1] = dc[j][1] * st[1] + __uint_as_float(kvr[j][0] & 0xffff0000u);
                st[2] = dc[j][2] * st[2] + __uint_as_float(kvr[j][1] << 16); st[3] = dc[j][3] * st[3] + __uint_as_float(kvr[j][1] & 0xffff0000u); }
        }
    }
}
__device__ __forceinline__ void hgrn_passC(ldsp_t lds, const bf16_t* qs, const float* lf, const bf16_t* vv, const bf16_t* sg, const bf16_t* ST, const float* normg, bf16_t* ob, int wg, int nwg) {
    const int tid = my_tid(), wid = tid >> 6, lane = tid & 63, c16 = lane & 15, g = lane >> 4;
    const int d = tid & 127, sq = tid >> 7;
    ldsp_t Qi = lds, Qc = lds + 17408, Kt = lds + 2 * 17408, VT = lds + 2 * 17408 + 43520, STl = VT + 18432;
    LAS float* refs = (LAS float*)(STl + 34816); LAS float* tot = refs + 512; LAS float* ssq = tot + 512;
    float lfn[16]; bf16_t qn[16], vn[16]; u32x4 stn[4];
#define HC_LOAD(IT) do { const int bh_ = (IT) >> 7, c_ = (IT) & 127, b_ = bh_ >> 3, h_ = bh_ & 7; const size_t t0_ = (size_t)b_ * SEQ + c_ * 64; \
        _Pragma("unroll") for (int tt = 0; tt < 16; ++tt) { const size_t o_ = (t0_ + 16 * sq + tt) * DM + h_ * 128 + d; lfn[tt] = lf[o_]; qn[tt] = qs[o_]; vn[tt] = vv[o_]; } \
        _Pragma("unroll") for (int i4 = 0; i4 < 4; ++i4) { const int p = tid + 512 * i4, v = p >> 4, ch = p & 15; stn[i4] = *(const u32x4*)(ST + ((size_t)(IT) * 128 + v) * 128 + ch * 8); } } while (0)
    if (wg < 4096) HC_LOAD(wg);
    for (int it = wg; it < 4096; it += nwg) {
        const int bh = it >> 7, c = it & 127, b = bh >> 3, h = bh & 7;
        const size_t tok0 = (size_t)b * SEQ + c * 64;
        float lfv[16], cum[16]; bf16_t qraw[16], vraw[16];
#pragma unroll
        for (int tt = 0; tt < 16; ++tt) { lfv[tt] = lfn[tt]; qraw[tt] = qn[tt]; vraw[tt] = vn[tt]; }
        float run = 0.f;
#pragma unroll
        for (int tt = 0; tt < 16; ++tt) { run += lfv[tt]; cum[tt] = run; }
        tot[sq * 128 + d] = run;
#pragma unroll
        for (int i4 = 0; i4 < 4; ++i4) { const int p = tid + 512 * i4, v = p >> 4, ch = p & 15;
            *(LAS u32x4*)(STl + v * HG_P272 + ch * 16) = stn[i4]; }
        { unsigned x[8];
#pragma unroll
          for (int p = 0; p < 8; ++p) x[p] = (unsigned)vraw[2 * p] | ((unsigned)vraw[2 * p + 1] << 16);
          *(LAS u32x4*)(VT + d * HG_P144 + sq * 32) = (u32x4){x[0], x[1], x[2], x[3]};
          *(LAS u32x4*)(VT + d * HG_P144 + sq * 32 + 16) = (u32x4){x[4], x[5], x[6], x[7]}; }
        if (it + nwg < 4096) HC_LOAD(it + nwg);
        __syncthreads();
        float off = 0.f;
#pragma unroll
        for (int q = 0; q < 4; ++q) { const float t = tot[q * 128 + d]; off += (q < sq) ? t : 0.f; }
#pragma unroll
        for (int tt = 0; tt < 16; ++tt) cum[tt] += off;
        refs[sq * 128 + d] = cum[0];
        __syncthreads();
        float rf[4];
#pragma unroll
        for (int i = 0; i < 4; ++i) rf[i] = refs[i * 128 + d];
        float rme = rf[0];
#pragma unroll
        for (int i = 1; i < 4; ++i) rme = (sq == i) ? rf[i] : rme;
#pragma unroll
        for (int tt = 0; tt < 16; ++tt) { const int t = 16 * sq + tt; const float qv = bf2f(qraw[tt]);
            *(LAS bf16_t*)(Qi + t * HG_P272 + d * 2) = f2bf(qv * __expf(cum[tt] - rme));
            *(LAS bf16_t*)(Qc + t * HG_P272 + d * 2) = f2bf(qv * __expf(cum[tt]));
            const float kvv = 1.f - __expf(lfv[tt]);
#pragma unroll
            for (int i = 0; i < 4; ++i) { const int rb = (i == 0) ? 0 : (i == 1) ? 16 : (i == 2) ? 48 : 96;
                if (i >= sq) *(LAS bf16_t*)(Kt + (rb + t) * HG_P272 + d * 2) = f2bf(kvv * __expf(rf[i] - cum[tt])); } }
        __syncthreads();
        const int ib = wid >> 1, vh = wid & 1;
        const int rbI = (ib == 0) ? 0 : (ib == 1) ? 16 : (ib == 2) ? 48 : 96;
        f32x4 sc[4];
#pragma unroll
        for (int a = 0; a < 4; ++a) { sc[a] = (f32x4){0.f, 0.f, 0.f, 0.f};
            if (a <= ib) {
#pragma unroll
                for (int ks = 0; ks < 4; ++ks) {
                    const bf16x8 A = *(const LAS bf16x8*)(Kt + (rbI + 16 * a + c16) * HG_P272 + (32 * ks + 8 * g) * 2);
                    const bf16x8 B = *(const LAS bf16x8*)(Qi + (16 * ib + c16) * HG_P272 + (32 * ks + 8 * g) * 2);
                    sc[a] = __builtin_amdgcn_mfma_f32_16x16x32_bf16(A, B, sc[a], 0, 0, 0); }
                if (a == ib) {
#pragma unroll
                    for (int r = 0; r < 4; ++r) if (4 * g + r > c16) sc[a][r] = 0.f; } } }
        bf16x8 pb[2];
#pragma unroll
        for (int p = 0; p < 2; ++p) { const u32x4 w = {cvtpk(sc[2 * p][0], sc[2 * p][1]), cvtpk(sc[2 * p][2], sc[2 * p][3]), cvtpk(sc[2 * p + 1][0], sc[2 * p + 1][1]), cvtpk(sc[2 * p + 1][2], sc[2 * p + 1][3])};
            pb[p] = *reinterpret_cast<const bf16x8*>(&w); }
        f32x4 ao[4]; float ssl = 0.f;
#pragma unroll
        for (int vt = 0; vt < 4; ++vt) { ao[vt] = (f32x4){0.f, 0.f, 0.f, 0.f}; const int vrow = 16 * (4 * vh + vt) + c16;
#pragma unroll
            for (int p = 0; p < 2; ++p) if (2 * p <= ib) {
                const u32x2 lo = *(const LAS u32x2*)(VT + vrow * HG_P144 + (32 * p + 4 * g) * 2), hi2 = *(const LAS u32x2*)(VT + vrow * HG_P144 + (32 * p + 16 + 4 * g) * 2);
                const u32x4 w = {lo[0], lo[1], hi2[0], hi2[1]};
                ao[vt] = __builtin_amdgcn_mfma_f32_16x16x32_bf16(*reinterpret_cast<const bf16x8*>(&w), pb[p], ao[vt], 0, 0, 0); }
#pragma unroll
            for (int ks = 0; ks < 4; ++ks) {
                const bf16x8 A = *(const LAS bf16x8*)(STl + vrow * HG_P272 + (32 * ks + 8 * g) * 2);
                const bf16x8 B = *(const LAS bf16x8*)(Qc + (16 * ib + c16) * HG_P272 + (32 * ks + 8 * g) * 2);
                ao[vt] = __builtin_amdgcn_mfma_f32_16x16x32_bf16(A, B, ao[vt], 0, 0, 0); }
            ssl += ao[vt][0] * ao[vt][0] + ao[vt][1] * ao[vt][1] + ao[vt][2] * ao[vt][2] + ao[vt][3] * ao[vt][3]; }
        ssl += __shfl_xor(ssl, 16); ssl += __shfl_xor(ssl, 32);
        if (g == 0) ssq[vh * 64 + 16 * ib + c16] = ssl;
        __syncthreads();
        const float rs = rsqrtf((ssq[16 * ib + c16] + ssq[64 + 16 * ib + c16]) * (1.f / 128.f) + LN_EPS);
        const size_t trow = (tok0 + 16 * ib + c16) * DM + h * 128;
#pragma unroll
        for (int vt = 0; vt < 4; ++vt) { const int v0 = 16 * (4 * vh + vt) + 4 * g;
            const f32x4 ng = *(const f32x4*)(normg + v0); const u32x2 sgr = *(const u32x2*)(sg + trow + v0);
            const float o0 = ao[vt][0] * rs * ng[0] * __uint_as_float(sgr[0] << 16), o1 = ao[vt][1] * rs * ng[1] * __uint_as_float(sgr[0] & 0xffff0000u);
            const float o2 = ao[vt][2] * rs * ng[2] * __uint_as_float(sgr[1] << 16), o3 = ao[vt][3] * rs * ng[3] * __uint_as_float(sgr[1] & 0xffff0000u);
            *(u32x2*)(ob + trow + v0) = (u32x2){cvtpk(o0, o1), cvtpk(o2, o3)}; }
        __syncthreads();
    }
}

#undef HC_LOAD
#define KSWZ(row, colB) ((row) * 256 + ((colB) ^ (((row) & 7) << 4)))
__device__ __forceinline__ int q_park(int wid) { return wid < 4 ? 2 * 32768 + wid * 8192 : 3 * 32768 + 2048 + (wid - 4) * 8192; }
constexpr int AT_V = 0, AT_K = 16384, AT_BUF = 32768, AT_WS = 3 * 32768, AT_END = 3 * 32768 + 8 * 64 * 4;
__device__ __forceinline__ int v_st(int k, int c) { const int kk = (k & ~0xC) | ((k & 4) << 1) | ((k & 8) >> 1); return ((kk >> 3) * 4 + (c >> 5)) * 512 + ((kk & 7) * 32 + (c & 31)) * 2; }
__device__ __forceinline__ int v_rd_base(int lane) { return ((lane & 3) << 3) | (((lane >> 2) & 3) << 6) | (((lane >> 4) & 1) << 5) | (((lane >> 5) & 1) << 8); }
constexpr int v_rd_off(int d0, int ks, int half) { return d0 * 512 + ks * 4096 + half * 2048; }
__device__ __forceinline__ int crow(int r, int hi) { return (r & 3) + 8 * (r >> 2) + 4 * hi; }
template <int D0_LO, int D0_HI>
__device__ __forceinline__ void qkt_range(f32x16& p0, f32x16& p1, ldsp_t Kt, int r32, int hi, const bf16x8* qr) {
    p0 = f32x16{}; p1 = f32x16{};
    ldsp_t kb[4];
#pragma unroll
    for (int dd = 0; dd < 4; ++dd) kb[dd] = Kt + KSWZ(r32, (dd * 16 + hi * 8) * 2);
#pragma unroll
    for (int d0 = D0_LO; d0 < D0_HI; ++d0) {
        ldsp_t a = kb[d0 & 3] + (d0 >> 2) * 128;
        const bf16x8 b0 = *(const LAS bf16x8*)(a);
        const bf16x8 b1 = *(const LAS bf16x8*)(a + 32 * 256);
        p0 = __builtin_amdgcn_mfma_f32_32x32x16_bf16(b0, qr[d0], p0, 0, 0, 0);
        p1 = __builtin_amdgcn_mfma_f32_32x32x16_bf16(b1, qr[d0], p1, 0, 0, 0); }
}
template <int D0_LO, int D0_HI>
__device__ __forceinline__ void qkt_range_lq(f32x16& p0, f32x16& p1, ldsp_t Kt, ldsp_t Qw, int r32, int hi) {
    p0 = f32x16{}; p1 = f32x16{};
    int ko[4];
#pragma unroll
    for (int dd = 0; dd < 4; ++dd) ko[dd] = KSWZ(r32, (dd * 16 + hi * 8) * 2);
#pragma unroll
    for (int d0 = D0_LO; d0 < D0_HI; ++d0) {
        const int off = ko[d0 & 3] + (d0 >> 2) * 128;
        const bf16x8 b0 = *(const LAS bf16x8*)(Kt + off);
        const bf16x8 b1 = *(const LAS bf16x8*)(Kt + off + 32 * 256);
        const bf16x8 q = *(const LAS bf16x8*)(Qw + off);
        p0 = __builtin_amdgcn_mfma_f32_32x32x16_bf16(b0, q, p0, 0, 0, 0);
        p1 = __builtin_amdgcn_mfma_f32_32x32x16_bf16(b1, q, p1, 0, 0, 0); }
}
template <int ND>
__device__ __forceinline__ void qkt(f32x16& p0, f32x16& p1, ldsp_t Kt, int r32, int hi, const bf16x8* qr) {
    p0 = f32x16{}; p1 = f32x16{};
    ldsp_t kb[4];
#pragma unroll
    for (int dd = 0; dd < 4; ++dd) kb[dd] = Kt + KSWZ(r32, (dd * 16 + hi * 8) * 2);
#pragma unroll
    for (int d0 = 0; d0 < ND; ++d0) {
        ldsp_t a = kb[d0 & 3] + (d0 >> 2) * 128;
        const bf16x8 b0 = *(const LAS bf16x8*)(a);
        const bf16x8 b1 = *(const LAS bf16x8*)(a + 32 * 256);
        p0 = __builtin_amdgcn_mfma_f32_32x32x16_bf16(b0, qr[d0], p0, 0, 0, 0);
        p1 = __builtin_amdgcn_mfma_f32_32x32x16_bf16(b1, qr[d0], p1, 0, 0, 0); }
}
__device__ __forceinline__ void pv_tile(f32x16* o, unsigned vb0, bf16x8 pa0, bf16x8 pa1, bf16x8 pa2, bf16x8 pa3) {
#define TRRD(dst, off) asm volatile("ds_read_b64_tr_b16 %0, %1 offset:%2" : "=&v"(dst) : "v"(vb0), "i"(off) : "memory")
#define PV_D0(d0) do { s16x4 l0, l1, l2, l3, h0, h1, h2, h3; constexpr int b_ = v_rd_off(d0, 0, 0); \
        TRRD(l0, b_); TRRD(h0, b_ + 2048); TRRD(l1, b_ + 4096); TRRD(h1, b_ + 6144); TRRD(l2, b_ + 8192); TRRD(h2, b_ + 10240); TRRD(l3, b_ + 12288); TRRD(h3, b_ + 14336); \
        asm volatile("s_waitcnt lgkmcnt(0)" ::: "memory"); __builtin_amdgcn_sched_barrier(0); \
        o[d0] = __builtin_amdgcn_mfma_f32_32x32x16_bf16(pa0, (bf16x8){l0[0], l0[1], l0[2], l0[3], h0[0], h0[1], h0[2], h0[3]}, o[d0], 0, 0, 0);   \
        o[d0] = __builtin_amdgcn_mfma_f32_32x32x16_bf16(pa1, (bf16x8){l1[0], l1[1], l1[2], l1[3], h1[0], h1[1], h1[2], h1[3]}, o[d0], 0, 0, 0);   \
        o[d0] = __builtin_amdgcn_mfma_f32_32x32x16_bf16(pa2, (bf16x8){l2[0], l2[1], l2[2], l2[3], h2[0], h2[1], h2[2], h2[3]}, o[d0], 0, 0, 0);   \
        o[d0] = __builtin_amdgcn_mfma_f32_32x32x16_bf16(pa3, (bf16x8){l3[0], l3[1], l3[2], l3[3], h3[0], h3[1], h3[2], h3[3]}, o[d0], 0, 0, 0); } while (0)
    PV_D0(0); PV_D0(1); PV_D0(2); PV_D0(3);
#undef PV_D0
#undef TRRD
}
__device__ __forceinline__ void pv_tile_h(f32x16* o, unsigned vb0, bf16x8 pa0, bf16x8 pa1, bf16x8 pa2, bf16x8 pa3) {
#define TRRD(dst, off) asm volatile("ds_read_b64_tr_b16 %0, %1 offset:%2" : "=&v"(dst) : "v"(vb0), "i"(off) : "memory")
#define PV_D0(d0) do { constexpr int b_ = v_rd_off(d0, 0, 0); \
        { s16x4 l0, l1, h0, h1; TRRD(l0, b_); TRRD(h0, b_ + 2048); TRRD(l1, b_ + 4096); TRRD(h1, b_ + 6144); \
          asm volatile("s_waitcnt lgkmcnt(0)" ::: "memory"); __builtin_amdgcn_sched_barrier(0); \
          o[d0] = __builtin_amdgcn_mfma_f32_32x32x16_bf16(pa0, (bf16x8){l0[0], l0[1], l0[2], l0[3], h0[0], h0[1], h0[2], h0[3]}, o[d0], 0, 0, 0);   \
          o[d0] = __builtin_amdgcn_mfma_f32_32x32x16_bf16(pa1, (bf16x8){l1[0], l1[1], l1[2], l1[3], h1[0], h1[1], h1[2], h1[3]}, o[d0], 0, 0, 0); } \
        { s16x4 l2, l3, h2, h3; TRRD(l2, b_ + 8192); TRRD(h2, b_ + 10240); TRRD(l3, b_ + 12288); TRRD(h3, b_ + 14336); \
          asm volatile("s_waitcnt lgkmcnt(0)" ::: "memory"); __builtin_amdgcn_sched_barrier(0); \
          o[d0] = __builtin_amdgcn_mfma_f32_32x32x16_bf16(pa2, (bf16x8){l2[0], l2[1], l2[2], l2[3], h2[0], h2[1], h2[2], h2[3]}, o[d0], 0, 0, 0);   \
          o[d0] = __builtin_amdgcn_mfma_f32_32x32x16_bf16(pa3, (bf16x8){l3[0], l3[1], l3[2], l3[3], h3[0], h3[1], h3[2], h3[3]}, o[d0], 0, 0, 0); } } while (0)
    PV_D0(0); PV_D0(1); PV_D0(2); PV_D0(3);
#undef PV_D0
#undef TRRD
}
__device__ __forceinline__ void pv_tile2(f32x16* oa, f32x16* ob_, unsigned vb0, const bf16x8* pa, const bf16x8* pb) {
#define TRRD(dst, off) asm volatile("ds_read_b64_tr_b16 %0, %1 offset:%2" : "=&v"(dst) : "v"(vb0), "i"(off) : "memory")
#define PV_D0(d0) do { s16x4 l0, l1, l2, l3, h0, h1, h2, h3; constexpr int b_ = v_rd_off(d0, 0, 0); \
        TRRD(l0, b_); TRRD(h0, b_ + 2048); TRRD(l1, b_ + 4096); TRRD(h1, b_ + 6144); TRRD(l2, b_ + 8192); TRRD(h2, b_ + 10240); TRRD(l3, b_ + 12288); TRRD(h3, b_ + 14336); \
        asm volatile("s_waitcnt lgkmcnt(0)" ::: "memory"); __builtin_amdgcn_sched_barrier(0); \
        const bf16x8 v0_ = (bf16x8){l0[0], l0[1], l0[2], l0[3], h0[0], h0[1], h0[2], h0[3]}, v1_ = (bf16x8){l1[0], l1[1], l1[2], l1[3], h1[0], h1[1], h1[2], h1[3]}; \
        const bf16x8 v2_ = (bf16x8){l2[0], l2[1], l2[2], l2[3], h2[0], h2[1], h2[2], h2[3]}, v3_ = (bf16x8){l3[0], l3[1], l3[2], l3[3], h3[0], h3[1], h3[2], h3[3]}; \
        oa[d0] = __builtin_amdgcn_mfma_f32_32x32x16_bf16(pa[0], v0_, oa[d0], 0, 0, 0); ob_[d0] = __builtin_amdgcn_mfma_f32_32x32x16_bf16(pb[0], v0_, ob_[d0], 0, 0, 0); \
        oa[d0] = __builtin_amdgcn_mfma_f32_32x32x16_bf16(pa[1], v1_, oa[d0], 0, 0, 0); ob_[d0] = __builtin_amdgcn_mfma_f32_32x32x16_bf16(pb[1], v1_, ob_[d0], 0, 0, 0); \
        oa[d0] = __builtin_amdgcn_mfma_f32_32x32x16_bf16(pa[2], v2_, oa[d0], 0, 0, 0); ob_[d0] = __builtin_amdgcn_mfma_f32_32x32x16_bf16(pb[2], v2_, ob_[d0], 0, 0, 0); \
        oa[d0] = __builtin_amdgcn_mfma_f32_32x32x16_bf16(pa[3], v3_, oa[d0], 0, 0, 0); ob_[d0] = __builtin_amdgcn_mfma_f32_32x32x16_bf16(pb[3], v3_, ob_[d0], 0, 0, 0); } while (0)
    PV_D0(0); PV_D0(1); PV_D0(2); PV_D0(3);
#undef PV_D0
#undef TRRD
}
__device__ __forceinline__ void partialSM(f32x16& p0, f32x16& p1, float& m_reg, float& alpha, float scale, float C2) {
    float pmax = p0[0];
#pragma unroll
    for (int r = 1; r < 16; ++r) pmax = fmaxf(pmax, p0[r]);
#pragma unroll
    for (int r = 0; r < 16; ++r) pmax = fmaxf(pmax, p1[r]);
    { auto rr = __builtin_amdgcn_permlane32_swap(__float_as_uint(pmax), __float_as_uint(pmax), false, false);
      pmax = fmaxf(__uint_as_float(rr[0]), __uint_as_float(rr[1])); }
    float mn;
    if (__all((pmax - m_reg) * scale <= 8.f)) { mn = m_reg; alpha = 1.f; }
    else { mn = fmaxf(m_reg, pmax); alpha = __builtin_amdgcn_exp2f((m_reg - mn) * C2); m_reg = mn; }
    const float mnL = -mn * C2;
#pragma unroll
    for (int r = 0; r < 16; ++r) { p0[r] = __builtin_amdgcn_exp2f(fmaf(p0[r], C2, mnL)); p1[r] = __builtin_amdgcn_exp2f(fmaf(p1[r], C2, mnL)); }
}
__device__ __forceinline__ float rowsum32(const f32x16& p0, const f32x16& p1) {
    float ps = 0.f;
#pragma unroll
    for (int r = 0; r < 16; ++r) ps += p0[r];
#pragma unroll
    for (int r = 0; r < 16; ++r) ps += p1[r];
    auto rr = __builtin_amdgcn_permlane32_swap(__float_as_uint(ps), __float_as_uint(ps), false, false);
    return __uint_as_float(rr[0]) + __uint_as_float(rr[1]);
}
__device__ __forceinline__ void packP(const f32x16& p0, const f32x16& p1, bf16x8& pa0, bf16x8& pa1, bf16x8& pa2, bf16x8& pa3) {
#define PK4(P, B_, OUT) do { unsigned a0 = cvtpk(P[B_+0], P[B_+1]), a1 = cvtpk(P[B_+2], P[B_+3]);                          \
        unsigned b0 = cvtpk(P[B_+4], P[B_+5]), b1 = cvtpk(P[B_+6], P[B_+7]);                                             \
        auto r0 = __builtin_amdgcn_permlane32_swap(a0, b0, false, false); auto r1 = __builtin_amdgcn_permlane32_swap(a1, b1, false, false); \
        u32x4 w = {r0[0], r1[0], r0[1], r1[1]}; OUT = *reinterpret_cast<bf16x8*>(&w); } while (0)
    PK4(p0, 0, pa0); PK4(p0, 8, pa1); PK4(p1, 0, pa2); PK4(p1, 8, pa3);
#undef PK4
}
__device__ __forceinline__ void rescaleO(f32x16* o, float alpha, LAS float* al_l, int r32, int hi) {
    if (__any(alpha < 1.f)) {
        if (hi == 0) al_l[r32] = alpha;
        asm volatile("s_waitcnt lgkmcnt(0)" ::: "memory");
#pragma unroll
        for (int q = 0; q < 4; ++q) { const f32x4 a = *(const LAS f32x4*)(al_l + 8 * q + 4 * hi);
#pragma unroll
            for (int d_ = 0; d_ < 4; ++d_)
#pragma unroll
                for (int i = 0; i < 4; ++i) o[d_][4 * q + i] *= a[i]; }
    }
}
__device__ __forceinline__ void row_scalars(float x, float* out16, LAS float* li_l, int r32, int hi) {
    if (hi == 0) li_l[r32] = x;
    asm volatile("s_waitcnt lgkmcnt(0)" ::: "memory");
#pragma unroll
    for (int r = 0; r < 16; ++r) out16[r] = li_l[crow(r, hi)];
    asm volatile("s_waitcnt lgkmcnt(0)" ::: "memory");
}
struct KVStage { bf16x8 k0, k1, v0, v1; };
template <int ND, bool WITH_V>
__device__ __forceinline__ void stage_load(KVStage& s, const bf16_t* Kg, const bf16_t* Vg, int tid) {
    if (ND == 8) { const int sr = tid >> 4, sc = (tid & 15) * 8;
        s.k0 = *(const bf16x8*)(Kg + (size_t)sr * 128 + sc); s.k1 = *(const bf16x8*)(Kg + (size_t)(32 + sr) * 128 + sc); }
    else { const int key = tid >> 3, c8 = (tid & 7) * 8; s.k0 = *(const bf16x8*)(Kg + (size_t)key * 64 + c8); }
    if (WITH_V) { const int sr = tid >> 4, sc = (tid & 15) * 8;
        s.v0 = *(const bf16x8*)(Vg + (size_t)sr * 128 + sc); s.v1 = *(const bf16x8*)(Vg + (size_t)(32 + sr) * 128 + sc); }
}
template <int ND, bool WITH_V>
__device__ __forceinline__ void stage_write(const KVStage& s, ldsp_t lds, int tid) {
    if (ND == 8) { const int sr = tid >> 4, sc = (tid & 15) * 8, kws = KSWZ(sr, sc * 2);
        *(LAS bf16x8*)(lds + AT_K + kws) = s.k0; *(LAS bf16x8*)(lds + AT_K + kws + 32 * 256) = s.k1; }
    else { const int key = tid >> 3, c8 = (tid & 7) * 8; *(LAS bf16x8*)(lds + AT_K + KSWZ(key, c8 * 2)) = s.k0; }
    if (WITH_V) { const int sr = tid >> 4, sc = (tid & 15) * 8;
        *(LAS bf16x8*)(lds + AT_V + v_st(sr, sc)) = s.v0; *(LAS bf16x8*)(lds + AT_V + v_st(32 + sr, sc)) = s.v1; }
}
__device__ __forceinline__ void stage_dma(ldsp_t buf, const bf16_t* Kg, const bf16_t* Vg, int wid_u, int lane) {
#pragma unroll
    for (int i = 0; i < 2; ++i) { const int q = (i * 8 + wid_u) * 64 + lane, row = q >> 4, cpos = q & 15;
        __builtin_amdgcn_global_load_lds((const unsigned*)(Kg + (size_t)row * 128 + ((cpos ^ (row & 7)) * 8)), (LAS unsigned*)(buf + AT_K + (i * 8 + wid_u) * 1024), 16, 0, 0); }
#pragma unroll
    for (int i = 0; i < 2; ++i) { const int q = (i * 8 + wid_u) * 64 + lane, sub = q >> 5, w5 = q & 31;
        const int kk = (sub >> 2) * 8 + (w5 >> 2), c = (sub & 3) * 32 + (w5 & 3) * 8, k = (kk & ~0xC) | ((kk & 4) << 1) | ((kk & 8) >> 1);
        __builtin_amdgcn_global_load_lds((const unsigned*)(Vg + (size_t)k * 128 + c), (LAS unsigned*)(buf + AT_V + (i * 8 + wid_u) * 1024), 16, 0, 0); }
}
enum { MK_CAUSAL = 0, MK_WINDOW = 1, MK_SLC = 2 };
template <int MK>
__device__ __forceinline__ int sweep_next(int j, int j_hi, unsigned un0, unsigned un1, unsigned un2, unsigned un3) {
    if (MK == MK_SLC) { while (j < j_hi) { const unsigned uw = (j < 32) ? un0 : (j < 64) ? un1 : (j < 96) ? un2 : un3; if ((uw >> (j & 31)) & 1u) break; ++j; } }
    return j;
}
template <int MK, int ND>
__device__ __forceinline__ void attn_sweep(ldsp_t lds, const bf16x8* qr, const bf16_t* Kg, const bf16_t* Vg, int j_lo, int j_hi, int pos,
                                           unsigned sel0, unsigned sel1, unsigned sel2, unsigned sel3, unsigned un0, unsigned un1, unsigned un2, unsigned un3,
                                           f32x16* o, float& m_reg, float& l_reg, float scale, int wspan) {
    const int tid = my_tid(), wid = tid >> 6, lane = tid & 63, r32 = lane & 31, hi = lane >> 5;
    const float C2 = scale * 1.4426950408889634f;
    LAS float* al_l = (LAS float*)(lds + AT_WS) + wid * 64;
    const unsigned vb0 = (unsigned)(size_t)(lds + AT_V) + v_rd_base(lane);
    const float NEG = -__builtin_inff();
    const int wpos0 = __builtin_amdgcn_readfirstlane(pos);
    static_assert(ND == 8, "LDS-DMA staging is written for 128-wide K rows");
    const int wid_u = __builtin_amdgcn_readfirstlane(wid);
    int j = sweep_next<MK>(j_lo, j_hi, un0, un1, un2, un3);
    if (j >= j_hi) { __syncthreads(); return; }
    int j1 = sweep_next<MK>(j + 1, j_hi, un0, un1, un2, un3);
    stage_dma(lds, Kg + (size_t)j * 64 * 128, Vg + (size_t)j * 64 * 128, wid_u, lane);
    if (j1 < j_hi) stage_dma(lds + AT_BUF, Kg + (size_t)j1 * 64 * 128, Vg + (size_t)j1 * 64 * 128, wid_u, lane);
    if (j1 < j_hi) asm volatile("s_waitcnt vmcnt(4)" ::: "memory"); else asm volatile("s_waitcnt vmcnt(0)" ::: "memory");
    __builtin_amdgcn_s_barrier(); asm volatile("" ::: "memory");
    int cur = 0;
    for (;;) {
        const int j2 = (j1 < j_hi) ? sweep_next<MK>(j1 + 1, j_hi, un0, un1, un2, un3) : j_hi;
        const int nb2 = cur >= 1 ? cur - 1 : 2;
        if (j2 < j_hi) stage_dma(lds + nb2 * AT_BUF, Kg + (size_t)j2 * 64 * 128, Vg + (size_t)j2 * 64 * 128, wid_u, lane);
        bool tsel = true;
        if (MK == MK_SLC) { const unsigned sw = (j < 32) ? sel0 : (j < 64) ? sel1 : (j < 96) ? sel2 : sel3; tsel = (sw >> (j & 31)) & 1u; }
        if (MK != MK_SLC || __any(tsel)) {
        f32x16 p0, p1; qkt<ND>(p0, p1, lds + cur * AT_BUF + AT_K, r32, hi, qr);
        bool need = (j * 64 + 63 > wpos0);
        if (MK == MK_WINDOW) need = need || (j * 64 <= wpos0 + wspan - 512);
        if (need) { const int kb = j * 64 + 4 * hi;
#pragma unroll
            for (int r = 0; r < 16; ++r) { const int k0 = kb + (r & 3) + 8 * (r >> 2), k1 = k0 + 32;
                bool ok0 = k0 <= pos, ok1 = k1 <= pos;
                if (MK == MK_WINDOW) { ok0 = ok0 && (k0 > pos - 512); ok1 = ok1 && (k1 > pos - 512); }
                if (!ok0) p0[r] = NEG; if (!ok1) p1[r] = NEG; } }
        if (MK == MK_SLC) { if (!__all(tsel)) {
#pragma unroll
            for (int r = 0; r < 16; ++r) { p0[r] = tsel ? p0[r] : NEG; p1[r] = tsel ? p1[r] : NEG; } } }
        float alpha; partialSM(p0, p1, m_reg, alpha, scale, C2);
        rescaleO(o, alpha, al_l, r32, hi);
        l_reg = l_reg * alpha + rowsum32(p0, p1);
        bf16x8 pa0, pa1, pa2, pa3; packP(p0, p1, pa0, pa1, pa2, pa3);
        pv_tile(o, vb0 + cur * AT_BUF, pa0, pa1, pa2, pa3);
        }
        if (j2 < j_hi) asm volatile("s_waitcnt vmcnt(4) lgkmcnt(0)" ::: "memory"); else asm volatile("s_waitcnt vmcnt(0) lgkmcnt(0)" ::: "memory");
        __builtin_amdgcn_s_barrier(); asm volatile("" ::: "memory");
        if (j1 >= j_hi) break;
        j = j1; j1 = j2; cur = cur == 2 ? 0 : cur + 1;
    }
}
__device__ __forceinline__ void store_O_bf16(const f32x16* o, const float* rs16, bf16_t* base  , size_t ld, int r32, int hi) {
#pragma unroll
    for (int r = 0; r < 16; ++r) { const int orow = crow(r, hi);
#pragma unroll
        for (int d0 = 0; d0 < 4; ++d0) { const float v = o[d0][r] * rs16[r]; const float vn = __shfl_xor(v, 1);
            if ((r32 & 1) == 0) *(unsigned*)(base + (size_t)orow * ld + d0 * 32 + r32) = cvtpk(v, vn); } }
}
__device__ __forceinline__ void da_sweep(ldsp_t lds, const bf16_t* Q, const bf16_t* K, const bf16_t* V, int bh, int qb, f32x16* o0, f32x16* o1, float& l0, float& l1) {
    const float SCALE = 0.125f, C2 = SCALE * 1.4426950408889634f, NEG = -__builtin_inff();
    const int tid = my_tid(), wid = tid >> 6, lane = tid & 63, r32 = lane & 31, hi = lane >> 5;
    LAS float* al_l = (LAS float*)(lds + AT_WS) + wid * 64;
    const unsigned vb0 = (unsigned)(size_t)(lds + AT_V) + v_rd_base(lane);
    const bf16_t* Kg = K + (size_t)bh * SEQ * 128; const bf16_t* Vg = V + (size_t)bh * SEQ * 128;
    ldsp_t Qw = lds + q_park(wid);
    { const bf16_t* Qb = Q + ((size_t)bh * SEQ + qb * 256 + wid * 32 + r32) * 128;
#pragma unroll
      for (int d0 = 0; d0 < 8; ++d0) *(LAS bf16x8*)(Qw + KSWZ(r32, (d0 * 16 + hi * 8) * 2)) = *(const bf16x8*)(Qb + d0 * 16 + hi * 8); }
    float m0 = -1e30f, m1 = -1e30f;
    const int wpos0 = qb * 256 + wid * 32, pos = wpos0 + r32, j_hi = 4 * (qb + 1);
    const int wid_u = __builtin_amdgcn_readfirstlane(wid);
    __syncthreads();
    stage_dma(lds, Kg, Vg, wid_u, lane);
    __syncthreads();
    int cur = 0;
    for (int j = 0; j < j_hi; ++j) {
        const bool has = j + 1 < j_hi;
        if (has) stage_dma(lds + (cur ^ 1) * AT_BUF, Kg + (size_t)(j + 1) * 64 * 128, Vg + (size_t)(j + 1) * 64 * 128, wid_u, lane);
        const bool need = (j * 64 + 63 > wpos0);
        const int kb = j * 64 + 4 * hi;
        if (j * 64 <= wpos0 + 31) {
        { f32x16 p0, p1; qkt_range_lq<0, 4>(p0, p1, lds + cur * AT_BUF + AT_K, Qw, r32, hi);
          if (need) {
#pragma unroll
              for (int r = 0; r < 16; ++r) { const int k0 = kb + (r & 3) + 8 * (r >> 2); if (k0 > pos) p0[r] = NEG; if (k0 + 32 > pos) p1[r] = NEG; } }
          float a0; partialSM(p0, p1, m0, a0, SCALE, C2); l0 = l0 * a0 + rowsum32(p0, p1);
          bf16x8 pa0, pa1, pa2, pa3; packP(p0, p1, pa0, pa1, pa2, pa3);
          rescaleO(o0, a0, al_l, r32, hi); pv_tile_h(o0, vb0 + cur * AT_BUF, pa0, pa1, pa2, pa3); }
        { f32x16 p0, p1; qkt_range_lq<4, 8>(p0, p1, lds + cur * AT_BUF + AT_K, Qw, r32, hi);
          if (need) {
#pragma unroll
              for (int r = 0; r < 16; ++r) { const int k0 = kb + (r & 3) + 8 * (r >> 2); if (k0 > pos) p0[r] = NEG; if (k0 + 32 > pos) p1[r] = NEG; } }
          float a1; partialSM(p0, p1, m1, a1, SCALE, C2); l1 = l1 * a1 + rowsum32(p0, p1);
          bf16x8 pa0, pa1, pa2, pa3; packP(p0, p1, pa0, pa1, pa2, pa3);
          rescaleO(o1, a1, al_l, r32, hi); pv_tile_h(o1, vb0 + cur * AT_BUF, pa0, pa1, pa2, pa3); }
        }
        __syncthreads();
        cur ^= 1;
    }
}
__device__ __forceinline__ void da_epilogue(ldsp_t lds, const f32x16* o0, const f32x16* o1, float l0, float l1, const float* lam, const float* normg, bf16_t* ob, int b, int h, int qb) {
    const float LAM_INIT = 0.35550906759096934f;
    const int tid = my_tid(), wid = tid >> 6, lane = tid & 63, r32 = lane & 31, hi = lane >> 5;
    LAS float* li_l = (LAS float*)(lds + AT_WS) + wid * 64 + 32;
    const float s1 = wave_sum(lam[lane] * lam[64 + lane]), s2 = wave_sum(lam[128 + lane] * lam[192 + lane]);
    const float lmb = __expf(s1) - __expf(s2) + LAM_INIT;
    float i0[16], i1[16]; row_scalars(1.f / l0, i0, li_l, r32, hi); row_scalars(lmb / l1, i1, li_l, r32, hi);
    float ng[4];
#pragma unroll
    for (int d0 = 0; d0 < 4; ++d0) ng[d0] = normg[d0 * 32 + r32] * (1.f - LAM_INIT);
    bf16_t* Ob = ob + ((size_t)b * SEQ + qb * 256 + wid * 32) * DM + h * 128;
#pragma unroll
    for (int r = 0; r < 16; ++r) {
        float x[4], ss = 0.f;
#pragma unroll
        for (int d0 = 0; d0 < 4; ++d0) { x[d0] = o0[d0][r] * i0[r] - o1[d0][r] * i1[r]; ss += x[d0] * x[d0]; }
        ss += __shfl_xor(ss, 1); ss += __shfl_xor(ss, 2); ss += __shfl_xor(ss, 4); ss += __shfl_xor(ss, 8); ss += __shfl_xor(ss, 16);
        const float rs = rsqrtf(ss * (1.f / 128.f) + LN_EPS);
        const int orow = crow(r, hi);
#pragma unroll
        for (int d0 = 0; d0 < 4; ++d0) { const float v = x[d0] * rs * ng[d0]; const float vn = __shfl_xor(v, 1);
            if ((r32 & 1) == 0) *(unsigned*)(Ob + (size_t)orow * DM + d0 * 32 + r32) = cvtpk(v, vn); } }
}
__device__ __forceinline__ void da_attn_phase(ldsp_t lds, const bf16_t* Q, const bf16_t* K, const bf16_t* V, const float* lam, const float* normg, bf16_t* ob, int wg, int nwg) {
    const int nround = (1024 + nwg - 1) / nwg;
    for (int n = 0; n < nround; ++n) {
        const int idx = n * nwg + ((n & 1) ? (nwg - 1 - wg) : wg);
        if (idx >= 1024) continue;
        const int qb = 31 - (idx >> 5), bh = idx & 31, b = bh >> 3, h = bh & 7;
        f32x16 o0[4] = {}, o1[4] = {}; float l0 = 0.f, l1 = 0.f;
        da_sweep(lds, Q, K, V, bh, qb, o0, o1, l0, l1);
        da_epilogue(lds, o0, o1, l0, l1, lam, normg, ob, b, h, qb);
        __syncthreads();
    }
}
__device__ __forceinline__ void sb_attn_phase(ldsp_t lds, const bf16_t* Q, const bf16_t* K, const bf16_t* V, bf16_t* ob, int wg, int nwg) {
    const int tid = my_tid(), wid = tid >> 6, lane = tid & 63, r32 = lane & 31, hi = lane >> 5;
    const float SCALE = 0.08838834764831845f;
    LAS int* flags = (LAS int*)(lds + LDS_MISC - 64);
    const unsigned vb0 = (unsigned)(size_t)(lds + AT_V) + v_rd_base(lane);
    for (int idx = wg; idx < 1024; idx += nwg) {
        const int qb = idx >> 5, bh = idx & 31, b = bh >> 3, h = bh & 7;
        const bf16_t* Qb = Q + ((size_t)bh * SEQ + qb * 256 + wid * 32 + r32) * 128;
        const bf16_t* Kb = K + (size_t)bh * SEQ * 128; const bf16_t* Vb = V + (size_t)bh * SEQ * 128;
        ldsp_t Qw = lds + q_park(wid);
#pragma unroll
        for (int d0 = 0; d0 < 8; ++d0) *(LAS bf16x8*)(Qw + KSWZ(r32, (d0 * 16 + hi * 8) * 2)) = *(const bf16x8*)(Qb + d0 * 16 + hi * 8);
        f32x16 o[4] = {}; float R = 0.f; bool done = false;
        const int wpos0 = qb * 256 + wid * 32, pos = wpos0 + r32;
        const int wid_u = __builtin_amdgcn_readfirstlane(wid);
        stage_dma(lds, Kb + (size_t)(4 * qb + 3) * 64 * 128, Vb + (size_t)(4 * qb + 3) * 64 * 128, wid_u, lane);
        int cur = 0;
        for (int j = 4 * qb + 3; j >= 0; --j) {
            if (lane == 0) flags[wid] = done ? 1 : 0;
            __syncthreads();
            int alld = 1;
#pragma unroll
            for (int k = 0; k < 8; ++k) alld &= flags[k];
            if (alld) break;
            if (j > 0) stage_dma(lds + (cur ^ 1) * AT_BUF, Kb + (size_t)(j - 1) * 64 * 128, Vb + (size_t)(j - 1) * 64 * 128, wid_u, lane);
            const unsigned vbc = vb0 + cur * AT_BUF; ldsp_t Kt = lds + cur * AT_BUF + AT_K;
            cur ^= 1;
            if (!done && 64 * j < wpos0 + 31) {
                f32x16 p0, p1; qkt_range_lq<0, 8>(p0, p1, Kt, Qw, r32, hi);
                float l0[16], l1[16];
                const int kb = j * 64 + 4 * hi;
#pragma unroll
                for (int r = 0; r < 16; ++r) { const int k0 = kb + (r & 3) + 8 * (r >> 2), k1 = k0 + 32;
                    const float z0 = p0[r] * SCALE, z1 = p1[r] * SCALE;
                    const float sp0 = fmaxf(z0, 0.f) + __logf(1.f + __expf(-fabsf(z0))), sp1 = fmaxf(z1, 0.f) + __logf(1.f + __expf(-fabsf(z1)));
                    l0[r] = (k0 < pos) ? -sp0 : 0.f; l1[r] = (k1 < pos) ? -sp1 : 0.f; p0[r] = z0; p1[r] = z1; }
                float gs0[4], gs1[4], pg0[4], pg1[4], A0[4], A1[4];
#pragma unroll
                for (int q = 0; q < 4; ++q) { gs0[q] = (l0[4 * q] + l0[4 * q + 1]) + (l0[4 * q + 2] + l0[4 * q + 3]); gs1[q] = (l1[4 * q] + l1[4 * q + 1]) + (l1[4 * q + 2] + l1[4 * q + 3]); }
#pragma unroll
                for (int q = 0; q < 4; ++q) { pg0[q] = __shfl_xor(gs0[q], 32); pg1[q] = __shfl_xor(gs1[q], 32); }
                const float t00 = gs0[0] + pg0[0], t01 = gs0[1] + pg0[1], t02 = gs0[2] + pg0[2], t03 = gs0[3] + pg0[3];
                const float t10 = gs1[0] + pg1[0], t11 = gs1[1] + pg1[1], t12 = gs1[2] + pg1[2], t13 = gs1[3] + pg1[3];
                const float T1 = (t10 + t11) + (t12 + t13), T0 = (t00 + t01) + (t02 + t03);
                A0[3] = T1; A0[2] = A0[3] + t03; A0[1] = A0[2] + t02; A0[0] = A0[1] + t01;
                A1[3] = 0.f; A1[2] = t13; A1[1] = A1[2] + t12; A1[0] = A1[1] + t11;
                if (hi == 0) {
#pragma unroll
                    for (int q = 0; q < 4; ++q) { A0[q] += pg0[q]; A1[q] += pg1[q]; } }
#pragma unroll
                for (int q = 0; q < 4; ++q) {
                    float af0 = A0[q] + R, af1 = A1[q] + R;
#pragma unroll
                    for (int i = 3; i >= 0; --i) { const int r = 4 * q + i; const int k0 = kb + i + 8 * q, k1 = k0 + 32;
                        const float a0 = (k0 < pos) ? __expf(p0[r] + l0[r] + af0) : 0.f, a1 = (k1 < pos) ? __expf(p1[r] + l1[r] + af1) : 0.f;
                        af0 += l0[r]; af1 += l1[r]; p0[r] = a0; p1[r] = a1; } }
                R += T0 + T1;
                bf16x8 pa0, pa1, pa2, pa3; packP(p0, p1, pa0, pa1, pa2, pa3);
                pv_tile(o, vbc, pa0, pa1, pa2, pa3);
                done = __all(R < -104.f);
            }
        }
        __syncthreads();
        float one[16];
#pragma unroll
        for (int r = 0; r < 16; ++r) one[r] = 1.f;
        store_O_bf16(o, one, ob + ((size_t)b * SEQ + qb * 256 + wid * 32) * DM + h * 128, DM, r32, hi);
    }
}

__device__ __forceinline__ float gelu_tanh(float x) { const float u = 0.7978845608028654f * (x + 0.044715f * x * x * x); const float e = __expf(2.f * u); const float th = 1.f - 2.f / (e + 1.f); return 0.5f * x * (1.f + th); }
__device__ __forceinline__ void nsa_compress_phase(ldsp_t lds, const bf16_t* kv, const bf16_t* W1t, const bf16_t* W2t, const float* biasp, bf16_t* KC, int wg, int nwg) {
    const int tid = my_tid(), wid = tid >> 6, lane = tid & 63, c16 = lane & 15, g = lane >> 4;
    const int rg = wid & 1, ch = wid >> 1;
    ldsp_t H1 = lds;
    LAS float* biasL = (LAS float*)(lds + 32 * HG_P272);
    if (tid < 256) { float sacc = 0.f; for (int p = 0; p < 32; ++p) sacc += biasp[((tid >> 7) * 32 + p) * 128 + (tid & 127)]; biasL[tid] = sacc; }
    __syncthreads();
    for (int it = wg; it < 256; it += nwg) {
        const int jj = it >> 7, bg = (it >> 4) & 7, ct = it & 15;
        const bf16_t* X = kv + ((size_t)(jj * 8 + bg) * SEQ) * 128;
        const bf16_t* W1 = W1t + (size_t)jj * 128 * 4096; const bf16_t* W2 = W2t + (size_t)jj * 128 * 128;
        int crow_ = ct * 32 + rg * 16 + c16; if (crow_ > 510) crow_ = 510;
        const bf16_t* Ar = X + (size_t)crow_ * 16 * 128 + 8 * g;
        const bf16_t* Br = W1 + (size_t)(32 * ch + c16) * 4096 + 8 * g;
        f32x4 acc[2];
#pragma unroll
        for (int nt = 0; nt < 2; ++nt) acc[nt] = (f32x4){0.f, 0.f, 0.f, 0.f};
        for (int ks = 0; ks < 128; ks += 4) {
            bf16x8 A[4], B[4][2];
#pragma unroll
            for (int u = 0; u < 4; ++u) { A[u] = *(const bf16x8*)(Ar + (ks + u) * 32);
#pragma unroll
                for (int nt = 0; nt < 2; ++nt) B[u][nt] = *(const bf16x8*)(Br + (size_t)(16 * nt) * 4096 + (ks + u) * 32); }
#pragma unroll
            for (int u = 0; u < 4; ++u)
#pragma unroll
                for (int nt = 0; nt < 2; ++nt) acc[nt] = __builtin_amdgcn_mfma_f32_16x16x32_bf16(A[u], B[u][nt], acc[nt], 0, 0, 0); }
#pragma unroll
        for (int nt = 0; nt < 2; ++nt) { const int n = 32 * ch + 16 * nt + c16; const float bs = biasL[jj * 128 + n];
#pragma unroll
            for (int r = 0; r < 4; ++r) *(LAS bf16_t*)(H1 + (16 * rg + 4 * g + r) * HG_P272 + n * 2) = f2bf(gelu_tanh(acc[nt][r] + bs)); }
        __syncthreads();
        f32x4 ac2[2];
#pragma unroll
        for (int nt = 0; nt < 2; ++nt) { ac2[nt] = (f32x4){0.f, 0.f, 0.f, 0.f};
#pragma unroll
            for (int ks = 0; ks < 4; ++ks) { const bf16x8 A = *(const LAS bf16x8*)(H1 + (16 * rg + c16) * HG_P272 + (32 * ks + 8 * g) * 2);
                const bf16x8 B = *(const bf16x8*)(W2 + (size_t)(32 * ch + 16 * nt + c16) * 128 + 32 * ks + 8 * g);
                ac2[nt] = __builtin_amdgcn_mfma_f32_16x16x32_bf16(A, B, ac2[nt], 0, 0, 0); } }
#pragma unroll
        for (int nt = 0; nt < 2; ++nt)
#pragma unroll
            for (int r = 0; r < 4; ++r) { const int c = ct * 32 + rg * 16 + 4 * g + r; const int n = 32 * ch + 16 * nt + c16;
                KC[((size_t)(jj * 8 + bg) * NCMP_P + c) * 128 + n] = (c <= 510) ? f2bf(ac2[nt][r]) : (bf16_t)0; }
        __syncthreads();
    }
}
constexpr int NS_IMPP = AT_END, NS_IMPS = NS_IMPP + 4096, NS_IMP = NS_IMPS + 4096, NS_CARRY = NS_IMP + 33792, NS_SEL = NS_CARRY + 512, NS_UN = NS_SEL + 1024, NS_END = NS_UN + 16;
static_assert(NS_END <= LDS_MISC, "NSA LDS");
__device__ __forceinline__ void nsa_cmp_sweep1(ldsp_t lds, const bf16x8* qr, const bf16_t* kcb, const bf16_t* vcb, int ntile, int pos, float& m_reg, float& l_reg) {
    const int tid = my_tid(), wid_u = __builtin_amdgcn_readfirstlane(tid >> 6), lane = tid & 63, r32 = lane & 31, hi = lane >> 5;
    const float SCALE = 0.08838834764831845f, C2 = SCALE * 1.4426950408889634f, NEG = -__builtin_inff();
    stage_dma(lds, kcb, vcb, wid_u, lane);
    int cur = 0;
    for (int jt = 0; jt < ntile; ++jt) {
        __syncthreads();
        if (jt + 1 < ntile) stage_dma(lds + (cur ^ 1) * AT_BUF, kcb + (size_t)(jt + 1) * 64 * 128, vcb + (size_t)(jt + 1) * 64 * 128, wid_u, lane);
        f32x16 p0, p1; qkt<8>(p0, p1, lds + cur * AT_BUF + AT_K, r32, hi, qr);
        const int kb = jt * 64 + 4 * hi;
#pragma unroll
        for (int r = 0; r < 16; ++r) { const int c0 = kb + (r & 3) + 8 * (r >> 2), c1 = c0 + 32;
            if (!(c0 < NCMP && 16 * c0 + 31 <= pos)) p0[r] = NEG; if (!(c1 < NCMP && 16 * c1 + 31 <= pos)) p1[r] = NEG; }
        float alpha; partialSM(p0, p1, m_reg, alpha, SCALE, C2);
        l_reg = l_reg * alpha + rowsum32(p0, p1);
        cur ^= 1;
    }
    __syncthreads();
}
__device__ __forceinline__ void nsa_cmp_sweep2(ldsp_t lds, const bf16x8* qr, const bf16_t* kcb, const bf16_t* vcb, int ntile, int pos, int tokl, float m_reg, float l_reg, f32x16* o) {
    const int tid = my_tid(), lane = tid & 63, r32 = lane & 31, hi = lane >> 5;
    const float SCALE = 0.08838834764831845f, C2 = SCALE * 1.4426950408889634f;
    LAS float* impP = (LAS float*)(lds + NS_IMPP); LAS float* impS = (LAS float*)(lds + NS_IMPS);
    LAS float* imp = (LAS float*)(lds + NS_IMP); LAS float* carry = (LAS float*)(lds + NS_CARRY);
    const unsigned vb0 = (unsigned)(size_t)(lds + AT_V) + v_rd_base(lane);
    const float inv_l = l_reg > 0.f ? 1.f / l_reg : 0.f;
    const float mL = -m_reg * C2;
    const int wid_u = __builtin_amdgcn_readfirstlane(tid >> 6);
    stage_dma(lds, kcb, vcb, wid_u, lane);
    int cur = 0;
    for (int jt = 0; jt < ntile; ++jt) {
        __syncthreads();
        if (jt + 1 < ntile) stage_dma(lds + (cur ^ 1) * AT_BUF, kcb + (size_t)(jt + 1) * 64 * 128, vcb + (size_t)(jt + 1) * 64 * 128, wid_u, lane);
        f32x16 p0, p1; qkt<8>(p0, p1, lds + cur * AT_BUF + AT_K, r32, hi, qr);
        const int kb = jt * 64 + 4 * hi;
#pragma unroll
        for (int r = 0; r < 16; ++r) { const int c0 = kb + (r & 3) + 8 * (r >> 2), c1 = c0 + 32;
            const bool ok0 = (c0 < NCMP && 16 * c0 + 31 <= pos), ok1 = (c1 < NCMP && 16 * c1 + 31 <= pos);
            p0[r] = ok0 ? __builtin_amdgcn_exp2f(fmaf(p0[r], C2, mL)) * inv_l : 0.f; p1[r] = ok1 ? __builtin_amdgcn_exp2f(fmaf(p1[r], C2, mL)) * inv_l : 0.f; }
#pragma unroll
        for (int q = 0; q < 4; ++q) {
            float sp0 = 0.5f * p0[4 * q + 3], sp1 = 0.5f * p1[4 * q + 3];
            float mn0 = (p0[4 * q] + p0[4 * q + 1]) + (p0[4 * q + 2] + sp0), mn1 = (p1[4 * q] + p1[4 * q + 1]) + (p1[4 * q + 2] + sp1);
            mn0 += __shfl_xor(mn0, 1); mn0 += __shfl_xor(mn0, 2); mn1 += __shfl_xor(mn1, 1); mn1 += __shfl_xor(mn1, 2);
            sp0 += __shfl_xor(sp0, 1); sp0 += __shfl_xor(sp0, 2); sp1 += __shfl_xor(sp1, 1); sp1 += __shfl_xor(sp1, 2);
            if ((r32 & 3) == 0) { const int i0 = tokl * 16 + 2 * q + hi; impP[i0] = mn0; impS[i0] = sp0; impP[i0 + 8] = mn1; impS[i0 + 8] = sp1; } }
        bf16x8 pa0, pa1, pa2, pa3; packP(p0, p1, pa0, pa1, pa2, pa3);
        pv_tile(o, vb0 + cur * AT_BUF, pa0, pa1, pa2, pa3);
        cur ^= 1;
        __syncthreads();
        { const int tk = tid >> 3, part = tid & 7;
#pragma unroll
          for (int e = 0; e < 2; ++e) { const int nb = 2 * part + e; float mm = impP[tk * 16 + nb];
              if (nb > 0) mm += impS[tk * 16 + nb - 1];
              if (nb == 0 && jt > 0) mm += carry[((jt - 1) & 1) * 64 + tk];
              imp[tk * 132 + 16 * jt + nb] = mm; }
          if (part == 7) carry[(jt & 1) * 64 + tk] = impS[tk * 16 + 15]; }
    }
    __syncthreads();
}
template <int CTRL> __device__ __forceinline__ int dpp_i(int v) { return __builtin_amdgcn_update_dpp(v, v, CTRL, 0xf, 0xf, false); }
template <int CTRL> __device__ __forceinline__ float dpp_f(float v) { return __int_as_float(__builtin_amdgcn_update_dpp(__float_as_int(v), __float_as_int(v), CTRL, 0xf, 0xf, false)); }
__device__ __forceinline__ void nsa_topk(ldsp_t lds, int cur) {
    const int tid = my_tid(), tk = tid >> 3, part = tid & 7;
    const float NEG = -__builtin_inff();
    LAS float* imp = (LAS float*)(lds + NS_IMP);
    LAS unsigned* selm = (LAS unsigned*)(lds + NS_SEL); LAS unsigned* unm = (LAS unsigned*)(lds + NS_UN);
    float vals[16]; unsigned mym = 0u;
#pragma unroll
    for (int q = 0; q < 4; ++q) { const f32x4 t = *(const LAS f32x4*)(imp + tk * 132 + part * 16 + 4 * q);
#pragma unroll
        for (int e = 0; e < 4; ++e) vals[4 * q + e] = t[e]; }
#pragma unroll
    for (int k = 0; k < 16; ++k) { const int nn = part * 16 + k; const bool forced = (nn == 0 || nn == cur || nn == cur - 1);
        mym |= forced ? (1u << k) : 0u; vals[k] = (nn > cur || forced) ? NEG : vals[k]; }
    const int nforced = cur >= 2 ? 3 : cur + 1;
    for (int rnd = nforced; rnd < 16; ++rnd) {
        float best = vals[0]; int bi = 0;
#pragma unroll
        for (int k = 1; k < 16; ++k) if (vals[k] > best) { best = vals[k]; bi = k; }
        int gi = part * 16 + bi;
        { const float ov = dpp_f<0xB1>(best); const int oi = dpp_i<0xB1>(gi); const bool t = (ov > best) || (ov == best && oi < gi); best = t ? ov : best; gi = t ? oi : gi; }
        { const float ov = dpp_f<0x4E>(best); const int oi = dpp_i<0x4E>(gi); const bool t = (ov > best) || (ov == best && oi < gi); best = t ? ov : best; gi = t ? oi : gi; }
        { const float ov = dpp_f<0x141>(best); const int oi = dpp_i<0x141>(gi); const bool t = (ov > best) || (ov == best && oi < gi); best = t ? ov : best; gi = t ? oi : gi; }
        const bool win = (best > -5e29f) && ((gi >> 4) == part);
        const int kk = win ? (gi & 15) : 16;
        mym |= win ? (1u << (gi & 15)) : 0u;
#pragma unroll
        for (int k = 0; k < 16; ++k) vals[k] = (k == kk) ? NEG : vals[k];
    }
    unsigned mw = mym << (16 * (part & 1));
    mw |= (unsigned)dpp_i<0xB1>((int)mw);
    if ((part & 1) == 0) { selm[tk * 4 + (part >> 1)] = mw; atomicOr((unsigned*)(unm + (part >> 1)), mw); }
}
__device__ __forceinline__ void nsa_load_q(bf16x8* qr, const bf16_t* Q, int b, int g, int s0) {
    const int tid = my_tid(), wid = tid >> 6, lane = tid & 63, r32 = lane & 31, hi = lane >> 5, hh = r32 & 3, tokl = 8 * wid + (r32 >> 2);
    const bf16_t* p = Q + (((size_t)b * 8 + g * 4 + hh) * SEQ + s0 + tokl) * 128 + hi * 8;
#pragma unroll
    for (int d0 = 0; d0 < 8; ++d0) qr[d0] = *(const bf16x8*)(p + d0 * 16);
}
template <int MODE>
__device__ __forceinline__ void nsa_branch_out(ldsp_t lds, f32x16* o, float l_reg, bool normalise, int which, const float* gates, float* OACC, bf16_t* ob, int b, int g, int s0) {
    const int tid = my_tid(), wid = tid >> 6, lane = tid & 63, r32 = lane & 31, hi = lane >> 5, hh = r32 & 3, tokl = 8 * wid + (r32 >> 2);
    LAS float* li_l = (LAS float*)(lds + AT_WS) + wid * 64 + 32;
    const float gt = gates[((size_t)b * SEQ + s0 + tokl) * 24 + (g * 4 + hh) * 3 + which];
    float gsc[16]; row_scalars(normalise ? gt * (l_reg > 0.f ? 1.f / l_reg : 0.f) : gt, gsc, li_l, r32, hi);
    f32x4* op = (f32x4*)(OACC + ((size_t)b * SEQ + s0) * DM + (size_t)g * (64 * 512)) + tid;
    const size_t base = ((size_t)b * SEQ + s0 + 8 * wid) * DM + (size_t)g * 512;
#pragma unroll
    for (int d0 = 0; d0 < 4; ++d0)
#pragma unroll
        for (int k = 0; k < 4; ++k) {
            f32x4 v = {o[d0][4 * k] * gsc[4 * k], o[d0][4 * k + 1] * gsc[4 * k + 1], o[d0][4 * k + 2] * gsc[4 * k + 2], o[d0][4 * k + 3] * gsc[4 * k + 3]};
            if (MODE == 0) op[(d0 * 4 + k) * 512] = v;
            else if (MODE == 1) op[(d0 * 4 + k) * 512] += v;
            else { v += op[(d0 * 4 + k) * 512];
#pragma unroll
                for (int e = 0; e < 4; ++e) { const int r = 4 * k + e; const int qi = crow(r, hi); const size_t ro = base + (size_t)(qi >> 2) * DM + (qi & 3) * 128;
                    const float vn = __shfl_xor(v[e], 1);
                    if ((r32 & 1) == 0) *(unsigned*)(ob + ro + d0 * 32 + r32) = cvtpk(v[e], vn); } } }
}
__device__ __forceinline__ void nsa_attn_phase(ldsp_t lds, const bf16_t* Qp, const bf16_t* Qr, const bf16_t* kv, const bf16_t* KC, const float* gates, float* OACC, bf16_t* ob, int wg, int nwg) {
    const float SCALE = 0.08838834764831845f;
    LAS float* imp = (LAS float*)(lds + NS_IMP);
    LAS unsigned* selm = (LAS unsigned*)(lds + NS_SEL); LAS unsigned* unm = (LAS unsigned*)(lds + NS_UN);
    const int nround = (1024 + nwg - 1) / nwg;
    for (int n = 0; n < nround; ++n) {
        const int idx = n * nwg + ((n & 1) ? (nwg - 1 - wg) : wg);
        if (idx >= 1024) continue;
        const int blk = 127 - (idx >> 3), bg = idx & 7, b = bg >> 1, g = bg & 1;
        const int s0 = blk * 64;
        const int tid = my_tid(), wid = tid >> 6, lane = tid & 63, tokl = 8 * wid + ((lane & 31) >> 2), pos = s0 + tokl;
        const bf16_t* kcb = KC + (size_t)bg * NCMP_P * 128; const bf16_t* vcb = KC + (size_t)(8 + bg) * NCMP_P * 128;
        for (int i = tid; i < 64 * 132; i += 512) imp[i] = 0.f;
        if (tid < 4) unm[tid] = 0u;
        bf16x8 qr[8];
        nsa_load_q(qr, Qp, b, g, s0);
        int nvalid = 4 * blk + 3; if (nvalid > NCMP) nvalid = NCMP;
        const int ntile = (nvalid + 63) >> 6;
        float m_reg = -1e30f, l_reg = 0.f;
        nsa_cmp_sweep1(lds, qr, kcb, vcb, ntile, pos, m_reg, l_reg);
        f32x16 o[4] = {};
        nsa_cmp_sweep2(lds, qr, kcb, vcb, ntile, pos, tokl, m_reg, l_reg, o);
        nsa_topk(lds, blk);
        nsa_branch_out<0>(lds, o, 1.f, false, 0, gates, OACC, ob, b, g, s0);
        __syncthreads();
        nsa_load_q(qr, Qr, b, g, s0);
        {
            const unsigned sel0 = selm[tokl * 4 + 0], sel1 = selm[tokl * 4 + 1], sel2 = selm[tokl * 4 + 2], sel3 = selm[tokl * 4 + 3];
            const unsigned un0 = unm[0], un1 = unm[1], un2 = unm[2], un3 = unm[3];
#pragma unroll
            for (int d0 = 0; d0 < 4; ++d0) o[d0] = f32x16{};
            m_reg = -1e30f; l_reg = 0.f;
            attn_sweep<MK_SLC, 8>(lds, qr, kv + (size_t)(2 * 8 + bg) * SEQ * 128, kv + (size_t)(3 * 8 + bg) * SEQ * 128, 0, blk + 1, pos, sel0, sel1, sel2, sel3, un0, un1, un2, un3, o, m_reg, l_reg, SCALE, 7);
            nsa_branch_out<1>(lds, o, l_reg, true, 1, gates, OACC, ob, b, g, s0);
        }
        {
#pragma unroll
            for (int d0 = 0; d0 < 4; ++d0) o[d0] = f32x16{};
            m_reg = -1e30f; l_reg = 0.f;
            attn_sweep<MK_WINDOW, 8>(lds, qr, kv + (size_t)(4 * 8 + bg) * SEQ * 128, kv + (size_t)(5 * 8 + bg) * SEQ * 128, blk > 8 ? blk - 8 : 0, blk + 1, pos, 0, 0, 0, 0, 0, 0, 0, 0, o, m_reg, l_reg, SCALE, 7);
            nsa_branch_out<2>(lds, o, l_reg, true, 2, gates, OACC, ob, b, g, s0);
        }
        __syncthreads();
    }
}

struct Args { const float* in[25]; float* out; unsigned char* ws; int ph_lo, ph_hi; };
enum { I_X = 0, I_HG_WIN, I_HG_LB, I_HG_NG, I_HG_WOUT, I_DA_WIN, I_DA_LAM, I_DA_NG, I_DA_WOUT, I_NSA_WIN, I_NSA_PE, I_NSA_W1, I_NSA_W2, I_NSA_WOUT,
       I_SB_WIN, I_SB_WOUT, I_FFN_WG, I_FFN_WU, I_FFN_WD, I_MOE_WR, I_MOE_WG, I_MOE_WU, I_MOE_WD, I_LN_G, I_LN_B };
__device__ __forceinline__ void rope_table(f32x2* tab, int half, double ratio, int wg, int nwg) {
    for (int i = wg * 512 + my_tid(); i < SEQ * half; i += nwg * 512) {
        const int s = i / half, j = i % half;
        double inv = 1.0; for (int k = 0; k < j; ++k) inv *= ratio;
        const float ang = (float)s * (float)inv;
        const double rev = (double)ang * 0.15915494309189535; const float fr = (float)(rev - floor(rev));
        tab[i] = (f32x2){__builtin_amdgcn_cosf(fr), __builtin_amdgcn_sinf(fr)};
    }
}
__device__ __forceinline__ void prologue_phase(ldsp_t lds, const Args& a, int wg, int nwg) {
    unsigned char* ws = a.ws; const int tid = my_tid();
    { const float* x = a.in[I_X]; bf16_t* hb = (bf16_t*)(ws + WS_HB);
      for (size_t i = ((size_t)wg * 512 + tid) * 8; i < (size_t)NT * DM; i += (size_t)nwg * 512 * 8)
          *(bf16x8*)(hb + i) = pack8(*(const f32x4*)(x + i), *(const f32x4*)(x + i + 4)); }
    if (wg == 0) { float* lbv = (float*)(ws + WS_LBV); const float* L = a.in[I_HG_LB];
        for (int d = tid; d < DM; d += 512) { float mx = L[d];
            for (int r = 1; r < 5; ++r) mx = fmaxf(mx, L[r * DM + d]);
            float s = 0.f; for (int r = 0; r < 5; ++r) s += __expf(L[r * DM + d] - mx);
            lbv[d] = __expf(L[d] - mx) / s; } }
    for (int u = wg; u < 64; u += nwg) { const int jj = u >> 5, p = u & 31; LAS float* red = (LAS float*)lds;
        const float* pe = a.in[I_NSA_PE] + (size_t)jj * 4096 + p * 128; const float* w1 = a.in[I_NSA_W1] + ((size_t)jj * 4096 + p * 128) * 128;
        const int nn = tid & 127, sub = tid >> 7; float sacc = 0.f;
#pragma unroll 8
        for (int k = sub * 32; k < sub * 32 + 32; ++k) sacc += pe[k] * w1[(size_t)k * 128 + nn];
        red[sub * 128 + nn] = sacc; __syncthreads();
        if (tid < 128) ((float*)(ws + WS_CMPBIAS))[(jj * 32 + p) * 128 + tid] = (red[tid] + red[128 + tid]) + (red[256 + tid] + red[384 + tid]);
        __syncthreads(); }
    rope_table((f32x2*)(ws + WS_ROPE_DA), 32, 0.7498942093324559, wg, nwg);
    rope_table((f32x2*)(ws + WS_ROPE_NSA), 64, 0.8659643233600653, wg, nwg);
    __syncthreads();
    convert_T(lds, (bf16_t*)(ws + WS_W_HGIN), 1, 0, 4096, 1024, MapId{a.in[I_HG_WIN], 4096, 4096}, wg, nwg);
    convert_T(lds, (bf16_t*)(ws + WS_W_HGOUT), 1, 0, 1024, 1024, MapId{a.in[I_HG_WOUT], 1024, 1024}, wg, nwg);
    convert_T(lds, (bf16_t*)(ws + WS_W_DAIN), 1, 0, 3072, 1024, MapRope64{a.in[I_DA_WIN], 3072}, wg, nwg);
    convert_T(lds, (bf16_t*)(ws + WS_W_DAOUT), 1, 0, 1024, 1024, MapId{a.in[I_DA_WOUT], 1024, 1024}, wg, nwg);
    convert_T(lds, (bf16_t*)(ws + WS_W_NSAIN), 1, 0, NSA_NPAD, 1024, MapNsa{a.in[I_NSA_WIN], 2584}, wg, nwg);
    convert_T(lds, (bf16_t*)(ws + WS_W_NSAOUT), 1, 0, 1024, 1024, MapId{a.in[I_NSA_WOUT], 1024, 1024}, wg, nwg);
    convert_T(lds, (bf16_t*)(ws + WS_W_SBIN), 1, 0, 3072, 1024, MapId{a.in[I_SB_WIN], 3072, 3072}, wg, nwg);
    convert_T(lds, (bf16_t*)(ws + WS_W_SBOUT), 1, 0, 1024, 1024, MapId{a.in[I_SB_WOUT], 1024, 1024}, wg, nwg);
    for (int j = 0; j < 2; ++j) {
        convert_T(lds, (bf16_t*)(ws + WS_W_FFNGU) + (size_t)j * 5632 * 1024, 1, 0, 5632, 1024, MapGU{a.in[I_FFN_WG] + (size_t)j * 1024 * DFF, a.in[I_FFN_WU] + (size_t)j * 1024 * DFF, DFF}, wg, nwg);
        convert_T(lds, (bf16_t*)(ws + WS_W_FFND) + (size_t)j * 1024 * DFF, 1, 0, 1024, DFF, MapId{a.in[I_FFN_WD] + (size_t)j * DFF * 1024, 1024, 1024}, wg, nwg);
        convert_T(lds, (bf16_t*)(ws + WS_W_CMP1) + (size_t)j * 128 * 4096, 1, 0, 128, 4096, MapId{a.in[I_NSA_W1] + (size_t)j * 4096 * 128, 128, 128}, wg, nwg);
        convert_T(lds, (bf16_t*)(ws + WS_W_CMP2) + (size_t)j * 128 * 128, 1, 0, 128, 128, MapId{a.in[I_NSA_W2] + (size_t)j * 128 * 128, 128, 128}, wg, nwg);
    }
}
__device__ __forceinline__ void moe_down_sub(ldsp_t lds, const bf16_t* A, const bf16_t* Bt, const pg8::Unit u, int rq, int cq, bf16_t* y) {
    using namespace pg8;
    constexpr int K = DFFE, nt = K / BK, STG = 16384, NST = 8;
    const int tid = my_tid(), wid = __builtin_amdgcn_readfirstlane(tid >> 6), lane = tid & 63, wm = wid >> 1, wc2 = wid & 1, fr = lane & 15, fq = lane >> 4;
    unsigned voffA, voffB;
    { int R, C; stage_rc(tid * 16, R, C); voffA = (unsigned)(R * K + C) * 2u; const int Rb = (R & ~31) + perm32(R & 31); voffB = (unsigned)(Rb * K + C) * 2u; }
    const char* cA = (const char*)A + ((size_t)u.pm * 256 + (size_t)rq * 64) * K * 2;
    const char* cB = (const char*)Bt + ((size_t)u.pn * 256 + (size_t)cq * 64) * K * 2;
    const unsigned ldsw = (unsigned)wid * 1024u;
    const int aoff = lds_byte(wm * 16 + fr, fq * 8), boff = 8192 + lds_byte(wc2 * 32 + fr, fq * 8);
#define MS_STAGE(s, t) do { const size_t ko_ = (size_t)(t) * (BK * 2); \
        __builtin_amdgcn_global_load_lds((const unsigned*)(cA + ko_ + voffA), (LAS unsigned*)(lds + (s) * STG + ldsw), 16, 0, 0); \
        __builtin_amdgcn_global_load_lds((const unsigned*)(cB + ko_ + voffB), (LAS unsigned*)(lds + (s) * STG + 8192 + ldsw), 16, 0, 0); } while (0)
    f32x4 acc[2] = {(f32x4){0.f, 0.f, 0.f, 0.f}, (f32x4){0.f, 0.f, 0.f, 0.f}};
#pragma unroll
    for (int t = 0; t < NST - 1; ++t) MS_STAGE(t, t);
    for (int t = 0; t < nt; ++t) {
        asm volatile("s_waitcnt vmcnt(12)" ::: "memory");
        __builtin_amdgcn_s_barrier();
        asm volatile("" ::: "memory");
        { const int tn = (t + NST - 1 < nt) ? t + NST - 1 : nt - 1;
          MS_STAGE((t + NST - 1) & (NST - 1), tn); }
        const int s = t & (NST - 1);
        bf16x8 At[2], Bf[2][2];
#pragma unroll
        for (int k = 0; k < 2; ++k) At[k] = *(const LAS bf16x8*)(lds + s * STG + aoff + k * 1024);
#pragma unroll
        for (int n = 0; n < 2; ++n)
#pragma unroll
            for (int k = 0; k < 2; ++k) Bf[n][k] = *(const LAS bf16x8*)(lds + s * STG + boff + n * 2048 + k * 1024);
#pragma unroll
        for (int n = 0; n < 2; ++n)
#pragma unroll
            for (int k = 0; k < 2; ++k) acc[n] = __builtin_amdgcn_mfma_f32_16x16x32_bf16(Bf[n][k], At[k], acc[n], 0, 0, 0);
        asm volatile("" ::: "memory");
    }
#undef MS_STAGE
    asm volatile("s_waitcnt vmcnt(0)" ::: "memory");
    { const int row = u.pm * 256 + rq * 64 + wm * 16 + fr, colL = (u.pn & 3) * 256 + cq * 64 + wc2 * 32 + 8 * fq;
      *(bf16x8*)(y + (size_t)row * DM + colL) = pack8(acc[0], acc[1]); }
    __syncthreads();
}
__device__ __forceinline__ void moe_convert_phase(ldsp_t lds, const Args& a, int j, int wg, int nwg) {
    unsigned char* ws = a.ws;
    const size_t eo = (size_t)(j * 8) * 1024 * DFFE;
    convert_T(lds, (bf16_t*)(ws + WS_W_MOEGU), 8, (size_t)1024 * DFFE, 7168, 1024, MapGU{a.in[I_MOE_WG] + eo, a.in[I_MOE_WU] + eo, DFFE}, wg, nwg);
    convert_T(lds, (bf16_t*)(ws + WS_W_MOED), 8, (size_t)1024 * DFFE, 1024, DFFE, MapId{a.in[I_MOE_WD] + eo, 1024, 1024}, wg, nwg);
}

__global__ void __launch_bounds__(512, 2) mega(Args a) {
    extern __shared__ __attribute__((aligned(16))) unsigned char lds_raw[];
    ldsp_t lds = (ldsp_t)lds_raw;
    const int tid = my_tid(), wg = blockIdx.x, nwg = gridDim.x;
    const int lo = a.ph_lo, hi = a.ph_hi;
    unsigned char* ws = a.ws;
    volatile LAS unsigned* misc = (volatile LAS unsigned*)(lds + LDS_MISC);
    XcdBarrier bar; bar.bar = (unsigned*)(ws + WS_BAR); bar.x = 0; bar.st = misc;
    if (hi - lo > 1) { if (tid == 0) { misc[0] = 0u; misc[1] = 0u; misc[2] = 0u; misc[3] = 0u; } __syncthreads(); bar = xcd_barrier_post((unsigned*)(ws + WS_BAR), misc); }
    int ph = 0;
#ifndef PH_MASK
#define PH_MASK 0xffffffffu
#endif
#ifndef REPEAT_ID
#define REPEAT_ID (-1)
#define REPEAT_N 1
#endif
#define PH_BEGIN(ID) if (((PH_MASK >> (ID)) & 1u) && ph >= lo && ph < hi) { for (int rep_ = 0; rep_ < ((ID) == REPEAT_ID ? REPEAT_N : 1); ++rep_) {
#define PH_END   } if (ph + 1 < hi) xcd_barrier(bar); } ++ph;
    bf16_t* hb = (bf16_t*)(ws + WS_HB); bf16_t* ob = (bf16_t*)(ws + WS_OB);
    unsigned* ctl = (unsigned*)(ws + WS_CTL);

    PH_BEGIN(0) prologue_phase(lds, a, wg, nwg); PH_END

    for (int layer = 0; layer < 4; ++layer) {
        if (layer == 0) {
            PH_BEGIN(1) { pg8::Gemm g{hb, (const bf16_t*)(ws + WS_W_HGIN), NT, 4096, 1024}; pg8::StaticOrder S; S.init(NT, 4096, nwg, wg);
                EpiHgIn E{(bf16_t*)(ws + SC_HG_QS), (bf16_t*)(ws + SC_HG_VV), (bf16_t*)(ws + SC_HG_SG), (float*)(ws + SC_HG_LF), (const float*)(ws + WS_LBV)};
                pg8::gemm_phase(lds, g, S, E); } PH_END
            PH_BEGIN(2) hgrn_passA(lds, (const float*)(ws + SC_HG_LF), (const bf16_t*)(ws + SC_HG_VV), (bf16_t*)(ws + SC_HG_ST), (float*)(ws + SC_HG_DEC), wg, nwg); PH_END
            PH_BEGIN(3) hgrn_passB((bf16_t*)(ws + SC_HG_ST), (const float*)(ws + SC_HG_DEC), wg, nwg); PH_END
            PH_BEGIN(4) hgrn_passC(lds, (const bf16_t*)(ws + SC_HG_QS), (const float*)(ws + SC_HG_LF), (const bf16_t*)(ws + SC_HG_VV), (const bf16_t*)(ws + SC_HG_SG),
                                (const bf16_t*)(ws + SC_HG_ST), a.in[I_HG_NG], ob, wg, nwg); PH_END
        } else if (layer == 1) {
            PH_BEGIN(5) { pg8::Gemm g{hb, (const bf16_t*)(ws + WS_W_DAIN), NT, 3072, 1024}; pg8::StaticOrder S; S.init(NT, 3072, nwg, wg);
                EpiDaIn E{(bf16_t*)(ws + SC_DA_Q), (bf16_t*)(ws + SC_DA_K), (bf16_t*)(ws + SC_DA_V), (const f32x2*)(ws + WS_ROPE_DA)};
                pg8::gemm_phase(lds, g, S, E); } PH_END
            PH_BEGIN(6) da_attn_phase(lds, (const bf16_t*)(ws + SC_DA_Q), (const bf16_t*)(ws + SC_DA_K), (const bf16_t*)(ws + SC_DA_V), a.in[I_DA_LAM], a.in[I_DA_NG], ob, wg, nwg); PH_END
        } else if (layer == 2) {
            PH_BEGIN(8) { pg8::Gemm g{hb, (const bf16_t*)(ws + WS_W_NSAIN), NT, NSA_NPAD, 1024}; pg8::StaticOrder S; S.init(NT, NSA_NPAD, nwg, wg);
                EpiNsaIn E{(bf16_t*)(ws + SC_NSA_Q), (bf16_t*)(ws + SC_NSA_QR), (bf16_t*)(ws + SC_NSA_KV), (float*)(ws + SC_NSA_GATE), (const f32x2*)(ws + WS_ROPE_NSA)};
                pg8::gemm_phase(lds, g, S, E); } PH_END
            PH_BEGIN(9) nsa_compress_phase(lds, (const bf16_t*)(ws + SC_NSA_KV), (const bf16_t*)(ws + WS_W_CMP1), (const bf16_t*)(ws + WS_W_CMP2), (const float*)(ws + WS_CMPBIAS), (bf16_t*)(ws + SC_NSA_KC), wg, nwg); PH_END
            PH_BEGIN(10) nsa_attn_phase(lds, (const bf16_t*)(ws + SC_NSA_Q), (const bf16_t*)(ws + SC_NSA_QR), (const bf16_t*)(ws + SC_NSA_KV), (const bf16_t*)(ws + SC_NSA_KC),
                                    (const float*)(ws + SC_NSA_GATE), (float*)(ws + SC_NSA_OACC), ob, wg, nwg); PH_END
        } else {
            PH_BEGIN(11) { pg8::Gemm g{hb, (const bf16_t*)(ws + WS_W_SBIN), NT, 3072, 1024}; pg8::StaticOrder S; S.init(NT, 3072, nwg, wg);
                EpiSbIn E{(bf16_t*)(ws + SC_SB_Q)};
                pg8::gemm_phase(lds, g, S, E); } PH_END
            PH_BEGIN(12) sb_attn_phase(lds, (const bf16_t*)(ws + SC_SB_Q), (const bf16_t*)(ws + SC_SB_K), (const bf16_t*)(ws + SC_SB_V), ob, wg, nwg); PH_END
        }
        const size_t wout_off = (layer == 0) ? WS_W_HGOUT : (layer == 1) ? WS_W_DAOUT : (layer == 2) ? WS_W_NSAOUT : WS_W_SBOUT;
        PH_BEGIN(13) { pg8::Gemm g{ob, (const bf16_t*)(ws + wout_off), NT, 1024, 1024}; pg8::StaticOrder S; S.init(NT, 1024, nwg, wg);
            bf16_t* zdst = rep_ ? (bf16_t*)a.out : hb;
            if (layer == 0) { EpiRes<true> E{a.in[I_X], zdst}; pg8::gemm_phase(lds, g, S, E); }
            else { EpiRes<false> E{hb, zdst}; pg8::gemm_phase(lds, g, S, E); } } PH_END
        const int j = layer >> 1;
        unsigned* cnt = ctl + 64 * j;
        const Route* route = (const Route*)(ws + SC_MOE_ROUTE);
        PH_BEGIN(14) ln_phase(lds, hb, rep_ ? a.out : nullptr, rep_ ? nullptr : hb, a.in[I_LN_G] + (size_t)(layer * 2) * DM, a.in[I_LN_B] + (size_t)(layer * 2) * DM, nullptr, nullptr, nullptr,
                          ((layer & 1) && !rep_) ? a.in[I_MOE_WR] + (size_t)j * DM * 8 : nullptr, (Route*)(ws + SC_MOE_ROUTE), cnt, wg, nwg); PH_END
        if ((layer & 1) == 0) {
            PH_BEGIN(15) { pg8::Gemm g{hb, (const bf16_t*)(ws + WS_W_FFNGU) + (size_t)j * 5632 * 1024, NT, 5632, 1024}; pg8::StaticOrder S; S.init(NT, 5632, nwg, wg);
                EpiSwiglu E{(bf16_t*)(ws + SC_FF_ACT), DFF, 22};
                pg8::gemm_phase(lds, g, S, E); } PH_END
            PH_BEGIN(16) { pg8::Gemm g{(const bf16_t*)(ws + SC_FF_ACT), (const bf16_t*)(ws + WS_W_FFND) + (size_t)j * 1024 * DFF, NT, 1024, DFF}; pg8::StaticOrder S; S.init(NT, 1024, nwg, wg);
                EpiRes<false> E{hb, rep_ ? (bf16_t*)a.out : hb};
                pg8::gemm_phase(lds, g, S, E); } PH_END
            PH_BEGIN(17) ln_phase(lds, hb, (layer == 3 || rep_) ? a.out : nullptr, rep_ ? nullptr : hb, a.in[I_LN_G] + (size_t)(layer * 2 + 1) * DM, a.in[I_LN_B] + (size_t)(layer * 2 + 1) * DM, nullptr, nullptr, nullptr,
                              nullptr, nullptr, nullptr, wg, nwg); PH_END
        } else {
            PH_BEGIN(18) moe_convert_phase(lds, a, j, wg, nwg);
                         moe_build_table(lds, (int*)(ws + SC_MOE_XS), route, cnt, wg, nwg); PH_END
            for (int ck = 0; ck < 2; ++ck) {
                int seg_tile[8], nT_, tile_lo_ = ck * MOE_CHUNK_TILES;
                { int s_ = 0;
#pragma unroll
                  for (int e = 0; e < 8; ++e) { seg_tile[e] = s_ >> 8; s_ += (int)((cnt[e] + 255u) & ~255u); }
                  int nt_all = s_ >> 8; int t_hi = tile_lo_ + MOE_CHUNK_TILES; if (t_hi > nt_all) t_hi = nt_all; nT_ = t_hi - tile_lo_; }
                PH_BEGIN(19) { MoeOrderT<true> MO; MO.G = nwg; MO.c = wg; MO.tile_lo = tile_lo_; MO.nT = nT_; MO.nNt = 28; MO.tok = (const int*)(ws + SC_MOE_XS);
#pragma unroll
                    for (int e = 0; e < 8; ++e) MO.seg_tile[e] = seg_tile[e];
                    pg8::Gemm g{hb, (const bf16_t*)(ws + WS_W_MOEGU), MOE_CHUNK_ROWS, 7168, 1024};
                    EpiSwiglu E{(bf16_t*)(ws + SC_MOE_ACT), DFFE, 28};
                    pg8::gemm_phase(lds, g, MO, E); } PH_END
                PH_BEGIN(20) { MoeOrderT<false> MO; MO.G = nwg; MO.c = wg; MO.tile_lo = tile_lo_; MO.nT = nT_; MO.nNt = 4; MO.tok = nullptr;
#pragma unroll
                    for (int e = 0; e < 8; ++e) MO.seg_tile[e] = seg_tile[e];
                    pg8::Gemm g{(const bf16_t*)(ws + SC_MOE_ACT), (const bf16_t*)(ws + WS_W_MOED), MOE_CHUNK_ROWS, 1024, DFFE};
                    EpiMoeDown E{(bf16_t*)(ws + SC_MOE_Y) + (size_t)ck * MOE_CHUNK_ROWS * DM};
                    const int nu_ = nT_ > 0 ? nT_ * 4 : 0, nfull_ = nu_ / nwg, ntail_ = nu_ - nfull_ * nwg;
                    const bool stail_ = (ntail_ > 0 && ntail_ <= 16 && nwg == 256);
                    if (stail_) MO.imax = nfull_;
                    pg8::gemm_phase(lds, g, MO, E);
                    if (stail_) { __syncthreads();
                        const int j_ = wg >> 3, uidx_ = (wg & 7) + 8 * (j_ >> 4), sub_ = j_ & 15;
                        if (uidx_ < ntail_) { pg8::Unit u_; MO.at((long)nfull_ * nwg + uidx_, u_); moe_down_sub(lds, g.A, g.Bt, u_, sub_ >> 2, sub_ & 3, E.y); } } } PH_END
            }
            PH_BEGIN(21) ln_phase(lds, hb, (layer == 3 || rep_) ? a.out : nullptr, rep_ ? nullptr : hb, a.in[I_LN_G] + (size_t)(layer * 2 + 1) * DM, a.in[I_LN_B] + (size_t)(layer * 2 + 1) * DM,
                              route, (const bf16_t*)(ws + SC_MOE_Y), cnt, nullptr, nullptr, nullptr, wg, nwg); PH_END
        }
    }
#undef PH_BEGIN
#undef PH_END
}
constexpr int NPHASES = 38;

#ifdef DBG_REPORT
__global__ void dbg_stats(const void* buf, size_t n, int isbf, float* acc, int slot) {
    float bad = 0.f, ss = 0.f;
    for (size_t i = (size_t)blockIdx.x * blockDim.x + threadIdx.x; i < n; i += (size_t)gridDim.x * blockDim.x) {
        const float v = isbf ? bf2f(((const bf16_t*)buf)[i]) : ((const float*)buf)[i];
        if (!(fabsf(v) < 3e38f)) bad += 1.f; else ss += v * v; }
    bad = wave_sum(bad); ss = wave_sum(ss);
    if ((threadIdx.x & 63) == 0) { atomicAdd(acc + 2 * slot, bad); atomicAdd(acc + 2 * slot + 1, ss); }
}
__global__ void dbg_write(const float* acc, int nslot, float* out, size_t nout) {
    float code = 1.f;
    for (int k = 0; k < nslot; ++k) if (acc[2 * k] > 0.f) code += (float)(1 << k);
    const float c = 10.f * code;
    for (size_t i = (size_t)blockIdx.x * blockDim.x + threadIdx.x; i < nout; i += (size_t)gridDim.x * blockDim.x) out[i] = c;
}
#endif
extern "C" void kernel_launch(void* const* d_in, const int* in_sizes, int n_in, void* d_out, int out_size, void* d_ws, size_t ws_size, hipStream_t stream) {
    static int grid = 0;
    if (grid == 0) {
        if (n_in != 25 || out_size != NT * DM || ws_size < WS_END) { fprintf(stderr, "kernel_launch: unexpected shapes / workspace (%d inputs, out %d, ws %zu < %zu)\n", n_in, out_size, ws_size, (size_t)WS_END); grid = -1; return; }
        int dev = 0, cus = 0;
        if (hipGetDevice(&dev) != hipSuccess || hipDeviceGetAttribute(&cus, hipDeviceAttributeMultiprocessorCount, dev) != hipSuccess) { grid = -1; return; }
        if (hipFuncSetAttribute((const void*)mega, hipFuncAttributeMaxDynamicSharedMemorySize, LDS_BYTES) != hipSuccess) { fprintf(stderr, "kernel_launch: hipFuncSetAttribute failed\n"); grid = -1; return; }
        int per_cu = 0;
        if (hipOccupancyMaxActiveBlocksPerMultiprocessor(&per_cu, (const void*)mega, 512, LDS_BYTES) != hipSuccess || per_cu < 1) { fprintf(stderr, "kernel_launch: occupancy query says %d blocks per CU\n", per_cu); }
        (void)hipGetLastError();
        grid = cus;
    }
    if (grid < 0) return;
    (void)hipMemsetAsync((char*)d_ws, 0, WS_ZERO_BYTES, stream);
    Args a{};
    for (int i = 0; i < 25; ++i) a.in[i] = (const float*)d_in[i];
    a.out = (float*)d_out; a.ws = (unsigned char*)d_ws;
#if MK_FUSED
    a.ph_lo = 0; a.ph_hi = NPHASES;
    hipLaunchKernelGGL(mega, dim3(grid), dim3(512), LDS_BYTES, stream, a);
#else
#ifndef DBG_NPH
#define DBG_NPH NPHASES
#endif
    for (int p = 0; p < DBG_NPH; ++p) { a.ph_lo = p; a.ph_hi = p + 1; hipLaunchKernelGGL(mega, dim3(grid), dim3(512), LDS_BYTES, stream, a); }
#ifdef DBG_REPORT
    { float* acc = (float*)((char*)d_ws + WS_CTL + 2048); char* w = (char*)d_ws;
      hipLaunchKernelGGL(dbg_stats, dim3(1024), dim3(256), 0, stream, (const void*)(w + SC_HG_VV), (size_t)NT * DM, 1, acc, 0);
      hipLaunchKernelGGL(dbg_stats, dim3(1024), dim3(256), 0, stream, (const void*)(w + SC_HG_ST), (size_t)4096 * 128 * 128, 1, acc, 1);
      hipLaunchKernelGGL(dbg_stats, dim3(1024), dim3(256), 0, stream, (const void*)(w + SC_HG_SG), (size_t)NT * DM, 1, acc, 2);
      hipLaunchKernelGGL(dbg_stats, dim3(1024), dim3(256), 0, stream, (const void*)(w + SC_HG_LF), (size_t)NT * DM, 0, acc, 3);
      hipLaunchKernelGGL(dbg_write, dim3(1024), dim3(256), 0, stream, (const float*)acc, 4, (float*)d_out, (size_t)NT * DM); }
#endif
#endif
}
```

```cpp
#include <hip/hip_runtime.h>
#include <stdint.h>
#include <stdio.h>

#ifndef MK_FUSED
#define MK_FUSED 1
#endif


#define LAS __attribute__((address_space(3)))
typedef unsigned short bf16_t;
typedef short bf16x8 __attribute__((ext_vector_type(8)));
typedef short s16x4 __attribute__((ext_vector_type(4)));
typedef float f32x2 __attribute__((ext_vector_type(2)));
typedef float f32x4 __attribute__((ext_vector_type(4)));
typedef float f32x16 __attribute__((ext_vector_type(16)));
typedef unsigned u32x2 __attribute__((ext_vector_type(2)));
typedef unsigned u32x4 __attribute__((ext_vector_type(4)));
typedef LAS unsigned char* ldsp_t;

constexpr int DM = 1024, NB = 4, SEQ = 8192, NT = NB * SEQ, NHEAD = 8, HDIM = 128;
constexpr int DFF = 2816, NEXP = 8, DFFE = 3584;
constexpr float ALPHA = 1.681792830507429f;
constexpr float LN_EPS = 1e-5f;
constexpr int NSA_NPAD = 2816;
constexpr int NCMP = 511, NCMP_P = 512;
constexpr int MOE_TILES_MAX = 264, MOE_CHUNK_TILES = 132, MOE_ROWS_MAX = MOE_TILES_MAX * 256, MOE_CHUNK_ROWS = MOE_CHUNK_TILES * 256;

constexpr size_t al256(size_t x) { return (x + 255) & ~(size_t)255; }
constexpr size_t WS_BAR = 0;
constexpr size_t WS_CTL = 16384;
constexpr size_t WS_ZERO_BYTES = 16384 + 4096;
constexpr size_t WS_SMALL = WS_ZERO_BYTES;
constexpr size_t WS_LBV = WS_SMALL;
constexpr size_t WS_CMPBIAS = WS_LBV + 4096;
constexpr size_t WS_ROPE_DA = WS_CMPBIAS + 32768;
constexpr size_t WS_ROPE_NSA = WS_ROPE_DA + (size_t)SEQ * 32 * 8;
constexpr size_t WS_HB = al256(WS_ROPE_NSA + (size_t)SEQ * 64 * 8);
constexpr size_t WS_OB = WS_HB + (size_t)NT * DM * 2;
constexpr size_t WS_W_HGIN = WS_OB + (size_t)NT * DM * 2;
constexpr size_t WS_W_HGOUT = WS_W_HGIN + (size_t)4096 * 1024 * 2;
constexpr size_t WS_W_DAIN = WS_W_HGOUT + (size_t)1024 * 1024 * 2;
constexpr size_t WS_W_DAOUT = WS_W_DAIN + (size_t)3072 * 1024 * 2;
constexpr size_t WS_W_NSAIN = WS_W_DAOUT + (size_t)1024 * 1024 * 2;
constexpr size_t WS_W_NSAOUT = WS_W_NSAIN + (size_t)NSA_NPAD * 1024 * 2;
constexpr size_t WS_W_SBIN = WS_W_NSAOUT + (size_t)1024 * 1024 * 2;
constexpr size_t WS_W_SBOUT = WS_W_SBIN + (size_t)3072 * 1024 * 2;
constexpr size_t WS_W_FFNGU = WS_W_SBOUT + (size_t)1024 * 1024 * 2;
constexpr size_t WS_W_FFND = WS_W_FFNGU + (size_t)2 * 5632 * 1024 * 2;
constexpr size_t WS_W_CMP1 = WS_W_FFND + (size_t)2 * 1024 * 2816 * 2;
constexpr size_t WS_W_CMP2 = WS_W_CMP1 + (size_t)2 * 128 * 4096 * 2;
constexpr size_t WS_W_MOEGU = WS_W_CMP2 + (size_t)2 * 128 * 128 * 2;
constexpr size_t WS_W_MOED = WS_W_MOEGU + (size_t)8 * 7168 * 1024 * 2;
constexpr size_t WS_SCR = al256(WS_W_MOED + (size_t)8 * 1024 * 3584 * 2);
constexpr size_t SC_HG_QS = WS_SCR;
constexpr size_t SC_HG_VV = SC_HG_QS + (size_t)NT * DM * 2;
constexpr size_t SC_HG_SG = SC_HG_VV + (size_t)NT * DM * 2;
constexpr size_t SC_HG_LF = SC_HG_SG + (size_t)NT * DM * 2;
constexpr size_t SC_HG_ST = SC_HG_LF + (size_t)NT * DM * 4;
constexpr size_t SC_HG_DEC = SC_HG_ST + (size_t)4096 * 128 * 128 * 2;
constexpr size_t SC_HG_END = SC_HG_DEC + (size_t)4096 * 128 * 4;
constexpr size_t SC_FF_ACT = WS_SCR;
constexpr size_t SC_FF_END = SC_FF_ACT + (size_t)NT * DFF * 2;
constexpr size_t SC_DA_Q = WS_SCR;
constexpr size_t SC_DA_K = SC_DA_Q + (size_t)NT * DM * 2;
constexpr size_t SC_DA_V = SC_DA_K + (size_t)NT * DM * 2;
constexpr size_t SC_DA_END = SC_DA_V + (size_t)NT * DM * 2;
constexpr size_t SC_MOE_ROUTE = WS_SCR;
constexpr size_t SC_MOE_XS = SC_MOE_ROUTE + (size_t)NT * 32;
constexpr size_t SC_MOE_ACT = SC_MOE_XS + al256((size_t)MOE_ROWS_MAX * 4);
constexpr size_t SC_MOE_Y = SC_MOE_ACT + (size_t)MOE_CHUNK_ROWS * DFFE * 2;
constexpr size_t SC_MOE_END = SC_MOE_Y + (size_t)MOE_ROWS_MAX * DM * 2;
constexpr size_t SC_NSA_Q = WS_SCR;
constexpr size_t SC_NSA_QR = SC_NSA_Q + (size_t)NT * DM * 2;
constexpr size_t SC_NSA_KV = SC_NSA_QR + (size_t)NT * DM * 2;
constexpr size_t SC_NSA_GATE = SC_NSA_KV + (size_t)6 * NT * 256 * 2;
constexpr size_t SC_NSA_KC = SC_NSA_GATE + (size_t)NT * 24 * 4;
constexpr size_t SC_NSA_OACC = SC_NSA_KC + (size_t)2 * 8 * NCMP_P * 128 * 2;
constexpr size_t SC_NSA_END = SC_NSA_OACC + (size_t)NT * DM * 4;
constexpr size_t SC_SB_Q = WS_SCR;
constexpr size_t SC_SB_K = SC_SB_Q + (size_t)NT * DM * 2;
constexpr size_t SC_SB_V = SC_SB_K + (size_t)NT * DM * 2;
constexpr size_t SC_SB_END = SC_SB_V + (size_t)NT * DM * 2;
constexpr size_t cmax(size_t a, size_t b) { return a > b ? a : b; }
constexpr size_t WS_END = cmax(cmax(cmax(SC_HG_END, SC_FF_END), cmax(SC_DA_END, SC_MOE_END)), cmax(SC_NSA_END, SC_SB_END));
static_assert(WS_END <= (size_t)981882880, "workspace budget (sum of the inputs)");

constexpr int LDS_BYTES = 152 * 1024;
constexpr int LDS_MISC = 150 * 1024;

__device__ __forceinline__ unsigned bf16_rne_bits(float f) { const unsigned u = __float_as_uint(f); return (u + 0x7fffu + ((u >> 16) & 1u)) >> 16; }
__device__ __forceinline__ unsigned cvtpk(float lo, float hi) {
    typedef __bf16 bf2_t __attribute__((ext_vector_type(2)));
    typedef float f2_t __attribute__((ext_vector_type(2)));
    const bf2_t r = __builtin_convertvector((f2_t){lo, hi}, bf2_t);
    return __builtin_bit_cast(unsigned, r);
}
__device__ __forceinline__ float bf2f(bf16_t b) { return __uint_as_float(((unsigned)b) << 16); }
__device__ __forceinline__ bf16_t f2bf(float f) { return (bf16_t)(cvtpk(f, 0.f) & 0xffffu); }
__device__ __forceinline__ bf16x8 pack8(f32x4 a, f32x4 b) { u32x4 w = {cvtpk(a[0], a[1]), cvtpk(a[2], a[3]), cvtpk(b[0], b[1]), cvtpk(b[2], b[3])}; return *reinterpret_cast<bf16x8*>(&w); }
__device__ __forceinline__ float sigmoidf_(float x) { return __builtin_amdgcn_rcpf(1.f + __expf(-x)); }
__device__ __forceinline__ float siluf_(float x) { return x * __builtin_amdgcn_rcpf(1.f + __expf(-x)); }
__device__ __forceinline__ int my_tid() { int t = threadIdx.x; asm volatile("" : "+v"(t)); return t; }
__device__ __forceinline__ float wave_sum(float v) {
#pragma unroll
    for (int o = 32; o > 0; o >>= 1) v += __shfl_xor(v, o);
    return v;
}

#define XB_TMO      128
#define XB_XCNT(j)  (256  + 64 * (j))
#define XB_XSUB(j)  (1280 + 64 * (j))
#define XB_XGEN(j)  (2304 + 64 * (j))
#define XB_TOP      3328
#define XB_TOPGEN   3392
#define XCD_BAR_WORDS 3456
#define XB_SPIN_CAP (1u << 18)
__device__ __forceinline__ unsigned xb_ld(unsigned* p)              { return __hip_atomic_load(p, __ATOMIC_RELAXED, __HIP_MEMORY_SCOPE_AGENT); }
__device__ __forceinline__ unsigned xb_add(unsigned* p, unsigned v) { return __hip_atomic_fetch_add(p, v, __ATOMIC_RELAXED, __HIP_MEMORY_SCOPE_AGENT); }
__device__ __forceinline__ unsigned xb_xcc_id() { return (unsigned)__builtin_amdgcn_s_getreg((3 << 11) | 20) & 0xFu; }
#define XB_SPIN(cond, bar) do { unsigned _sp = 0; while (cond) { __builtin_amdgcn_s_sleep(1); \
    if ((++_sp & 255u) == 0u) { if (xb_ld(&(bar)[XB_TMO])) break; if (_sp > XB_SPIN_CAP) { atomicAdd(&(bar)[XB_TMO], 1u); break; } } } } while (0)
struct XcdBarrier { unsigned* bar; unsigned x; volatile LAS unsigned* st; };
__device__ __forceinline__ XcdBarrier xcd_barrier_post(unsigned* bar, volatile LAS unsigned* st) {
    XcdBarrier b; b.bar = bar; b.x = xb_xcc_id(); b.st = st;
    if (threadIdx.x == 0) (void)xb_add(&bar[XB_XCNT(b.x)], 1u);
    return b;
}
__device__ __forceinline__ void xcd_barrier_complete(unsigned* bar, unsigned x, unsigned& nloc, unsigned& nx) {
    const unsigned G = gridDim.x * gridDim.y * gridDim.z;
    unsigned sum, cnt, mine, sp = 0u;
    for (;;) {
        sum = 0u; cnt = 0u; mine = 0u;
#pragma unroll
        for (unsigned j = 0; j < 16; ++j) { const unsigned c = xb_ld(&bar[XB_XCNT(j)]); sum += c; cnt += (c > 0u) ? 1u : 0u; mine = (j == x) ? c : mine; }
        if (sum == G) break;
        __builtin_amdgcn_s_sleep(1);
        if ((++sp & 255u) == 0u) { if (xb_ld(&bar[XB_TMO])) break; if (sp > XB_SPIN_CAP) { atomicAdd(&bar[XB_TMO], 1u); break; } }
    }
    nloc = mine > 0u ? mine : 1u; nx = cnt > 0u ? cnt : 1u;
}
__device__ __forceinline__ void xcd_barrier(const XcdBarrier& b) {
    asm volatile("s_waitcnt vmcnt(0)" ::: "memory");
    __syncthreads();
    if (threadIdx.x == 0) {
        unsigned* bar = b.bar;
        __builtin_amdgcn_s_waitcnt(0);
        unsigned nloc = b.st[0], nx = b.st[1];
        if (nloc == 0u) { xcd_barrier_complete(bar, b.x, nloc, nx); b.st[0] = nloc; b.st[1] = nx; }
        const unsigned old = xb_add(&bar[XB_XSUB(b.x)], 1u);
        const unsigned gen = old / nloc;
        if (old + 1u == (gen + 1u) * nloc) {
            __builtin_amdgcn_fence(__ATOMIC_RELEASE, "agent");
            asm volatile("s_waitcnt vmcnt(0)" ::: "memory");
            const unsigned og = xb_add(&bar[XB_TOP], 1u);
            const unsigned tg = og / nx;
            if (og + 1u == (tg + 1u) * nx) xb_add(&bar[XB_TOPGEN], 1u);
            else XB_SPIN(xb_ld(&bar[XB_TOPGEN]) == tg, bar);
            __builtin_amdgcn_fence(__ATOMIC_ACQUIRE, "agent");
            xb_add(&bar[XB_XGEN(b.x)], 1u);
            asm volatile("s_waitcnt vmcnt(0)" ::: "memory");
        } else {
            XB_SPIN(xb_ld(&bar[XB_XGEN(b.x)]) == gen, bar);
            __builtin_amdgcn_fence(__ATOMIC_ACQUIRE, "agent");
            asm volatile("s_waitcnt vmcnt(0)" ::: "memory");
        }
    }
    __syncthreads();
}

namespace pg8 {
constexpr int BM = 256, BK = 64, HALF = 128, HTB = HALF * BK * 2, STAGE_BYTES = 8 * HTB, NXCD = 8, WGM = 8;
__host__ __device__ __forceinline__ int lds_byte(int r, int c) { const int st = (r >> 4) * 2 + (c >> 5), rr = r & 15, cc = c & 31, ob = rr * 64 + cc * 2; return st * 1024 + (ob ^ (((ob >> 9) & 1) << 5)); }
__host__ __device__ __forceinline__ void stage_rc(int b, int& R, int& C) { const int st = b / 1024, sb = b % 1024, swz = sb ^ (((sb >> 9) & 1) << 5); R = (st >> 1) * 16 + swz / 64; C = (st & 1) * 32 + (swz % 64) / 2; }
__host__ __device__ __forceinline__ int perm32(int rho) { const int n = rho >> 4, i = rho & 15; return 8 * (i >> 2) + 4 * n + (i & 3); }
struct Unit { int pm, pn; };
struct Gemm { const bf16_t* A; const bf16_t* Bt; int M, N, K; };
struct StaticOrder {
    static constexpr bool GATHER = false; static constexpr int tile_lo = 0;
    __device__ __forceinline__ int row_token(int) const { return 0; }
    int nM, nN, nwg, G, c;
    __device__ void init(int M, int N, int G_, int c_) { nM = M / BM; nN = N / BM; nwg = nM * nN; G = G_; c = c_; }
    __device__ bool next(int i, Unit& u) const {
        const long L = (long)i * G + c; if (L >= nwg) return false;
        int wgid = (int)L; { const int q = nwg / NXCD, r = nwg % NXCD, xcd = wgid % NXCD, off = wgid / NXCD; wgid = (xcd < r ? xcd * (q + 1) : r * (q + 1) + (xcd - r) * q) + off; }
        const int nig = WGM * nN, gid = wgid / nig, fm = gid * WGM, gsz = (nM - fm) < WGM ? (nM - fm) : WGM;
        u.pm = fm + ((wgid % nig) % gsz); u.pn = (wgid % nig) / gsz; return true;
    }
};
template <class Epi, class Sched>
__device__ __forceinline__ void gemm_phase(ldsp_t lds, const Gemm g, const Sched& S, const Epi& E) {
    constexpr bool GA = Sched::GATHER;
    const int tid = my_tid(), wid = __builtin_amdgcn_readfirstlane(tid >> 6), lane = tid & 63, wr = wid >> 2, wc = wid & 3, fr = lane & 15, fq = lane >> 4;
    const int K = g.K, nt = K / BK;
    unsigned voffA[2], voffB[2]; int Rr[2]; unsigned Cc2[2];
#pragma unroll
    for (int i = 0; i < 2; ++i) { int R, C; stage_rc(tid * 16 + i * 8192, R, C); const int Rb = (R & ~31) + perm32(R & 31);
        voffA[i] = (unsigned)(R * K + C) * 2u; voffB[i] = (unsigned)(Rb * K + C) * 2u; Rr[i] = R; Cc2[i] = (unsigned)C * 2u; }
    LAS int* gtab = (LAS int*)(lds + STAGE_BYTES);
    if (GA) { Unit u_; for (int i = 0; S.next(i, u_); ++i) { if (tid < 256) gtab[i * 256 + tid] = S.row_token((S.tile_lo + u_.pm) * 256 + tid); }
        __syncthreads(); }
    unsigned vC[2][2], vN[2][2], vX[2][2];
#define PG8_LOADV(V, UI) do { _Pragma("unroll") for (int h_ = 0; h_ < 2; ++h_) _Pragma("unroll") for (int i_ = 0; i_ < 2; ++i_) \
        V[h_][i_] = (unsigned)gtab[(UI) * 256 + h_ * 128 + Rr[i_]] * (unsigned)(K * 2) + Cc2[i_]; } while (0)
    const size_t kstep = (size_t)(BK * 2);
    const size_t hstep = (size_t)HALF * K * 2;
    const size_t tstep = 2 * hstep;
    const unsigned ldsw = (unsigned)wid * 1024u;
    const int aoff = lds_byte(wr * 64 + fr, fq * 8), boff = lds_byte(wc * 32 + fr, fq * 8);
#define PG8_SA(b, h) (((b) * 2 + (h)) * HTB)
#define PG8_SB(b, h) ((4 + (b) * 2 + (h)) * HTB)
#define PG8_STAGE(bufoff, gbase, voff) do { _Pragma("unroll") for (int _i = 0; _i < 2; ++_i) \
        __builtin_amdgcn_global_load_lds((const unsigned*)((const char*)(gbase) + (voff)[_i]), (LAS unsigned*)(lds + (bufoff) + ldsw + _i * 8192), 16, 0, 0); } while (0)
#define PG8_STAGE_A(bufoff, gbase, H, V) do { _Pragma("unroll") for (int _i = 0; _i < 2; ++_i) \
        __builtin_amdgcn_global_load_lds((const unsigned*)((const char*)(gbase) + (GA ? (size_t)0 : (size_t)(H) * hstep) + (GA ? (V)[H][_i] : voffA[_i])), (LAS unsigned*)(lds + (bufoff) + ldsw + _i * 8192), 16, 0, 0); } while (0)
#define PG8_LDA(dst, b, h) do { _Pragma("unroll") for (int m = 0; m < 4; ++m) _Pragma("unroll") for (int k = 0; k < 2; ++k) dst[m][k] = *(const LAS bf16x8*)(lds + PG8_SA(b, h) + aoff + m * 2048 + k * 1024); } while (0)
#define PG8_LDB(dst, b, h) do { _Pragma("unroll") for (int n = 0; n < 2; ++n) _Pragma("unroll") for (int k = 0; k < 2; ++k) dst[n][k] = *(const LAS bf16x8*)(lds + PG8_SB(b, h) + boff + n * 2048 + k * 1024); } while (0)
#define PG8_MMA(ai, bj, At, Bt) do { __builtin_amdgcn_s_setprio(1); _Pragma("unroll") for (int m = 0; m < 4; ++m) _Pragma("unroll") for (int n = 0; n < 2; ++n) _Pragma("unroll") for (int k = 0; k < 2; ++k) \
        acc[ai][bj][m][n] = __builtin_amdgcn_mfma_f32_16x16x32_bf16(Bt[n][k], At[m][k], acc[ai][bj][m][n], 0, 0, 0); __builtin_amdgcn_s_setprio(0); } while (0)
#define PG8_WAIT_V(n) asm volatile("s_waitcnt vmcnt(" #n ")" ::: "memory")
#define PG8_WAIT_L(n) asm volatile("s_waitcnt lgkmcnt(" #n ")" ::: "memory")
#define PG8_BAR __builtin_amdgcn_s_barrier()
#define PG8_SCHED __builtin_amdgcn_sched_barrier(0)
    Unit cur, nxt; int ui = 0;
    if (!S.next(0, cur)) return;
    f32x4 acc[2][2][4][2];
#pragma unroll
    for (int a = 0; a < 2; ++a)
#pragma unroll
        for (int b = 0; b < 2; ++b)
#pragma unroll
            for (int m = 0; m < 4; ++m)
#pragma unroll
                for (int n = 0; n < 2; ++n) acc[a][b][m][n] = (f32x4){0.f, 0.f, 0.f, 0.f};
    bf16x8 At[4][2], B0[2][2], B1[2][2];
    const char* cA = (const char*)g.A + (GA ? (size_t)0 : (size_t)cur.pm * tstep); const char* cB = (const char*)g.Bt + (size_t)cur.pn * tstep;
    if (GA) { PG8_LOADV(vC, 0); }
    PG8_STAGE(PG8_SB(0, 0), cB, voffB); PG8_STAGE(PG8_SB(0, 1), cB + hstep, voffB); PG8_STAGE_A(PG8_SA(0, 0), cA, 0, vC); PG8_STAGE_A(PG8_SA(0, 1), cA, 1, vC);
    if (wr == 1) PG8_BAR;
    PG8_WAIT_V(2); PG8_BAR;
    PG8_STAGE(PG8_SB(1, 0), cB + kstep, voffB); PG8_STAGE_A(PG8_SA(1, 0), cA + kstep, 0, vC); PG8_STAGE(PG8_SB(1, 1), cB + hstep + kstep, voffB);
    PG8_WAIT_V(6); PG8_BAR;
    for (;;) {
        const bool has_next = S.next(ui + 1, nxt);
        const char* nA = (has_next && !GA) ? (const char*)g.A + (size_t)nxt.pm * tstep : cA; const char* nB = has_next ? (const char*)g.Bt + (size_t)nxt.pn * tstep : cB;
        if (GA) { if (has_next) { PG8_LOADV(vN, ui + 1); } else {
#pragma unroll
            for (int h_ = 0; h_ < 2; ++h_)
#pragma unroll
                for (int i_ = 0; i_ < 2; ++i_) vN[h_][i_] = vC[h_][i_]; } }
        for (int t = 0; t < nt; t += 2) {
            const bool last = (t == nt - 2);
            if (GA) {
#pragma unroll
                for (int h_ = 0; h_ < 2; ++h_)
#pragma unroll
                    for (int i_ = 0; i_ < 2; ++i_) vX[h_][i_] = last ? vN[h_][i_] : vC[h_][i_]; }
            const char* a1 = cA + (size_t)(t + 1) * kstep;
            const char* a2 = last ? nA : cA + (size_t)(t + 2) * kstep; const char* b2 = last ? nB : cB + (size_t)(t + 2) * kstep;
            const char* a3 = a2 + kstep; const char* b3 = b2 + kstep;
            PG8_LDB(B0, 0, 0); PG8_LDB(B1, 0, 1); PG8_SCHED; PG8_LDA(At, 0, 0); PG8_STAGE_A(PG8_SA(1, 1), a1, 1, vC);
            PG8_WAIT_V(8); PG8_WAIT_L(0); PG8_BAR; PG8_MMA(0, 0, At, B0); PG8_MMA(0, 1, At, B1); PG8_BAR; PG8_SCHED;
            PG8_LDA(At, 0, 1); PG8_STAGE(PG8_SB(0, 0), b2, voffB); PG8_STAGE(PG8_SB(0, 1), b2 + hstep, voffB); PG8_STAGE_A(PG8_SA(0, 0), a2, 0, vX);
            PG8_WAIT_V(8); PG8_WAIT_L(0); PG8_BAR; PG8_MMA(1, 0, At, B0); PG8_MMA(1, 1, At, B1); PG8_BAR; PG8_SCHED;
            PG8_LDB(B0, 1, 0); PG8_LDB(B1, 1, 1); PG8_SCHED; PG8_LDA(At, 1, 0); PG8_STAGE_A(PG8_SA(0, 1), a2, 1, vX);
            PG8_WAIT_V(8); PG8_WAIT_L(0); PG8_BAR; PG8_MMA(0, 0, At, B0); PG8_MMA(0, 1, At, B1); PG8_BAR; PG8_SCHED;
            PG8_LDA(At, 1, 1); PG8_STAGE(PG8_SB(1, 0), b3, voffB); PG8_STAGE(PG8_SB(1, 1), b3 + hstep, voffB); PG8_STAGE_A(PG8_SA(1, 0), a3, 0, vX);
            PG8_WAIT_V(8); PG8_WAIT_L(0); PG8_BAR; PG8_MMA(1, 0, At, B0); PG8_MMA(1, 1, At, B1); PG8_BAR; PG8_SCHED;
        }
        if (wr == 0) PG8_BAR;
        E(acc, cur, wr, wc, fr, fq);
        if (!has_next) break;
#pragma unroll
        for (int a = 0; a < 2; ++a)
#pragma unroll
            for (int b = 0; b < 2; ++b)
#pragma unroll
                for (int m = 0; m < 4; ++m)
#pragma unroll
                    for (int n = 0; n < 2; ++n) acc[a][b][m][n] = (f32x4){0.f, 0.f, 0.f, 0.f};
        cur = nxt; cA = nA; cB = nB; ++ui;
        if (GA) {
#pragma unroll
            for (int h_ = 0; h_ < 2; ++h_)
#pragma unroll
                for (int i_ = 0; i_ < 2; ++i_) vC[h_][i_] = vN[h_][i_]; }
        if (wr == 1) PG8_BAR;
    }
    PG8_WAIT_V(0);
    PG8_BAR;
#undef PG8_SA
#undef PG8_SB
#undef PG8_STAGE
#undef PG8_STAGE_A
#undef PG8_LOADV
#undef PG8_LDA
#undef PG8_LDB
#undef PG8_MMA
#undef PG8_WAIT_V
#undef PG8_WAIT_L
#undef PG8_BAR
#undef PG8_SCHED
}
}
using pg8::Unit;
typedef f32x4 acc_t[2][2][4][2];
#define EPI_BEGIN \
    _Pragma("unroll") for (int ai = 0; ai < 2; ++ai) _Pragma("unroll") for (int m = 0; m < 4; ++m) _Pragma("unroll") for (int bj = 0; bj < 2; ++bj) { \
        const int row = u.pm * 256 + ai * 128 + wr * 64 + m * 16 + fr; const int col = u.pn * 256 + bj * 128 + wc * 32 + 8 * fq; \
        const f32x4 v0 = acc[ai][bj][m][0], v1 = acc[ai][bj][m][1];
#define EPI_END if (bj == 1 && (m & 1)) asm volatile("" ::: "memory"); }

template <bool RES_F32>
struct EpiRes {
    const void* res; bf16_t* out;
    __device__ __forceinline__ void operator()(const acc_t& acc, const Unit& u, int wr, int wc, int fr, int fq) const {
        asm volatile("" : "+v"(fr), "+v"(fq));
        constexpr int MB = RES_F32 ? 2 : 4;
#pragma unroll
        for (int ai = 0; ai < 2; ++ai)
#pragma unroll
            for (int mp = 0; mp < 4 / MB; ++mp) {
                f32x4 rf[MB][2][2]; u32x4 rb[MB][2];
#pragma unroll
                for (int mm = 0; mm < MB; ++mm)
#pragma unroll
                    for (int bj = 0; bj < 2; ++bj) { const size_t o = (size_t)(u.pm * 256 + ai * 128 + wr * 64 + (MB * mp + mm) * 16 + fr) * DM + u.pn * 256 + bj * 128 + wc * 32 + 8 * fq;
                        if (RES_F32) { rf[mm][bj][0] = *(const f32x4*)((const float*)res + o); rf[mm][bj][1] = *(const f32x4*)((const float*)res + o + 4); }
                        else rb[mm][bj] = *(const u32x4*)((const bf16_t*)res + o); }
#pragma unroll
                for (int mm = 0; mm < MB; ++mm)
#pragma unroll
                    for (int bj = 0; bj < 2; ++bj) { const int m = MB * mp + mm; const size_t o = (size_t)(u.pm * 256 + ai * 128 + wr * 64 + m * 16 + fr) * DM + u.pn * 256 + bj * 128 + wc * 32 + 8 * fq;
                        f32x4 r0, r1;
                        if (RES_F32) { r0 = rf[mm][bj][0]; r1 = rf[mm][bj][1]; }
                        else { const u32x4 w = rb[mm][bj];
                            r0 = (f32x4){__uint_as_float(w[0] << 16), __uint_as_float(w[0] & 0xffff0000u), __uint_as_float(w[1] << 16), __uint_as_float(w[1] & 0xffff0000u)};
                            r1 = (f32x4){__uint_as_float(w[2] << 16), __uint_as_float(w[2] & 0xffff0000u), __uint_as_float(w[3] << 16), __uint_as_float(w[3] & 0xffff0000u)}; }
                        *(bf16x8*)(out + o) = pack8(r0 * ALPHA + acc[ai][bj][m][0], r1 * ALPHA + acc[ai][bj][m][1]); }
                asm volatile("" ::: "memory");
            }
    }
};
struct EpiHgIn {
    bf16_t* qs; bf16_t* vv; bf16_t* sg; float* lf; const float* lbv;
    __device__ __forceinline__ void operator()(const acc_t& acc, const Unit& u, int wr, int wc, int fr, int fq) const {
        asm volatile("" : "+v"(fr), "+v"(fq));
        const int typ = u.pn >> 2;
        EPI_BEGIN { const int c = col & 1023; const size_t o = (size_t)row * DM + c;
            if (typ == 0) { f32x4 a, b;
#pragma unroll
                for (int e = 0; e < 4; ++e) { a[e] = siluf_(v0[e]); b[e] = siluf_(v1[e]); }
                *(bf16x8*)(qs + o) = pack8(a, b); }
            else if (typ == 1) { const f32x4 l0 = *(const f32x4*)(lbv + c), l1 = *(const f32x4*)(lbv + c + 4); f32x4 a, b;
#pragma unroll
                for (int e = 0; e < 4; ++e) { a[e] = __logf(l0[e] + (1.f - l0[e]) * sigmoidf_(v0[e])); b[e] = __logf(l1[e] + (1.f - l1[e]) * sigmoidf_(v1[e])); }
                *(f32x4*)(lf + o) = a; *(f32x4*)(lf + o + 4) = b; }
            else if (typ == 2) { *(bf16x8*)(vv + o) = pack8(v0, v1); }
            else { f32x4 a, b;
#pragma unroll
                for (int e = 0; e < 4; ++e) { a[e] = sigmoidf_(v0[e]); b[e] = sigmoidf_(v1[e]); }
                *(bf16x8*)(sg + o) = pack8(a, b); } } EPI_END
    }
};
struct EpiSwiglu {
    bf16_t* act; int ldact; int ntile;
    __device__ __forceinline__ void operator()(const acc_t& acc, const Unit& u, int wr, int wc, int fr, int fq) const {
        asm volatile("" : "+v"(fr), "+v"(fq));
        const int pnl = u.pn % ntile;
#pragma unroll
        for (int ai = 0; ai < 2; ++ai)
#pragma unroll
            for (int m = 0; m < 4; ++m) { const int row = u.pm * 256 + ai * 128 + wr * 64 + m * 16 + fr, cl = pnl * 128 + wc * 32 + 8 * fq;
                const f32x4 g0 = acc[ai][0][m][0], g1 = acc[ai][0][m][1], u0 = acc[ai][1][m][0], u1 = acc[ai][1][m][1];
                f32x4 a, b;
#pragma unroll
                for (int e = 0; e < 4; ++e) { a[e] = siluf_(g0[e]) * u0[e]; b[e] = siluf_(g1[e]) * u1[e]; }
                *(bf16x8*)(act + (size_t)row * ldact + cl) = pack8(a, b);
                if (m & 1) asm volatile("" ::: "memory"); }
    }
};
struct EpiMoeDown {
    bf16_t* y;
    __device__ __forceinline__ void operator()(const acc_t& acc, const Unit& u, int wr, int wc, int fr, int fq) const {
        asm volatile("" : "+v"(fr), "+v"(fq));
        const int pnl = u.pn & 3;
        EPI_BEGIN { *(bf16x8*)(y + (size_t)row * DM + pnl * 256 + (col & 255)) = pack8(v0, v1); } EPI_END
    }
};
struct EpiDaIn {
    bf16_t* q; bf16_t* k; bf16_t* v; const f32x2* rope;
    __device__ __forceinline__ void operator()(const acc_t& acc, const Unit& u, int wr, int wc, int fr, int fq) const {
        asm volatile("" : "+v"(fr), "+v"(fq));
        const bool isqk = (u.pn * 256 < 2048);
        if (isqk) {
            const int blk = u.pn * 4 + wc, which = blk >> 4, hb = blk & 15, j0 = 8 * fq;
#pragma unroll
            for (int ai = 0; ai < 2; ++ai)
#pragma unroll
                for (int mp = 0; mp < 2; ++mp) {
                    f32x4 t[2][4];
#pragma unroll
                    for (int mm = 0; mm < 2; ++mm) { const int row = u.pm * 256 + ai * 128 + wr * 64 + (2 * mp + mm) * 16 + fr, pos = row & (SEQ - 1);
#pragma unroll
                        for (int i = 0; i < 4; ++i) t[mm][i] = *(const f32x4*)(rope + (size_t)pos * 32 + j0 + 2 * i); }
#pragma unroll
                    for (int mm = 0; mm < 2; ++mm) { const int m = 2 * mp + mm; const int row = u.pm * 256 + ai * 128 + wr * 64 + m * 16 + fr, b = row >> 13, pos = row & (SEQ - 1);
                        f32x4 y1[2], y2[2];
#pragma unroll
                        for (int h = 0; h < 2; ++h) { const f32x4 x1 = acc[ai][0][m][h], x2 = acc[ai][1][m][h]; const f32x4 ta = t[mm][2 * h], tb = t[mm][2 * h + 1];
                            const float cs[4] = {ta[0], ta[2], tb[0], tb[2]}, sn[4] = {ta[1], ta[3], tb[1], tb[3]};
#pragma unroll
                            for (int e = 0; e < 4; ++e) { y1[h][e] = x1[e] * cs[e] - x2[e] * sn[e]; y2[h][e] = x2[e] * cs[e] + x1[e] * sn[e]; } }
                        bf16_t* dst = (which ? k : q) + (((size_t)b * 8 + (hb >> 1)) * SEQ + pos) * 128 + (hb & 1) * 64 + j0;
                        *(bf16x8*)dst = pack8(y1[0], y1[1]); *(bf16x8*)(dst + 32) = pack8(y2[0], y2[1]); }
                    asm volatile("" ::: "memory");
                }
        } else {
            EPI_BEGIN { const int b = row >> 13, pos = row & (SEQ - 1), h = (col - 2048) >> 7, d = col & 127;
                *(bf16x8*)(v + (((size_t)b * 8 + h) * SEQ + pos) * 128 + d) = pack8(v0, v1); } EPI_END
        }
    }
};
struct EpiNsaIn {
    bf16_t* q; bf16_t* qr; bf16_t* kv; float* gates; const f32x2* rope;
    __device__ __forceinline__ void operator()(const acc_t& acc, const Unit& u, int wr, int wc, int fr, int fq) const {
        asm volatile("" : "+v"(fr), "+v"(fq));
        const bool isrope = (u.pn < 10);
        if (isrope) {
            const int blk = u.pn * 2 + (wc >> 1), j0 = 32 * (wc & 1) + 8 * fq;
            const int jj = (blk - 8) >> 1, g = (blk - 8) & 1; const bool rot = (jj == 2) || (jj == 4);
#pragma unroll
            for (int ai = 0; ai < 2; ++ai)
#pragma unroll
                for (int mp = 0; mp < 2; ++mp) {
                    f32x4 t[2][4];
#pragma unroll
                    for (int mm = 0; mm < 2; ++mm) { const int row = u.pm * 256 + ai * 128 + wr * 64 + (2 * mp + mm) * 16 + fr, pos = row & (SEQ - 1);
#pragma unroll
                        for (int i = 0; i < 4; ++i) t[mm][i] = *(const f32x4*)(rope + (size_t)pos * 64 + j0 + 2 * i); }
#pragma unroll
                    for (int mm = 0; mm < 2; ++mm) { const int m = 2 * mp + mm; const int row = u.pm * 256 + ai * 128 + wr * 64 + m * 16 + fr, b = row >> 13, pos = row & (SEQ - 1);
                        f32x4 y1[2], y2[2];
#pragma unroll
                        for (int h = 0; h < 2; ++h) { const f32x4 x1 = acc[ai][0][m][h], x2 = acc[ai][1][m][h]; const f32x4 ta = t[mm][2 * h], tb = t[mm][2 * h + 1];
                            const float cs[4] = {ta[0], ta[2], tb[0], tb[2]}, sn[4] = {ta[1], ta[3], tb[1], tb[3]};
#pragma unroll
                            for (int e = 0; e < 4; ++e) { y1[h][e] = x1[e] * cs[e] - x2[e] * sn[e]; y2[h][e] = x2[e] * cs[e] + x1[e] * sn[e]; } }
                        const bf16x8 p1 = pack8(acc[ai][0][m][0], acc[ai][0][m][1]), p2 = pack8(acc[ai][1][m][0], acc[ai][1][m][1]);
                        const bf16x8 r1 = pack8(y1[0], y1[1]), r2 = pack8(y2[0], y2[1]);
                        if (blk < 8) { const size_t o = (((size_t)b * 8 + blk) * SEQ + pos) * 128 + j0;
                            *(bf16x8*)(q + o) = p1; *(bf16x8*)(q + o + 64) = p2; *(bf16x8*)(qr + o) = r1; *(bf16x8*)(qr + o + 64) = r2; }
                        else { const size_t o = (((size_t)jj * 8 + b * 2 + g) * SEQ + pos) * 128 + j0;
                            *(bf16x8*)(kv + o) = rot ? r1 : p1; *(bf16x8*)(kv + o + 64) = rot ? r2 : p2; } }
                    asm volatile("" ::: "memory");
                }
        } else {
            EPI_BEGIN { const int gi = col - 2560;
                if (gi < 24) { f32x4 a, bb;
#pragma unroll
                    for (int e = 0; e < 4; ++e) { a[e] = sigmoidf_(v0[e]); bb[e] = sigmoidf_(v1[e]); }
                    *(f32x4*)(gates + (size_t)row * 24 + gi) = a; *(f32x4*)(gates + (size_t)row * 24 + gi + 4) = bb; } } EPI_END
        }
    }
};
struct EpiSbIn {
    bf16_t* qkv;
    __device__ __forceinline__ void operator()(const acc_t& acc, const Unit& u, int wr, int wc, int fr, int fq) const {
        asm volatile("" : "+v"(fr), "+v"(fq));
        EPI_BEGIN { const int b = row >> 13, pos = row & (SEQ - 1), which = col >> 10, h = (col >> 7) & 7, d = col & 127;
            *(bf16x8*)(qkv + (size_t)which * NT * DM + (((size_t)b * 8 + h) * SEQ + pos) * 128 + d) = pack8(v0, v1); } EPI_END
    }
};
using pg8::NXCD; using pg8::WGM;
template <bool GATHER_>
struct MoeOrderT {
    static constexpr bool GATHER = GATHER_;
    int G, c, tile_lo, nT, nNt; int seg_tile[8]; const int* tok; int imax = 0x7fffffff;
    __device__ __forceinline__ int row_token(int r) const { return tok[r]; }
    __device__ __forceinline__ bool next(int i, Unit& u) const { return i < imax && at((long)i * G + c, u); }
    __device__ __forceinline__ bool at(long L, Unit& u) const {
        const int nwg = nT * nNt;
        if (nT <= 0 || L >= (long)nwg) return false;
        int wgid = (int)L; { const int q = nwg / NXCD, r = nwg % NXCD, xcd = wgid % NXCD, off = wgid / NXCD; wgid = (xcd < r ? xcd * (q + 1) : r * (q + 1) + (xcd - r) * q) + off; }
        const int nig = WGM * nNt, gid = wgid / nig, fm = gid * WGM, gsz = (nT - fm) < WGM ? (nT - fm) : WGM;
        const int pml = fm + ((wgid % nig) % gsz), pn = (wgid % nig) / gsz, tile = tile_lo + pml;
        int e = 0;
#pragma unroll
        for (int k = 1; k < 8; ++k) e += (tile >= seg_tile[k]) ? 1 : 0;
        u.pm = pml; u.pn = e * nNt + pn; return true;
    }
};

struct MapId { const float* src; int ld, nsrc; __device__ __forceinline__ const float* operator()(int n) const { return n < nsrc ? src + n : nullptr; }
    __device__ __forceinline__ MapId shifted(size_t off) const { return MapId{src + off, ld, nsrc}; } };
struct MapRope64 { const float* src; int ld; __device__ __forceinline__ const float* operator()(int n) const {
    if (n >= 2048) return src + n; const int l = n & 255; return src + (n & ~255) + 64 * ((l >> 5) & 3) + 32 * (l >> 7) + (l & 31); }
    __device__ __forceinline__ MapRope64 shifted(size_t off) const { return MapRope64{src + off, ld}; } };
struct MapNsa { const float* src; int ld; __device__ __forceinline__ const float* operator()(int n) const {
    if (n >= 2584) return nullptr; if (n >= 2560) return src + n; const int l = n & 255, wc = (l >> 5) & 3; return src + (n & ~255) + 128 * (wc >> 1) + 64 * (l >> 7) + 32 * (wc & 1) + (l & 31); }
    __device__ __forceinline__ MapNsa shifted(size_t off) const { return MapNsa{src + off, ld}; } };
struct MapGU { const float* gate; const float* up; int ld; __device__ __forceinline__ const float* operator()(int n) const {
    const int u = n >> 8, c = n & 255; return c < 128 ? gate + 128 * u + c : up + 128 * u + (c - 128); }
    __device__ __forceinline__ MapGU shifted(size_t off) const { return MapGU{gate + off, up + off, ld}; } };
template <class Map>
__device__ __forceinline__ void convert_T(ldsp_t lds, bf16_t* dst, int nb, size_t src_bstride, int Ndst, int K, const Map map0, int wg, int nwg) {
    const int tid = my_tid(), ntn = Ndst >> 6, per = ntn * (K >> 6), ntiles = per * nb;
    LAS bf16_t* tl = (LAS bf16_t*)lds;
    const int ln = tid & 63, lk = tid >> 6, sn = tid >> 3, skc = (tid & 7) * 8;
    float va[8], vb[8];
#define CT_LOAD(V, TILE) do { const int bi_ = (TILE) / per, tt_ = (TILE) % per, n0_ = (tt_ % ntn) << 6, k0_ = (tt_ / ntn) << 6; \
        const Map m_ = map0.shifted((size_t)bi_ * src_bstride); const float* cp_ = m_(n0_ + ln); \
        _Pragma("unroll") for (int it = 0; it < 8; ++it) V[it] = cp_ ? __builtin_nontemporal_load(cp_ + (size_t)(k0_ + lk + 8 * it) * m_.ld) : 0.f; } while (0)
    float vc[8], vd[8];
    int tile = wg, buf = 0;
    if (tile < ntiles) CT_LOAD(va, tile);
    if (tile + nwg < ntiles) CT_LOAD(vb, tile + nwg);
    if (tile + 2 * nwg < ntiles) CT_LOAD(vc, tile + 2 * nwg);
#define CT_STEP(VCUR, VNEW) do { if (tile < ntiles) { \
        if (tile + 3 * nwg < ntiles) CT_LOAD(VNEW, tile + 3 * nwg); \
        LAS bf16_t* tb = tl + buf * (64 * 66); \
        _Pragma("unroll") for (int it = 0; it < 8; ++it) tb[ln * 66 + lk + 8 * it] = f2bf(VCUR[it]); \
        __syncthreads(); \
        { const int bi = tile / per, tt = tile % per, n0 = (tt % ntn) << 6, k0 = (tt / ntn) << 6; \
          const LAS unsigned* rp = (const LAS unsigned*)(tb + sn * 66 + skc); \
          const u32x4 w = {rp[0], rp[1], rp[2], rp[3]}; \
          *(u32x4*)(dst + ((size_t)bi * Ndst + n0 + sn) * K + k0 + skc) = w; } \
        tile += nwg; buf ^= 1; } } while (0)
    while (tile < ntiles) { CT_STEP(va, vd); CT_STEP(vb, va); CT_STEP(vc, vb); CT_STEP(vd, vc); }
#undef CT_STEP
    __syncthreads();
#undef CT_LOAD
}

struct Route { int e0, e1, p0, p1; float g0, g1; int pad0, pad1; };
__device__ __forceinline__ void moe_segments_lds(const unsigned* cnt, LAS int* segL) {
    if (threadIdx.x == 0) { int s = 0;
        for (int e = 0; e < 8; ++e) { segL[e] = s; s += (int)((cnt[e] + 255u) & ~255u); }
        segL[8] = s; }
    __syncthreads();
}
__device__ __forceinline__ void ln_phase(ldsp_t lds, const bf16_t* src, float* dst_f32, bf16_t* dst_bf16, const float* lng, const float* lnb,
                                         const Route* route_in, const bf16_t* ybuf, const unsigned* cnt_in,
                                         const float* wrouter, Route* route_out, unsigned* cnt_out, int wg, int nwg) {
    const int tid = my_tid(), wid = tid >> 6, lane = tid & 63;
    LAS float* wl = (LAS float*)lds;
    LAS int* rinfo = (LAS int*)(lds + 32768);
    LAS unsigned* cntL = (LAS unsigned*)(lds + 32768 + 4096);
    LAS int* seg_start = (LAS int*)(lds + 32768 + 4096 + 256);
    if (route_in) moe_segments_lds(cnt_in, seg_start);
    if (wrouter) { for (int i = tid; i < 8192; i += 512) { const int d = i >> 3, e = i & 7; wl[e * 1024 + d] = wrouter[i]; } }
    f32x4 gv[4], bv[4];
#pragma unroll
    for (int q = 0; q < 4; ++q) { gv[q] = *(const f32x4*)(lng + 4 * lane + 256 * q); bv[q] = *(const f32x4*)(lnb + 4 * lane + 256 * q); }
    for (int chunk = wg; chunk < NT / 128; chunk += nwg) {
        if (wrouter) { if (tid < 8) cntL[tid] = 0u; }
        __syncthreads();
        u32x2 zn[4], yan[4], ybn[4]; Route rn; rn.e0 = 0; rn.e1 = 0; rn.p0 = 0; rn.p1 = 0; rn.g0 = 0.f; rn.g1 = 0.f; rn.pad0 = 0; rn.pad1 = 0;
#define LN_LOAD(ROW) do { _Pragma("unroll") for (int q = 0; q < 4; ++q) zn[q] = *(const u32x2*)(src + (size_t)(ROW) * DM + 4 * lane + 256 * q); \
            if (route_in) { rn = route_in[(ROW)]; const size_t s0_ = (size_t)(seg_start[rn.e0] + rn.p0) * DM, s1_ = (size_t)(seg_start[rn.e1] + rn.p1) * DM; \
                _Pragma("unroll") for (int q = 0; q < 4; ++q) { yan[q] = *(const u32x2*)(ybuf + s0_ + 4 * lane + 256 * q); ybn[q] = *(const u32x2*)(ybuf + s1_ + 4 * lane + 256 * q); } } } while (0)
        LN_LOAD(chunk * 128 + wid * 16);
        for (int i = 0; i < 16; ++i) {
            const int rl = wid * 16 + i, row = chunk * 128 + rl;
            f32x4 z[4]; u32x2 ya[4], yb[4]; const Route r = rn;
#pragma unroll
            for (int q = 0; q < 4; ++q) { const u32x2 w = zn[q]; ya[q] = yan[q]; yb[q] = ybn[q];
                z[q] = (f32x4){__uint_as_float(w[0] << 16), __uint_as_float(w[0] & 0xffff0000u), __uint_as_float(w[1] << 16), __uint_as_float(w[1] & 0xffff0000u)}; }
            if (i + 1 < 16) LN_LOAD(row + 1);
            if (route_in) {
#pragma unroll
                for (int q = 0; q < 4; ++q) { const u32x2 a = ya[q], b = yb[q];
                    z[q][0] = z[q][0] * ALPHA + r.g0 * __uint_as_float(a[0] << 16) + r.g1 * __uint_as_float(b[0] << 16);
                    z[q][1] = z[q][1] * ALPHA + r.g0 * __uint_as_float(a[0] & 0xffff0000u) + r.g1 * __uint_as_float(b[0] & 0xffff0000u);
                    z[q][2] = z[q][2] * ALPHA + r.g0 * __uint_as_float(a[1] << 16) + r.g1 * __uint_as_float(b[1] << 16);
                    z[q][3] = z[q][3] * ALPHA + r.g0 * __uint_as_float(a[1] & 0xffff0000u) + r.g1 * __uint_as_float(b[1] & 0xffff0000u); }
            }
            float s = 0.f;
#pragma unroll
            for (int q = 0; q < 4; ++q) s += (z[q][0] + z[q][1]) + (z[q][2] + z[q][3]);
            const float mean = wave_sum(s) * (1.f / DM);
            float v = 0.f;
#pragma unroll
            for (int q = 0; q < 4; ++q) { z[q] = z[q] - mean; v += (z[q][0] * z[q][0] + z[q][1] * z[q][1]) + (z[q][2] * z[q][2] + z[q][3] * z[q][3]); }
            const float rstd = rsqrtf(wave_sum(v) * (1.f / DM) + LN_EPS);
#pragma unroll
            for (int q = 0; q < 4; ++q) { z[q] = z[q] * rstd * gv[q] + bv[q]; if (dst_f32) *(f32x4*)(dst_f32 + (size_t)row * DM + 4 * lane + 256 * q) = z[q]; }
            if (dst_bf16) {
#pragma unroll
                for (int q = 0; q < 4; ++q) *(u32x2*)(dst_bf16 + (size_t)row * DM + 4 * lane + 256 * q) = (u32x2){cvtpk(z[q][0], z[q][1]), cvtpk(z[q][2], z[q][3])};
            }
            if (wrouter) {
                float lg[8];
#pragma unroll
                for (int e = 0; e < 8; ++e) { float a = 0.f;
#pragma unroll
                    for (int q = 0; q < 4; ++q) { const f32x4 w = *(const LAS f32x4*)(wl + e * 1024 + 4 * lane + 256 * q); a += z[q][0] * w[0] + z[q][1] * w[1] + z[q][2] * w[2] + z[q][3] * w[3]; }
                    lg[e] = wave_sum(a); }
                int e0 = 0; float v0 = lg[0];
#pragma unroll
                for (int e = 1; e < 8; ++e) if (lg[e] > v0) { v0 = lg[e]; e0 = e; }
                int e1 = -1; float v1 = -3.0e38f;
#pragma unroll
                for (int e = 0; e < 8; ++e) if (e != e0 && lg[e] > v1) { v1 = lg[e]; e1 = e; }
                if (e1 < 0) { e1 = (e0 + 1) & 7; v1 = v0; }
                if (lane == 0) {
                    const float g1 = 1.f / (1.f + __expf(v0 - v1)), g0 = 1.f - g1;
                    const int p0 = (int)atomicAdd((unsigned*)(cntL + e0), 1u), p1 = (int)atomicAdd((unsigned*)(cntL + e1), 1u);
                    rinfo[rl * 6 + 0] = e0; rinfo[rl * 6 + 1] = e1; rinfo[rl * 6 + 2] = p0; rinfo[rl * 6 + 3] = p1;
                    rinfo[rl * 6 + 4] = __float_as_int(g0); rinfo[rl * 6 + 5] = __float_as_int(g1);
                }
            }
        }
        if (wrouter) {
            __syncthreads();
            if (tid < 8) cntL[8 + tid] = atomicAdd(cnt_out + tid, cntL[tid]);
            __syncthreads();
            if (tid < 128) { Route r; r.e0 = rinfo[tid * 6 + 0]; r.e1 = rinfo[tid * 6 + 1];
                r.p0 = rinfo[tid * 6 + 2] + (int)cntL[8 + r.e0]; r.p1 = rinfo[tid * 6 + 3] + (int)cntL[8 + r.e1];
                r.g0 = __int_as_float(rinfo[tid * 6 + 4]); r.g1 = __int_as_float(rinfo[tid * 6 + 5]); r.pad0 = 0; r.pad1 = 0;
                route_out[chunk * 128 + tid] = r; }
            __syncthreads();
        }
    }
}
#undef LN_LOAD
__device__ __forceinline__ void moe_build_table(ldsp_t lds, int* tab, const Route* route, const unsigned* cnt, int wg, int nwg) {
    const int tid = my_tid();
    LAS int* seg_start = (LAS int*)lds; moe_segments_lds(cnt, seg_start);
    for (int t = wg * 512 + tid; t < NT; t += nwg * 512) { const Route r = route[t]; tab[seg_start[r.e0] + r.p0] = t; tab[seg_start[r.e1] + r.p1] = t; }
    for (int i = wg * 512 + tid; i < 8 * 256; i += nwg * 512) { const int e = i >> 8, k = i & 255; const int c = (int)cnt[e], pad = (c + 255) & ~255;
        if (c + k < pad) tab[seg_start[e] + c + k] = 0; }
    __syncthreads();
}

constexpr int HG_P144 = 144, HG_P272 = 272;
__device__ __forceinline__ void hgrn_passA(ldsp_t lds, const float* lf, const bf16_t* vv, bf16_t* ST, float* dec, int wg, int nwg) {
    const int tid = my_tid(), wid = tid >> 6, lane = tid & 63, r32 = lane & 31, hi = lane >> 5;
    const int d = tid & 127, sq = tid >> 7;
    ldsp_t KhT = lds, VT = lds + 128 * HG_P144; LAS float* tot = (LAS float*)(lds + 2 * 128 * HG_P144);
    float lfn[16]; bf16_t vnx[16];
#define HA_LOAD(IT) do { const int bh_ = (IT) >> 7, c_ = (IT) & 127, b_ = bh_ >> 3, h_ = bh_ & 7; const size_t t0_ = (size_t)b_ * SEQ + c_ * 64; \
        _Pragma("unroll") for (int tt = 0; tt < 16; ++tt) { const size_t o_ = (t0_ + 16 * sq + tt) * DM + h_ * 128 + d; lfn[tt] = lf[o_]; vnx[tt] = vv[o_]; } } while (0)
    if (wg < 4096) HA_LOAD(wg);
    for (int it = wg; it < 4096; it += nwg) {
        const int bh = it >> 7, c = it & 127, b = bh >> 3, h = bh & 7;
        const size_t tok0 = (size_t)b * SEQ + c * 64; (void)tok0; (void)b; (void)h;
        float lfv[16], cs[16]; bf16_t vraw[16];
#pragma unroll
        for (int tt = 0; tt < 16; ++tt) { lfv[tt] = lfn[tt]; vraw[tt] = vnx[tt]; }
        if (it + nwg < 4096) HA_LOAD(it + nwg);
        float run = 0.f;
#pragma unroll
        for (int tt = 0; tt < 16; ++tt) { run += lfv[tt]; cs[tt] = run; }
        tot[sq * 128 + d] = run;
        __syncthreads();
        float off = 0.f, cl = 0.f;
#pragma unroll
        for (int q = 0; q < 4; ++q) { const float t = tot[q * 128 + d]; cl += t; off += (q < sq) ? t : 0.f; }
        if (sq == 0) dec[(size_t)it * 128 + d] = __expf(cl);
        { unsigned w[8];
#pragma unroll
          for (int p = 0; p < 8; ++p) { const float c0 = off + cs[2 * p], c1 = off + cs[2 * p + 1];
              w[p] = cvtpk((1.f - __expf(lfv[2 * p])) * __expf(cl - c0), (1.f - __expf(lfv[2 * p + 1])) * __expf(cl - c1)); }
          *(LAS u32x4*)(KhT + d * HG_P144 + sq * 32) = (u32x4){w[0], w[1], w[2], w[3]};
          *(LAS u32x4*)(KhT + d * HG_P144 + sq * 32 + 16) = (u32x4){w[4], w[5], w[6], w[7]};
          unsigned x[8];
#pragma unroll
          for (int p = 0; p < 8; ++p) x[p] = (unsigned)vraw[2 * p] | ((unsigned)vraw[2 * p + 1] << 16);
          *(LAS u32x4*)(VT + d * HG_P144 + sq * 32) = (u32x4){x[0], x[1], x[2], x[3]};
          *(LAS u32x4*)(VT + d * HG_P144 + sq * 32 + 16) = (u32x4){x[4], x[5], x[6], x[7]}; }
        __syncthreads();
        const int mt = wid >> 1;
#pragma unroll
        for (int nn = 0; nn < 2; ++nn) { const int nt = (wid & 1) * 2 + nn; f32x16 acc = {};
#pragma unroll
            for (int ks = 0; ks < 4; ++ks) {
                const bf16x8 a = *(const LAS bf16x8*)(VT + (32 * mt + r32) * HG_P144 + (16 * ks + 8 * hi) * 2);
                const bf16x8 bb = *(const LAS bf16x8*)(KhT + (32 * nt + r32) * HG_P144 + (16 * ks + 8 * hi) * 2);
                acc = __builtin_amdgcn_mfma_f32_32x32x16_bf16(a, bb, acc, 0, 0, 0); }
#pragma unroll
            for (int r = 0; r < 16; ++r) { const int v = 32 * mt + (r & 3) + 8 * (r >> 2) + 4 * hi;
                ST[((size_t)it * 128 + v) * 128 + 32 * nt + r32] = f2bf(acc[r]); } }
        __syncthreads();
    }
}
#undef HA_LOAD
__device__ __forceinline__ void hgrn_passB(bf16_t* ST, const float* dec, int wg, int nwg) {
    for (int eg = wg * 512 + my_tid(); eg < 32 * 4096; eg += nwg * 512) {
        const int bh = eg >> 12, w = eg & 4095, v = w >> 5, d4 = (w & 31) * 4;
        float st[4] = {0.f, 0.f, 0.f, 0.f};
        for (int c0 = 0; c0 < 128; c0 += 8) {
            u32x2 kvr[8]; f32x4 dc[8];
#pragma unroll
            for (int j = 0; j < 8; ++j) { const size_t it = (size_t)bh * 128 + c0 + j;
                kvr[j] = *(const u32x2*)(ST + (it * 128 + v) * 128 + d4); dc[j] = *(const f32x4*)(dec + it * 128 + d4); }
#pragma unroll
            for (int j = 0; j < 8; ++j) { const size_t it = (size_t)bh * 128 + c0 + j;
                *(u32x2*)(ST + (it * 128 + v) * 128 + d4) = (u32x2){cvtpk(st[0], st[1]), cvtpk(st[2], st[3])};
                st[0] = dc[j][0] * st[0] + __uint_as_float(kvr[j][0] << 16); st[1] = dc[j][1] * st[1] + __uint_as_float(kvr[j][0] & 0xffff0000u);
                st[2] = dc[j][2] * st[2] + __uint_as_float(kvr[j][1] << 16); st[3] = dc[j][3] * st[3] + __uint_as_float(kvr[j][1] & 0xffff0000u); }
        }
    }
}
__device__ __forceinline__ void hgrn_passC(ldsp_t lds, const bf16_t* qs, const float* lf, const bf16_t* vv, const bf16_t* sg, const bf16_t* ST, const float* normg, bf16_t* ob, int wg, int nwg) {
    const int tid = my_tid(), wid = tid >> 6, lane = tid & 63, c16 = lane & 15, g = lane >> 4;
    const int d = tid & 127, sq = tid >> 7;
    ldsp_t Qi = lds, Qc = lds + 17408, Kt = lds + 2 * 17408, VT = lds + 2 * 17408 + 43520, STl = VT + 18432;
    LAS float* refs = (LAS float*)(STl + 34816); LAS float* tot = refs + 512; LAS float* ssq = tot + 512;
    float lfn[16]; bf16_t qn[16], vn[16]; u32x4 stn[4];
#define HC_LOAD(IT) do { const int bh_ = (IT) >> 7, c_ = (IT) & 127, b_ = bh_ >> 3, h_ = bh_ & 7; const size_t t0_ = (size_t)b_ * SEQ + c_ * 64; \
        _Pragma("unroll") for (int tt = 0; tt < 16; ++tt) { const size_t o_ = (t0_ + 16 * sq + tt) * DM + h_ * 128 + d; lfn[tt] = lf[o_]; qn[tt] = qs[o_]; vn[tt] = vv[o_]; } \
        _Pragma("unroll") for (int i4 = 0; i4 < 4; ++i4) { const int p = tid + 512 * i4, v = p >> 4, ch = p & 15; stn[i4] = *(const u32x4*)(ST + ((size_t)(IT) * 128 + v) * 128 + ch * 8); } } while (0)
    if (wg < 4096) HC_LOAD(wg);
    for (int it = wg; it < 4096; it += nwg) {
        const int bh = it >> 7, c = it & 127, b = bh >> 3, h = bh & 7;
        const size_t tok0 = (size_t)b * SEQ + c * 64;
        float lfv[16], cum[16]; bf16_t qraw[16], vraw[16];
#pragma unroll
        for (int tt = 0; tt < 16; ++tt) { lfv[tt] = lfn[tt]; qraw[tt] = qn[tt]; vraw[tt] = vn[tt]; }
        float run = 0.f;
#pragma unroll
        for (int tt = 0; tt < 16; ++tt) { run += lfv[tt]; cum[tt] = run; }
        tot[sq * 128 + d] = run;
#pragma unroll
        for (int i4 = 0; i4 < 4; ++i4) { const int p = tid + 512 * i4, v = p >> 4, ch = p & 15;
            *(LAS u32x4*)(STl + v * HG_P272 + ch * 16) = stn[i4]; }
        { unsigned x[8];
#pragma unroll
          for (int p = 0; p < 8; ++p) x[p] = (unsigned)vraw[2 * p] | ((unsigned)vraw[2 * p + 1] << 16);
          *(LAS u32x4*)(VT + d * HG_P144 + sq * 32) = (u32x4){x[0], x[1], x[2], x[3]};
          *(LAS u32x4*)(VT + d * HG_P144 + sq * 32 + 16) = (u32x4){x[4], x[5], x[6], x[7]}; }
        if (it + nwg < 4096) HC_LOAD(it + nwg);
        __syncthreads();
        float off = 0.f;
#pragma unroll
        for (int q = 0; q < 4; ++q) { const float t = tot[q * 128 + d]; off += (q < sq) ? t : 0.f; }
#pragma unroll
        for (int tt = 0; tt < 16; ++tt) cum[tt] += off;
        refs[sq * 128 + d] = cum[0];
        __syncthreads();
        float rf[4];
#pragma unroll
        for (int i = 0; i < 4; ++i) rf[i] = refs[i * 128 + d];
        float rme = rf[0];
#pragma unroll
        for (int i = 1; i < 4; ++i) rme = (sq == i) ? rf[i] : rme;
#pragma unroll
        for (int tt = 0; tt < 16; ++tt) { const int t = 16 * sq + tt; const float qv = bf2f(qraw[tt]);
            *(LAS bf16_t*)(Qi + t * HG_P272 + d * 2) = f2bf(qv * __expf(cum[tt] - rme));
            *(LAS bf16_t*)(Qc + t * HG_P272 + d * 2) = f2bf(qv * __expf(cum[tt]));
            const float kvv = 1.f - __expf(lfv[tt]);
#pragma unroll
            for (int i = 0; i < 4; ++i) { const int rb = (i == 0) ? 0 : (i == 1) ? 16 : (i == 2) ? 48 : 96;
                if (i >= sq) *(LAS bf16_t*)(Kt + (rb + t) * HG_P272 + d * 2) = f2bf(kvv * __expf(rf[i] - cum[tt])); } }
        __syncthreads();
        const int ib = wid >> 1, vh = wid & 1;
        const int rbI = (ib == 0) ? 0 : (ib == 1) ? 16 : (ib == 2) ? 48 : 96;
        f32x4 sc[4];
#pragma unroll
        for (int a = 0; a < 4; ++a) { sc[a] = (f32x4){0.f, 0.f, 0.f, 0.f};
            if (a <= ib) {
#pragma unroll
                for (int ks = 0; ks < 4; ++ks) {
                    const bf16x8 A = *(const LAS bf16x8*)(Kt + (rbI + 16 * a + c16) * HG_P272 + (32 * ks + 8 * g) * 2);
                    const bf16x8 B = *(const LAS bf16x8*)(Qi + (16 * ib + c16) * HG_P272 + (32 * ks + 8 * g) * 2);
                    sc[a] = __builtin_amdgcn_mfma_f32_16x16x32_bf16(A, B, sc[a], 0, 0, 0); }
                if (a == ib) {
#pragma unroll
                    for (int r = 0; r < 4; ++r) if (4 * g + r > c16) sc[a][r] = 0.f; } } }
        bf16x8 pb[2];
#pragma unroll
        for (int p = 0; p < 2; ++p) { const u32x4 w = {cvtpk(sc[2 * p][0], sc[2 * p][1]), cvtpk(sc[2 * p][2], sc[2 * p][3]), cvtpk(sc[2 * p + 1][0], sc[2 * p + 1][1]), cvtpk(sc[2 * p + 1][2], sc[2 * p + 1][3])};
            pb[p] = *reinterpret_cast<const bf16x8*>(&w); }
        f32x4 ao[4]; float ssl = 0.f;
#pragma unroll
        for (int vt = 0; vt < 4; ++vt) { ao[vt] = (f32x4){0.f, 0.f, 0.f, 0.f}; const int vrow = 16 * (4 * vh + vt) + c16;
#pragma unroll
            for (int p = 0; p < 2; ++p) if (2 * p <= ib) {
                const u32x2 lo = *(const LAS u32x2*)(VT + vrow * HG_P144 + (32 * p + 4 * g) * 2), hi2 = *(const LAS u32x2*)(VT + vrow * HG_P144 + (32 * p + 16 + 4 * g) * 2);
                const u32x4 w = {lo[0], lo[1], hi2[0], hi2[1]};
                ao[vt] = __builtin_amdgcn_mfma_f32_16x16x32_bf16(*reinterpret_cast<const bf16x8*>(&w), pb[p], ao[vt], 0, 0, 0); }
#pragma unroll
            for (int ks = 0; ks < 4; ++ks) {
                const bf16x8 A = *(const LAS bf16x8*)(STl + vrow * HG_P272 + (32 * ks + 8 * g) * 2);
                const bf16x8 B = *(const LAS bf16x8*)(Qc + (16 * ib + c16) * HG_P272 + (32 * ks + 8 * g) * 2);
                ao[vt] = __builtin_amdgcn_mfma_f32_16x16x32_bf16(A, B, ao[vt], 0, 0, 0); }
            ssl += ao[vt][0] * ao[vt][0] + ao[vt][1] * ao[vt][1] + ao[vt][2] * ao[vt][2] + ao[vt][3] * ao[vt][3]; }
        ssl += __shfl_xor(ssl, 16); ssl += __shfl_xor(ssl, 32);
        if (g == 0) ssq[vh * 64 + 16 * ib + c16] = ssl;
        __syncthreads();
        const float rs = rsqrtf((ssq[16 * ib + c16] + ssq[64 + 16 * ib + c16]) * (1.f / 128.f) + LN_EPS);
        const size_t trow = (tok0 + 16 * ib + c16) * DM + h * 128;
#pragma unroll
        for (int vt = 0; vt < 4; ++vt) { const int v0 = 16 * (4 * vh + vt) + 4 * g;
            const f32x4 ng = *(const f32x4*)(normg + v0); const u32x2 sgr = *(const u32x2*)(sg + trow + v0);
            const float o0 = ao[vt][0] * rs * ng[0] * __uint_as_float(sgr[0] << 16), o1 = ao[vt][1] * rs * ng[1] * __uint_as_float(sgr[0] & 0xffff0000u);
            const float o2 = ao[vt][2] * rs * ng[2] * __uint_as_float(sgr[1] << 16), o3 = ao[vt][3] * rs * ng[3] * __uint_as_float(sgr[1] & 0xffff0000u);
            *(u32x2*)(ob + trow + v0) = (u32x2){cvtpk(o0, o1), cvtpk(o2, o3)}; }
        __syncthreads();
    }
}

#undef HC_LOAD
#define KSWZ(row, colB) ((row) * 256 + ((colB) ^ (((row) & 7) << 4)))
__device__ __forceinline__ int q_park(int wid) { return wid < 4 ? 2 * 32768 + wid * 8192 : 3 * 32768 + 2048 + (wid - 4) * 8192; }
constexpr int AT_V = 0, AT_K = 16384, AT_BUF = 32768, AT_WS = 3 * 32768, AT_END = 3 * 32768 + 8 * 64 * 4;
__device__ __forceinline__ int v_st(int k, int c) { const int kk = (k & ~0xC) | ((k & 4) << 1) | ((k & 8) >> 1); return ((kk >> 3) * 4 + (c >> 5)) * 512 + ((kk & 7) * 32 + (c & 31)) * 2; }
__device__ __forceinline__ int v_rd_base(int lane) { return ((lane & 3) << 3) | (((lane >> 2) & 3) << 6) | (((lane >> 4) & 1) << 5) | (((lane >> 5) & 1) << 8); }
constexpr int v_rd_off(int d0, int ks, int half) { return d0 * 512 + ks * 4096 + half * 2048; }
__device__ __forceinline__ int crow(int r, int hi) { return (r & 3) + 8 * (r >> 2) + 4 * hi; }
template <int D0_LO, int D0_HI>
__device__ __forceinline__ void qkt_range(f32x16& p0, f32x16& p1, ldsp_t Kt, int r32, int hi, const bf16x8* qr) {
    p0 = f32x16{}; p1 = f32x16{};
    ldsp_t kb[4];
#pragma unroll
    for (int dd = 0; dd < 4; ++dd) kb[dd] = Kt + KSWZ(r32, (dd * 16 + hi * 8) * 2);
#pragma unroll
    for (int d0 = D0_LO; d0 < D0_HI; ++d0) {
        ldsp_t a = kb[d0 & 3] + (d0 >> 2) * 128;
        const bf16x8 b0 = *(const LAS bf16x8*)(a);
        const bf16x8 b1 = *(const LAS bf16x8*)(a + 32 * 256);
        p0 = __builtin_amdgcn_mfma_f32_32x32x16_bf16(b0, qr[d0], p0, 0, 0, 0);
        p1 = __builtin_amdgcn_mfma_f32_32x32x16_bf16(b1, qr[d0], p1, 0, 0, 0); }
}
template <int D0_LO, int D0_HI>
__device__ __forceinline__ void qkt_range_lq(f32x16& p0, f32x16& p1, ldsp_t Kt, ldsp_t Qw, int r32, int hi) {
    p0 = f32x16{}; p1 = f32x16{};
    int ko[4];
#pragma unroll
    for (int dd = 0; dd < 4; ++dd) ko[dd] = KSWZ(r32, (dd * 16 + hi * 8) * 2);
#pragma unroll
    for (int d0 = D0_LO; d0 < D0_HI; ++d0) {
        const int off = ko[d0 & 3] + (d0 >> 2) * 128;
        const bf16x8 b0 = *(const LAS bf16x8*)(Kt + off);
        const bf16x8 b1 = *(const LAS bf16x8*)(Kt + off + 32 * 256);
        const bf16x8 q = *(const LAS bf16x8*)(Qw + off);
        p0 = __builtin_amdgcn_mfma_f32_32x32x16_bf16(b0, q, p0, 0, 0, 0);
        p1 = __builtin_amdgcn_mfma_f32_32x32x16_bf16(b1, q, p1, 0, 0, 0); }
}
template <int ND>
__device__ __forceinline__ void qkt(f32x16& p0, f32x16& p1, ldsp_t Kt, int r32, int hi, const bf16x8* qr) {
    p0 = f32x16{}; p1 = f32x16{};
    ldsp_t kb[4];
#pragma unroll
    for (int dd = 0; dd < 4; ++dd) kb[dd] = Kt + KSWZ(r32, (dd * 16 + hi * 8) * 2);
#pragma unroll
    for (int d0 = 0; d0 < ND; ++d0) {
        ldsp_t a = kb[d0 & 3] + (d0 >> 2) * 128;
        const bf16x8 b0 = *(const LAS bf16x8*)(a);
        const bf16x8 b1 = *(const LAS bf16x8*)(a + 32 * 256);
        p0 = __builtin_amdgcn_mfma_f32_32x32x16_bf16(b0, qr[d0], p0, 0, 0, 0);
        p1 = __builtin_amdgcn_mfma_f32_32x32x16_bf16(b1, qr[d0], p1, 0, 0, 0); }
}
__device__ __forceinline__ void pv_tile(f32x16* o, unsigned vb0, bf16x8 pa0, bf16x8 pa1, bf16x8 pa2, bf16x8 pa3) {
#define TRRD(dst, off) asm volatile("ds_read_b64_tr_b16 %0, %1 offset:%2" : "=&v"(dst) : "v"(vb0), "i"(off) : "memory")
#define PV_D0(d0) do { s16x4 l0, l1, l2, l3, h0, h1, h2, h3; constexpr int b_ = v_rd_off(d0, 0, 0); \
        TRRD(l0, b_); TRRD(h0, b_ + 2048); TRRD(l1, b_ + 4096); TRRD(h1, b_ + 6144); TRRD(l2, b_ + 8192); TRRD(h2, b_ + 10240); TRRD(l3, b_ + 12288); TRRD(h3, b_ + 14336); \
        asm volatile("s_waitcnt lgkmcnt(0)" ::: "memory"); __builtin_amdgcn_sched_barrier(0); \
        o[d0] = __builtin_amdgcn_mfma_f32_32x32x16_bf16(pa0, (bf16x8){l0[0], l0[1], l0[2], l0[3], h0[0], h0[1], h0[2], h0[3]}, o[d0], 0, 0, 0);   \
        o[d0] = __builtin_amdgcn_mfma_f32_32x32x16_bf16(pa1, (bf16x8){l1[0], l1[1], l1[2], l1[3], h1[0], h1[1], h1[2], h1[3]}, o[d0], 0, 0, 0);   \
        o[d0] = __builtin_amdgcn_mfma_f32_32x32x16_bf16(pa2, (bf16x8){l2[0], l2[1], l2[2], l2[3], h2[0], h2[1], h2[2], h2[3]}, o[d0], 0, 0, 0);   \
        o[d0] = __builtin_amdgcn_mfma_f32_32x32x16_bf16(pa3, (bf16x8){l3[0], l3[1], l3[2], l3[3], h3[0], h3[1], h3[2], h3[3]}, o[d0], 0, 0, 0); } while (0)
    PV_D0(0); PV_D0(1); PV_D0(2); PV_D0(3);
#undef PV_D0
#undef TRRD
}
__device__ __forceinline__ void pv_tile_h(f32x16* o, unsigned vb0, bf16x8 pa0, bf16x8 pa1, bf16x8 pa2, bf16x8 pa3) {
#define TRRD(dst, off) asm volatile("ds_read_b64_tr_b16 %0, %1 offset:%2" : "=&v"(dst) : "v"(vb0), "i"(off) : "memory")
#define PV_D0(d0) do { constexpr int b_ = v_rd_off(d0, 0, 0); \
        { s16x4 l0, l1, h0, h1; TRRD(l0, b_); TRRD(h0, b_ + 2048); TRRD(l1, b_ + 4096); TRRD(h1, b_ + 6144); \
          asm volatile("s_waitcnt lgkmcnt(0)" ::: "memory"); __builtin_amdgcn_sched_barrier(0); \
          o[d0] = __builtin_amdgcn_mfma_f32_32x32x16_bf16(pa0, (bf16x8){l0[0], l0[1], l0[2], l0[3], h0[0], h0[1], h0[2], h0[3]}, o[d0], 0, 0, 0);   \
          o[d0] = __builtin_amdgcn_mfma_f32_32x32x16_bf16(pa1, (bf16x8){l1[0], l1[1], l1[2], l1[3], h1[0], h1[1], h1[2], h1[3]}, o[d0], 0, 0, 0); } \
        { s16x4 l2, l3, h2, h3; TRRD(l2, b_ + 8192); TRRD(h2, b_ + 10240); TRRD(l3, b_ + 12288); TRRD(h3, b_ + 14336); \
          asm volatile("s_waitcnt lgkmcnt(0)" ::: "memory"); __builtin_amdgcn_sched_barrier(0); \
          o[d0] = __builtin_amdgcn_mfma_f32_32x32x16_bf16(pa2, (bf16x8){l2[0], l2[1], l2[2], l2[3], h2[0], h2[1], h2[2], h2[3]}, o[d0], 0, 0, 0);   \
          o[d0] = __builtin_amdgcn_mfma_f32_32x32x16_bf16(pa3, (bf16x8){l3[0], l3[1], l3[2], l3[3], h3[0], h3[1], h3[2], h3[3]}, o[d0], 0, 0, 0); } } while (0)
    PV_D0(0); PV_D0(1); PV_D0(2); PV_D0(3);
#undef PV_D0
#undef TRRD
}
__device__ __forceinline__ void pv_tile2(f32x16* oa, f32x16* ob_, unsigned vb0, const bf16x8* pa, const bf16x8* pb) {
#define TRRD(dst, off) asm volatile("ds_read_b64_tr_b16 %0, %1 offset:%2" : "=&v"(dst) : "v"(vb0), "i"(off) : "memory")
#define PV_D0(d0) do { s16x4 l0, l1, l2, l3, h0, h1, h2, h3; constexpr int b_ = v_rd_off(d0, 0, 0); \
        TRRD(l0, b_); TRRD(h0, b_ + 2048); TRRD(l1, b_ + 4096); TRRD(h1, b_ + 6144); TRRD(l2, b_ + 8192); TRRD(h2, b_ + 10240); TRRD(l3, b_ + 12288); TRRD(h3, b_ + 14336); \
        asm volatile("s_waitcnt lgkmcnt(0)" ::: "memory"); __builtin_amdgcn_sched_barrier(0); \
        const bf16x8 v0_ = (bf16x8){l0[0], l0[1], l0[2], l0[3], h0[0], h0[1], h0[2], h0[3]}, v1_ = (bf16x8){l1[0], l1[1], l1[2], l1[3], h1[0], h1[1], h1[2], h1[3]}; \
        const bf16x8 v2_ = (bf16x8){l2[0], l2[1], l2[2], l2[3], h2[0], h2[1], h2[2], h2[3]}, v3_ = (bf16x8){l3[0], l3[1], l3[2], l3[3], h3[0], h3[1], h3[2], h3[3]}; \
        oa[d0] = __builtin_amdgcn_mfma_f32_32x32x16_bf16(pa[0], v0_, oa[d0], 0, 0, 0); ob_[d0] = __builtin_amdgcn_mfma_f32_32x32x16_bf16(pb[0], v0_, ob_[d0], 0, 0, 0); \
        oa[d0] = __builtin_amdgcn_mfma_f32_32x32x16_bf16(pa[1], v1_, oa[d0], 0, 0, 0); ob_[d0] = __builtin_amdgcn_mfma_f32_32x32x16_bf16(pb[1], v1_, ob_[d0], 0, 0, 0); \
        oa[d0] = __builtin_amdgcn_mfma_f32_32x32x16_bf16(pa[2], v2_, oa[d0], 0, 0, 0); ob_[d0] = __builtin_amdgcn_mfma_f32_32x32x16_bf16(pb[2], v2_, ob_[d0], 0, 0, 0); \
        oa[d0] = __builtin_amdgcn_mfma_f32_32x32x16_bf16(pa[3], v3_, oa[d0], 0, 0, 0); ob_[d0] = __builtin_amdgcn_mfma_f32_32x32x16_bf16(pb[3], v3_, ob_[d0], 0, 0, 0); } while (0)
    PV_D0(0); PV_D0(1); PV_D0(2); PV_D0(3);
#undef PV_D0
#undef TRRD
}
__device__ __forceinline__ void partialSM(f32x16& p0, f32x16& p1, float& m_reg, float& alpha, float scale, float C2) {
    float pmax = p0[0];
#pragma unroll
    for (int r = 1; r < 16; ++r) pmax = fmaxf(pmax, p0[r]);
#pragma unroll
    for (int r = 0; r < 16; ++r) pmax = fmaxf(pmax, p1[r]);
    { auto rr = __builtin_amdgcn_permlane32_swap(__float_as_uint(pmax), __float_as_uint(pmax), false, false);
      pmax = fmaxf(__uint_as_float(rr[0]), __uint_as_float(rr[1])); }
    float mn;
    if (__all((pmax - m_reg) * scale <= 8.f)) { mn = m_reg; alpha = 1.f; }
    else { mn = fmaxf(m_reg, pmax); alpha = __builtin_amdgcn_exp2f((m_reg - mn) * C2); m_reg = mn; }
    const float mnL = -mn * C2;
#pragma unroll
    for (int r = 0; r < 16; ++r) { p0[r] = __builtin_amdgcn_exp2f(fmaf(p0[r], C2, mnL)); p1[r] = __builtin_amdgcn_exp2f(fmaf(p1[r], C2, mnL)); }
}
__device__ __forceinline__ float rowsum32(const f32x16& p0, const f32x16& p1) {
    float ps = 0.f;
#pragma unroll
    for (int r = 0; r < 16; ++r) ps += p0[r];
#pragma unroll
    for (int r = 0; r < 16; ++r) ps += p1[r];
    auto rr = __builtin_amdgcn_permlane32_swap(__float_as_uint(ps), __float_as_uint(ps), false, false);
    return __uint_as_float(rr[0]) + __uint_as_float(rr[1]);
}
__device__ __forceinline__ void packP(const f32x16& p0, const f32x16& p1, bf16x8& pa0, bf16x8& pa1, bf16x8& pa2, bf16x8& pa3) {
#define PK4(P, B_, OUT) do { unsigned a0 = cvtpk(P[B_+0], P[B_+1]), a1 = cvtpk(P[B_+2], P[B_+3]);                          \
        unsigned b0 = cvtpk(P[B_+4], P[B_+5]), b1 = cvtpk(P[B_+6], P[B_+7]);                                             \
        auto r0 = __builtin_amdgcn_permlane32_swap(a0, b0, false, false); auto r1 = __builtin_amdgcn_permlane32_swap(a1, b1, false, false); \
        u32x4 w = {r0[0], r1[0], r0[1], r1[1]}; OUT = *reinterpret_cast<bf16x8*>(&w); } while (0)
    PK4(p0, 0, pa0); PK4(p0, 8, pa1); PK4(p1, 0, pa2); PK4(p1, 8, pa3);
#undef PK4
}
__device__ __forceinline__ void rescaleO(f32x16* o, float alpha, LAS float* al_l, int r32, int hi) {
    if (__any(alpha < 1.f)) {
        if (hi == 0) al_l[r32] = alpha;
        asm volatile("s_waitcnt lgkmcnt(0)" ::: "memory");
#pragma unroll
        for (int q = 0; q < 4; ++q) { const f32x4 a = *(const LAS f32x4*)(al_l + 8 * q + 4 * hi);
#pragma unroll
            for (int d_ = 0; d_ < 4; ++d_)
#pragma unroll
                for (int i = 0; i < 4; ++i) o[d_][4 * q + i] *= a[i]; }
    }
}
__device__ __forceinline__ void row_scalars(float x, float* out16, LAS float* li_l, int r32, int hi) {
    if (hi == 0) li_l[r32] = x;
    asm volatile("s_waitcnt lgkmcnt(0)" ::: "memory");
#pragma unroll
    for (int r = 0; r < 16; ++r) out16[r] = li_l[crow(r, hi)];
    asm volatile("s_waitcnt lgkmcnt(0)" ::: "memory");
}
struct KVStage { bf16x8 k0, k1, v0, v1; };
template <int ND, bool WITH_V>
__device__ __forceinline__ void stage_load(KVStage& s, const bf16_t* Kg, const bf16_t* Vg, int tid) {
    if (ND == 8) { const int sr = tid >> 4, sc = (tid & 15) * 8;
        s.k0 = *(const bf16x8*)(Kg + (size_t)sr * 128 + sc); s.k1 = *(const bf16x8*)(Kg + (size_t)(32 + sr) * 128 + sc); }
    else { const int key = tid >> 3, c8 = (tid & 7) * 8; s.k0 = *(const bf16x8*)(Kg + (size_t)key * 64 + c8); }
    if (WITH_V) { const int sr = tid >> 4, sc = (tid & 15) * 8;
        s.v0 = *(const bf16x8*)(Vg + (size_t)sr * 128 + sc); s.v1 = *(const bf16x8*)(Vg + (size_t)(32 + sr) * 128 + sc); }
}
template <int ND, bool WITH_V>
__device__ __forceinline__ void stage_write(const KVStage& s, ldsp_t lds, int tid) {
    if (ND == 8) { const int sr = tid >> 4, sc = (tid & 15) * 8, kws = KSWZ(sr, sc * 2);
        *(LAS bf16x8*)(lds + AT_K + kws) = s.k0; *(LAS bf16x8*)(lds + AT_K + kws + 32 * 256) = s.k1; }
    else { const int key = tid >> 3, c8 = (tid & 7) * 8; *(LAS bf16x8*)(lds + AT_K + KSWZ(key, c8 * 2)) = s.k0; }
    if (WITH_V) { const int sr = tid >> 4, sc = (tid & 15) * 8;
        *(LAS bf16x8*)(lds + AT_V + v_st(sr, sc)) = s.v0; *(LAS bf16x8*)(lds + AT_V + v_st(32 + sr, sc)) = s.v1; }
}
__device__ __forceinline__ void stage_dma(ldsp_t buf, const bf16_t* Kg, const bf16_t* Vg, int wid_u, int lane) {
#pragma unroll
    for (int i = 0; i < 2; ++i) { const int q = (i * 8 + wid_u) * 64 + lane, row = q >> 4, cpos = q & 15;
        __builtin_amdgcn_global_load_lds((const unsigned*)(Kg + (size_t)row * 128 + ((cpos ^ (row & 7)) * 8)), (LAS unsigned*)(buf + AT_K + (i * 8 + wid_u) * 1024), 16, 0, 0); }
#pragma unroll
    for (int i = 0; i < 2; ++i) { const int q = (i * 8 + wid_u) * 64 + lane, sub = q >> 5, w5 = q & 31;
        const int kk = (sub >> 2) * 8 + (w5 >> 2), c = (sub & 3) * 32 + (w5 & 3) * 8, k = (kk & ~0xC) | ((kk & 4) << 1) | ((kk & 8) >> 1);
        __builtin_amdgcn_global_load_lds((const unsigned*)(Vg + (size_t)k * 128 + c), (LAS unsigned*)(buf + AT_V + (i * 8 + wid_u) * 1024), 16, 0, 0); }
}
enum { MK_CAUSAL = 0, MK_WINDOW = 1, MK_SLC = 2 };
template <int MK>
__device__ __forceinline__ int sweep_next(int j, int j_hi, unsigned un0, unsigned un1, unsigned un2, unsigned un3) {
    if (MK == MK_SLC) { while (j < j_hi) { const unsigned uw = (j < 32) ? un0 : (j < 64) ? un1 : (j < 96) ? un2 : un3; if ((uw >> (j & 31)) & 1u) break; ++j; } }
    return j;
}
template <int MK, int ND>
__device__ __forceinline__ void attn_sweep(ldsp_t lds, const bf16x8* qr, const bf16_t* Kg, const bf16_t* Vg, int j_lo, int j_hi, int pos,
                                           unsigned sel0, unsigned sel1, unsigned sel2, unsigned sel3, unsigned un0, unsigned un1, unsigned un2, unsigned un3,
                                           f32x16* o, float& m_reg, float& l_reg, float scale, int wspan) {
    const int tid = my_tid(), wid = tid >> 6, lane = tid & 63, r32 = lane & 31, hi = lane >> 5;
    const float C2 = scale * 1.4426950408889634f;
    LAS float* al_l = (LAS float*)(lds + AT_WS) + wid * 64;
    const unsigned vb0 = (unsigned)(size_t)(lds + AT_V) + v_rd_base(lane);
    const float NEG = -__builtin_inff();
    const int wpos0 = __builtin_amdgcn_readfirstlane(pos);
    static_assert(ND == 8, "LDS-DMA staging is written for 128-wide K rows");
    const int wid_u = __builtin_amdgcn_readfirstlane(wid);
    int j = sweep_next<MK>(j_lo, j_hi, un0, un1, un2, un3);
    if (j >= j_hi) { __syncthreads(); return; }
    int j1 = sweep_next<MK>(j + 1, j_hi, un0, un1, un2, un3);
    stage_dma(lds, Kg + (size_t)j * 64 * 128, Vg + (size_t)j * 64 * 128, wid_u, lane);
    if (j1 < j_hi) stage_dma(lds + AT_BUF, Kg + (size_t)j1 * 64 * 128, Vg + (size_t)j1 * 64 * 128, wid_u, lane);
    if (j1 < j_hi) asm volatile("s_waitcnt vmcnt(4)" ::: "memory"); else asm volatile("s_waitcnt vmcnt(0)" ::: "memory");
    __builtin_amdgcn_s_barrier(); asm volatile("" ::: "memory");
    int cur = 0;
    for (;;) {
        const int j2 = (j1 < j_hi) ? sweep_next<MK>(j1 + 1, j_hi, un0, un1, un2, un3) : j_hi;
        const int nb2 = cur >= 1 ? cur - 1 : 2;
        if (j2 < j_hi) stage_dma(lds + nb2 * AT_BUF, Kg + (size_t)j2 * 64 * 128, Vg + (size_t)j2 * 64 * 128, wid_u, lane);
        bool tsel = true;
        if (MK == MK_SLC) { const unsigned sw = (j < 32) ? sel0 : (j < 64) ? sel1 : (j < 96) ? sel2 : sel3; tsel = (sw >> (j & 31)) & 1u; }
        if (MK != MK_SLC || __any(tsel)) {
        f32x16 p0, p1; qkt<ND>(p0, p1, lds + cur * AT_BUF + AT_K, r32, hi, qr);
        bool need = (j * 64 + 63 > wpos0);
        if (MK == MK_WINDOW) need = need || (j * 64 <= wpos0 + wspan - 512);
        if (need) { const int kb = j * 64 + 4 * hi;
#pragma unroll
            for (int r = 0; r < 16; ++r) { const int k0 = kb + (r & 3) + 8 * (r >> 2), k1 = k0 + 32;
                bool ok0 = k0 <= pos, ok1 = k1 <= pos;
                if (MK == MK_WINDOW) { ok0 = ok0 && (k0 > pos - 512); ok1 = ok1 && (k1 > pos - 512); }
                if (!ok0) p0[r] = NEG; if (!ok1) p1[r] = NEG; } }
        if (MK == MK_SLC) { if (!__all(tsel)) {
#pragma unroll
            for (int r = 0; r < 16; ++r) { p0[r] = tsel ? p0[r] : NEG; p1[r] = tsel ? p1[r] : NEG; } } }
        float alpha; partialSM(p0, p1, m_reg, alpha, scale, C2);
        rescaleO(o, alpha, al_l, r32, hi);
        l_reg = l_reg * alpha + rowsum32(p0, p1);
        bf16x8 pa0, pa1, pa2, pa3; packP(p0, p1, pa0, pa1, pa2, pa3);
        pv_tile(o, vb0 + cur * AT_BUF, pa0, pa1, pa2, pa3);
        }
        if (j2 < j_hi) asm volatile("s_waitcnt vmcnt(4) lgkmcnt(0)" ::: "memory"); else asm volatile("s_waitcnt vmcnt(0) lgkmcnt(0)" ::: "memory");
        __builtin_amdgcn_s_barrier(); asm volatile("" ::: "memory");
        if (j1 >= j_hi) break;
        j = j1; j1 = j2; cur = cur == 2 ? 0 : cur + 1;
    }
}
__device__ __forceinline__ void store_O_bf16(const f32x16* o, const float* rs16, bf16_t* base  , size_t ld, int r32, int hi) {
#pragma unroll
    for (int r = 0; r < 16; ++r) { const int orow = crow(r, hi);
#pragma unroll
        for (int d0 = 0; d0 < 4; ++d0) { const float v = o[d0][r] * rs16[r]; const float vn = __shfl_xor(v, 1);
            if ((r32 & 1) == 0) *(unsigned*)(base + (size_t)orow * ld + d0 * 32 + r32) = cvtpk(v, vn); } }
}
__device__ __forceinline__ void da_sweep(ldsp_t lds, const bf16_t* Q, const bf16_t* K, const bf16_t* V, int bh, int qb, f32x16* o0, f32x16* o1, float& l0, float& l1) {
    const float SCALE = 0.125f, C2 = SCALE * 1.4426950408889634f, NEG = -__builtin_inff();
    const int tid = my_tid(), wid = tid >> 6, lane = tid & 63, r32 = lane & 31, hi = lane >> 5;
    LAS float* al_l = (LAS float*)(lds + AT_WS) + wid * 64;
    const unsigned vb0 = (unsigned)(size_t)(lds + AT_V) + v_rd_base(lane);
    const bf16_t* Kg = K + (size_t)bh * SEQ * 128; const bf16_t* Vg = V + (size_t)bh * SEQ * 128;
    ldsp_t Qw = lds + q_park(wid);
    { const bf16_t* Qb = Q + ((size_t)bh * SEQ + qb * 256 + wid * 32 + r32) * 128;
#pragma unroll
      for (int d0 = 0; d0 < 8; ++d0) *(LAS bf16x8*)(Qw + KSWZ(r32, (d0 * 16 + hi * 8) * 2)) = *(const bf16x8*)(Qb + d0 * 16 + hi * 8); }
    float m0 = -1e30f, m1 = -1e30f;
    const int wpos0 = qb * 256 + wid * 32, pos = wpos0 + r32, j_hi = 4 * (qb + 1);
    const int wid_u = __builtin_amdgcn_readfirstlane(wid);
    __syncthreads();
    stage_dma(lds, Kg, Vg, wid_u, lane);
    __syncthreads();
    int cur = 0;
    for (int j = 0; j < j_hi; ++j) {
        const bool has = j + 1 < j_hi;
        if (has) stage_dma(lds + (cur ^ 1) * AT_BUF, Kg + (size_t)(j + 1) * 64 * 128, Vg + (size_t)(j + 1) * 64 * 128, wid_u, lane);
        const bool need = (j * 64 + 63 > wpos0);
        const int kb = j * 64 + 4 * hi;
        if (j * 64 <= wpos0 + 31) {
        { f32x16 p0, p1; qkt_range_lq<0, 4>(p0, p1, lds + cur * AT_BUF + AT_K, Qw, r32, hi);
          if (need) {
#pragma unroll
              for (int r = 0; r < 16; ++r) { const int k0 = kb + (r & 3) + 8 * (r >> 2); if (k0 > pos) p0[r] = NEG; if (k0 + 32 > pos) p1[r] = NEG; } }
          float a0; partialSM(p0, p1, m0, a0, SCALE, C2); l0 = l0 * a0 + rowsum32(p0, p1);
          bf16x8 pa0, pa1, pa2, pa3; packP(p0, p1, pa0, pa1, pa2, pa3);
          rescaleO(o0, a0, al_l, r32, hi); pv_tile_h(o0, vb0 + cur * AT_BUF, pa0, pa1, pa2, pa3); }
        { f32x16 p0, p1; qkt_range_lq<4, 8>(p0, p1, lds + cur * AT_BUF + AT_K, Qw, r32, hi);
          if (need) {
#pragma unroll
              for (int r = 0; r < 16; ++r) { const int k0 = kb + (r & 3) + 8 * (r >> 2); if (k0 > pos) p0[r] = NEG; if (k0 + 32 > pos) p1[r] = NEG; } }
          float a1; partialSM(p0, p1, m1, a1, SCALE, C2); l1 = l1 * a1 + rowsum32(p0, p1);
          bf16x8 pa0, pa1, pa2, pa3; packP(p0, p1, pa0, pa1, pa2, pa3);
          rescaleO(o1, a1, al_l, r32, hi); pv_tile_h(o1, vb0 + cur * AT_BUF, pa0, pa1, pa2, pa3); }
        }
        __syncthreads();
        cur ^= 1;
    }
}
__device__ __forceinline__ void da_epilogue(ldsp_t lds, const f32x16* o0, const f32x16* o1, float l0, float l1, const float* lam, const float* normg, bf16_t* ob, int b, int h, int qb) {
    const float LAM_INIT = 0.35550906759096934f;
    const int tid = my_tid(), wid = tid >> 6, lane = tid & 63, r32 = lane & 31, hi = lane >> 5;
    LAS float* li_l = (LAS float*)(lds + AT_WS) + wid * 64 + 32;
    const float s1 = wave_sum(lam[lane] * lam[64 + lane]), s2 = wave_sum(lam[128 + lane] * lam[192 + lane]);
    const float lmb = __expf(s1) - __expf(s2) + LAM_INIT;
    float i0[16], i1[16]; row_scalars(1.f / l0, i0, li_l, r32, hi); row_scalars(lmb / l1, i1, li_l, r32, hi);
    float ng[4];
#pragma unroll
    for (int d0 = 0; d0 < 4; ++d0) ng[d0] = normg[d0 * 32 + r32] * (1.f - LAM_INIT);
    bf16_t* Ob = ob + ((size_t)b * SEQ + qb * 256 + wid * 32) * DM + h * 128;
#pragma unroll
    for (int r = 0; r < 16; ++r) {
        float x[4], ss = 0.f;
#pragma unroll
        for (int d0 = 0; d0 < 4; ++d0) { x[d0] = o0[d0][r] * i0[r] - o1[d0][r] * i1[r]; ss += x[d0] * x[d0]; }
        ss += __shfl_xor(ss, 1); ss += __shfl_xor(ss, 2); ss += __shfl_xor(ss, 4); ss += __shfl_xor(ss, 8); ss += __shfl_xor(ss, 16);
        const float rs = rsqrtf(ss * (1.f / 128.f) + LN_EPS);
        const int orow = crow(r, hi);
#pragma unroll
        for (int d0 = 0; d0 < 4; ++d0) { const float v = x[d0] * rs * ng[d0]; const float vn = __shfl_xor(v, 1);
            if ((r32 & 1) == 0) *(unsigned*)(Ob + (size_t)orow * DM + d0 * 32 + r32) = cvtpk(v, vn); } }
}
__device__ __forceinline__ void da_attn_phase(ldsp_t lds, const bf16_t* Q, const bf16_t* K, const bf16_t* V, const float* lam, const float* normg, bf16_t* ob, int wg, int nwg) {
    const int nround = (1024 + nwg - 1) / nwg;
    for (int n = 0; n < nround; ++n) {
        const int idx = n * nwg + ((n & 1) ? (nwg - 1 - wg) : wg);
        if (idx >= 1024) continue;
        const int qb = 31 - (idx >> 5), bh = idx & 31, b = bh >> 3, h = bh & 7;
        f32x16 o0[4] = {}, o1[4] = {}; float l0 = 0.f, l1 = 0.f;
        da_sweep(lds, Q, K, V, bh, qb, o0, o1, l0, l1);
        da_epilogue(lds, o0, o1, l0, l1, lam, normg, ob, b, h, qb);
        __syncthreads();
    }
}
__device__ __forceinline__ void sb_attn_phase(ldsp_t lds, const bf16_t* Q, const bf16_t* K, const bf16_t* V, bf16_t* ob, int wg, int nwg) {
    const int tid = my_tid(), wid = tid >> 6, lane = tid & 63, r32 = lane & 31, hi = lane >> 5;
    const float SCALE = 0.08838834764831845f;
    LAS int* flags = (LAS int*)(lds + LDS_MISC - 64);
    const unsigned vb0 = (unsigned)(size_t)(lds + AT_V) + v_rd_base(lane);
    for (int idx = wg; idx < 1024; idx += nwg) {
        const int qb = idx >> 5, bh = idx & 31, b = bh >> 3, h = bh & 7;
        const bf16_t* Qb = Q + ((size_t)bh * SEQ + qb * 256 + wid * 32 + r32) * 128;
        const bf16_t* Kb = K + (size_t)bh * SEQ * 128; const bf16_t* Vb = V + (size_t)bh * SEQ * 128;
        ldsp_t Qw = lds + q_park(wid);
#pragma unroll
        for (int d0 = 0; d0 < 8; ++d0) *(LAS bf16x8*)(Qw + KSWZ(r32, (d0 * 16 + hi * 8) * 2)) = *(const bf16x8*)(Qb + d0 * 16 + hi * 8);
        f32x16 o[4] = {}; float R = 0.f; bool done = false;
        const int wpos0 = qb * 256 + wid * 32, pos = wpos0 + r32;
        const int wid_u = __builtin_amdgcn_readfirstlane(wid);
        stage_dma(lds, Kb + (size_t)(4 * qb + 3) * 64 * 128, Vb + (size_t)(4 * qb + 3) * 64 * 128, wid_u, lane);
        int cur = 0;
        for (int j = 4 * qb + 3; j >= 0; --j) {
            if (lane == 0) flags[wid] = done ? 1 : 0;
            __syncthreads();
            int alld = 1;
#pragma unroll
            for (int k = 0; k < 8; ++k) alld &= flags[k];
            if (alld) break;
            if (j > 0) stage_dma(lds + (cur ^ 1) * AT_BUF, Kb + (size_t)(j - 1) * 64 * 128, Vb + (size_t)(j - 1) * 64 * 128, wid_u, lane);
            const unsigned vbc = vb0 + cur * AT_BUF; ldsp_t Kt = lds + cur * AT_BUF + AT_K;
            cur ^= 1;
            if (!done && 64 * j < wpos0 + 31) {
                f32x16 p0, p1; qkt_range_lq<0, 8>(p0, p1, Kt, Qw, r32, hi);
                float l0[16], l1[16];
                const int kb = j * 64 + 4 * hi;
#pragma unroll
                for (int r = 0; r < 16; ++r) { const int k0 = kb + (r & 3) + 8 * (r >> 2), k1 = k0 + 32;
                    const float z0 = p0[r] * SCALE, z1 = p1[r] * SCALE;
                    const float sp0 = fmaxf(z0, 0.f) + __logf(1.f + __expf(-fabsf(z0))), sp1 = fmaxf(z1, 0.f) + __logf(1.f + __expf(-fabsf(z1)));
                    l0[r] = (k0 < pos) ? -sp0 : 0.f; l1[r] = (k1 < pos) ? -sp1 : 0.f; p0[r] = z0; p1[r] = z1; }
                float gs0[4], gs1[4], pg0[4], pg1[4], A0[4], A1[4];
#pragma unroll
                for (int q = 0; q < 4; ++q) { gs0[q] = (l0[4 * q] + l0[4 * q + 1]) + (l0[4 * q + 2] + l0[4 * q + 3]); gs1[q] = (l1[4 * q] + l1[4 * q + 1]) + (l1[4 * q + 2] + l1[4 * q + 3]); }
#pragma unroll
                for (int q = 0; q < 4; ++q) { pg0[q] = __shfl_xor(gs0[q], 32); pg1[q] = __shfl_xor(gs1[q], 32); }
                const float t00 = gs0[0] + pg0[0], t01 = gs0[1] + pg0[1], t02 = gs0[2] + pg0[2], t03 = gs0[3] + pg0[3];
                const float t10 = gs1[0] + pg1[0], t11 = gs1[1] + pg1[1], t12 = gs1[2] + pg1[2], t13 = gs1[3] + pg1[3];
                const float T1 = (t10 + t11) + (t12 + t13), T0 = (t00 + t01) + (t02 + t03);
                A0[3] = T1; A0[2] = A0[3] + t03; A0[1] = A0[2] + t02; A0[0] = A0[1] + t01;
                A1[3] = 0.f; A1[2] = t13; A1[1] = A1[2] + t12; A1[0] = A1[1] + t11;
                if (hi == 0) {
#pragma unroll
                    for (int q = 0; q < 4; ++q) { A0[q] += pg0[q]; A1[q] += pg1[q]; } }
#pragma unroll
                for (int q = 0; q < 4; ++q) {
                    float af0 = A0[q] + R, af1 = A1[q] + R;
#pragma unroll
                    for (int i = 3; i >= 0; --i) { const int r = 4 * q + i; const int k0 = kb + i + 8 * q, k1 = k0 + 32;
                        const float a0 = (k0 < pos) ? __expf(p0[r] + l0[r] + af0) : 0.f, a1 = (k1 < pos) ? __expf(p1[r] + l1[r] + af1) : 0.f;
                        af0 += l0[r]; af1 += l1[r]; p0[r] = a0; p1[r] = a1; } }
                R += T0 + T1;
                bf16x8 pa0, pa1, pa2, pa3; packP(p0, p1, pa0, pa1, pa2, pa3);
                pv_tile(o, vbc, pa0, pa1, pa2, pa3);
                done = __all(R < -104.f);
            }
        }
        __syncthreads();
        float one[16];
#pragma unroll
        for (int r = 0; r < 16; ++r) one[r] = 1.f;
        store_O_bf16(o, one, ob + ((size_t)b * SEQ + qb * 256 + wid * 32) * DM + h * 128, DM, r32, hi);
    }
}

__device__ __forceinline__ float gelu_tanh(float x) { const float u = 0.7978845608028654f * (x + 0.044715f * x * x * x); const float e = __expf(2.f * u); const float th = 1.f - 2.f / (e + 1.f); return 0.5f * x * (1.f + th); }
__device__ __forceinline__ void nsa_compress_phase(ldsp_t lds, const bf16_t* kv, const bf16_t* W1t, const bf16_t* W2t, const float* biasp, bf16_t* KC, int wg, int nwg) {
    const int tid = my_tid(), wid = tid >> 6, lane = tid & 63, c16 = lane & 15, g = lane >> 4;
    const int rg = wid & 1, ch = wid >> 1;
    ldsp_t H1 = lds;
    LAS float* biasL = (LAS float*)(lds + 32 * HG_P272);
    if (tid < 256) { float sacc = 0.f; for (int p = 0; p < 32; ++p) sacc += biasp[((tid >> 7) * 32 + p) * 128 + (tid & 127)]; biasL[tid] = sacc; }
    __syncthreads();
    for (int it = wg; it < 256; it += nwg) {
        const int jj = it >> 7, bg = (it >> 4) & 7, ct = it & 15;
        const bf16_t* X = kv + ((size_t)(jj * 8 + bg) * SEQ) * 128;
        const bf16_t* W1 = W1t + (size_t)jj * 128 * 4096; const bf16_t* W2 = W2t + (size_t)jj * 128 * 128;
        int crow_ = ct * 32 + rg * 16 + c16; if (crow_ > 510) crow_ = 510;
        const bf16_t* Ar = X + (size_t)crow_ * 16 * 128 + 8 * g;
        const bf16_t* Br = W1 + (size_t)(32 * ch + c16) * 4096 + 8 * g;
        f32x4 acc[2];
#pragma unroll
        for (int nt = 0; nt < 2; ++nt) acc[nt] = (f32x4){0.f, 0.f, 0.f, 0.f};
        for (int ks = 0; ks < 128; ks += 4) {
            bf16x8 A[4], B[4][2];
#pragma unroll
            for (int u = 0; u < 4; ++u) { A[u] = *(const bf16x8*)(Ar + (ks + u) * 32);
#pragma unroll
                for (int nt = 0; nt < 2; ++nt) B[u][nt] = *(const bf16x8*)(Br + (size_t)(16 * nt) * 4096 + (ks + u) * 32); }
#pragma unroll
            for (int u = 0; u < 4; ++u)
#pragma unroll
                for (int nt = 0; nt < 2; ++nt) acc[nt] = __builtin_amdgcn_mfma_f32_16x16x32_bf16(A[u], B[u][nt], acc[nt], 0, 0, 0); }
#pragma unroll
        for (int nt = 0; nt < 2; ++nt) { const int n = 32 * ch + 16 * nt + c16; const float bs = biasL[jj * 128 + n];
#pragma unroll
            for (int r = 0; r < 4; ++r) *(LAS bf16_t*)(H1 + (16 * rg + 4 * g + r) * HG_P272 + n * 2) = f2bf(gelu_tanh(acc[nt][r] + bs)); }
        __syncthreads();
        f32x4 ac2[2];
#pragma unroll
        for (int nt = 0; nt < 2; ++nt) { ac2[nt] = (f32x4){0.f, 0.f, 0.f, 0.f};
#pragma unroll
            for (int ks = 0; ks < 4; ++ks) { const bf16x8 A = *(const LAS bf16x8*)(H1 + (16 * rg + c16) * HG_P272 + (32 * ks + 8 * g) * 2);
                const bf16x8 B = *(const bf16x8*)(W2 + (size_t)(32 * ch + 16 * nt + c16) * 128 + 32 * ks + 8 * g);
                ac2[nt] = __builtin_amdgcn_mfma_f32_16x16x32_bf16(A, B, ac2[nt], 0, 0, 0); } }
#pragma unroll
        for (int nt = 0; nt < 2; ++nt)
#pragma unroll
            for (int r = 0; r < 4; ++r) { const int c = ct * 32 + rg * 16 + 4 * g + r; const int n = 32 * ch + 16 * nt + c16;
                KC[((size_t)(jj * 8 + bg) * NCMP_P + c) * 128 + n] = (c <= 510) ? f2bf(ac2[nt][r]) : (bf16_t)0; }
        __syncthreads();
    }
}
constexpr int NS_IMPP = AT_END, NS_IMPS = NS_IMPP + 4096, NS_IMP = NS_IMPS + 4096, NS_CARRY = NS_IMP + 33792, NS_SEL = NS_CARRY + 512, NS_UN = NS_SEL + 1024, NS_END = NS_UN + 16;
static_assert(NS_END <= LDS_MISC, "NSA LDS");
__device__ __forceinline__ void nsa_cmp_sweep1(ldsp_t lds, const bf16x8* qr, const bf16_t* kcb, const bf16_t* vcb, int ntile, int pos, float& m_reg, float& l_reg) {
    const int tid = my_tid(), wid_u = __builtin_amdgcn_readfirstlane(tid >> 6), lane = tid & 63, r32 = lane & 31, hi = lane >> 5;
    const float SCALE = 0.08838834764831845f, C2 = SCALE * 1.4426950408889634f, NEG = -__builtin_inff();
    stage_dma(lds, kcb, vcb, wid_u, lane);
    int cur = 0;
    for (int jt = 0; jt < ntile; ++jt) {
        __syncthreads();
        if (jt + 1 < ntile) stage_dma(lds + (cur ^ 1) * AT_BUF, kcb + (size_t)(jt + 1) * 64 * 128, vcb + (size_t)(jt + 1) * 64 * 128, wid_u, lane);
        f32x16 p0, p1; qkt<8>(p0, p1, lds + cur * AT_BUF + AT_K, r32, hi, qr);
        const int kb = jt * 64 + 4 * hi;
#pragma unroll
        for (int r = 0; r < 16; ++r) { const int c0 = kb + (r & 3) + 8 * (r >> 2), c1 = c0 + 32;
            if (!(c0 < NCMP && 16 * c0 + 31 <= pos)) p0[r] = NEG; if (!(c1 < NCMP && 16 * c1 + 31 <= pos)) p1[r] = NEG; }
        float alpha; partialSM(p0, p1, m_reg, alpha, SCALE, C2);
        l_reg = l_reg * alpha + rowsum32(p0, p1);
        cur ^= 1;
    }
    __syncthreads();
}
__device__ __forceinline__ void nsa_cmp_sweep2(ldsp_t lds, const bf16x8* qr, const bf16_t* kcb, const bf16_t* vcb, int ntile, int pos, int tokl, float m_reg, float l_reg, f32x16* o) {
    const int tid = my_tid(), lane = tid & 63, r32 = lane & 31, hi = lane >> 5;
    const float SCALE = 0.08838834764831845f, C2 = SCALE * 1.4426950408889634f;
    LAS float* impP = (LAS float*)(lds + NS_IMPP); LAS float* impS = (LAS float*)(lds + NS_IMPS);
    LAS float* imp = (LAS float*)(lds + NS_IMP); LAS float* carry = (LAS float*)(lds + NS_CARRY);
    const unsigned vb0 = (unsigned)(size_t)(lds + AT_V) + v_rd_base(lane);
    const float inv_l = l_reg > 0.f ? 1.f / l_reg : 0.f;
    const float mL = -m_reg * C2;
    const int wid_u = __builtin_amdgcn_readfirstlane(tid >> 6);
    stage_dma(lds, kcb, vcb, wid_u, lane);
    int cur = 0;
    for (int jt = 0; jt < ntile; ++jt) {
        __syncthreads();
        if (jt + 1 < ntile) stage_dma(lds + (cur ^ 1) * AT_BUF, kcb + (size_t)(jt + 1) * 64 * 128, vcb + (size_t)(jt + 1) * 64 * 128, wid_u, lane);
        f32x16 p0, p1; qkt<8>(p0, p1, lds + cur * AT_BUF + AT_K, r32, hi, qr);
        const int kb = jt * 64 + 4 * hi;
#pragma unroll
        for (int r = 0; r < 16; ++r) { const int c0 = kb + (r & 3) + 8 * (r >> 2), c1 = c0 + 32;
            const bool ok0 = (c0 < NCMP && 16 * c0 + 31 <= pos), ok1 = (c1 < NCMP && 16 * c1 + 31 <= pos);
            p0[r] = ok0 ? __builtin_amdgcn_exp2f(fmaf(p0[r], C2, mL)) * inv_l : 0.f; p1[r] = ok1 ? __builtin_amdgcn_exp2f(fmaf(p1[r], C2, mL)) * inv_l : 0.f; }
#pragma unroll
        for (int q = 0; q < 4; ++q) {
            float sp0 = 0.5f * p0[4 * q + 3], sp1 = 0.5f * p1[4 * q + 3];
            float mn0 = (p0[4 * q] + p0[4 * q + 1]) + (p0[4 * q + 2] + sp0), mn1 = (p1[4 * q] + p1[4 * q + 1]) + (p1[4 * q + 2] + sp1);
            mn0 += __shfl_xor(mn0, 1); mn0 += __shfl_xor(mn0, 2); mn1 += __shfl_xor(mn1, 1); mn1 += __shfl_xor(mn1, 2);
            sp0 += __shfl_xor(sp0, 1); sp0 += __shfl_xor(sp0, 2); sp1 += __shfl_xor(sp1, 1); sp1 += __shfl_xor(sp1, 2);
            if ((r32 & 3) == 0) { const int i0 = tokl * 16 + 2 * q + hi; impP[i0] = mn0; impS[i0] = sp0; impP[i0 + 8] = mn1; impS[i0 + 8] = sp1; } }
        bf16x8 pa0, pa1, pa2, pa3; packP(p0, p1, pa0, pa1, pa2, pa3);
        pv_tile(o, vb0 + cur * AT_BUF, pa0, pa1, pa2, pa3);
        cur ^= 1;
        __syncthreads();
        { const int tk = tid >> 3, part = tid & 7;
#pragma unroll
          for (int e = 0; e < 2; ++e) { const int nb = 2 * part + e; float mm = impP[tk * 16 + nb];
              if (nb > 0) mm += impS[tk * 16 + nb - 1];
              if (nb == 0 && jt > 0) mm += carry[((jt - 1) & 1) * 64 + tk];
              imp[tk * 132 + 16 * jt + nb] = mm; }
          if (part == 7) carry[(jt & 1) * 64 + tk] = impS[tk * 16 + 15]; }
    }
    __syncthreads();
}
template <int CTRL> __device__ __forceinline__ int dpp_i(int v) { return __builtin_amdgcn_update_dpp(v, v, CTRL, 0xf, 0xf, false); }
template <int CTRL> __device__ __forceinline__ float dpp_f(float v) { return __int_as_float(__builtin_amdgcn_update_dpp(__float_as_int(v), __float_as_int(v), CTRL, 0xf, 0xf, false)); }
__device__ __forceinline__ void nsa_topk(ldsp_t lds, int cur) {
    const int tid = my_tid(), tk = tid >> 3, part = tid & 7;
    const float NEG = -__builtin_inff();
    LAS float* imp = (LAS float*)(lds + NS_IMP);
    LAS unsigned* selm = (LAS unsigned*)(lds + NS_SEL); LAS unsigned* unm = (LAS unsigned*)(lds + NS_UN);
    float vals[16]; unsigned mym = 0u;
#pragma unroll
    for (int q = 0; q < 4; ++q) { const f32x4 t = *(const LAS f32x4*)(imp + tk * 132 + part * 16 + 4 * q);
#pragma unroll
        for (int e = 0; e < 4; ++e) vals[4 * q + e] = t[e]; }
#pragma unroll
    for (int k = 0; k < 16; ++k) { const int nn = part * 16 + k; const bool forced = (nn == 0 || nn == cur || nn == cur - 1);
        mym |= forced ? (1u << k) : 0u; vals[k] = (nn > cur || forced) ? NEG : vals[k]; }
    const int nforced = cur >= 2 ? 3 : cur + 1;
    for (int rnd = nforced; rnd < 16; ++rnd) {
        float best = vals[0]; int bi = 0;
#pragma unroll
        for (int k = 1; k < 16; ++k) if (vals[k] > best) { best = vals[k]; bi = k; }
        int gi = part * 16 + bi;
        { const float ov = dpp_f<0xB1>(best); const int oi = dpp_i<0xB1>(gi); const bool t = (ov > best) || (ov == best && oi < gi); best = t ? ov : best; gi = t ? oi : gi; }
        { const float ov = dpp_f<0x4E>(best); const int oi = dpp_i<0x4E>(gi); const bool t = (ov > best) || (ov == best && oi < gi); best = t ? ov : best; gi = t ? oi : gi; }
        { const float ov = dpp_f<0x141>(best); const int oi = dpp_i<0x141>(gi); const bool t = (ov > best) || (ov == best && oi < gi); best = t ? ov : best; gi = t ? oi : gi; }
        const bool win = (best > -5e29f) && ((gi >> 4) == part);
        const int kk = win ? (gi & 15) : 16;
        mym |= win ? (1u << (gi & 15)) : 0u;
#pragma unroll
        for (int k = 0; k < 16; ++k) vals[k] = (k == kk) ? NEG : vals[k];
    }
    unsigned mw = mym << (16 * (part & 1));
    mw |= (unsigned)dpp_i<0xB1>((int)mw);
    if ((part & 1) == 0) { selm[tk * 4 + (part >> 1)] = mw; atomicOr((unsigned*)(unm + (part >> 1)), mw); }
}
__device__ __forceinline__ void nsa_load_q(bf16x8* qr, const bf16_t* Q, int b, int g, int s0) {
    const int tid = my_tid(), wid = tid >> 6, lane = tid & 63, r32 = lane & 31, hi = lane >> 5, hh = r32 & 3, tokl = 8 * wid + (r32 >> 2);
    const bf16_t* p = Q + (((size_t)b * 8 + g * 4 + hh) * SEQ + s0 + tokl) * 128 + hi * 8;
#pragma unroll
    for (int d0 = 0; d0 < 8; ++d0) qr[d0] = *(const bf16x8*)(p + d0 * 16);
}
template <int MODE>
__device__ __forceinline__ void nsa_branch_out(ldsp_t lds, f32x16* o, float l_reg, bool normalise, int which, const float* gates, float* OACC, bf16_t* ob, int b, int g, int s0) {
    const int tid = my_tid(), wid = tid >> 6, lane = tid & 63, r32 = lane & 31, hi = lane >> 5, hh = r32 & 3, tokl = 8 * wid + (r32 >> 2);
    LAS float* li_l = (LAS float*)(lds + AT_WS) + wid * 64 + 32;
    const float gt = gates[((size_t)b * SEQ + s0 + tokl) * 24 + (g * 4 + hh) * 3 + which];
    float gsc[16]; row_scalars(normalise ? gt * (l_reg > 0.f ? 1.f / l_reg : 0.f) : gt, gsc, li_l, r32, hi);
    f32x4* op = (f32x4*)(OACC + ((size_t)b * SEQ + s0) * DM + (size_t)g * (64 * 512)) + tid;
    const size_t base = ((size_t)b * SEQ + s0 + 8 * wid) * DM + (size_t)g * 512;
#pragma unroll
    for (int d0 = 0; d0 < 4; ++d0)
#pragma unroll
        for (int k = 0; k < 4; ++k) {
            f32x4 v = {o[d0][4 * k] * gsc[4 * k], o[d0][4 * k + 1] * gsc[4 * k + 1], o[d0][4 * k + 2] * gsc[4 * k + 2], o[d0][4 * k + 3] * gsc[4 * k + 3]};
            if (MODE == 0) op[(d0 * 4 + k) * 512] = v;
            else if (MODE == 1) op[(d0 * 4 + k) * 512] += v;
            else { v += op[(d0 * 4 + k) * 512];
#pragma unroll
                for (int e = 0; e < 4; ++e) { const int r = 4 * k + e; const int qi = crow(r, hi); const size_t ro = base + (size_t)(qi >> 2) * DM + (qi & 3) * 128;
                    const float vn = __shfl_xor(v[e], 1);
                    if ((r32 & 1) == 0) *(unsigned*)(ob + ro + d0 * 32 + r32) = cvtpk(v[e], vn); } } }
}
__device__ __forceinline__ void nsa_attn_phase(ldsp_t lds, const bf16_t* Qp, const bf16_t* Qr, const bf16_t* kv, const bf16_t* KC, const float* gates, float* OACC, bf16_t* ob, int wg, int nwg) {
    const float SCALE = 0.08838834764831845f;
    LAS float* imp = (LAS float*)(lds + NS_IMP);
    LAS unsigned* selm = (LAS unsigned*)(lds + NS_SEL); LAS unsigned* unm = (LAS unsigned*)(lds + NS_UN);
    const int nround = (1024 + nwg - 1) / nwg;
    for (int n = 0; n < nround; ++n) {
        const int idx = n * nwg + ((n & 1) ? (nwg - 1 - wg) : wg);
        if (idx >= 1024) continue;
        const int blk = 127 - (idx >> 3), bg = idx & 7, b = bg >> 1, g = bg & 1;
        const int s0 = blk * 64;
        const int tid = my_tid(), wid = tid >> 6, lane = tid & 63, tokl = 8 * wid + ((lane & 31) >> 2), pos = s0 + tokl;
        const bf16_t* kcb = KC + (size_t)bg * NCMP_P * 128; const bf16_t* vcb = KC + (size_t)(8 + bg) * NCMP_P * 128;
        for (int i = tid; i < 64 * 132; i += 512) imp[i] = 0.f;
        if (tid < 4) unm[tid] = 0u;
        bf16x8 qr[8];
        nsa_load_q(qr, Qp, b, g, s0);
        int nvalid = 4 * blk + 3; if (nvalid > NCMP) nvalid = NCMP;
        const int ntile = (nvalid + 63) >> 6;
        float m_reg = -1e30f, l_reg = 0.f;
        nsa_cmp_sweep1(lds, qr, kcb, vcb, ntile, pos, m_reg, l_reg);
        f32x16 o[4] = {};
        nsa_cmp_sweep2(lds, qr, kcb, vcb, ntile, pos, tokl, m_reg, l_reg, o);
        nsa_topk(lds, blk);
        nsa_branch_out<0>(lds, o, 1.f, false, 0, gates, OACC, ob, b, g, s0);
        __syncthreads();
        nsa_load_q(qr, Qr, b, g, s0);
        {
            const unsigned sel0 = selm[tokl * 4 + 0], sel1 = selm[tokl * 4 + 1], sel2 = selm[tokl * 4 + 2], sel3 = selm[tokl * 4 + 3];
            const unsigned un0 = unm[0], un1 = unm[1], un2 = unm[2], un3 = unm[3];
#pragma unroll
            for (int d0 = 0; d0 < 4; ++d0) o[d0] = f32x16{};
            m_reg = -1e30f; l_reg = 0.f;
            attn_sweep<MK_SLC, 8>(lds, qr, kv + (size_t)(2 * 8 + bg) * SEQ * 128, kv + (size_t)(3 * 8 + bg) * SEQ * 128, 0, blk + 1, pos, sel0, sel1, sel2, sel3, un0, un1, un2, un3, o, m_reg, l_reg, SCALE, 7);
            nsa_branch_out<1>(lds, o, l_reg, true, 1, gates, OACC, ob, b, g, s0);
        }
        {
#pragma unroll
            for (int d0 = 0; d0 < 4; ++d0) o[d0] = f32x16{};
            m_reg = -1e30f; l_reg = 0.f;
            attn_sweep<MK_WINDOW, 8>(lds, qr, kv + (size_t)(4 * 8 + bg) * SEQ * 128, kv + (size_t)(5 * 8 + bg) * SEQ * 128, blk > 8 ? blk - 8 : 0, blk + 1, pos, 0, 0, 0, 0, 0, 0, 0, 0, o, m_reg, l_reg, SCALE, 7);
            nsa_branch_out<2>(lds, o, l_reg, true, 2, gates, OACC, ob, b, g, s0);
        }
        __syncthreads();
    }
}

struct Args { const float* in[25]; float* out; unsigned char* ws; int ph_lo, ph_hi; };
enum { I_X = 0, I_HG_WIN, I_HG_LB, I_HG_NG, I_HG_WOUT, I_DA_WIN, I_DA_LAM, I_DA_NG, I_DA_WOUT, I_NSA_WIN, I_NSA_PE, I_NSA_W1, I_NSA_W2, I_NSA_WOUT,
       I_SB_WIN, I_SB_WOUT, I_FFN_WG, I_FFN_WU, I_FFN_WD, I_MOE_WR, I_MOE_WG, I_MOE_WU, I_MOE_WD, I_LN_G, I_LN_B };
__device__ __forceinline__ void rope_table(f32x2* tab, int half, double ratio, int wg, int nwg) {
    for (int i = wg * 512 + my_tid(); i < SEQ * half; i += nwg * 512) {
        const int s = i / half, j = i % half;
        double inv = 1.0; for (int k = 0; k < j; ++k) inv *= ratio;
        const float ang = (float)s * (float)inv;
        const double rev = (double)ang * 0.15915494309189535; const float fr = (float)(rev - floor(rev));
        tab[i] = (f32x2){__builtin_amdgcn_cosf(fr), __builtin_amdgcn_sinf(fr)};
    }
}
__device__ __forceinline__ void prologue_phase(ldsp_t lds, const Args& a, int wg, int nwg) {
    unsigned char* ws = a.ws; const int tid = my_tid();
    { const float* x = a.in[I_X]; bf16_t* hb = (bf16_t*)(ws + WS_HB);
      for (size_t i = ((size_t)wg * 512 + tid) * 8; i < (size_t)NT * DM; i += (size_t)nwg * 512 * 8)
          *(bf16x8*)(hb + i) = pack8(*(const f32x4*)(x + i), *(const f32x4*)(x + i + 4)); }
    if (wg == 0) { float* lbv = (float*)(ws + WS_LBV); const float* L = a.in[I_HG_LB];
        for (int d = tid; d < DM; d += 512) { float mx = L[d];
            for (int r = 1; r < 5; ++r) mx = fmaxf(mx, L[r * DM + d]);
            float s = 0.f; for (int r = 0; r < 5; ++r) s += __expf(L[r * DM + d] - mx);
            lbv[d] = __expf(L[d] - mx) / s; } }
    for (int u = wg; u < 64; u += nwg) { const int jj = u >> 5, p = u & 31; LAS float* red = (LAS float*)lds;
        const float* pe = a.in[I_NSA_PE] + (size_t)jj * 4096 + p * 128; const float* w1 = a.in[I_NSA_W1] + ((size_t)jj * 4096 + p * 128) * 128;
        const int nn = tid & 127, sub = tid >> 7; float sacc = 0.f;
#pragma unroll 8
        for (int k = sub * 32; k < sub * 32 + 32; ++k) sacc += pe[k] * w1[(size_t)k * 128 + nn];
        red[sub * 128 + nn] = sacc; __syncthreads();
        if (tid < 128) ((float*)(ws + WS_CMPBIAS))[(jj * 32 + p) * 128 + tid] = (red[tid] + red[128 + tid]) + (red[256 + tid] + red[384 + tid]);
        __syncthreads(); }
    rope_table((f32x2*)(ws + WS_ROPE_DA), 32, 0.7498942093324559, wg, nwg);
    rope_table((f32x2*)(ws + WS_ROPE_NSA), 64, 0.8659643233600653, wg, nwg);
    __syncthreads();
    convert_T(lds, (bf16_t*)(ws + WS_W_HGIN), 1, 0, 4096, 1024, MapId{a.in[I_HG_WIN], 4096, 4096}, wg, nwg);
    convert_T(lds, (bf16_t*)(ws + WS_W_HGOUT), 1, 0, 1024, 1024, MapId{a.in[I_HG_WOUT], 1024, 1024}, wg, nwg);
    convert_T(lds, (bf16_t*)(ws + WS_W_DAIN), 1, 0, 3072, 1024, MapRope64{a.in[I_DA_WIN], 3072}, wg, nwg);
    convert_T(lds, (bf16_t*)(ws + WS_W_DAOUT), 1, 0, 1024, 1024, MapId{a.in[I_DA_WOUT], 1024, 1024}, wg, nwg);
    convert_T(lds, (bf16_t*)(ws + WS_W_NSAIN), 1, 0, NSA_NPAD, 1024, MapNsa{a.in[I_NSA_WIN], 2584}, wg, nwg);
    convert_T(lds, (bf16_t*)(ws + WS_W_NSAOUT), 1, 0, 1024, 1024, MapId{a.in[I_NSA_WOUT], 1024, 1024}, wg, nwg);
    convert_T(lds, (bf16_t*)(ws + WS_W_SBIN), 1, 0, 3072, 1024, MapId{a.in[I_SB_WIN], 3072, 3072}, wg, nwg);
    convert_T(lds, (bf16_t*)(ws + WS_W_SBOUT), 1, 0, 1024, 1024, MapId{a.in[I_SB_WOUT], 1024, 1024}, wg, nwg);
    for (int j = 0; j < 2; ++j) {
        convert_T(lds, (bf16_t*)(ws + WS_W_FFNGU) + (size_t)j * 5632 * 1024, 1, 0, 5632, 1024, MapGU{a.in[I_FFN_WG] + (size_t)j * 1024 * DFF, a.in[I_FFN_WU] + (size_t)j * 1024 * DFF, DFF}, wg, nwg);
        convert_T(lds, (bf16_t*)(ws + WS_W_FFND) + (size_t)j * 1024 * DFF, 1, 0, 1024, DFF, MapId{a.in[I_FFN_WD] + (size_t)j * DFF * 1024, 1024, 1024}, wg, nwg);
        convert_T(lds, (bf16_t*)(ws + WS_W_CMP1) + (size_t)j * 128 * 4096, 1, 0, 128, 4096, MapId{a.in[I_NSA_W1] + (size_t)j * 4096 * 128, 128, 128}, wg, nwg);
        convert_T(lds, (bf16_t*)(ws + WS_W_CMP2) + (size_t)j * 128 * 128, 1, 0, 128, 128, MapId{a.in[I_NSA_W2] + (size_t)j * 128 * 128, 128, 128}, wg, nwg);
    }
}
__device__ __forceinline__ void moe_down_sub(ldsp_t lds, const bf16_t* A, const bf16_t* Bt, const pg8::Unit u, int rq, int cq, bf16_t* y) {
    using namespace pg8;
    constexpr int K = DFFE, nt = K / BK, STG = 16384, NST = 8;
    const int tid = my_tid(), wid = __builtin_amdgcn_readfirstlane(tid >> 6), lane = tid & 63, wm = wid >> 1, wc2 = wid & 1, fr = lane & 15, fq = lane >> 4;
    unsigned voffA, voffB;
    { int R, C; stage_rc(tid * 16, R, C); voffA = (unsigned)(R * K + C) * 2u; const int Rb = (R & ~31) + perm32(R & 31); voffB = (unsigned)(Rb * K + C) * 2u; }
    const char* cA = (const char*)A + ((size_t)u.pm * 256 + (size_t)rq * 64) * K * 2;
    const char* cB = (const char*)Bt + ((size_t)u.pn * 256 + (size_t)cq * 64) * K * 2;
    const unsigned ldsw = (unsigned)wid * 1024u;
    const int aoff = lds_byte(wm * 16 + fr, fq * 8), boff = 8192 + lds_byte(wc2 * 32 + fr, fq * 8);
#define MS_STAGE(s, t) do { const size_t ko_ = (size_t)(t) * (BK * 2); \
        __builtin_amdgcn_global_load_lds((const unsigned*)(cA + ko_ + voffA), (LAS unsigned*)(lds + (s) * STG + ldsw), 16, 0, 0); \
        __builtin_amdgcn_global_load_lds((const unsigned*)(cB + ko_ + voffB), (LAS unsigned*)(lds + (s) * STG + 8192 + ldsw), 16, 0, 0); } while (0)
    f32x4 acc[2] = {(f32x4){0.f, 0.f, 0.f, 0.f}, (f32x4){0.f, 0.f, 0.f, 0.f}};
#pragma unroll
    for (int t = 0; t < NST - 1; ++t) MS_STAGE(t, t);
    for (int t = 0; t < nt; ++t) {
        asm volatile("s_waitcnt vmcnt(12)" ::: "memory");
        __builtin_amdgcn_s_barrier();
        asm volatile("" ::: "memory");
        { const int tn = (t + NST - 1 < nt) ? t + NST - 1 : nt - 1;
          MS_STAGE((t + NST - 1) & (NST - 1), tn); }
        const int s = t & (NST - 1);
        bf16x8 At[2], Bf[2][2];
#pragma unroll
        for (int k = 0; k < 2; ++k) At[k] = *(const LAS bf16x8*)(lds + s * STG + aoff + k * 1024);
#pragma unroll
        for (int n = 0; n < 2; ++n)
#pragma unroll
            for (int k = 0; k < 2; ++k) Bf[n][k] = *(const LAS bf16x8*)(lds + s * STG + boff + n * 2048 + k * 1024);
#pragma unroll
        for (int n = 0; n < 2; ++n)
#pragma unroll
            for (int k = 0; k < 2; ++k) acc[n] = __builtin_amdgcn_mfma_f32_16x16x32_bf16(Bf[n][k], At[k], acc[n], 0, 0, 0);
        asm volatile("" ::: "memory");
    }
#undef MS_STAGE
    asm volatile("s_waitcnt vmcnt(0)" ::: "memory");
    { const int row = u.pm * 256 + rq * 64 + wm * 16 + fr, colL = (u.pn & 3) * 256 + cq * 64 + wc2 * 32 + 8 * fq;
      *(bf16x8*)(y + (size_t)row * DM + colL) = pack8(acc[0], acc[1]); }
    __syncthreads();
}
__device__ __forceinline__ void moe_convert_phase(ldsp_t lds, const Args& a, int j, int wg, int nwg) {
    unsigned char* ws = a.ws;
    const size_t eo = (size_t)(j * 8) * 1024 * DFFE;
    convert_T(lds, (bf16_t*)(ws + WS_W_MOEGU), 8, (size_t)1024 * DFFE, 7168, 1024, MapGU{a.in[I_MOE_WG] + eo, a.in[I_MOE_WU] + eo, DFFE}, wg, nwg);
    convert_T(lds, (bf16_t*)(ws + WS_W_MOED), 8, (size_t)1024 * DFFE, 1024, DFFE, MapId{a.in[I_MOE_WD] + eo, 1024, 1024}, wg, nwg);
}

__global__ void __launch_bounds__(512, 2) mega(Args a) {
    extern __shared__ __attribute__((aligned(16))) unsigned char lds_raw[];
    ldsp_t lds = (ldsp_t)lds_raw;
    const int tid = my_tid(), wg = blockIdx.x, nwg = gridDim.x;
    const int lo = a.ph_lo, hi = a.ph_hi;
    unsigned char* ws = a.ws;
    volatile LAS unsigned* misc = (volatile LAS unsigned*)(lds + LDS_MISC);
    XcdBarrier bar; bar.bar = (unsigned*)(ws + WS_BAR); bar.x = 0; bar.st = misc;
    if (hi - lo > 1) { if (tid == 0) { misc[0] = 0u; misc[1] = 0u; misc[2] = 0u; misc[3] = 0u; } __syncthreads(); bar = xcd_barrier_post((unsigned*)(ws + WS_BAR), misc); }
    int ph = 0;
#ifndef PH_MASK
#define PH_MASK 0xffffffffu
#endif
#ifndef REPEAT_ID
#define REPEAT_ID (-1)
#define REPEAT_N 1
#endif
#define PH_BEGIN(ID) if (((PH_MASK >> (ID)) & 1u) && ph >= lo && ph < hi) { for (int rep_ = 0; rep_ < ((ID) == REPEAT_ID ? REPEAT_N : 1); ++rep_) {
#define PH_END   } if (ph + 1 < hi) xcd_barrier(bar); } ++ph;
    bf16_t* hb = (bf16_t*)(ws + WS_HB); bf16_t* ob = (bf16_t*)(ws + WS_OB);
    unsigned* ctl = (unsigned*)(ws + WS_CTL);

    PH_BEGIN(0) prologue_phase(lds, a, wg, nwg); PH_END

    for (int layer = 0; layer < 4; ++layer) {
        if (layer == 0) {
            PH_BEGIN(1) { pg8::Gemm g{hb, (const bf16_t*)(ws + WS_W_HGIN), NT, 4096, 1024}; pg8::StaticOrder S; S.init(NT, 4096, nwg, wg);
                EpiHgIn E{(bf16_t*)(ws + SC_HG_QS), (bf16_t*)(ws + SC_HG_VV), (bf16_t*)(ws + SC_HG_SG), (float*)(ws + SC_HG_LF), (const float*)(ws + WS_LBV)};
                pg8::gemm_phase(lds, g, S, E); } PH_END
            PH_BEGIN(2) hgrn_passA(lds, (const float*)(ws + SC_HG_LF), (const bf16_t*)(ws + SC_HG_VV), (bf16_t*)(ws + SC_HG_ST), (float*)(ws + SC_HG_DEC), wg, nwg); PH_END
            PH_BEGIN(3) hgrn_passB((bf16_t*)(ws + SC_HG_ST), (const float*)(ws + SC_HG_DEC), wg, nwg); PH_END
            PH_BEGIN(4) hgrn_passC(lds, (const bf16_t*)(ws + SC_HG_QS), (const float*)(ws + SC_HG_LF), (const bf16_t*)(ws + SC_HG_VV), (const bf16_t*)(ws + SC_HG_SG),
                                (const bf16_t*)(ws + SC_HG_ST), a.in[I_HG_NG], ob, wg, nwg); PH_END
        } else if (layer == 1) {
            PH_BEGIN(5) { pg8::Gemm g{hb, (const bf16_t*)(ws + WS_W_DAIN), NT, 3072, 1024}; pg8::StaticOrder S; S.init(NT, 3072, nwg, wg);
                EpiDaIn E{(bf16_t*)(ws + SC_DA_Q), (bf16_t*)(ws + SC_DA_K), (bf16_t*)(ws + SC_DA_V), (const f32x2*)(ws + WS_ROPE_DA)};
                pg8::gemm_phase(lds, g, S, E); } PH_END
            PH_BEGIN(6) da_attn_phase(lds, (const bf16_t*)(ws + SC_DA_Q), (const bf16_t*)(ws + SC_DA_K), (const bf16_t*)(ws + SC_DA_V), a.in[I_DA_LAM], a.in[I_DA_NG], ob, wg, nwg); PH_END
        } else if (layer == 2) {
            PH_BEGIN(8) { pg8::Gemm g{hb, (const bf16_t*)(ws + WS_W_NSAIN), NT, NSA_NPAD, 1024}; pg8::StaticOrder S; S.init(NT, NSA_NPAD, nwg, wg);
                EpiNsaIn E{(bf16_t*)(ws + SC_NSA_Q), (bf16_t*)(ws + SC_NSA_QR), (bf16_t*)(ws + SC_NSA_KV), (float*)(ws + SC_NSA_GATE), (const f32x2*)(ws + WS_ROPE_NSA)};
                pg8::gemm_phase(lds, g, S, E); } PH_END
            PH_BEGIN(9) nsa_compress_phase(lds, (const bf16_t*)(ws + SC_NSA_KV), (const bf16_t*)(ws + WS_W_CMP1), (const bf16_t*)(ws + WS_W_CMP2), (const float*)(ws + WS_CMPBIAS), (bf16_t*)(ws + SC_NSA_KC), wg, nwg); PH_END
            PH_BEGIN(10) nsa_attn_phase(lds, (const bf16_t*)(ws + SC_NSA_Q), (const bf16_t*)(ws + SC_NSA_QR), (const bf16_t*)(ws + SC_NSA_KV), (const bf16_t*)(ws + SC_NSA_KC),
                                    (const float*)(ws + SC_NSA_GATE), (float*)(ws + SC_NSA_OACC), ob, wg, nwg); PH_END
        } else {
            PH_BEGIN(11) { pg8::Gemm g{hb, (const bf16_t*)(ws + WS_W_SBIN), NT, 3072, 1024}; pg8::StaticOrder S; S.init(NT, 3072, nwg, wg);
                EpiSbIn E{(bf16_t*)(ws + SC_SB_Q)};
                pg8::gemm_phase(lds, g, S, E); } PH_END
            PH_BEGIN(12) sb_attn_phase(lds, (const bf16_t*)(ws + SC_SB_Q), (const bf16_t*)(ws + SC_SB_K), (const bf16_t*)(ws + SC_SB_V), ob, wg, nwg); PH_END
        }
        const size_t wout_off = (layer == 0) ? WS_W_HGOUT : (layer == 1) ? WS_W_DAOUT : (layer == 2) ? WS_W_NSAOUT : WS_W_SBOUT;
        PH_BEGIN(13) { pg8::Gemm g{ob, (const bf16_t*)(ws + wout_off), NT, 1024, 1024}; pg8::StaticOrder S; S.init(NT, 1024, nwg, wg);
            bf16_t* zdst = rep_ ? (bf16_t*)a.out : hb;
            if (layer == 0) { EpiRes<true> E{a.in[I_X], zdst}; pg8::gemm_phase(lds, g, S, E); }
            else { EpiRes<false> E{hb, zdst}; pg8::gemm_phase(lds, g, S, E); } } PH_END
        const int j = layer >> 1;
        unsigned* cnt = ctl + 64 * j;
        const Route* route = (const Route*)(ws + SC_MOE_ROUTE);
        PH_BEGIN(14) ln_phase(lds, hb, rep_ ? a.out : nullptr, rep_ ? nullptr : hb, a.in[I_LN_G] + (size_t)(layer * 2) * DM, a.in[I_LN_B] + (size_t)(layer * 2) * DM, nullptr, nullptr, nullptr,
                          ((layer & 1) && !rep_) ? a.in[I_MOE_WR] + (size_t)j * DM * 8 : nullptr, (Route*)(ws + SC_MOE_ROUTE), cnt, wg, nwg); PH_END
        if ((layer & 1) == 0) {
            PH_BEGIN(15) { pg8::Gemm g{hb, (const bf16_t*)(ws + WS_W_FFNGU) + (size_t)j * 5632 * 1024, NT, 5632, 1024}; pg8::StaticOrder S; S.init(NT, 5632, nwg, wg);
                EpiSwiglu E{(bf16_t*)(ws + SC_FF_ACT), DFF, 22};
                pg8::gemm_phase(lds, g, S, E); } PH_END
            PH_BEGIN(16) { pg8::Gemm g{(const bf16_t*)(ws + SC_FF_ACT), (const bf16_t*)(ws + WS_W_FFND) + (size_t)j * 1024 * DFF, NT, 1024, DFF}; pg8::StaticOrder S; S.init(NT, 1024, nwg, wg);
                EpiRes<false> E{hb, rep_ ? (bf16_t*)a.out : hb};
                pg8::gemm_phase(lds, g, S, E); } PH_END
            PH_BEGIN(17) ln_phase(lds, hb, (layer == 3 || rep_) ? a.out : nullptr, rep_ ? nullptr : hb, a.in[I_LN_G] + (size_t)(layer * 2 + 1) * DM, a.in[I_LN_B] + (size_t)(layer * 2 + 1) * DM, nullptr, nullptr, nullptr,
                              nullptr, nullptr, nullptr, wg, nwg); PH_END
        } else {
            PH_BEGIN(18) moe_convert_phase(lds, a, j, wg, nwg);
                         moe_build_table(lds, (int*)(ws + SC_MOE_XS), route, cnt, wg, nwg); PH_END
            for (int ck = 0; ck < 2; ++ck) {
                int seg_tile[8], nT_, tile_lo_ = ck * MOE_CHUNK_TILES;
                { int s_ = 0;
#pragma unroll
                  for (int e = 0; e < 8; ++e) { seg_tile[e] = s_ >> 8; s_ += (int)((cnt[e] + 255u) & ~255u); }
                  int nt_all = s_ >> 8; int t_hi = tile_lo_ + MOE_CHUNK_TILES; if (t_hi > nt_all) t_hi = nt_all; nT_ = t_hi - tile_lo_; }
                PH_BEGIN(19) { MoeOrderT<true> MO; MO.G = nwg; MO.c = wg; MO.tile_lo = tile_lo_; MO.nT = nT_; MO.nNt = 28; MO.tok = (const int*)(ws + SC_MOE_XS);
#pragma unroll
                    for (int e = 0; e < 8; ++e) MO.seg_tile[e] = seg_tile[e];
                    pg8::Gemm g{hb, (const bf16_t*)(ws + WS_W_MOEGU), MOE_CHUNK_ROWS, 7168, 1024};
                    EpiSwiglu E{(bf16_t*)(ws + SC_MOE_ACT), DFFE, 28};
                    pg8::gemm_phase(lds, g, MO, E); } PH_END
                PH_BEGIN(20) { MoeOrderT<false> MO; MO.G = nwg; MO.c = wg; MO.tile_lo = tile_lo_; MO.nT = nT_; MO.nNt = 4; MO.tok = nullptr;
#pragma unroll
                    for (int e = 0; e < 8; ++e) MO.seg_tile[e] = seg_tile[e];
                    pg8::Gemm g{(const bf16_t*)(ws + SC_MOE_ACT), (const bf16_t*)(ws + WS_W_MOED), MOE_CHUNK_ROWS, 1024, DFFE};
                    EpiMoeDown E{(bf16_t*)(ws + SC_MOE_Y) + (size_t)ck * MOE_CHUNK_ROWS * DM};
                    const int nu_ = nT_ > 0 ? nT_ * 4 : 0, nfull_ = nu_ / nwg, ntail_ = nu_ - nfull_ * nwg;
                    const bool stail_ = (ntail_ > 0 && ntail_ <= 16 && nwg == 256);
                    if (stail_) MO.imax = nfull_;
                    pg8::gemm_phase(lds, g, MO, E);
                    if (stail_) { __syncthreads();
                        const int j_ = wg >> 3, uidx_ = (wg & 7) + 8 * (j_ >> 4), sub_ = j_ & 15;
                        if (uidx_ < ntail_) { pg8::Unit u_; MO.at((long)nfull_ * nwg + uidx_, u_); moe_down_sub(lds, g.A, g.Bt, u_, sub_ >> 2, sub_ & 3, E.y); } } } PH_END
            }
            PH_BEGIN(21) ln_phase(lds, hb, (layer == 3 || rep_) ? a.out : nullptr, rep_ ? nullptr : hb, a.in[I_LN_G] + (size_t)(layer * 2 + 1) * DM, a.in[I_LN_B] + (size_t)(layer * 2 + 1) * DM,
                              route, (const bf16_t*)(ws + SC_MOE_Y), cnt, nullptr, nullptr, nullptr, wg, nwg); PH_END
        }
    }
#undef PH_BEGIN
#undef PH_END
}
constexpr int NPHASES = 38;

#ifdef DBG_REPORT
__global__ void dbg_stats(const void* buf, size_t n, int isbf, float* acc, int slot) {
    float bad = 0.f, ss = 0.f;
    for (size_t i = (size_t)blockIdx.x * blockDim.x + threadIdx.x; i < n; i += (size_t)gridDim.x * blockDim.x) {
        const float v = isbf ? bf2f(((const bf16_t*)buf)[i]) : ((const float*)buf)[i];
        if (!(fabsf(v) < 3e38f)) bad += 1.f; else ss += v * v; }
    bad = wave_sum(bad); ss = wave_sum(ss);
    if ((threadIdx.x & 63) == 0) { atomicAdd(acc + 2 * slot, bad); atomicAdd(acc + 2 * slot + 1, ss); }
}
__global__ void dbg_write(const float* acc, int nslot, float* out, size_t nout) {
    float code = 1.f;
    for (int k = 0; k < nslot; ++k) if (acc[2 * k] > 0.f) code += (float)(1 << k);
    const float c = 10.f * code;
    for (size_t i = (size_t)blockIdx.x * blockDim.x + threadIdx.x; i < nout; i += (size_t)gridDim.x * blockDim.x) out[i] = c;
}
#endif
extern "C" void kernel_launch(void* const* d_in, const int* in_sizes, int n_in, void* d_out, int out_size, void* d_ws, size_t ws_size, hipStream_t stream) {
    static int grid = 0;
    if (grid == 0) {
        if (n_in != 25 || out_size != NT * DM || ws_size < WS_END) { fprintf(stderr, "kernel_launch: unexpected shapes / workspace (%d inputs, out %d, ws %zu < %zu)\n", n_in, out_size, ws_size, (size_t)WS_END); grid = -1; return; }
        int dev = 0, cus = 0;
        if (hipGetDevice(&dev) != hipSuccess || hipDeviceGetAttribute(&cus, hipDeviceAttributeMultiprocessorCount, dev) != hipSuccess) { grid = -1; return; }
        if (hipFuncSetAttribute((const void*)mega, hipFuncAttributeMaxDynamicSharedMemorySize, LDS_BYTES) != hipSuccess) { fprintf(stderr, "kernel_launch: hipFuncSetAttribute failed\n"); grid = -1; return; }
        int per_cu = 0;
        if (hipOccupancyMaxActiveBlocksPerMultiprocessor(&per_cu, (const void*)mega, 512, LDS_BYTES) != hipSuccess || per_cu < 1) { fprintf(stderr, "kernel_launch: occupancy query says %d blocks per CU\n", per_cu); }
        (void)hipGetLastError();
        grid = cus;
    }
    if (grid < 0) return;
    (void)hipMemsetAsync((char*)d_ws, 0, WS_ZERO_BYTES, stream);
    Args a{};
    for (int i = 0; i < 25; ++i) a.in[i] = (const float*)d_in[i];
    a.out = (float*)d_out; a.ws = (unsigned char*)d_ws;
#if MK_FUSED
    a.ph_lo = 0; a.ph_hi = NPHASES;
    hipLaunchKernelGGL(mega, dim3(grid), dim3(512), LDS_BYTES, stream, a);
#else
#ifndef DBG_NPH
#define DBG_NPH NPHASES
#endif
    for (int p = 0; p < DBG_NPH; ++p) { a.ph_lo = p; a.ph_hi = p + 1; hipLaunchKernelGGL(mega, dim3(grid), dim3(512), LDS_BYTES, stream, a); }
#ifdef DBG_REPORT
    { float* acc = (float*)((char*)d_ws + WS_CTL + 2048); char* w = (char*)d_ws;
      hipLaunchKernelGGL(dbg_stats, dim3(1024), dim3(256), 0, stream, (const void*)(w + SC_HG_VV), (size_t)NT * DM, 1, acc, 0);
      hipLaunchKernelGGL(dbg_stats, dim3(1024), dim3(256), 0, stream, (const void*)(w + SC_HG_ST), (size_t)4096 * 128 * 128, 1, acc, 1);
      hipLaunchKernelGGL(dbg_stats, dim3(1024), dim3(256), 0, stream, (const void*)(w + SC_HG_SG), (size_t)NT * DM, 1, acc, 2);
      hipLaunchKernelGGL(dbg_stats, dim3(1024), dim3(256), 0, stream, (const void*)(w + SC_HG_LF), (size_t)NT * DM, 0, acc, 3);
      hipLaunchKernelGGL(dbg_write, dim3(1024), dim3(256), 0, stream, (const float*)acc, 4, (float*)d_out, (size_t)NT * DM); }
#endif
#endif
}
```

```cpp
#include <hip/hip_runtime.h>
#include <stdint.h>
#include <stdio.h>

#ifndef MK_FUSED
#define MK_FUSED 1
#endif


#define LAS __attribute__((address_space(3)))
typedef unsigned short bf16_t;
typedef short bf16x8 __attribute__((ext_vector_type(8)));
typedef short s16x4 __attribute__((ext_vector_type(4)));
typedef float f32x2 __attribute__((ext_vector_type(2)));
typedef float f32x4 __attribute__((ext_vector_type(4)));
typedef float f32x16 __attribute__((ext_vector_type(16)));
typedef unsigned u32x2 __attribute__((ext_vector_type(2)));
typedef unsigned u32x4 __attribute__((ext_vector_type(4)));
typedef LAS unsigned char* ldsp_t;

constexpr int DM = 1024, NB = 4, SEQ = 8192, NT = NB * SEQ, NHEAD = 8, HDIM = 128;
constexpr int DFF = 2816, NEXP = 8, DFFE = 3584;
constexpr float ALPHA = 1.681792830507429f;
constexpr float LN_EPS = 1e-5f;
constexpr int NSA_NPAD = 2816;
constexpr int NCMP = 511, NCMP_P = 512;
constexpr int MOE_TILES_MAX = 264, MOE_CHUNK_TILES = 132, MOE_ROWS_MAX = MOE_TILES_MAX * 256, MOE_CHUNK_ROWS = MOE_CHUNK_TILES * 256;

constexpr size_t al256(size_t x) { return (x + 255) & ~(size_t)255; }
constexpr size_t WS_BAR = 0;
constexpr size_t WS_CTL = 16384;
constexpr size_t WS_ZERO_BYTES = 16384 + 4096;
constexpr size_t WS_SMALL = WS_ZERO_BYTES;
constexpr size_t WS_LBV = WS_SMALL;
constexpr size_t WS_CMPBIAS = WS_LBV + 4096;
constexpr size_t WS_ROPE_DA = WS_CMPBIAS + 32768;
constexpr size_t WS_ROPE_NSA = WS_ROPE_DA + (size_t)SEQ * 32 * 8;
constexpr size_t WS_HB = al256(WS_ROPE_NSA + (size_t)SEQ * 64 * 8);
constexpr size_t WS_OB = WS_HB + (size_t)NT * DM * 2;
constexpr size_t WS_W_HGIN = WS_OB + (size_t)NT * DM * 2;
constexpr size_t WS_W_HGOUT = WS_W_HGIN + (size_t)4096 * 1024 * 2;
constexpr size_t WS_W_DAIN = WS_W_HGOUT + (size_t)1024 * 1024 * 2;
constexpr size_t WS_W_DAOUT = WS_W_DAIN + (size_t)3072 * 1024 * 2;
constexpr size_t WS_W_NSAIN = WS_W_DAOUT + (size_t)1024 * 1024 * 2;
constexpr size_t WS_W_NSAOUT = WS_W_NSAIN + (size_t)NSA_NPAD * 1024 * 2;
constexpr size_t WS_W_SBIN = WS_W_NSAOUT + (size_t)1024 * 1024 * 2;
constexpr size_t WS_W_SBOUT = WS_W_SBIN + (size_t)3072 * 1024 * 2;
constexpr size_t WS_W_FFNGU = WS_W_SBOUT + (size_t)1024 * 1024 * 2;
constexpr size_t WS_W_FFND = WS_W_FFNGU + (size_t)2 * 5632 * 1024 * 2;
constexpr size_t WS_W_CMP1 = WS_W_FFND + (size_t)2 * 1024 * 2816 * 2;
constexpr size_t WS_W_CMP2 = WS_W_CMP1 + (size_t)2 * 128 * 4096 * 2;
constexpr size_t WS_W_MOEGU = WS_W_CMP2 + (size_t)2 * 128 * 128 * 2;
constexpr size_t WS_W_MOED = WS_W_MOEGU + (size_t)8 * 7168 * 1024 * 2;
constexpr size_t WS_SCR = al256(WS_W_MOED + (size_t)8 * 1024 * 3584 * 2);
constexpr size_t SC_HG_QS = WS_SCR;
constexpr size_t SC_HG_VV = SC_HG_QS + (size_t)NT * DM * 2;
constexpr size_t SC_HG_SG = SC_HG_VV + (size_t)NT * DM * 2;
constexpr size_t SC_HG_LF = SC_HG_SG + (size_t)NT * DM * 2;
constexpr size_t SC_HG_ST = SC_HG_LF + (size_t)NT * DM * 4;
constexpr size_t SC_HG_DEC = SC_HG_ST + (size_t)4096 * 128 * 128 * 2;
constexpr size_t SC_HG_END = SC_HG_DEC + (size_t)4096 * 128 * 4;
constexpr size_t SC_FF_ACT = WS_SCR;
constexpr size_t SC_FF_END = SC_FF_ACT + (size_t)NT * DFF * 2;
constexpr size_t SC_DA_Q = WS_SCR;
constexpr size_t SC_DA_K = SC_DA_Q + (size_t)NT * DM * 2;
constexpr size_t SC_DA_V = SC_DA_K + (size_t)NT * DM * 2;
constexpr size_t SC_DA_END = SC_DA_V + (size_t)NT * DM * 2;
constexpr size_t SC_MOE_ROUTE = WS_SCR;
constexpr size_t SC_MOE_XS = SC_MOE_ROUTE + (size_t)NT * 32;
constexpr size_t SC_MOE_ACT = SC_MOE_XS + al256((size_t)MOE_ROWS_MAX * 4);
constexpr size_t SC_MOE_Y = SC_MOE_ACT + (size_t)MOE_CHUNK_ROWS * DFFE * 2;
constexpr size_t SC_MOE_END = SC_MOE_Y + (size_t)MOE_ROWS_MAX * DM * 2;
constexpr size_t SC_NSA_Q = WS_SCR;
constexpr size_t SC_NSA_QR = SC_NSA_Q + (size_t)NT * DM * 2;
constexpr size_t SC_NSA_KV = SC_NSA_QR + (size_t)NT * DM * 2;
constexpr size_t SC_NSA_GATE = SC_NSA_KV + (size_t)6 * NT * 256 * 2;
constexpr size_t SC_NSA_KC = SC_NSA_GATE + (size_t)NT * 24 * 4;
constexpr size_t SC_NSA_OACC = SC_NSA_KC + (size_t)2 * 8 * NCMP_P * 128 * 2;
constexpr size_t SC_NSA_END = SC_NSA_OACC + (size_t)NT * DM * 4;
constexpr size_t SC_SB_Q = WS_SCR;
constexpr size_t SC_SB_K = SC_SB_Q + (size_t)NT * DM * 2;
constexpr size_t SC_SB_V = SC_SB_K + (size_t)NT * DM * 2;
constexpr size_t SC_SB_END = SC_SB_V + (size_t)NT * DM * 2;
constexpr size_t cmax(size_t a, size_t b) { return a > b ? a : b; }
constexpr size_t WS_END = cmax(cmax(cmax(SC_HG_END, SC_FF_END), cmax(SC_DA_END, SC_MOE_END)), cmax(SC_NSA_END, SC_SB_END));
static_assert(WS_END <= (size_t)981882880, "workspace budget (sum of the inputs)");

constexpr int LDS_BYTES = 152 * 1024;
constexpr int LDS_MISC = 150 * 1024;

__device__ __forceinline__ unsigned bf16_rne_bits(float f) { const unsigned u = __float_as_uint(f); return (u + 0x7fffu + ((u >> 16) & 1u)) >> 16; }
__device__ __forceinline__ unsigned cvtpk(float lo, float hi) {
    typedef __bf16 bf2_t __attribute__((ext_vector_type(2)));
    typedef float f2_t __attribute__((ext_vector_type(2)));
    const bf2_t r = __builtin_convertvector((f2_t){lo, hi}, bf2_t);
    return __builtin_bit_cast(unsigned, r);
}
__device__ __forceinline__ float bf2f(bf16_t b) { return __uint_as_float(((unsigned)b) << 16); }
__device__ __forceinline__ bf16_t f2bf(float f) { return (bf16_t)(cvtpk(f, 0.f) & 0xffffu); }
__device__ __forceinline__ bf16x8 pack8(f32x4 a, f32x4 b) { u32x4 w = {cvtpk(a[0], a[1]), cvtpk(a[2], a[3]), cvtpk(b[0], b[1]), cvtpk(b[2], b[3])}; return *reinterpret_cast<bf16x8*>(&w); }
__device__ __forceinline__ float sigmoidf_(float x) { return __builtin_amdgcn_rcpf(1.f + __expf(-x)); }
__device__ __forceinline__ float siluf_(float x) { return x * __builtin_amdgcn_rcpf(1.f + __expf(-x)); }
__device__ __forceinline__ int my_tid() { int t = threadIdx.x; asm volatile("" : "+v"(t)); return t; }
template <int CTRL> __device__ __forceinline__ int dpp_i(int v) { return __builtin_amdgcn_update_dpp(v, v, CTRL, 0xf, 0xf, false); }
template <int CTRL> __device__ __forceinline__ float dpp_f(float v) { return __int_as_float(__builtin_amdgcn_update_dpp(__float_as_int(v), __float_as_int(v), CTRL, 0xf, 0xf, false)); }
__device__ __forceinline__ float lane_xor1(float v) { return dpp_f<0xB1>(v); }
__device__ __forceinline__ float lane_xor2(float v) { return dpp_f<0x4E>(v); }
__device__ __forceinline__ float sum_rows16(float v) { auto rr = __builtin_amdgcn_permlane16_swap(__float_as_uint(v), __float_as_uint(v), false, false); return __uint_as_float(rr[0]) + __uint_as_float(rr[1]); }
__device__ __forceinline__ float sum_halves32(float v) { auto rr = __builtin_amdgcn_permlane32_swap(__float_as_uint(v), __float_as_uint(v), false, false); return __uint_as_float(rr[0]) + __uint_as_float(rr[1]); }
__device__ __forceinline__ float other_half32(float v, int hi) { auto rr = __builtin_amdgcn_permlane32_swap(__float_as_uint(v), __float_as_uint(v), false, false); return __uint_as_float(hi ? rr[0] : rr[1]); }
__device__ __forceinline__ float row16_sum(float v) { v += dpp_f<0xB1>(v); v += dpp_f<0x4E>(v); v += dpp_f<0x141>(v); v += dpp_f<0x140>(v); return v; }
__device__ __forceinline__ float wave_sum(float v) { return sum_halves32(sum_rows16(row16_sum(v))); }

#define XB_TMO      128
#define XB_XCNT(j)  (256  + 64 * (j))
#define XB_XSUB(j)  (1280 + 64 * (j))
#define XB_XGEN(j)  (2304 + 64 * (j))
#define XB_TOP      3328
#define XB_TOPGEN   3392
#define XCD_BAR_WORDS 3456
#define XB_SPIN_CAP (1u << 18)
__device__ __forceinline__ unsigned xb_ld(unsigned* p)              { return __hip_atomic_load(p, __ATOMIC_RELAXED, __HIP_MEMORY_SCOPE_AGENT); }
__device__ __forceinline__ unsigned xb_add(unsigned* p, unsigned v) { return __hip_atomic_fetch_add(p, v, __ATOMIC_RELAXED, __HIP_MEMORY_SCOPE_AGENT); }
__device__ __forceinline__ unsigned xb_xcc_id() { return (unsigned)__builtin_amdgcn_s_getreg((3 << 11) | 20) & 0xFu; }
#define XB_SPIN(cond, bar) do { unsigned _sp = 0; while (cond) { __builtin_amdgcn_s_sleep(1); \
    if ((++_sp & 255u) == 0u) { if (xb_ld(&(bar)[XB_TMO])) break; if (_sp > XB_SPIN_CAP) { atomicAdd(&(bar)[XB_TMO], 1u); break; } } } } while (0)
struct XcdBarrier { unsigned* bar; unsigned x; volatile LAS unsigned* st; };
__device__ __forceinline__ XcdBarrier xcd_barrier_post(unsigned* bar, volatile LAS unsigned* st) {
    XcdBarrier b; b.bar = bar; b.x = xb_xcc_id(); b.st = st;
    if (threadIdx.x == 0) (void)xb_add(&bar[XB_XCNT(b.x)], 1u);
    return b;
}
__device__ __forceinline__ void xcd_barrier_complete(unsigned* bar, unsigned x, unsigned& nloc, unsigned& nx) {
    const unsigned G = gridDim.x * gridDim.y * gridDim.z;
    unsigned sum, cnt, mine, sp = 0u;
    for (;;) {
        sum = 0u; cnt = 0u; mine = 0u;
#pragma unroll
        for (unsigned j = 0; j < 16; ++j) { const unsigned c = xb_ld(&bar[XB_XCNT(j)]); sum += c; cnt += (c > 0u) ? 1u : 0u; mine = (j == x) ? c : mine; }
        if (sum == G) break;
        __builtin_amdgcn_s_sleep(1);
        if ((++sp & 255u) == 0u) { if (xb_ld(&bar[XB_TMO])) break; if (sp > XB_SPIN_CAP) { atomicAdd(&bar[XB_TMO], 1u); break; } }
    }
    nloc = mine > 0u ? mine : 1u; nx = cnt > 0u ? cnt : 1u;
}
__device__ __forceinline__ void xcd_barrier(const XcdBarrier& b) {
    asm volatile("s_waitcnt vmcnt(0)" ::: "memory");
    __syncthreads();
    if (threadIdx.x == 0) {
        unsigned* bar = b.bar;
        __builtin_amdgcn_s_waitcnt(0);
        unsigned nloc = b.st[0], nx = b.st[1];
        if (nloc == 0u) { xcd_barrier_complete(bar, b.x, nloc, nx); b.st[0] = nloc; b.st[1] = nx; }
        const unsigned old = xb_add(&bar[XB_XSUB(b.x)], 1u);
        const unsigned gen = old / nloc;
        if (old + 1u == (gen + 1u) * nloc) {
            __builtin_amdgcn_fence(__ATOMIC_RELEASE, "agent");
            asm volatile("s_waitcnt vmcnt(0)" ::: "memory");
            const unsigned og = xb_add(&bar[XB_TOP], 1u);
            const unsigned tg = og / nx;
            if (og + 1u == (tg + 1u) * nx) xb_add(&bar[XB_TOPGEN], 1u);
            else XB_SPIN(xb_ld(&bar[XB_TOPGEN]) == tg, bar);
            __builtin_amdgcn_fence(__ATOMIC_ACQUIRE, "agent");
            xb_add(&bar[XB_XGEN(b.x)], 1u);
            asm volatile("s_waitcnt vmcnt(0)" ::: "memory");
        } else {
            XB_SPIN(xb_ld(&bar[XB_XGEN(b.x)]) == gen, bar);
            __builtin_amdgcn_fence(__ATOMIC_ACQUIRE, "agent");
            asm volatile("s_waitcnt vmcnt(0)" ::: "memory");
        }
    }
    __syncthreads();
}

namespace pg8 {
constexpr int BM = 256, BK = 64, HALF = 128, HTB = HALF * BK * 2, STAGE_BYTES = 8 * HTB, NXCD = 8, WGM = 8;
__host__ __device__ __forceinline__ int lds_byte(int r, int c) { const int st = (r >> 4) * 2 + (c >> 5), rr = r & 15, cc = c & 31, ob = rr * 64 + cc * 2; return st * 1024 + (ob ^ (((ob >> 9) & 1) << 5)); }
__host__ __device__ __forceinline__ void stage_rc(int b, int& R, int& C) { const int st = b / 1024, sb = b % 1024, swz = sb ^ (((sb >> 9) & 1) << 5); R = (st >> 1) * 16 + swz / 64; C = (st & 1) * 32 + (swz % 64) / 2; }
__host__ __device__ __forceinline__ int perm32(int rho) { const int n = rho >> 4, i = rho & 15; return 8 * (i >> 2) + 4 * n + (i & 3); }
struct Unit { int pm, pn; };
struct Gemm { const bf16_t* A; const bf16_t* Bt; int M, N, K; };
struct StaticOrder {
    static constexpr bool GATHER = false; static constexpr int tile_lo = 0;
    __device__ __forceinline__ int row_token(int) const { return 0; }
    int nM, nN, nwg, G, c;
    __device__ void init(int M, int N, int G_, int c_) { nM = M / BM; nN = N / BM; nwg = nM * nN; G = G_; c = c_; }
    __device__ bool next(int i, Unit& u) const {
        const long L = (long)i * G + c; if (L >= nwg) return false;
        int wgid = (int)L; { const int q = nwg / NXCD, r = nwg % NXCD, xcd = wgid % NXCD, off = wgid / NXCD; wgid = (xcd < r ? xcd * (q + 1) : r * (q + 1) + (xcd - r) * q) + off; }
        const int nig = WGM * nN, gid = wgid / nig, fm = gid * WGM, gsz = (nM - fm) < WGM ? (nM - fm) : WGM;
        u.pm = fm + ((wgid % nig) % gsz); u.pn = (wgid % nig) / gsz; return true;
    }
};
template <class Epi, class Sched>
__device__ __forceinline__ void gemm_phase(ldsp_t lds, const Gemm g, const Sched& S, const Epi& E) {
    constexpr bool GA = Sched::GATHER;
    const int tid = my_tid(), wid = __builtin_amdgcn_readfirstlane(tid >> 6), lane = tid & 63, wr = wid >> 2, wc = wid & 3, fr = lane & 15, fq = lane >> 4;
    const int K = g.K, nt = K / BK;
    unsigned voffA[2], voffB[2]; int Rr[2]; unsigned Cc2[2];
#pragma unroll
    for (int i = 0; i < 2; ++i) { int R, C; stage_rc(tid * 16 + i * 8192, R, C); const int Rb = (R & ~31) + perm32(R & 31);
        voffA[i] = (unsigned)(R * K + C) * 2u; voffB[i] = (unsigned)(Rb * K + C) * 2u; Rr[i] = R; Cc2[i] = (unsigned)C * 2u; }
    LAS int* gtab = (LAS int*)(lds + STAGE_BYTES);
    if (GA) { Unit u_; for (int i = 0; S.next(i, u_); ++i) { if (tid < 256) gtab[i * 256 + tid] = S.row_token((S.tile_lo + u_.pm) * 256 + tid); }
        __syncthreads(); }
    unsigned vC[2][2], vN[2][2], vX[2][2];
#define PG8_LOADV(V, UI) do { _Pragma("unroll") for (int h_ = 0; h_ < 2; ++h_) _Pragma("unroll") for (int i_ = 0; i_ < 2; ++i_) \
        V[h_][i_] = (unsigned)gtab[(UI) * 256 + h_ * 128 + Rr[i_]] * (unsigned)(K * 2) + Cc2[i_]; } while (0)
    const size_t kstep = (size_t)(BK * 2);
    const size_t hstep = (size_t)HALF * K * 2;
    const size_t tstep = 2 * hstep;
    const unsigned ldsw = (unsigned)wid * 1024u;
    const int aoff = lds_byte(wr * 64 + fr, fq * 8), boff = lds_byte(wc * 32 + fr, fq * 8);
#define PG8_SA(b, h) (((b) * 2 + (h)) * HTB)
#define PG8_SB(b, h) ((4 + (b) * 2 + (h)) * HTB)
#define PG8_STAGE(bufoff, gbase, voff) do { _Pragma("unroll") for (int _i = 0; _i < 2; ++_i) \
        __builtin_amdgcn_global_load_lds((const unsigned*)((const char*)(gbase) + (voff)[_i]), (LAS unsigned*)(lds + (bufoff) + ldsw + _i * 8192), 16, 0, 0); } while (0)
#define PG8_STAGE_A(bufoff, gbase, H, V) do { _Pragma("unroll") for (int _i = 0; _i < 2; ++_i) \
        __builtin_amdgcn_global_load_lds((const unsigned*)((const char*)(gbase) + (GA ? (size_t)0 : (size_t)(H) * hstep) + (GA ? (V)[H][_i] : voffA[_i])), (LAS unsigned*)(lds + (bufoff) + ldsw + _i * 8192), 16, 0, 0); } while (0)
#define PG8_LDA(dst, b, h) do { _Pragma("unroll") for (int m = 0; m < 4; ++m) _Pragma("unroll") for (int k = 0; k < 2; ++k) dst[m][k] = *(const LAS bf16x8*)(lds + PG8_SA(b, h) + aoff + m * 2048 + k * 1024); } while (0)
#define PG8_LDB(dst, b, h) do { _Pragma("unroll") for (int n = 0; n < 2; ++n) _Pragma("unroll") for (int k = 0; k < 2; ++k) dst[n][k] = *(const LAS bf16x8*)(lds + PG8_SB(b, h) + boff + n * 2048 + k * 1024); } while (0)
#define PG8_MMA(ai, bj, At, Bt) do { __builtin_amdgcn_s_setprio(1); _Pragma("unroll") for (int m = 0; m < 4; ++m) _Pragma("unroll") for (int n = 0; n < 2; ++n) _Pragma("unroll") for (int k = 0; k < 2; ++k) \
        acc[ai][bj][m][n] = __builtin_amdgcn_mfma_f32_16x16x32_bf16(Bt[n][k], At[m][k], acc[ai][bj][m][n], 0, 0, 0); __builtin_amdgcn_s_setprio(0); } while (0)
#define PG8_WAIT_V(n) asm volatile("s_waitcnt vmcnt(" #n ")" ::: "memory")
#define PG8_WAIT_L(n) asm volatile("s_waitcnt lgkmcnt(" #n ")" ::: "memory")
#define PG8_BAR __builtin_amdgcn_s_barrier()
#define PG8_SCHED __builtin_amdgcn_sched_barrier(0)
    Unit cur, nxt; int ui = 0;
    if (!S.next(0, cur)) return;
    f32x4 acc[2][2][4][2];
#pragma unroll
    for (int a = 0; a < 2; ++a)
#pragma unroll
        for (int b = 0; b < 2; ++b)
#pragma unroll
            for (int m = 0; m < 4; ++m)
#pragma unroll
                for (int n = 0; n < 2; ++n) acc[a][b][m][n] = (f32x4){0.f, 0.f, 0.f, 0.f};
    bf16x8 At[4][2], B0[2][2], B1[2][2];
    const char* cA = (const char*)g.A + (GA ? (size_t)0 : (size_t)cur.pm * tstep); const char* cB = (const char*)g.Bt + (size_t)cur.pn * tstep;
    if (GA) { PG8_LOADV(vC, 0); }
    PG8_STAGE(PG8_SB(0, 0), cB, voffB); PG8_STAGE(PG8_SB(0, 1), cB + hstep, voffB); PG8_STAGE_A(PG8_SA(0, 0), cA, 0, vC); PG8_STAGE_A(PG8_SA(0, 1), cA, 1, vC);
    if (wr == 1) PG8_BAR;
    PG8_WAIT_V(2); PG8_BAR;
    PG8_STAGE(PG8_SB(1, 0), cB + kstep, voffB); PG8_STAGE_A(PG8_SA(1, 0), cA + kstep, 0, vC); PG8_STAGE(PG8_SB(1, 1), cB + hstep + kstep, voffB);
    PG8_WAIT_V(6); PG8_BAR;
    for (;;) {
        const bool has_next = S.next(ui + 1, nxt);
        const char* nA = (has_next && !GA) ? (const char*)g.A + (size_t)nxt.pm * tstep : cA; const char* nB = has_next ? (const char*)g.Bt + (size_t)nxt.pn * tstep : cB;
        if (GA) { if (has_next) { PG8_LOADV(vN, ui + 1); } else {
#pragma unroll
            for (int h_ = 0; h_ < 2; ++h_)
#pragma unroll
                for (int i_ = 0; i_ < 2; ++i_) vN[h_][i_] = vC[h_][i_]; } }
        for (int t = 0; t < nt; t += 2) {
            const bool last = (t == nt - 2);
            if (GA) {
#pragma unroll
                for (int h_ = 0; h_ < 2; ++h_)
#pragma unroll
                    for (int i_ = 0; i_ < 2; ++i_) vX[h_][i_] = last ? vN[h_][i_] : vC[h_][i_]; }
            const char* a1 = cA + (size_t)(t + 1) * kstep;
            const char* a2 = last ? nA : cA + (size_t)(t + 2) * kstep; const char* b2 = last ? nB : cB + (size_t)(t + 2) * kstep;
            const char* a3 = a2 + kstep; const char* b3 = b2 + kstep;
            PG8_LDB(B0, 0, 0); PG8_LDB(B1, 0, 1); PG8_SCHED; PG8_LDA(At, 0, 0); PG8_STAGE_A(PG8_SA(1, 1), a1, 1, vC);
            PG8_WAIT_V(8); PG8_WAIT_L(0); PG8_BAR; PG8_MMA(0, 0, At, B0); PG8_MMA(0, 1, At, B1); PG8_BAR; PG8_SCHED;
            PG8_LDA(At, 0, 1); PG8_STAGE(PG8_SB(0, 0), b2, voffB); PG8_STAGE(PG8_SB(0, 1), b2 + hstep, voffB); PG8_STAGE_A(PG8_SA(0, 0), a2, 0, vX);
            PG8_WAIT_V(8); PG8_WAIT_L(0); PG8_BAR; PG8_MMA(1, 0, At, B0); PG8_MMA(1, 1, At, B1); PG8_BAR; PG8_SCHED;
            PG8_LDB(B0, 1, 0); PG8_LDB(B1, 1, 1); PG8_SCHED; PG8_LDA(At, 1, 0); PG8_STAGE_A(PG8_SA(0, 1), a2, 1, vX);
            PG8_WAIT_V(8); PG8_WAIT_L(0); PG8_BAR; PG8_MMA(0, 0, At, B0); PG8_MMA(0, 1, At, B1); PG8_BAR; PG8_SCHED;
            PG8_LDA(At, 1, 1); PG8_STAGE(PG8_SB(1, 0), b3, voffB); PG8_STAGE(PG8_SB(1, 1), b3 + hstep, voffB); PG8_STAGE_A(PG8_SA(1, 0), a3, 0, vX);
            PG8_WAIT_V(8); PG8_WAIT_L(0); PG8_BAR; PG8_MMA(1, 0, At, B0); PG8_MMA(1, 1, At, B1); PG8_BAR; PG8_SCHED;
        }
        if (wr == 0) PG8_BAR;
        E(acc, cur, wr, wc, fr, fq);
        if (!has_next) break;
#pragma unroll
        for (int a = 0; a < 2; ++a)
#pragma unroll
            for (int b = 0; b < 2; ++b)
#pragma unroll
                for (int m = 0; m < 4; ++m)
#pragma unroll
                    for (int n = 0; n < 2; ++n) acc[a][b][m][n] = (f32x4){0.f, 0.f, 0.f, 0.f};
        cur = nxt; cA = nA; cB = nB; ++ui;
        if (GA) {
#pragma unroll
            for (int h_ = 0; h_ < 2; ++h_)
#pragma unroll
                for (int i_ = 0; i_ < 2; ++i_) vC[h_][i_] = vN[h_][i_]; }
        if (wr == 1) PG8_BAR;
    }
    PG8_WAIT_V(0);
    PG8_BAR;
#undef PG8_SA
#undef PG8_SB
#undef PG8_STAGE
#undef PG8_STAGE_A
#undef PG8_LOADV
#undef PG8_LDA
#undef PG8_LDB
#undef PG8_MMA
#undef PG8_WAIT_V
#undef PG8_WAIT_L
#undef PG8_BAR
#undef PG8_SCHED
}
}
using pg8::Unit;
typedef f32x4 acc_t[2][2][4][2];
#define EPI_BEGIN \
    _Pragma("unroll") for (int ai = 0; ai < 2; ++ai) _Pragma("unroll") for (int m = 0; m < 4; ++m) _Pragma("unroll") for (int bj = 0; bj < 2; ++bj) { \
        const int row = u.pm * 256 + ai * 128 + wr * 64 + m * 16 + fr; const int col = u.pn * 256 + bj * 128 + wc * 32 + 8 * fq; \
        const f32x4 v0 = acc[ai][bj][m][0], v1 = acc[ai][bj][m][1];
#define EPI_END if (bj == 1 && (m & 1)) asm volatile("" ::: "memory"); }

template <bool RES_F32>
struct EpiRes {
    const void* res; bf16_t* out;
    __device__ __forceinline__ void operator()(const acc_t& acc, const Unit& u, int wr, int wc, int fr, int fq) const {
        asm volatile("" : "+v"(fr), "+v"(fq));
        constexpr int MB = RES_F32 ? 2 : 4;
#pragma unroll
        for (int ai = 0; ai < 2; ++ai)
#pragma unroll
            for (int mp = 0; mp < 4 / MB; ++mp) {
                f32x4 rf[MB][2][2]; u32x4 rb[MB][2];
#pragma unroll
                for (int mm = 0; mm < MB; ++mm)
#pragma unroll
                    for (int bj = 0; bj < 2; ++bj) { const size_t o = (size_t)(u.pm * 256 + ai * 128 + wr * 64 + (MB * mp + mm) * 16 + fr) * DM + u.pn * 256 + bj * 128 + wc * 32 + 8 * fq;
                        if (RES_F32) { rf[mm][bj][0] = *(const f32x4*)((const float*)res + o); rf[mm][bj][1] = *(const f32x4*)((const float*)res + o + 4); }
                        else rb[mm][bj] = *(const u32x4*)((const bf16_t*)res + o); }
#pragma unroll
                for (int mm = 0; mm < MB; ++mm)
#pragma unroll
                    for (int bj = 0; bj < 2; ++bj) { const int m = MB * mp + mm; const size_t o = (size_t)(u.pm * 256 + ai * 128 + wr * 64 + m * 16 + fr) * DM + u.pn * 256 + bj * 128 + wc * 32 + 8 * fq;
                        f32x4 r0, r1;
                        if (RES_F32) { r0 = rf[mm][bj][0]; r1 = rf[mm][bj][1]; }
                        else { const u32x4 w = rb[mm][bj];
                            r0 = (f32x4){__uint_as_float(w[0] << 16), __uint_as_float(w[0] & 0xffff0000u), __uint_as_float(w[1] << 16), __uint_as_float(w[1] & 0xffff0000u)};
                            r1 = (f32x4){__uint_as_float(w[2] << 16), __uint_as_float(w[2] & 0xffff0000u), __uint_as_float(w[3] << 16), __uint_as_float(w[3] & 0xffff0000u)}; }
                        *(bf16x8*)(out + o) = pack8(r0 * ALPHA + acc[ai][bj][m][0], r1 * ALPHA + acc[ai][bj][m][1]); }
                asm volatile("" ::: "memory");
            }
    }
};
struct EpiHgIn {
    bf16_t* qs; bf16_t* vv; bf16_t* sg; float* lf; const float* lbv;
    __device__ __forceinline__ void operator()(const acc_t& acc, const Unit& u, int wr, int wc, int fr, int fq) const {
        asm volatile("" : "+v"(fr), "+v"(fq));
        const int typ = u.pn >> 2;
        EPI_BEGIN { const int c = col & 1023; const size_t o = (size_t)row * DM + c;
            if (typ == 0) { f32x4 a, b;
#pragma unroll
                for (int e = 0; e < 4; ++e) { a[e] = siluf_(v0[e]); b[e] = siluf_(v1[e]); }
                *(bf16x8*)(qs + o) = pack8(a, b); }
            else if (typ == 1) { const f32x4 l0 = *(const f32x4*)(lbv + c), l1 = *(const f32x4*)(lbv + c + 4); f32x4 a, b;
#pragma unroll
                for (int e = 0; e < 4; ++e) { a[e] = __logf(l0[e] + (1.f - l0[e]) * sigmoidf_(v0[e])); b[e] = __logf(l1[e] + (1.f - l1[e]) * sigmoidf_(v1[e])); }
                *(f32x4*)(lf + o) = a; *(f32x4*)(lf + o + 4) = b; }
            else if (typ == 2) { *(bf16x8*)(vv + o) = pack8(v0, v1); }
            else { f32x4 a, b;
#pragma unroll
                for (int e = 0; e < 4; ++e) { a[e] = sigmoidf_(v0[e]); b[e] = sigmoidf_(v1[e]); }
                *(bf16x8*)(sg + o) = pack8(a, b); } } EPI_END
    }
};
struct EpiSwiglu {
    bf16_t* act; int ldact; int ntile;
    __device__ __forceinline__ void operator()(const acc_t& acc, const Unit& u, int wr, int wc, int fr, int fq) const {
        asm volatile("" : "+v"(fr), "+v"(fq));
        const int pnl = u.pn % ntile;
#pragma unroll
        for (int ai = 0; ai < 2; ++ai)
#pragma unroll
            for (int m = 0; m < 4; ++m) { const int row = u.pm * 256 + ai * 128 + wr * 64 + m * 16 + fr, cl = pnl * 128 + wc * 32 + 8 * fq;
                const f32x4 g0 = acc[ai][0][m][0], g1 = acc[ai][0][m][1], u0 = acc[ai][1][m][0], u1 = acc[ai][1][m][1];
                f32x4 a, b;
#pragma unroll
                for (int e = 0; e < 4; ++e) { a[e] = siluf_(g0[e]) * u0[e]; b[e] = siluf_(g1[e]) * u1[e]; }
                *(bf16x8*)(act + (size_t)row * ldact + cl) = pack8(a, b);
                if (m & 1) asm volatile("" ::: "memory"); }
    }
};
struct EpiMoeDown {
    bf16_t* y;
    __device__ __forceinline__ void operator()(const acc_t& acc, const Unit& u, int wr, int wc, int fr, int fq) const {
        asm volatile("" : "+v"(fr), "+v"(fq));
        const int pnl = u.pn & 3;
        EPI_BEGIN { *(bf16x8*)(y + (size_t)row * DM + pnl * 256 + (col & 255)) = pack8(v0, v1); } EPI_END
    }
};
struct EpiDaIn {
    bf16_t* q; bf16_t* k; bf16_t* v; const f32x2* rope;
    __device__ __forceinline__ void operator()(const acc_t& acc, const Unit& u, int wr, int wc, int fr, int fq) const {
        asm volatile("" : "+v"(fr), "+v"(fq));
        const bool isqk = (u.pn * 256 < 2048);
        if (isqk) {
            const int blk = u.pn * 4 + wc, which = blk >> 4, hb = blk & 15, j0 = 8 * fq;
#pragma unroll
            for (int ai = 0; ai < 2; ++ai)
#pragma unroll
                for (int mp = 0; mp < 2; ++mp) {
                    f32x4 t[2][4];
#pragma unroll
                    for (int mm = 0; mm < 2; ++mm) { const int row = u.pm * 256 + ai * 128 + wr * 64 + (2 * mp + mm) * 16 + fr, pos = row & (SEQ - 1);
#pragma unroll
                        for (int i = 0; i < 4; ++i) t[mm][i] = *(const f32x4*)(rope + (size_t)pos * 32 + j0 + 2 * i); }
#pragma unroll
                    for (int mm = 0; mm < 2; ++mm) { const int m = 2 * mp + mm; const int row = u.pm * 256 + ai * 128 + wr * 64 + m * 16 + fr, b = row >> 13, pos = row & (SEQ - 1);
                        f32x4 y1[2], y2[2];
#pragma unroll
                        for (int h = 0; h < 2; ++h) { const f32x4 x1 = acc[ai][0][m][h], x2 = acc[ai][1][m][h]; const f32x4 ta = t[mm][2 * h], tb = t[mm][2 * h + 1];
                            const float cs[4] = {ta[0], ta[2], tb[0], tb[2]}, sn[4] = {ta[1], ta[3], tb[1], tb[3]};
#pragma unroll
                            for (int e = 0; e < 4; ++e) { y1[h][e] = x1[e] * cs[e] - x2[e] * sn[e]; y2[h][e] = x2[e] * cs[e] + x1[e] * sn[e]; } }
                        bf16_t* dst = (which ? k : q) + (((size_t)b * 8 + (hb >> 1)) * SEQ + pos) * 128 + (hb & 1) * 64 + j0;
                        *(bf16x8*)dst = pack8(y1[0], y1[1]); *(bf16x8*)(dst + 32) = pack8(y2[0], y2[1]); }
                    asm volatile("" ::: "memory");
                }
        } else {
            EPI_BEGIN { const int b = row >> 13, pos = row & (SEQ - 1), h = (col - 2048) >> 7, d = col & 127;
                *(bf16x8*)(v + (((size_t)b * 8 + h) * SEQ + pos) * 128 + d) = pack8(v0, v1); } EPI_END
        }
    }
};
struct EpiNsaIn {
    bf16_t* q; bf16_t* qr; bf16_t* kv; float* gates; const f32x2* rope;
    __device__ __forceinline__ void operator()(const acc_t& acc, const Unit& u, int wr, int wc, int fr, int fq) const {
        asm volatile("" : "+v"(fr), "+v"(fq));
        const bool isrope = (u.pn < 10);
        if (isrope) {
            const int blk = u.pn * 2 + (wc >> 1), j0 = 32 * (wc & 1) + 8 * fq;
            const int jj = (blk - 8) >> 1, g = (blk - 8) & 1; const bool rot = (jj == 2) || (jj == 4);
#pragma unroll
            for (int ai = 0; ai < 2; ++ai)
#pragma unroll
                for (int mp = 0; mp < 2; ++mp) {
                    f32x4 t[2][4];
#pragma unroll
                    for (int mm = 0; mm < 2; ++mm) { const int row = u.pm * 256 + ai * 128 + wr * 64 + (2 * mp + mm) * 16 + fr, pos = row & (SEQ - 1);
#pragma unroll
                        for (int i = 0; i < 4; ++i) t[mm][i] = *(const f32x4*)(rope + (size_t)pos * 64 + j0 + 2 * i); }
#pragma unroll
                    for (int mm = 0; mm < 2; ++mm) { const int m = 2 * mp + mm; const int row = u.pm * 256 + ai * 128 + wr * 64 + m * 16 + fr, b = row >> 13, pos = row & (SEQ - 1);
                        f32x4 y1[2], y2[2];
#pragma unroll
                        for (int h = 0; h < 2; ++h) { const f32x4 x1 = acc[ai][0][m][h], x2 = acc[ai][1][m][h]; const f32x4 ta = t[mm][2 * h], tb = t[mm][2 * h + 1];
                            const float cs[4] = {ta[0], ta[2], tb[0], tb[2]}, sn[4] = {ta[1], ta[3], tb[1], tb[3]};
#pragma unroll
                            for (int e = 0; e < 4; ++e) { y1[h][e] = x1[e] * cs[e] - x2[e] * sn[e]; y2[h][e] = x2[e] * cs[e] + x1[e] * sn[e]; } }
                        const bf16x8 p1 = pack8(acc[ai][0][m][0], acc[ai][0][m][1]), p2 = pack8(acc[ai][1][m][0], acc[ai][1][m][1]);
                        const bf16x8 r1 = pack8(y1[0], y1[1]), r2 = pack8(y2[0], y2[1]);
                        if (blk < 8) { const size_t o = (((size_t)b * 8 + blk) * SEQ + pos) * 128 + j0;
                            *(bf16x8*)(q + o) = p1; *(bf16x8*)(q + o + 64) = p2; *(bf16x8*)(qr + o) = r1; *(bf16x8*)(qr + o + 64) = r2; }
                        else { const size_t o = (((size_t)jj * 8 + b * 2 + g) * SEQ + pos) * 128 + j0;
                            *(bf16x8*)(kv + o) = rot ? r1 : p1; *(bf16x8*)(kv + o + 64) = rot ? r2 : p2; } }
                    asm volatile("" ::: "memory");
                }
        } else {
            EPI_BEGIN { const int gi = col - 2560;
                if (gi < 24) { f32x4 a, bb;
#pragma unroll
                    for (int e = 0; e < 4; ++e) { a[e] = sigmoidf_(v0[e]); bb[e] = sigmoidf_(v1[e]); }
                    *(f32x4*)(gates + (size_t)row * 24 + gi) = a; *(f32x4*)(gates + (size_t)row * 24 + gi + 4) = bb; } } EPI_END
        }
    }
};
struct EpiSbIn {
    bf16_t* qkv;
    __device__ __forceinline__ void operator()(const acc_t& acc, const Unit& u, int wr, int wc, int fr, int fq) const {
        asm volatile("" : "+v"(fr), "+v"(fq));
        EPI_BEGIN { const int b = row >> 13, pos = row & (SEQ - 1), which = col >> 10, h = (col >> 7) & 7, d = col & 127;
            *(bf16x8*)(qkv + (size_t)which * NT * DM + (((size_t)b * 8 + h) * SEQ + pos) * 128 + d) = pack8(v0, v1); } EPI_END
    }
};
using pg8::NXCD; using pg8::WGM;
template <bool GATHER_>
struct MoeOrderT {
    static constexpr bool GATHER = GATHER_;
    int G, c, tile_lo, nT, nNt; int seg_tile[8]; const int* tok; int imax = 0x7fffffff;
    __device__ __forceinline__ int row_token(int r) const { return tok[r]; }
    __device__ __forceinline__ bool next(int i, Unit& u) const { return i < imax && at((long)i * G + c, u); }
    __device__ __forceinline__ bool at(long L, Unit& u) const {
        const int nwg = nT * nNt;
        if (nT <= 0 || L >= (long)nwg) return false;
        int wgid = (int)L; { const int q = nwg / NXCD, r = nwg % NXCD, xcd = wgid % NXCD, off = wgid / NXCD; wgid = (xcd < r ? xcd * (q + 1) : r * (q + 1) + (xcd - r) * q) + off; }
        const int nig = WGM * nNt, gid = wgid / nig, fm = gid * WGM, gsz = (nT - fm) < WGM ? (nT - fm) : WGM;
        const int pml = fm + ((wgid % nig) % gsz), pn = (wgid % nig) / gsz, tile = tile_lo + pml;
        int e = 0;
#pragma unroll
        for (int k = 1; k < 8; ++k) e += (tile >= seg_tile[k]) ? 1 : 0;
        u.pm = pml; u.pn = e * nNt + pn; return true;
    }
};

struct MapId { const float* src; int ld, nsrc; __device__ __forceinline__ const float* operator()(int n) const { return n < nsrc ? src + n : nullptr; }
    __device__ __forceinline__ MapId shifted(size_t off) const { return MapId{src + off, ld, nsrc}; } };
struct MapRope64 { const float* src; int ld; __device__ __forceinline__ const float* operator()(int n) const {
    if (n >= 2048) return src + n; const int l = n & 255; return src + (n & ~255) + 64 * ((l >> 5) & 3) + 32 * (l >> 7) + (l & 31); }
    __device__ __forceinline__ MapRope64 shifted(size_t off) const { return MapRope64{src + off, ld}; } };
struct MapNsa { const float* src; int ld; __device__ __forceinline__ const float* operator()(int n) const {
    if (n >= 2584) return nullptr; if (n >= 2560) return src + n; const int l = n & 255, wc = (l >> 5) & 3; return src + (n & ~255) + 128 * (wc >> 1) + 64 * (l >> 7) + 32 * (wc & 1) + (l & 31); }
    __device__ __forceinline__ MapNsa shifted(size_t off) const { return MapNsa{src + off, ld}; } };
struct MapGU { const float* gate; const float* up; int ld; __device__ __forceinline__ const float* operator()(int n) const {
    const int u = n >> 8, c = n & 255; return c < 128 ? gate + 128 * u + c : up + 128 * u + (c - 128); }
    __device__ __forceinline__ MapGU shifted(size_t off) const { return MapGU{gate + off, up + off, ld}; } };
template <class Map>
__device__ __forceinline__ void convert_T(ldsp_t lds, bf16_t* dst, int nb, size_t src_bstride, int Ndst, int K, const Map map0, int wg, int nwg) {
    const int tid = my_tid(), ntn = Ndst >> 6, per = ntn * (K >> 6), ntiles = per * nb;
    LAS bf16_t* tl = (LAS bf16_t*)lds;
    const int ln = tid & 63, lk = tid >> 6, sn = tid >> 3, skc = (tid & 7) * 8;
    float va[8], vb[8];
#define CT_LOAD(V, TILE) do { const int bi_ = (TILE) / per, tt_ = (TILE) % per, n0_ = (tt_ % ntn) << 6, k0_ = (tt_ / ntn) << 6; \
        const Map m_ = map0.shifted((size_t)bi_ * src_bstride); const float* cp_ = m_(n0_ + ln); \
        _Pragma("unroll") for (int it = 0; it < 8; ++it) V[it] = cp_ ? __builtin_nontemporal_load(cp_ + (size_t)(k0_ + lk + 8 * it) * m_.ld) : 0.f; } while (0)
    float vc[8], vd[8];
    int tile = wg, buf = 0;
    if (tile < ntiles) CT_LOAD(va, tile);
    if (tile + nwg < ntiles) CT_LOAD(vb, tile + nwg);
    if (tile + 2 * nwg < ntiles) CT_LOAD(vc, tile + 2 * nwg);
#define CT_STEP(VCUR, VNEW) do { if (tile < ntiles) { \
        if (tile + 3 * nwg < ntiles) CT_LOAD(VNEW, tile + 3 * nwg); \
        LAS bf16_t* tb = tl + buf * (64 * 66); \
        _Pragma("unroll") for (int it = 0; it < 8; ++it) tb[ln * 66 + lk + 8 * it] = f2bf(VCUR[it]); \
        __syncthreads(); \
        { const int bi = tile / per, tt = tile % per, n0 = (tt % ntn) << 6, k0 = (tt / ntn) << 6; \
          const LAS unsigned* rp = (const LAS unsigned*)(tb + sn * 66 + skc); \
          const u32x4 w = {rp[0], rp[1], rp[2], rp[3]}; \
          *(u32x4*)(dst + ((size_t)bi * Ndst + n0 + sn) * K + k0 + skc) = w; } \
        tile += nwg; buf ^= 1; } } while (0)
    while (tile < ntiles) { CT_STEP(va, vd); CT_STEP(vb, va); CT_STEP(vc, vb); CT_STEP(vd, vc); }
#undef CT_STEP
    __syncthreads();
#undef CT_LOAD
}

struct Route { int e0, e1, p0, p1; float g0, g1; int pad0, pad1; };
__device__ __forceinline__ void moe_segments_lds(const unsigned* cnt, LAS int* segL) {
    if (threadIdx.x == 0) { int s = 0;
        for (int e = 0; e < 8; ++e) { segL[e] = s; s += (int)((cnt[e] + 255u) & ~255u); }
        segL[8] = s; }
    __syncthreads();
}
__device__ __forceinline__ void ln_phase(ldsp_t lds, const bf16_t* src, float* dst_f32, bf16_t* dst_bf16, const float* lng, const float* lnb,
                                         const Route* route_in, const bf16_t* ybuf, const unsigned* cnt_in,
                                         const float* wrouter, Route* route_out, unsigned* cnt_out, int wg, int nwg) {
    const int tid = my_tid(), wid = tid >> 6, lane = tid & 63;
    LAS float* wl = (LAS float*)lds;
    LAS int* rinfo = (LAS int*)(lds + 32768);
    LAS unsigned* cntL = (LAS unsigned*)(lds + 32768 + 4096);
    LAS int* seg_start = (LAS int*)(lds + 32768 + 4096 + 256);
    if (route_in) moe_segments_lds(cnt_in, seg_start);
    if (wrouter) { for (int i = tid; i < 8192; i += 512) { const int d = i >> 3, e = i & 7; wl[e * 1024 + d] = wrouter[i]; } }
    f32x4 gv[4], bv[4];
#pragma unroll
    for (int q = 0; q < 4; ++q) { gv[q] = *(const f32x4*)(lng + 4 * lane + 256 * q); bv[q] = *(const f32x4*)(lnb + 4 * lane + 256 * q); }
    for (int chunk = wg; chunk < NT / 128; chunk += nwg) {
        if (wrouter) { if (tid < 8) cntL[tid] = 0u; }
        __syncthreads();
        u32x2 zn[4], yan[4], ybn[4]; Route rn; rn.e0 = 0; rn.e1 = 0; rn.p0 = 0; rn.p1 = 0; rn.g0 = 0.f; rn.g1 = 0.f; rn.pad0 = 0; rn.pad1 = 0;
#define LN_LOAD(ROW) do { _Pragma("unroll") for (int q = 0; q < 4; ++q) zn[q] = *(const u32x2*)(src + (size_t)(ROW) * DM + 4 * lane + 256 * q); \
            if (route_in) { rn = route_in[(ROW)]; const size_t s0_ = (size_t)(seg_start[rn.e0] + rn.p0) * DM, s1_ = (size_t)(seg_start[rn.e1] + rn.p1) * DM; \
                _Pragma("unroll") for (int q = 0; q < 4; ++q) { yan[q] = *(const u32x2*)(ybuf + s0_ + 4 * lane + 256 * q); ybn[q] = *(const u32x2*)(ybuf + s1_ + 4 * lane + 256 * q); } } } while (0)
        LN_LOAD(chunk * 128 + wid * 16);
        for (int i = 0; i < 16; ++i) {
            const int rl = wid * 16 + i, row = chunk * 128 + rl;
            f32x4 z[4]; u32x2 ya[4], yb[4]; const Route r = rn;
#pragma unroll
            for (int q = 0; q < 4; ++q) { const u32x2 w = zn[q]; ya[q] = yan[q]; yb[q] = ybn[q];
                z[q] = (f32x4){__uint_as_float(w[0] << 16), __uint_as_float(w[0] & 0xffff0000u), __uint_as_float(w[1] << 16), __uint_as_float(w[1] & 0xffff0000u)}; }
            if (i + 1 < 16) LN_LOAD(row + 1);
            if (route_in) {
#pragma unroll
                for (int q = 0; q < 4; ++q) { const u32x2 a = ya[q], b = yb[q];
                    z[q][0] = z[q][0] * ALPHA + r.g0 * __uint_as_float(a[0] << 16) + r.g1 * __uint_as_float(b[0] << 16);
                    z[q][1] = z[q][1] * ALPHA + r.g0 * __uint_as_float(a[0] & 0xffff0000u) + r.g1 * __uint_as_float(b[0] & 0xffff0000u);
                    z[q][2] = z[q][2] * ALPHA + r.g0 * __uint_as_float(a[1] << 16) + r.g1 * __uint_as_float(b[1] << 16);
                    z[q][3] = z[q][3] * ALPHA + r.g0 * __uint_as_float(a[1] & 0xffff0000u) + r.g1 * __uint_as_float(b[1] & 0xffff0000u); }
            }
            float s = 0.f;
#pragma unroll
            for (int q = 0; q < 4; ++q) s += (z[q][0] + z[q][1]) + (z[q][2] + z[q][3]);
            const float mean = wave_sum(s) * (1.f / DM);
            float v = 0.f;
#pragma unroll
            for (int q = 0; q < 4; ++q) { z[q] = z[q] - mean; v += (z[q][0] * z[q][0] + z[q][1] * z[q][1]) + (z[q][2] * z[q][2] + z[q][3] * z[q][3]); }
            const float rstd = rsqrtf(wave_sum(v) * (1.f / DM) + LN_EPS);
#pragma unroll
            for (int q = 0; q < 4; ++q) { z[q] = z[q] * rstd * gv[q] + bv[q]; if (dst_f32) *(f32x4*)(dst_f32 + (size_t)row * DM + 4 * lane + 256 * q) = z[q]; }
            if (dst_bf16) {
#pragma unroll
                for (int q = 0; q < 4; ++q) *(u32x2*)(dst_bf16 + (size_t)row * DM + 4 * lane + 256 * q) = (u32x2){cvtpk(z[q][0], z[q][1]), cvtpk(z[q][2], z[q][3])};
            }
            if (wrouter) {
                float lg[8];
#pragma unroll
                for (int e = 0; e < 8; ++e) { float a = 0.f;
#pragma unroll
                    for (int q = 0; q < 4; ++q) { const f32x4 w = *(const LAS f32x4*)(wl + e * 1024 + 4 * lane + 256 * q); a += z[q][0] * w[0] + z[q][1] * w[1] + z[q][2] * w[2] + z[q][3] * w[3]; }
                    lg[e] = wave_sum(a); }
                int e0 = 0; float v0 = lg[0];
#pragma unroll
                for (int e = 1; e < 8; ++e) if (lg[e] > v0) { v0 = lg[e]; e0 = e; }
                int e1 = -1; float v1 = -3.0e38f;
#pragma unroll
                for (int e = 0; e < 8; ++e) if (e != e0 && lg[e] > v1) { v1 = lg[e]; e1 = e; }
                if (e1 < 0) { e1 = (e0 + 1) & 7; v1 = v0; }
                if (lane == 0) {
                    const float g1 = 1.f / (1.f + __expf(v0 - v1)), g0 = 1.f - g1;
                    const int p0 = (int)atomicAdd((unsigned*)(cntL + e0), 1u), p1 = (int)atomicAdd((unsigned*)(cntL + e1), 1u);
                    rinfo[rl * 6 + 0] = e0; rinfo[rl * 6 + 1] = e1; rinfo[rl * 6 + 2] = p0; rinfo[rl * 6 + 3] = p1;
                    rinfo[rl * 6 + 4] = __float_as_int(g0); rinfo[rl * 6 + 5] = __float_as_int(g1);
                }
            }
        }
        if (wrouter) {
            __syncthreads();
            if (tid < 8) cntL[8 + tid] = atomicAdd(cnt_out + tid, cntL[tid]);
            __syncthreads();
            if (tid < 128) { Route r; r.e0 = rinfo[tid * 6 + 0]; r.e1 = rinfo[tid * 6 + 1];
                r.p0 = rinfo[tid * 6 + 2] + (int)cntL[8 + r.e0]; r.p1 = rinfo[tid * 6 + 3] + (int)cntL[8 + r.e1];
                r.g0 = __int_as_float(rinfo[tid * 6 + 4]); r.g1 = __int_as_float(rinfo[tid * 6 + 5]); r.pad0 = 0; r.pad1 = 0;
                route_out[chunk * 128 + tid] = r; }
            __syncthreads();
        }
    }
}
#undef LN_LOAD
__device__ __forceinline__ void moe_build_table(ldsp_t lds, int* tab, const Route* route, const unsigned* cnt, int wg, int nwg) {
    const int tid = my_tid();
    LAS int* seg_start = (LAS int*)lds; moe_segments_lds(cnt, seg_start);
    for (int t = wg * 512 + tid; t < NT; t += nwg * 512) { const Route r = route[t]; tab[seg_start[r.e0] + r.p0] = t; tab[seg_start[r.e1] + r.p1] = t; }
    for (int i = wg * 512 + tid; i < 8 * 256; i += nwg * 512) { const int e = i >> 8, k = i & 255; const int c = (int)cnt[e], pad = (c + 255) & ~255;
        if (c + k < pad) tab[seg_start[e] + c + k] = 0; }
    __syncthreads();
}

constexpr int HG_P144 = 144, HG_P272 = 272;
__device__ __forceinline__ void hgrn_passA(ldsp_t lds, const float* lf, const bf16_t* vv, bf16_t* ST, float* dec, int wg, int nwg) {
    const int tid = my_tid(), wid = tid >> 6, lane = tid & 63, r32 = lane & 31, hi = lane >> 5;
    const int d = tid & 127, sq = tid >> 7;
    ldsp_t KhT = lds, VT = lds + 128 * HG_P144; LAS float* tot = (LAS float*)(lds + 2 * 128 * HG_P144);
    float lfn[16]; bf16_t vnx[16];
#define HA_LOAD(IT) do { const int bh_ = (IT) >> 7, c_ = (IT) & 127, b_ = bh_ >> 3, h_ = bh_ & 7; const size_t t0_ = (size_t)b_ * SEQ + c_ * 64; \
        _Pragma("unroll") for (int tt = 0; tt < 16; ++tt) { const size_t o_ = (t0_ + 16 * sq + tt) * DM + h_ * 128 + d; lfn[tt] = lf[o_]; vnx[tt] = vv[o_]; } } while (0)
    if (wg < 4096) HA_LOAD(wg);
    for (int it = wg; it < 4096; it += nwg) {
        const int bh = it >> 7, c = it & 127, b = bh >> 3, h = bh & 7;
        const size_t tok0 = (size_t)b * SEQ + c * 64; (void)tok0; (void)b; (void)h;
        float lfv[16], cs[16]; bf16_t vraw[16];
#pragma unroll
        for (int tt = 0; tt < 16; ++tt) { lfv[tt] = lfn[tt]; vraw[tt] = vnx[tt]; }
        if (it + nwg < 4096) HA_LOAD(it + nwg);
        float run = 0.f;
#pragma unroll
        for (int tt = 0; tt < 16; ++tt) { run += lfv[tt]; cs[tt] = run; }
        tot[sq * 128 + d] = run;
        __syncthreads();
        float off = 0.f, cl = 0.f;
#pragma unroll
        for (int q = 0; q < 4; ++q) { const float t = tot[q * 128 + d]; cl += t; off += (q < sq) ? t : 0.f; }
        if (sq == 0) dec[(size_t)it * 128 + d] = __expf(cl);
        { unsigned w[8];
#pragma unroll
          for (int p = 0; p < 8; ++p) { const float c0 = off + cs[2 * p], c1 = off + cs[2 * p + 1];
              w[p] = cvtpk((1.f - __expf(lfv[2 * p])) * __expf(cl - c0), (1.f - __expf(lfv[2 * p + 1])) * __expf(cl - c1)); }
          *(LAS u32x4*)(KhT + d * HG_P144 + sq * 32) = (u32x4){w[0], w[1], w[2], w[3]};
          *(LAS u32x4*)(KhT + d * HG_P144 + sq * 32 + 16) = (u32x4){w[4], w[5], w[6], w[7]};
          unsigned x[8];
#pragma unroll
          for (int p = 0; p < 8; ++p) x[p] = (unsigned)vraw[2 * p] | ((unsigned)vraw[2 * p + 1] << 16);
          *(LAS u32x4*)(VT + d * HG_P144 + sq * 32) = (u32x4){x[0], x[1], x[2], x[3]};
          *(LAS u32x4*)(VT + d * HG_P144 + sq * 32 + 16) = (u32x4){x[4], x[5], x[6], x[7]}; }
        __syncthreads();
        const int mt = wid >> 1;
#pragma unroll
        for (int nn = 0; nn < 2; ++nn) { const int nt = (wid & 1) * 2 + nn; f32x16 acc = {};
#pragma unroll
            for (int ks = 0; ks < 4; ++ks) {
                const bf16x8 a = *(const LAS bf16x8*)(VT + (32 * mt + r32) * HG_P144 + (16 * ks + 8 * hi) * 2);
                const bf16x8 bb = *(const LAS bf16x8*)(KhT + (32 * nt + r32) * HG_P144 + (16 * ks + 8 * hi) * 2);
                acc = __builtin_amdgcn_mfma_f32_32x32x16_bf16(a, bb, acc, 0, 0, 0); }
#pragma unroll
            for (int r = 0; r < 16; ++r) { const int v = 32 * mt + (r & 3) + 8 * (r >> 2) + 4 * hi;
                ST[((size_t)it * 128 + v) * 128 + 32 * nt + r32] = f2bf(acc[r]); } }
        __syncthreads();
    }
}
#undef HA_LOAD
__device__ __forceinline__ void hgrn_passB(bf16_t* ST, const float* dec, int wg, int nwg) {
    for (int eg = wg * 512 + my_tid(); eg < 32 * 4096; eg += nwg * 512) {
        const int bh = eg >> 12, w = eg & 4095, v = w >> 5, d4 = (w & 31) * 4;
        float st[4] = {0.f, 0.f, 0.f, 0.f};
        for (int c0 = 0; c0 < 128; c0 += 8) {
            u32x2 kvr[8]; f32x4 dc[8];
#pragma unroll
            for (int j = 0; j < 8; ++j) { const size_t it = (size_t)bh * 128 + c0 + j;
                kvr[j] = *(const u32x2*)(ST + (it * 128 + v) * 128 + d4); dc[j] = *(const f32x4*)(dec + it * 128 + d4); }
#pragma unroll
            for (int j = 0; j < 8; ++j) { const size_t it = (size_t)bh * 128 + c0 + j;
                *(u32x2*)(ST + (it * 128 + v) * 128 + d4) = (u32x2){cvtpk(st[0], st[1]), cvtpk(st[2], st[3])};
                st[0] = dc[j][0] * st[0] + __uint_as_float(kvr[j][0] << 16); st[1] = dc[j][1] * st[1] + __uint_as_float(kvr[j][0] & 0xffff0000u);
                st[2] = dc[j][2] * st[2] + __uint_as_float(kvr[j][1] << 16); st[3] = dc[j][3] * st[3] + __uint_as_float(kvr[j][1] & 0xffff0000u); }
        }
    }
}
__device__ __forceinline__ void hgrn_passC(ldsp_t lds, const bf16_t* qs, const float* lf, const bf16_t* vv, const bf16_t* sg, const bf16_t* ST, const float* normg, bf16_t* ob, int wg, int nwg) {
    const int tid = my_tid(), wid = tid >> 6, lane = tid & 63, c16 = lane & 15, g = lane >> 4;
    const int d = tid & 127, sq = tid >> 7;
    ldsp_t Qi = lds, Qc = lds + 17408, Kt = lds + 2 * 17408, VT = lds + 2 * 17408 + 43520, STl = VT + 18432;
    LAS float* refs = (LAS float*)(STl + 34816); LAS float* tot = refs + 512; LAS float* ssq = tot + 512;
    float lfn[16]; bf16_t qn[16], vn[16]; u32x4 stn[4];
#define HC_LOAD(IT) do { const int bh_ = (IT) >> 7, c_ = (IT) & 127, b_ = bh_ >> 3, h_ = bh_ & 7; const size_t t0_ = (size_t)b_ * SEQ + c_ * 64; \
        _Pragma("unroll") for (int tt = 0; tt < 16; ++tt) { const size_t o_ = (t0_ + 16 * sq + tt) * DM + h_ * 128 + d; lfn[tt] = lf[o_]; qn[tt] = qs[o_]; vn[tt] = vv[o_]; } \
        _Pragma("unroll") for (int i4 = 0; i4 < 4; ++i4) { const int p = tid + 512 * i4, v = p >> 4, ch = p & 15; stn[i4] = *(const u32x4*)(ST + ((size_t)(IT) * 128 + v) * 128 + ch * 8); } } while (0)
    if (wg < 4096) HC_LOAD(wg);
    for (int it = wg; it < 4096; it += nwg) {
        const int bh = it >> 7, c = it & 127, b = bh >> 3, h = bh & 7;
        const size_t tok0 = (size_t)b * SEQ + c * 64;
        float lfv[16], cum[16]; bf16_t qraw[16], vraw[16];
#pragma unroll
        for (int tt = 0; tt < 16; ++tt) { lfv[tt] = lfn[tt]; qraw[tt] = qn[tt]; vraw[tt] = vn[tt]; }
        float run = 0.f;
#pragma unroll
        for (int tt = 0; tt < 16; ++tt) { run += lfv[tt]; cum[tt] = run; }
        tot[sq * 128 + d] = run;
#pragma unroll
        for (int i4 = 0; i4 < 4; ++i4) { const int p = tid + 512 * i4, v = p >> 4, ch = p & 15;
            *(LAS u32x4*)(STl + v * HG_P272 + ch * 16) = stn[i4]; }
        { unsigned x[8];
#pragma unroll
          for (int p = 0; p < 8; ++p) x[p] = (unsigned)vraw[2 * p] | ((unsigned)vraw[2 * p + 1] << 16);
          *(LAS u32x4*)(VT + d * HG_P144 + sq * 32) = (u32x4){x[0], x[1], x[2], x[3]};
          *(LAS u32x4*)(VT + d * HG_P144 + sq * 32 + 16) = (u32x4){x[4], x[5], x[6], x[7]}; }
        if (it + nwg < 4096) HC_LOAD(it + nwg);
        __syncthreads();
        float off = 0.f;
#pragma unroll
        for (int q = 0; q < 4; ++q) { const float t = tot[q * 128 + d]; off += (q < sq) ? t : 0.f; }
#pragma unroll
        for (int tt = 0; tt < 16; ++tt) cum[tt] += off;
        refs[sq * 128 + d] = cum[0];
        __syncthreads();
        float rf[4];
#pragma unroll
        for (int i = 0; i < 4; ++i) rf[i] = refs[i * 128 + d];
        float rme = rf[0];
#pragma unroll
        for (int i = 1; i < 4; ++i) rme = (sq == i) ? rf[i] : rme;
#pragma unroll
        for (int tt = 0; tt < 16; ++tt) { const int t = 16 * sq + tt; const float qv = bf2f(qraw[tt]);
            *(LAS bf16_t*)(Qi + t * HG_P272 + d * 2) = f2bf(qv * __expf(cum[tt] - rme));
            *(LAS bf16_t*)(Qc + t * HG_P272 + d * 2) = f2bf(qv * __expf(cum[tt]));
            const float kvv = 1.f - __expf(lfv[tt]);
#pragma unroll
            for (int i = 0; i < 4; ++i) { const int rb = (i == 0) ? 0 : (i == 1) ? 16 : (i == 2) ? 48 : 96;
                if (i >= sq) *(LAS bf16_t*)(Kt + (rb + t) * HG_P272 + d * 2) = f2bf(kvv * __expf(rf[i] - cum[tt])); } }
        __syncthreads();
        const int ib = wid >> 1, vh = wid & 1;
        const int rbI = (ib == 0) ? 0 : (ib == 1) ? 16 : (ib == 2) ? 48 : 96;
        f32x4 sc[4];
#pragma unroll
        for (int a = 0; a < 4; ++a) { sc[a] = (f32x4){0.f, 0.f, 0.f, 0.f};
            if (a <= ib) {
#pragma unroll
                for (int ks = 0; ks < 4; ++ks) {
                    const bf16x8 A = *(const LAS bf16x8*)(Kt + (rbI + 16 * a + c16) * HG_P272 + (32 * ks + 8 * g) * 2);
                    const bf16x8 B = *(const LAS bf16x8*)(Qi + (16 * ib + c16) * HG_P272 + (32 * ks + 8 * g) * 2);
                    sc[a] = __builtin_amdgcn_mfma_f32_16x16x32_bf16(A, B, sc[a], 0, 0, 0); }
                if (a == ib) {
#pragma unroll
                    for (int r = 0; r < 4; ++r) if (4 * g + r > c16) sc[a][r] = 0.f; } } }
        bf16x8 pb[2];
#pragma unroll
        for (int p = 0; p < 2; ++p) { const u32x4 w = {cvtpk(sc[2 * p][0], sc[2 * p][1]), cvtpk(sc[2 * p][2], sc[2 * p][3]), cvtpk(sc[2 * p + 1][0], sc[2 * p + 1][1]), cvtpk(sc[2 * p + 1][2], sc[2 * p + 1][3])};
            pb[p] = *reinterpret_cast<const bf16x8*>(&w); }
        f32x4 ao[4]; float ssl = 0.f;
#pragma unroll
        for (int vt = 0; vt < 4; ++vt) { ao[vt] = (f32x4){0.f, 0.f, 0.f, 0.f}; const int vrow = 16 * (4 * vh + vt) + c16;
#pragma unroll
            for (int p = 0; p < 2; ++p) if (2 * p <= ib) {
                const u32x2 lo = *(const LAS u32x2*)(VT + vrow * HG_P144 + (32 * p + 4 * g) * 2), hi2 = *(const LAS u32x2*)(VT + vrow * HG_P144 + (32 * p + 16 + 4 * g) * 2);
                const u32x4 w = {lo[0], lo[1], hi2[0], hi2[1]};
                ao[vt] = __builtin_amdgcn_mfma_f32_16x16x32_bf16(*reinterpret_cast<const bf16x8*>(&w), pb[p], ao[vt], 0, 0, 0); }
#pragma unroll
            for (int ks = 0; ks < 4; ++ks) {
                const bf16x8 A = *(const LAS bf16x8*)(STl + vrow * HG_P272 + (32 * ks + 8 * g) * 2);
                const bf16x8 B = *(const LAS bf16x8*)(Qc + (16 * ib + c16) * HG_P272 + (32 * ks + 8 * g) * 2);
                ao[vt] = __builtin_amdgcn_mfma_f32_16x16x32_bf16(A, B, ao[vt], 0, 0, 0); }
            ssl += ao[vt][0] * ao[vt][0] + ao[vt][1] * ao[vt][1] + ao[vt][2] * ao[vt][2] + ao[vt][3] * ao[vt][3]; }
        ssl = sum_halves32(sum_rows16(ssl));
        if (g == 0) ssq[vh * 64 + 16 * ib + c16] = ssl;
        __syncthreads();
        const float rs = rsqrtf((ssq[16 * ib + c16] + ssq[64 + 16 * ib + c16]) * (1.f / 128.f) + LN_EPS);
        const size_t trow = (tok0 + 16 * ib + c16) * DM + h * 128;
#pragma unroll
        for (int vt = 0; vt < 4; ++vt) { const int v0 = 16 * (4 * vh + vt) + 4 * g;
            const f32x4 ng = *(const f32x4*)(normg + v0); const u32x2 sgr = *(const u32x2*)(sg + trow + v0);
            const float o0 = ao[vt][0] * rs * ng[0] * __uint_as_float(sgr[0] << 16), o1 = ao[vt][1] * rs * ng[1] * __uint_as_float(sgr[0] & 0xffff0000u);
            const float o2 = ao[vt][2] * rs * ng[2] * __uint_as_float(sgr[1] << 16), o3 = ao[vt][3] * rs * ng[3] * __uint_as_float(sgr[1] & 0xffff0000u);
            *(u32x2*)(ob + trow + v0) = (u32x2){cvtpk(o0, o1), cvtpk(o2, o3)}; }
        __syncthreads();
    }
}

#undef HC_LOAD
#define KSWZ(row, colB) ((row) * 256 + ((colB) ^ (((row) & 7) << 4)))
__device__ __forceinline__ int q_park(int wid) { return wid < 4 ? 2 * 32768 + wid * 8192 : 3 * 32768 + 2048 + (wid - 4) * 8192; }
constexpr int AT_V = 0, AT_K = 16384, AT_BUF = 32768, AT_WS = 3 * 32768, AT_END = 3 * 32768 + 8 * 64 * 4;
__device__ __forceinline__ int v_st(int k, int c) { const int kk = (k & ~0xC) | ((k & 4) << 1) | ((k & 8) >> 1); return ((kk >> 3) * 4 + (c >> 5)) * 512 + ((kk & 7) * 32 + (c & 31)) * 2; }
__device__ __forceinline__ int v_rd_base(int lane) { return ((lane & 3) << 3) | (((lane >> 2) & 3) << 6) | (((lane >> 4) & 1) << 5) | (((lane >> 5) & 1) << 8); }
constexpr int v_rd_off(int d0, int ks, int half) { return d0 * 512 + ks * 4096 + half * 2048; }
__device__ __forceinline__ int crow(int r, int hi) { return (r & 3) + 8 * (r >> 2) + 4 * hi; }
template <int D0_LO, int D0_HI>
__device__ __forceinline__ void qkt_range(f32x16& p0, f32x16& p1, ldsp_t Kt, int r32, int hi, const bf16x8* qr) {
    p0 = f32x16{}; p1 = f32x16{};
    ldsp_t kb[4];
#pragma unroll
    for (int dd = 0; dd < 4; ++dd) kb[dd] = Kt + KSWZ(r32, (dd * 16 + hi * 8) * 2);
#pragma unroll
    for (int d0 = D0_LO; d0 < D0_HI; ++d0) {
        ldsp_t a = kb[d0 & 3] + (d0 >> 2) * 128;
        const bf16x8 b0 = *(const LAS bf16x8*)(a);
        const bf16x8 b1 = *(const LAS bf16x8*)(a + 32 * 256);
        p0 = __builtin_amdgcn_mfma_f32_32x32x16_bf16(b0, qr[d0], p0, 0, 0, 0);
        p1 = __builtin_amdgcn_mfma_f32_32x32x16_bf16(b1, qr[d0], p1, 0, 0, 0); }
}
template <int D0_LO, int D0_HI>
__device__ __forceinline__ void qkt_range_lq(f32x16& p0, f32x16& p1, ldsp_t Kt, ldsp_t Qw, int r32, int hi) {
    p0 = f32x16{}; p1 = f32x16{};
    int ko[4];
#pragma unroll
    for (int dd = 0; dd < 4; ++dd) ko[dd] = KSWZ(r32, (dd * 16 + hi * 8) * 2);
#pragma unroll
    for (int d0 = D0_LO; d0 < D0_HI; ++d0) {
        const int off = ko[d0 & 3] + (d0 >> 2) * 128;
        const bf16x8 b0 = *(const LAS bf16x8*)(Kt + off);
        const bf16x8 b1 = *(const LAS bf16x8*)(Kt + off + 32 * 256);
        const bf16x8 q = *(const LAS bf16x8*)(Qw + off);
        p0 = __builtin_amdgcn_mfma_f32_32x32x16_bf16(b0, q, p0, 0, 0, 0);
        p1 = __builtin_amdgcn_mfma_f32_32x32x16_bf16(b1, q, p1, 0, 0, 0); }
}
template <int ND>
__device__ __forceinline__ void qkt(f32x16& p0, f32x16& p1, ldsp_t Kt, int r32, int hi, const bf16x8* qr) {
    p0 = f32x16{}; p1 = f32x16{};
    ldsp_t kb[4];
#pragma unroll
    for (int dd = 0; dd < 4; ++dd) kb[dd] = Kt + KSWZ(r32, (dd * 16 + hi * 8) * 2);
#pragma unroll
    for (int d0 = 0; d0 < ND; ++d0) {
        ldsp_t a = kb[d0 & 3] + (d0 >> 2) * 128;
        const bf16x8 b0 = *(const LAS bf16x8*)(a);
        const bf16x8 b1 = *(const LAS bf16x8*)(a + 32 * 256);
        p0 = __builtin_amdgcn_mfma_f32_32x32x16_bf16(b0, qr[d0], p0, 0, 0, 0);
        p1 = __builtin_amdgcn_mfma_f32_32x32x16_bf16(b1, qr[d0], p1, 0, 0, 0); }
}
__device__ __forceinline__ void pv_tile(f32x16* o, unsigned vb0, bf16x8 pa0, bf16x8 pa1, bf16x8 pa2, bf16x8 pa3) {
#define TRRD(dst, off) asm volatile("ds_read_b64_tr_b16 %0, %1 offset:%2" : "=&v"(dst) : "v"(vb0), "i"(off) : "memory")
#define PV_D0(d0) do { s16x4 l0, l1, l2, l3, h0, h1, h2, h3; constexpr int b_ = v_rd_off(d0, 0, 0); \
        TRRD(l0, b_); TRRD(h0, b_ + 2048); TRRD(l1, b_ + 4096); TRRD(h1, b_ + 6144); TRRD(l2, b_ + 8192); TRRD(h2, b_ + 10240); TRRD(l3, b_ + 12288); TRRD(h3, b_ + 14336); \
        asm volatile("s_waitcnt lgkmcnt(0)" ::: "memory"); __builtin_amdgcn_sched_barrier(0); \
        o[d0] = __builtin_amdgcn_mfma_f32_32x32x16_bf16(pa0, (bf16x8){l0[0], l0[1], l0[2], l0[3], h0[0], h0[1], h0[2], h0[3]}, o[d0], 0, 0, 0);   \
        o[d0] = __builtin_amdgcn_mfma_f32_32x32x16_bf16(pa1, (bf16x8){l1[0], l1[1], l1[2], l1[3], h1[0], h1[1], h1[2], h1[3]}, o[d0], 0, 0, 0);   \
        o[d0] = __builtin_amdgcn_mfma_f32_32x32x16_bf16(pa2, (bf16x8){l2[0], l2[1], l2[2], l2[3], h2[0], h2[1], h2[2], h2[3]}, o[d0], 0, 0, 0);   \
        o[d0] = __builtin_amdgcn_mfma_f32_32x32x16_bf16(pa3, (bf16x8){l3[0], l3[1], l3[2], l3[3], h3[0], h3[1], h3[2], h3[3]}, o[d0], 0, 0, 0); } while (0)
    PV_D0(0); PV_D0(1); PV_D0(2); PV_D0(3);
#undef PV_D0
#undef TRRD
}
__device__ __forceinline__ void pv_tile_h(f32x16* o, unsigned vb0, bf16x8 pa0, bf16x8 pa1, bf16x8 pa2, bf16x8 pa3) {
#define TRRD(dst, off) asm volatile("ds_read_b64_tr_b16 %0, %1 offset:%2" : "=&v"(dst) : "v"(vb0), "i"(off) : "memory")
#define PV_D0(d0) do { constexpr int b_ = v_rd_off(d0, 0, 0); \
        { s16x4 l0, l1, h0, h1; TRRD(l0, b_); TRRD(h0, b_ + 2048); TRRD(l1, b_ + 4096); TRRD(h1, b_ + 6144); \
          asm volatile("s_waitcnt lgkmcnt(0)" ::: "memory"); __builtin_amdgcn_sched_barrier(0); \
          o[d0] = __builtin_amdgcn_mfma_f32_32x32x16_bf16(pa0, (bf16x8){l0[0], l0[1], l0[2], l0[3], h0[0], h0[1], h0[2], h0[3]}, o[d0], 0, 0, 0);   \
          o[d0] = __builtin_amdgcn_mfma_f32_32x32x16_bf16(pa1, (bf16x8){l1[0], l1[1], l1[2], l1[3], h1[0], h1[1], h1[2], h1[3]}, o[d0], 0, 0, 0); } \
        { s16x4 l2, l3, h2, h3; TRRD(l2, b_ + 8192); TRRD(h2, b_ + 10240); TRRD(l3, b_ + 12288); TRRD(h3, b_ + 14336); \
          asm volatile("s_waitcnt lgkmcnt(0)" ::: "memory"); __builtin_amdgcn_sched_barrier(0); \
          o[d0] = __builtin_amdgcn_mfma_f32_32x32x16_bf16(pa2, (bf16x8){l2[0], l2[1], l2[2], l2[3], h2[0], h2[1], h2[2], h2[3]}, o[d0], 0, 0, 0);   \
          o[d0] = __builtin_amdgcn_mfma_f32_32x32x16_bf16(pa3, (bf16x8){l3[0], l3[1], l3[2], l3[3], h3[0], h3[1], h3[2], h3[3]}, o[d0], 0, 0, 0); } } while (0)
    PV_D0(0); PV_D0(1); PV_D0(2); PV_D0(3);
#undef PV_D0
#undef TRRD
}
__device__ __forceinline__ void pv_tile2(f32x16* oa, f32x16* ob_, unsigned vb0, const bf16x8* pa, const bf16x8* pb) {
#define TRRD(dst, off) asm volatile("ds_read_b64_tr_b16 %0, %1 offset:%2" : "=&v"(dst) : "v"(vb0), "i"(off) : "memory")
#define PV_D0(d0) do { s16x4 l0, l1, l2, l3, h0, h1, h2, h3; constexpr int b_ = v_rd_off(d0, 0, 0); \
        TRRD(l0, b_); TRRD(h0, b_ + 2048); TRRD(l1, b_ + 4096); TRRD(h1, b_ + 6144); TRRD(l2, b_ + 8192); TRRD(h2, b_ + 10240); TRRD(l3, b_ + 12288); TRRD(h3, b_ + 14336); \
        asm volatile("s_waitcnt lgkmcnt(0)" ::: "memory"); __builtin_amdgcn_sched_barrier(0); \
        const bf16x8 v0_ = (bf16x8){l0[0], l0[1], l0[2], l0[3], h0[0], h0[1], h0[2], h0[3]}, v1_ = (bf16x8){l1[0], l1[1], l1[2], l1[3], h1[0], h1[1], h1[2], h1[3]}; \
        const bf16x8 v2_ = (bf16x8){l2[0], l2[1], l2[2], l2[3], h2[0], h2[1], h2[2], h2[3]}, v3_ = (bf16x8){l3[0], l3[1], l3[2], l3[3], h3[0], h3[1], h3[2], h3[3]}; \
        oa[d0] = __builtin_amdgcn_mfma_f32_32x32x16_bf16(pa[0], v0_, oa[d0], 0, 0, 0); ob_[d0] = __builtin_amdgcn_mfma_f32_32x32x16_bf16(pb[0], v0_, ob_[d0], 0, 0, 0); \
        oa[d0] = __builtin_amdgcn_mfma_f32_32x32x16_bf16(pa[1], v1_, oa[d0], 0, 0, 0); ob_[d0] = __builtin_amdgcn_mfma_f32_32x32x16_bf16(pb[1], v1_, ob_[d0], 0, 0, 0); \
        oa[d0] = __builtin_amdgcn_mfma_f32_32x32x16_bf16(pa[2], v2_, oa[d0], 0, 0, 0); ob_[d0] = __builtin_amdgcn_mfma_f32_32x32x16_bf16(pb[2], v2_, ob_[d0], 0, 0, 0); \
        oa[d0] = __builtin_amdgcn_mfma_f32_32x32x16_bf16(pa[3], v3_, oa[d0], 0, 0, 0); ob_[d0] = __builtin_amdgcn_mfma_f32_32x32x16_bf16(pb[3], v3_, ob_[d0], 0, 0, 0); } while (0)
    PV_D0(0); PV_D0(1); PV_D0(2); PV_D0(3);
#undef PV_D0
#undef TRRD
}
__device__ __forceinline__ void partialSM(f32x16& p0, f32x16& p1, float& m_reg, float& alpha, float scale, float C2) {
    float pmax = p0[0];
#pragma unroll
    for (int r = 1; r < 16; ++r) pmax = fmaxf(pmax, p0[r]);
#pragma unroll
    for (int r = 0; r < 16; ++r) pmax = fmaxf(pmax, p1[r]);
    { auto rr = __builtin_amdgcn_permlane32_swap(__float_as_uint(pmax), __float_as_uint(pmax), false, false);
      pmax = fmaxf(__uint_as_float(rr[0]), __uint_as_float(rr[1])); }
    float mn;
    if (__all((pmax - m_reg) * scale <= 8.f)) { mn = m_reg; alpha = 1.f; }
    else { mn = fmaxf(m_reg, pmax); alpha = __builtin_amdgcn_exp2f((m_reg - mn) * C2); m_reg = mn; }
    const float mnL = -mn * C2;
#pragma unroll
    for (int r = 0; r < 16; ++r) { p0[r] = __builtin_amdgcn_exp2f(fmaf(p0[r], C2, mnL)); p1[r] = __builtin_amdgcn_exp2f(fmaf(p1[r], C2, mnL)); }
}
__device__ __forceinline__ float rowsum32(const f32x16& p0, const f32x16& p1) {
    float ps = 0.f;
#pragma unroll
    for (int r = 0; r < 16; ++r) ps += p0[r];
#pragma unroll
    for (int r = 0; r < 16; ++r) ps += p1[r];
    auto rr = __builtin_amdgcn_permlane32_swap(__float_as_uint(ps), __float_as_uint(ps), false, false);
    return __uint_as_float(rr[0]) + __uint_as_float(rr[1]);
}
__device__ __forceinline__ void packP(const f32x16& p0, const f32x16& p1, bf16x8& pa0, bf16x8& pa1, bf16x8& pa2, bf16x8& pa3) {
#define PK4(P, B_, OUT) do { unsigned a0 = cvtpk(P[B_+0], P[B_+1]), a1 = cvtpk(P[B_+2], P[B_+3]);                          \
        unsigned b0 = cvtpk(P[B_+4], P[B_+5]), b1 = cvtpk(P[B_+6], P[B_+7]);                                             \
        auto r0 = __builtin_amdgcn_permlane32_swap(a0, b0, false, false); auto r1 = __builtin_amdgcn_permlane32_swap(a1, b1, false, false); \
        u32x4 w = {r0[0], r1[0], r0[1], r1[1]}; OUT = *reinterpret_cast<bf16x8*>(&w); } while (0)
    PK4(p0, 0, pa0); PK4(p0, 8, pa1); PK4(p1, 0, pa2); PK4(p1, 8, pa3);
#undef PK4
}
__device__ __forceinline__ void rescaleO(f32x16* o, float alpha, LAS float* al_l, int r32, int hi) {
    if (__any(alpha < 1.f)) {
        if (hi == 0) al_l[r32] = alpha;
        asm volatile("s_waitcnt lgkmcnt(0)" ::: "memory");
#pragma unroll
        for (int q = 0; q < 4; ++q) { const f32x4 a = *(const LAS f32x4*)(al_l + 8 * q + 4 * hi);
#pragma unroll
            for (int d_ = 0; d_ < 4; ++d_)
#pragma unroll
                for (int i = 0; i < 4; ++i) o[d_][4 * q + i] *= a[i]; }
    }
}
__device__ __forceinline__ void row_scalars(float x, float* out16, LAS float* li_l, int r32, int hi) {
    if (hi == 0) li_l[r32] = x;
    asm volatile("s_waitcnt lgkmcnt(0)" ::: "memory");
#pragma unroll
    for (int r = 0; r < 16; ++r) out16[r] = li_l[crow(r, hi)];
    asm volatile("s_waitcnt lgkmcnt(0)" ::: "memory");
}
struct KVStage { bf16x8 k0, k1, v0, v1; };
template <int ND, bool WITH_V>
__device__ __forceinline__ void stage_load(KVStage& s, const bf16_t* Kg, const bf16_t* Vg, int tid) {
    if (ND == 8) { const int sr = tid >> 4, sc = (tid & 15) * 8;
        s.k0 = *(const bf16x8*)(Kg + (size_t)sr * 128 + sc); s.k1 = *(const bf16x8*)(Kg + (size_t)(32 + sr) * 128 + sc); }
    else { const int key = tid >> 3, c8 = (tid & 7) * 8; s.k0 = *(const bf16x8*)(Kg + (size_t)key * 64 + c8); }
    if (WITH_V) { const int sr = tid >> 4, sc = (tid & 15) * 8;
        s.v0 = *(const bf16x8*)(Vg + (size_t)sr * 128 + sc); s.v1 = *(const bf16x8*)(Vg + (size_t)(32 + sr) * 128 + sc); }
}
template <int ND, bool WITH_V>
__device__ __forceinline__ void stage_write(const KVStage& s, ldsp_t lds, int tid) {
    if (ND == 8) { const int sr = tid >> 4, sc = (tid & 15) * 8, kws = KSWZ(sr, sc * 2);
        *(LAS bf16x8*)(lds + AT_K + kws) = s.k0; *(LAS bf16x8*)(lds + AT_K + kws + 32 * 256) = s.k1; }
    else { const int key = tid >> 3, c8 = (tid & 7) * 8; *(LAS bf16x8*)(lds + AT_K + KSWZ(key, c8 * 2)) = s.k0; }
    if (WITH_V) { const int sr = tid >> 4, sc = (tid & 15) * 8;
        *(LAS bf16x8*)(lds + AT_V + v_st(sr, sc)) = s.v0; *(LAS bf16x8*)(lds + AT_V + v_st(32 + sr, sc)) = s.v1; }
}
__device__ __forceinline__ void stage_dma(ldsp_t buf, const bf16_t* Kg, const bf16_t* Vg, int wid_u, int lane) {
#pragma unroll
    for (int i = 0; i < 2; ++i) { const int q = (i * 8 + wid_u) * 64 + lane, row = q >> 4, cpos = q & 15;
        __builtin_amdgcn_global_load_lds((const unsigned*)(Kg + (size_t)row * 128 + ((cpos ^ (row & 7)) * 8)), (LAS unsigned*)(buf + AT_K + (i * 8 + wid_u) * 1024), 16, 0, 0); }
#pragma unroll
    for (int i = 0; i < 2; ++i) { const int q = (i * 8 + wid_u) * 64 + lane, sub = q >> 5, w5 = q & 31;
        const int kk = (sub >> 2) * 8 + (w5 >> 2), c = (sub & 3) * 32 + (w5 & 3) * 8, k = (kk & ~0xC) | ((kk & 4) << 1) | ((kk & 8) >> 1);
        __builtin_amdgcn_global_load_lds((const unsigned*)(Vg + (size_t)k * 128 + c), (LAS unsigned*)(buf + AT_V + (i * 8 + wid_u) * 1024), 16, 0, 0); }
}
enum { MK_CAUSAL = 0, MK_WINDOW = 1, MK_SLC = 2 };
template <int MK>
__device__ __forceinline__ int sweep_next(int j, int j_hi, unsigned un0, unsigned un1, unsigned un2, unsigned un3) {
    if (MK == MK_SLC) { while (j < j_hi) { const unsigned uw = (j < 32) ? un0 : (j < 64) ? un1 : (j < 96) ? un2 : un3; if ((uw >> (j & 31)) & 1u) break; ++j; } }
    return j;
}
template <int MK, int ND>
__device__ __forceinline__ void attn_sweep(ldsp_t lds, const bf16x8* qr, const bf16_t* Kg, const bf16_t* Vg, int j_lo, int j_hi, int pos,
                                           unsigned sel0, unsigned sel1, unsigned sel2, unsigned sel3, unsigned un0, unsigned un1, unsigned un2, unsigned un3,
                                           f32x16* o, float& m_reg, float& l_reg, float scale, int wspan) {
    const int tid = my_tid(), wid = tid >> 6, lane = tid & 63, r32 = lane & 31, hi = lane >> 5;
    const float C2 = scale * 1.4426950408889634f;
    LAS float* al_l = (LAS float*)(lds + AT_WS) + wid * 64;
    const unsigned vb0 = (unsigned)(size_t)(lds + AT_V) + v_rd_base(lane);
    const float NEG = -__builtin_inff();
    const int wpos0 = __builtin_amdgcn_readfirstlane(pos);
    static_assert(ND == 8, "LDS-DMA staging is written for 128-wide K rows");
    const int wid_u = __builtin_amdgcn_readfirstlane(wid);
    int j = sweep_next<MK>(j_lo, j_hi, un0, un1, un2, un3);
    if (j >= j_hi) { __syncthreads(); return; }
    int j1 = sweep_next<MK>(j + 1, j_hi, un0, un1, un2, un3);
    stage_dma(lds, Kg + (size_t)j * 64 * 128, Vg + (size_t)j * 64 * 128, wid_u, lane);
    if (j1 < j_hi) stage_dma(lds + AT_BUF, Kg + (size_t)j1 * 64 * 128, Vg + (size_t)j1 * 64 * 128, wid_u, lane);
    if (j1 < j_hi) asm volatile("s_waitcnt vmcnt(4)" ::: "memory"); else asm volatile("s_waitcnt vmcnt(0)" ::: "memory");
    __builtin_amdgcn_s_barrier(); asm volatile("" ::: "memory");
    int cur = 0;
    for (;;) {
        const int j2 = (j1 < j_hi) ? sweep_next<MK>(j1 + 1, j_hi, un0, un1, un2, un3) : j_hi;
        const int nb2 = cur >= 1 ? cur - 1 : 2;
        if (j2 < j_hi) stage_dma(lds + nb2 * AT_BUF, Kg + (size_t)j2 * 64 * 128, Vg + (size_t)j2 * 64 * 128, wid_u, lane);
        bool tsel = true;
        if (MK == MK_SLC) { const unsigned sw = (j < 32) ? sel0 : (j < 64) ? sel1 : (j < 96) ? sel2 : sel3; tsel = (sw >> (j & 31)) & 1u; }
        if (MK != MK_SLC || __any(tsel)) {
        f32x16 p0, p1; qkt<ND>(p0, p1, lds + cur * AT_BUF + AT_K, r32, hi, qr);
        bool need = (j * 64 + 63 > wpos0);
        if (MK == MK_WINDOW) need = need || (j * 64 <= wpos0 + wspan - 512);
        if (need) { const int kb = j * 64 + 4 * hi;
#pragma unroll
            for (int r = 0; r < 16; ++r) { const int k0 = kb + (r & 3) + 8 * (r >> 2), k1 = k0 + 32;
                bool ok0 = k0 <= pos, ok1 = k1 <= pos;
                if (MK == MK_WINDOW) { ok0 = ok0 && (k0 > pos - 512); ok1 = ok1 && (k1 > pos - 512); }
                if (!ok0) p0[r] = NEG; if (!ok1) p1[r] = NEG; } }
        if (MK == MK_SLC) { if (!__all(tsel)) {
#pragma unroll
            for (int r = 0; r < 16; ++r) { p0[r] = tsel ? p0[r] : NEG; p1[r] = tsel ? p1[r] : NEG; } } }
        float alpha; partialSM(p0, p1, m_reg, alpha, scale, C2);
        rescaleO(o, alpha, al_l, r32, hi);
        l_reg = l_reg * alpha + rowsum32(p0, p1);
        bf16x8 pa0, pa1, pa2, pa3; packP(p0, p1, pa0, pa1, pa2, pa3);
        pv_tile(o, vb0 + cur * AT_BUF, pa0, pa1, pa2, pa3);
        }
        if (j2 < j_hi) asm volatile("s_waitcnt vmcnt(4) lgkmcnt(0)" ::: "memory"); else asm volatile("s_waitcnt vmcnt(0) lgkmcnt(0)" ::: "memory");
        __builtin_amdgcn_s_barrier(); asm volatile("" ::: "memory");
        if (j1 >= j_hi) break;
        j = j1; j1 = j2; cur = cur == 2 ? 0 : cur + 1;
    }
}
__device__ __forceinline__ void store_O_bf16(const f32x16* o, const float* rs16, bf16_t* base  , size_t ld, int r32, int hi) {
#pragma unroll
    for (int r = 0; r < 16; ++r) { const int orow = crow(r, hi);
#pragma unroll
        for (int d0 = 0; d0 < 4; ++d0) { const float v = o[d0][r] * rs16[r]; const float vn = lane_xor1(v);
            if ((r32 & 1) == 0) *(unsigned*)(base + (size_t)orow * ld + d0 * 32 + r32) = cvtpk(v, vn); } }
}
__device__ __forceinline__ void da_sweep(ldsp_t lds, const bf16_t* Q, const bf16_t* K, const bf16_t* V, int bh, int qb, f32x16* o0, f32x16* o1, float& l0, float& l1) {
    const float SCALE = 0.125f, C2 = SCALE * 1.4426950408889634f, NEG = -__builtin_inff();
    const int tid = my_tid(), wid = tid >> 6, lane = tid & 63, r32 = lane & 31, hi = lane >> 5;
    LAS float* al_l = (LAS float*)(lds + AT_WS) + wid * 64;
    const unsigned vb0 = (unsigned)(size_t)(lds + AT_V) + v_rd_base(lane);
    const bf16_t* Kg = K + (size_t)bh * SEQ * 128; const bf16_t* Vg = V + (size_t)bh * SEQ * 128;
    ldsp_t Qw = lds + q_park(wid);
    { const bf16_t* Qb = Q + ((size_t)bh * SEQ + qb * 256 + wid * 32 + r32) * 128;
#pragma unroll
      for (int d0 = 0; d0 < 8; ++d0) *(LAS bf16x8*)(Qw + KSWZ(r32, (d0 * 16 + hi * 8) * 2)) = *(const bf16x8*)(Qb + d0 * 16 + hi * 8); }
    float m0 = -1e30f, m1 = -1e30f;
    const int wpos0 = qb * 256 + wid * 32, pos = wpos0 + r32, j_hi = 4 * (qb + 1);
    const int wid_u = __builtin_amdgcn_readfirstlane(wid);
    __syncthreads();
    stage_dma(lds, Kg, Vg, wid_u, lane);
    __syncthreads();
    int cur = 0;
    for (int j = 0; j < j_hi; ++j) {
        const bool has = j + 1 < j_hi;
        if (has) stage_dma(lds + (cur ^ 1) * AT_BUF, Kg + (size_t)(j + 1) * 64 * 128, Vg + (size_t)(j + 1) * 64 * 128, wid_u, lane);
        const bool need = (j * 64 + 63 > wpos0);
        const int kb = j * 64 + 4 * hi;
        if (j * 64 <= wpos0 + 31) {
        { f32x16 p0, p1; qkt_range_lq<0, 4>(p0, p1, lds + cur * AT_BUF + AT_K, Qw, r32, hi);
          if (need) {
#pragma unroll
              for (int r = 0; r < 16; ++r) { const int k0 = kb + (r & 3) + 8 * (r >> 2); if (k0 > pos) p0[r] = NEG; if (k0 + 32 > pos) p1[r] = NEG; } }
          float a0; partialSM(p0, p1, m0, a0, SCALE, C2); l0 = l0 * a0 + rowsum32(p0, p1);
          bf16x8 pa0, pa1, pa2, pa3; packP(p0, p1, pa0, pa1, pa2, pa3);
          rescaleO(o0, a0, al_l, r32, hi); pv_tile_h(o0, vb0 + cur * AT_BUF, pa0, pa1, pa2, pa3); }
        { f32x16 p0, p1; qkt_range_lq<4, 8>(p0, p1, lds + cur * AT_BUF + AT_K, Qw, r32, hi);
          if (need) {
#pragma unroll
              for (int r = 0; r < 16; ++r) { const int k0 = kb + (r & 3) + 8 * (r >> 2); if (k0 > pos) p0[r] = NEG; if (k0 + 32 > pos) p1[r] = NEG; } }
          float a1; partialSM(p0, p1, m1, a1, SCALE, C2); l1 = l1 * a1 + rowsum32(p0, p1);
          bf16x8 pa0, pa1, pa2, pa3; packP(p0, p1, pa0, pa1, pa2, pa3);
          rescaleO(o1, a1, al_l, r32, hi); pv_tile_h(o1, vb0 + cur * AT_BUF, pa0, pa1, pa2, pa3); }
        }
        __syncthreads();
        cur ^= 1;
    }
}
__device__ __forceinline__ void da_epilogue(ldsp_t lds, const f32x16* o0, const f32x16* o1, float l0, float l1, const float* lam, const float* normg, bf16_t* ob, int b, int h, int qb) {
    const float LAM_INIT = 0.35550906759096934f;
    const int tid = my_tid(), wid = tid >> 6, lane = tid & 63, r32 = lane & 31, hi = lane >> 5;
    LAS float* li_l = (LAS float*)(lds + AT_WS) + wid * 64 + 32;
    const float s1 = wave_sum(lam[lane] * lam[64 + lane]), s2 = wave_sum(lam[128 + lane] * lam[192 + lane]);
    const float lmb = __expf(s1) - __expf(s2) + LAM_INIT;
    float i0[16], i1[16]; row_scalars(1.f / l0, i0, li_l, r32, hi); row_scalars(lmb / l1, i1, li_l, r32, hi);
    float ng[4];
#pragma unroll
    for (int d0 = 0; d0 < 4; ++d0) ng[d0] = normg[d0 * 32 + r32] * (1.f - LAM_INIT);
    bf16_t* Ob = ob + ((size_t)b * SEQ + qb * 256 + wid * 32) * DM + h * 128;
#pragma unroll
    for (int r = 0; r < 16; ++r) {
        float x[4], ss = 0.f;
#pragma unroll
        for (int d0 = 0; d0 < 4; ++d0) { x[d0] = o0[d0][r] * i0[r] - o1[d0][r] * i1[r]; ss += x[d0] * x[d0]; }
        ss = sum_rows16(row16_sum(ss));
        const float rs = rsqrtf(ss * (1.f / 128.f) + LN_EPS);
        const int orow = crow(r, hi);
#pragma unroll
        for (int d0 = 0; d0 < 4; ++d0) { const float v = x[d0] * rs * ng[d0]; const float vn = lane_xor1(v);
            if ((r32 & 1) == 0) *(unsigned*)(Ob + (size_t)orow * DM + d0 * 32 + r32) = cvtpk(v, vn); } }
}
__device__ __forceinline__ void da_attn_phase(ldsp_t lds, const bf16_t* Q, const bf16_t* K, const bf16_t* V, const float* lam, const float* normg, bf16_t* ob, int wg, int nwg) {
    const int nround = (1024 + nwg - 1) / nwg;
    for (int n = 0; n < nround; ++n) {
        const int idx = n * nwg + ((n & 1) ? (nwg - 1 - wg) : wg);
        if (idx >= 1024) continue;
        const int qb = 31 - (idx >> 5), bh = idx & 31, b = bh >> 3, h = bh & 7;
        f32x16 o0[4] = {}, o1[4] = {}; float l0 = 0.f, l1 = 0.f;
        da_sweep(lds, Q, K, V, bh, qb, o0, o1, l0, l1);
        da_epilogue(lds, o0, o1, l0, l1, lam, normg, ob, b, h, qb);
        __syncthreads();
    }
}
__device__ __forceinline__ void sb_attn_phase(ldsp_t lds, const bf16_t* Q, const bf16_t* K, const bf16_t* V, bf16_t* ob, int wg, int nwg) {
    const int tid = my_tid(), wid = tid >> 6, lane = tid & 63, r32 = lane & 31, hi = lane >> 5;
    const float SCALE = 0.08838834764831845f;
    LAS int* flags = (LAS int*)(lds + LDS_MISC - 64);
    const unsigned vb0 = (unsigned)(size_t)(lds + AT_V) + v_rd_base(lane);
    for (int idx = wg; idx < 1024; idx += nwg) {
        const int qb = idx >> 5, bh = idx & 31, b = bh >> 3, h = bh & 7;
        const bf16_t* Qb = Q + ((size_t)bh * SEQ + qb * 256 + wid * 32 + r32) * 128;
        const bf16_t* Kb = K + (size_t)bh * SEQ * 128; const bf16_t* Vb = V + (size_t)bh * SEQ * 128;
        ldsp_t Qw = lds + q_park(wid);
#pragma unroll
        for (int d0 = 0; d0 < 8; ++d0) *(LAS bf16x8*)(Qw + KSWZ(r32, (d0 * 16 + hi * 8) * 2)) = *(const bf16x8*)(Qb + d0 * 16 + hi * 8);
        f32x16 o[4] = {}; float R = 0.f; bool done = false;
        const int wpos0 = qb * 256 + wid * 32, pos = wpos0 + r32;
        const int wid_u = __builtin_amdgcn_readfirstlane(wid);
        stage_dma(lds, Kb + (size_t)(4 * qb + 3) * 64 * 128, Vb + (size_t)(4 * qb + 3) * 64 * 128, wid_u, lane);
        int cur = 0;
        for (int j = 4 * qb + 3; j >= 0; --j) {
            if (lane == 0) flags[wid] = done ? 1 : 0;
            __syncthreads();
            int alld = 1;
#pragma unroll
            for (int k = 0; k < 8; ++k) alld &= flags[k];
            if (alld) break;
            if (j > 0) stage_dma(lds + (cur ^ 1) * AT_BUF, Kb + (size_t)(j - 1) * 64 * 128, Vb + (size_t)(j - 1) * 64 * 128, wid_u, lane);
            const unsigned vbc = vb0 + cur * AT_BUF; ldsp_t Kt = lds + cur * AT_BUF + AT_K;
            cur ^= 1;
            if (!done && 64 * j < wpos0 + 31) {
                f32x16 p0, p1; qkt_range_lq<0, 8>(p0, p1, Kt, Qw, r32, hi);
                float l0[16], l1[16];
                const int kb = j * 64 + 4 * hi;
#pragma unroll
                for (int r = 0; r < 16; ++r) { const int k0 = kb + (r & 3) + 8 * (r >> 2), k1 = k0 + 32;
                    const float z0 = p0[r] * SCALE, z1 = p1[r] * SCALE;
                    const float sp0 = fmaxf(z0, 0.f) + __logf(1.f + __expf(-fabsf(z0))), sp1 = fmaxf(z1, 0.f) + __logf(1.f + __expf(-fabsf(z1)));
                    l0[r] = (k0 < pos) ? -sp0 : 0.f; l1[r] = (k1 < pos) ? -sp1 : 0.f; p0[r] = z0; p1[r] = z1; }
                float gs0[4], gs1[4], pg0[4], pg1[4], A0[4], A1[4];
#pragma unroll
                for (int q = 0; q < 4; ++q) { gs0[q] = (l0[4 * q] + l0[4 * q + 1]) + (l0[4 * q + 2] + l0[4 * q + 3]); gs1[q] = (l1[4 * q] + l1[4 * q + 1]) + (l1[4 * q + 2] + l1[4 * q + 3]); }
#pragma unroll
                for (int q = 0; q < 4; ++q) { pg0[q] = other_half32(gs0[q], hi); pg1[q] = other_half32(gs1[q], hi); }
                const float t00 = gs0[0] + pg0[0], t01 = gs0[1] + pg0[1], t02 = gs0[2] + pg0[2], t03 = gs0[3] + pg0[3];
                const float t10 = gs1[0] + pg1[0], t11 = gs1[1] + pg1[1], t12 = gs1[2] + pg1[2], t13 = gs1[3] + pg1[3];
                const float T1 = (t10 + t11) + (t12 + t13), T0 = (t00 + t01) + (t02 + t03);
                A0[3] = T1; A0[2] = A0[3] + t03; A0[1] = A0[2] + t02; A0[0] = A0[1] + t01;
                A1[3] = 0.f; A1[2] = t13; A1[1] = A1[2] + t12; A1[0] = A1[1] + t11;
                if (hi == 0) {
#pragma unroll
                    for (int q = 0; q < 4; ++q) { A0[q] += pg0[q]; A1[q] += pg1[q]; } }
#pragma unroll
                for (int q = 0; q < 4; ++q) {
                    float af0 = A0[q] + R, af1 = A1[q] + R;
#pragma unroll
                    for (int i = 3; i >= 0; --i) { const int r = 4 * q + i; const int k0 = kb + i + 8 * q, k1 = k0 + 32;
                        const float a0 = (k0 < pos) ? __expf(p0[r] + l0[r] + af0) : 0.f, a1 = (k1 < pos) ? __expf(p1[r] + l1[r] + af1) : 0.f;
                        af0 += l0[r]; af1 += l1[r]; p0[r] = a0; p1[r] = a1; } }
                R += T0 + T1;
                bf16x8 pa0, pa1, pa2, pa3; packP(p0, p1, pa0, pa1, pa2, pa3);
                pv_tile(o, vbc, pa0, pa1, pa2, pa3);
                done = __all(R < -104.f);
            }
        }
        __syncthreads();
        float one[16];
#pragma unroll
        for (int r = 0; r < 16; ++r) one[r] = 1.f;
        store_O_bf16(o, one, ob + ((size_t)b * SEQ + qb * 256 + wid * 32) * DM + h * 128, DM, r32, hi);
    }
}

__device__ __forceinline__ float gelu_tanh(float x) { const float u = 0.7978845608028654f * (x + 0.044715f * x * x * x); const float e = __expf(2.f * u); const float th = 1.f - 2.f / (e + 1.f); return 0.5f * x * (1.f + th); }
__device__ __forceinline__ void nsa_compress_phase(ldsp_t lds, const bf16_t* kv, const bf16_t* W1t, const bf16_t* W2t, const float* biasp, bf16_t* KC, int wg, int nwg) {
    const int tid = my_tid(), wid = tid >> 6, lane = tid & 63, c16 = lane & 15, g = lane >> 4;
    const int rg = wid & 1, ch = wid >> 1;
    ldsp_t H1 = lds;
    LAS float* biasL = (LAS float*)(lds + 32 * HG_P272);
    if (tid < 256) { float sacc = 0.f; for (int p = 0; p < 32; ++p) sacc += biasp[((tid >> 7) * 32 + p) * 128 + (tid & 127)]; biasL[tid] = sacc; }
    __syncthreads();
    for (int it = wg; it < 256; it += nwg) {
        const int jj = it >> 7, bg = (it >> 4) & 7, ct = it & 15;
        const bf16_t* X = kv + ((size_t)(jj * 8 + bg) * SEQ) * 128;
        const bf16_t* W1 = W1t + (size_t)jj * 128 * 4096; const bf16_t* W2 = W2t + (size_t)jj * 128 * 128;
        int crow_ = ct * 32 + rg * 16 + c16; if (crow_ > 510) crow_ = 510;
        const bf16_t* Ar = X + (size_t)crow_ * 16 * 128 + 8 * g;
        const bf16_t* Br = W1 + (size_t)(32 * ch + c16) * 4096 + 8 * g;
        f32x4 acc[2];
#pragma unroll
        for (int nt = 0; nt < 2; ++nt) acc[nt] = (f32x4){0.f, 0.f, 0.f, 0.f};
        for (int ks = 0; ks < 128; ks += 4) {
            bf16x8 A[4], B[4][2];
#pragma unroll
            for (int u = 0; u < 4; ++u) { A[u] = *(const bf16x8*)(Ar + (ks + u) * 32);
#pragma unroll
                for (int nt = 0; nt < 2; ++nt) B[u][nt] = *(const bf16x8*)(Br + (size_t)(16 * nt) * 4096 + (ks + u) * 32); }
#pragma unroll
            for (int u = 0; u < 4; ++u)
#pragma unroll
                for (int nt = 0; nt < 2; ++nt) acc[nt] = __builtin_amdgcn_mfma_f32_16x16x32_bf16(A[u], B[u][nt], acc[nt], 0, 0, 0); }
#pragma unroll
        for (int nt = 0; nt < 2; ++nt) { const int n = 32 * ch + 16 * nt + c16; const float bs = biasL[jj * 128 + n];
#pragma unroll
            for (int r = 0; r < 4; ++r) *(LAS bf16_t*)(H1 + (16 * rg + 4 * g + r) * HG_P272 + n * 2) = f2bf(gelu_tanh(acc[nt][r] + bs)); }
        __syncthreads();
        f32x4 ac2[2];
#pragma unroll
        for (int nt = 0; nt < 2; ++nt) { ac2[nt] = (f32x4){0.f, 0.f, 0.f, 0.f};
#pragma unroll
            for (int ks = 0; ks < 4; ++ks) { const bf16x8 A = *(const LAS bf16x8*)(H1 + (16 * rg + c16) * HG_P272 + (32 * ks + 8 * g) * 2);
                const bf16x8 B = *(const bf16x8*)(W2 + (size_t)(32 * ch + 16 * nt + c16) * 128 + 32 * ks + 8 * g);
                ac2[nt] = __builtin_amdgcn_mfma_f32_16x16x32_bf16(A, B, ac2[nt], 0, 0, 0); } }
#pragma unroll
        for (int nt = 0; nt < 2; ++nt)
#pragma unroll
            for (int r = 0; r < 4; ++r) { const int c = ct * 32 + rg * 16 + 4 * g + r; const int n = 32 * ch + 16 * nt + c16;
                KC[((size_t)(jj * 8 + bg) * NCMP_P + c) * 128 + n] = (c <= 510) ? f2bf(ac2[nt][r]) : (bf16_t)0; }
        __syncthreads();
    }
}
constexpr int NS_IMPP = AT_END, NS_IMPS = NS_IMPP + 4096, NS_IMP = NS_IMPS + 4096, NS_CARRY = NS_IMP + 33792, NS_SEL = NS_CARRY + 512, NS_UN = NS_SEL + 1024, NS_END = NS_UN + 16;
static_assert(NS_END <= LDS_MISC, "NSA LDS");
__device__ __forceinline__ void nsa_cmp_sweep1(ldsp_t lds, const bf16x8* qr, const bf16_t* kcb, const bf16_t* vcb, int ntile, int pos, float& m_reg, float& l_reg) {
    const int tid = my_tid(), wid_u = __builtin_amdgcn_readfirstlane(tid >> 6), lane = tid & 63, r32 = lane & 31, hi = lane >> 5;
    const float SCALE = 0.08838834764831845f, C2 = SCALE * 1.4426950408889634f, NEG = -__builtin_inff();
    stage_dma(lds, kcb, vcb, wid_u, lane);
    int cur = 0;
    for (int jt = 0; jt < ntile; ++jt) {
        __syncthreads();
        if (jt + 1 < ntile) stage_dma(lds + (cur ^ 1) * AT_BUF, kcb + (size_t)(jt + 1) * 64 * 128, vcb + (size_t)(jt + 1) * 64 * 128, wid_u, lane);
        f32x16 p0, p1; qkt<8>(p0, p1, lds + cur * AT_BUF + AT_K, r32, hi, qr);
        const int kb = jt * 64 + 4 * hi;
#pragma unroll
        for (int r = 0; r < 16; ++r) { const int c0 = kb + (r & 3) + 8 * (r >> 2), c1 = c0 + 32;
            if (!(c0 < NCMP && 16 * c0 + 31 <= pos)) p0[r] = NEG; if (!(c1 < NCMP && 16 * c1 + 31 <= pos)) p1[r] = NEG; }
        float alpha; partialSM(p0, p1, m_reg, alpha, SCALE, C2);
        l_reg = l_reg * alpha + rowsum32(p0, p1);
        cur ^= 1;
    }
    __syncthreads();
}
__device__ __forceinline__ void nsa_cmp_sweep2(ldsp_t lds, const bf16x8* qr, const bf16_t* kcb, const bf16_t* vcb, int ntile, int pos, int tokl, float m_reg, float l_reg, f32x16* o) {
    const int tid = my_tid(), lane = tid & 63, r32 = lane & 31, hi = lane >> 5;
    const float SCALE = 0.08838834764831845f, C2 = SCALE * 1.4426950408889634f;
    LAS float* impP = (LAS float*)(lds + NS_IMPP); LAS float* impS = (LAS float*)(lds + NS_IMPS);
    LAS float* imp = (LAS float*)(lds + NS_IMP); LAS float* carry = (LAS float*)(lds + NS_CARRY);
    const unsigned vb0 = (unsigned)(size_t)(lds + AT_V) + v_rd_base(lane);
    const float inv_l = l_reg > 0.f ? 1.f / l_reg : 0.f;
    const float mL = -m_reg * C2;
    const int wid_u = __builtin_amdgcn_readfirstlane(tid >> 6);
    stage_dma(lds, kcb, vcb, wid_u, lane);
    int cur = 0;
    for (int jt = 0; jt < ntile; ++jt) {
        __syncthreads();
        if (jt + 1 < ntile) stage_dma(lds + (cur ^ 1) * AT_BUF, kcb + (size_t)(jt + 1) * 64 * 128, vcb + (size_t)(jt + 1) * 64 * 128, wid_u, lane);
        f32x16 p0, p1; qkt<8>(p0, p1, lds + cur * AT_BUF + AT_K, r32, hi, qr);
        const int kb = jt * 64 + 4 * hi;
#pragma unroll
        for (int r = 0; r < 16; ++r) { const int c0 = kb + (r & 3) + 8 * (r >> 2), c1 = c0 + 32;
            const bool ok0 = (c0 < NCMP && 16 * c0 + 31 <= pos), ok1 = (c1 < NCMP && 16 * c1 + 31 <= pos);
            p0[r] = ok0 ? __builtin_amdgcn_exp2f(fmaf(p0[r], C2, mL)) * inv_l : 0.f; p1[r] = ok1 ? __builtin_amdgcn_exp2f(fmaf(p1[r], C2, mL)) * inv_l : 0.f; }
#pragma unroll
        for (int q = 0; q < 4; ++q) {
            float sp0 = 0.5f * p0[4 * q + 3], sp1 = 0.5f * p1[4 * q + 3];
            float mn0 = (p0[4 * q] + p0[4 * q + 1]) + (p0[4 * q + 2] + sp0), mn1 = (p1[4 * q] + p1[4 * q + 1]) + (p1[4 * q + 2] + sp1);
            mn0 += lane_xor1(mn0); mn0 += lane_xor2(mn0); mn1 += lane_xor1(mn1); mn1 += lane_xor2(mn1);
            sp0 += lane_xor1(sp0); sp0 += lane_xor2(sp0); sp1 += lane_xor1(sp1); sp1 += lane_xor2(sp1);
            if ((r32 & 3) == 0) { const int i0 = tokl * 16 + 2 * q + hi; impP[i0] = mn0; impS[i0] = sp0; impP[i0 + 8] = mn1; impS[i0 + 8] = sp1; } }
        bf16x8 pa0, pa1, pa2, pa3; packP(p0, p1, pa0, pa1, pa2, pa3);
        pv_tile(o, vb0 + cur * AT_BUF, pa0, pa1, pa2, pa3);
        cur ^= 1;
        __syncthreads();
        { const int tk = tid >> 3, part = tid & 7;
#pragma unroll
          for (int e = 0; e < 2; ++e) { const int nb = 2 * part + e; float mm = impP[tk * 16 + nb];
              if (nb > 0) mm += impS[tk * 16 + nb - 1];
              if (nb == 0 && jt > 0) mm += carry[((jt - 1) & 1) * 64 + tk];
              imp[tk * 132 + 16 * jt + nb] = mm; }
          if (part == 7) carry[(jt & 1) * 64 + tk] = impS[tk * 16 + 15]; }
    }
    __syncthreads();
}
__device__ __forceinline__ void nsa_topk(ldsp_t lds, int cur) {
    const int tid = my_tid(), tk = tid >> 3, part = tid & 7;
    const float NEG = -__builtin_inff();
    LAS float* imp = (LAS float*)(lds + NS_IMP);
    LAS unsigned* selm = (LAS unsigned*)(lds + NS_SEL); LAS unsigned* unm = (LAS unsigned*)(lds + NS_UN);
    float vals[16]; unsigned mym = 0u;
#pragma unroll
    for (int q = 0; q < 4; ++q) { const f32x4 t = *(const LAS f32x4*)(imp + tk * 132 + part * 16 + 4 * q);
#pragma unroll
        for (int e = 0; e < 4; ++e) vals[4 * q + e] = t[e]; }
#pragma unroll
    for (int k = 0; k < 16; ++k) { const int nn = part * 16 + k; const bool forced = (nn == 0 || nn == cur || nn == cur - 1);
        mym |= forced ? (1u << k) : 0u; vals[k] = (nn > cur || forced) ? NEG : vals[k]; }
    const int nforced = cur >= 2 ? 3 : cur + 1;
    for (int rnd = nforced; rnd < 16; ++rnd) {
        float best = vals[0]; int bi = 0;
#pragma unroll
        for (int k = 1; k < 16; ++k) if (vals[k] > best) { best = vals[k]; bi = k; }
        int gi = part * 16 + bi;
        { const float ov = dpp_f<0xB1>(best); const int oi = dpp_i<0xB1>(gi); const bool t = (ov > best) || (ov == best && oi < gi); best = t ? ov : best; gi = t ? oi : gi; }
        { const float ov = dpp_f<0x4E>(best); const int oi = dpp_i<0x4E>(gi); const bool t = (ov > best) || (ov == best && oi < gi); best = t ? ov : best; gi = t ? oi : gi; }
        { const float ov = dpp_f<0x141>(best); const int oi = dpp_i<0x141>(gi); const bool t = (ov > best) || (ov == best && oi < gi); best = t ? ov : best; gi = t ? oi : gi; }
        const bool win = (best > -5e29f) && ((gi >> 4) == part);
        const int kk = win ? (gi & 15) : 16;
        mym |= win ? (1u << (gi & 15)) : 0u;
#pragma unroll
        for (int k = 0; k < 16; ++k) vals[k] = (k == kk) ? NEG : vals[k];
    }
    unsigned mw = mym << (16 * (part & 1));
    mw |= (unsigned)dpp_i<0xB1>((int)mw);
    if ((part & 1) == 0) { selm[tk * 4 + (part >> 1)] = mw; atomicOr((unsigned*)(unm + (part >> 1)), mw); }
}
__device__ __forceinline__ void nsa_load_q(bf16x8* qr, const bf16_t* Q, int b, int g, int s0) {
    const int tid = my_tid(), wid = tid >> 6, lane = tid & 63, r32 = lane & 31, hi = lane >> 5, hh = r32 & 3, tokl = 8 * wid + (r32 >> 2);
    const bf16_t* p = Q + (((size_t)b * 8 + g * 4 + hh) * SEQ + s0 + tokl) * 128 + hi * 8;
#pragma unroll
    for (int d0 = 0; d0 < 8; ++d0) qr[d0] = *(const bf16x8*)(p + d0 * 16);
}
template <int MODE>
__device__ __forceinline__ void nsa_branch_out(ldsp_t lds, f32x16* o, float l_reg, bool normalise, int which, const float* gates, float* OACC, bf16_t* ob, int b, int g, int s0) {
    const int tid = my_tid(), wid = tid >> 6, lane = tid & 63, r32 = lane & 31, hi = lane >> 5, hh = r32 & 3, tokl = 8 * wid + (r32 >> 2);
    LAS float* li_l = (LAS float*)(lds + AT_WS) + wid * 64 + 32;
    const float gt = gates[((size_t)b * SEQ + s0 + tokl) * 24 + (g * 4 + hh) * 3 + which];
    float gsc[16]; row_scalars(normalise ? gt * (l_reg > 0.f ? 1.f / l_reg : 0.f) : gt, gsc, li_l, r32, hi);
    f32x4* op = (f32x4*)(OACC + ((size_t)b * SEQ + s0) * DM + (size_t)g * (64 * 512)) + tid;
    const size_t base = ((size_t)b * SEQ + s0 + 8 * wid) * DM + (size_t)g * 512;
#pragma unroll
    for (int d0 = 0; d0 < 4; ++d0)
#pragma unroll
        for (int k = 0; k < 4; ++k) {
            f32x4 v = {o[d0][4 * k] * gsc[4 * k], o[d0][4 * k + 1] * gsc[4 * k + 1], o[d0][4 * k + 2] * gsc[4 * k + 2], o[d0][4 * k + 3] * gsc[4 * k + 3]};
            if (MODE == 0) op[(d0 * 4 + k) * 512] = v;
            else if (MODE == 1) op[(d0 * 4 + k) * 512] += v;
            else { v += op[(d0 * 4 + k) * 512];
#pragma unroll
                for (int e = 0; e < 4; ++e) { const int r = 4 * k + e; const int qi = crow(r, hi); const size_t ro = base + (size_t)(qi >> 2) * DM + (qi & 3) * 128;
                    const float vn = lane_xor1(v[e]);
                    if ((r32 & 1) == 0) *(unsigned*)(ob + ro + d0 * 32 + r32) = cvtpk(v[e], vn); } } }
}
__device__ __forceinline__ void nsa_attn_phase(ldsp_t lds, const bf16_t* Qp, const bf16_t* Qr, const bf16_t* kv, const bf16_t* KC, const float* gates, float* OACC, bf16_t* ob, int wg, int nwg) {
    const float SCALE = 0.08838834764831845f;
    LAS float* imp = (LAS float*)(lds + NS_IMP);
    LAS unsigned* selm = (LAS unsigned*)(lds + NS_SEL); LAS unsigned* unm = (LAS unsigned*)(lds + NS_UN);
    const int nround = (1024 + nwg - 1) / nwg;
    for (int n = 0; n < nround; ++n) {
        const int idx = n * nwg + ((n & 1) ? (nwg - 1 - wg) : wg);
        if (idx >= 1024) continue;
        const int blk = 127 - (idx >> 3), bg = idx & 7, b = bg >> 1, g = bg & 1;
        const int s0 = blk * 64;
        const int tid = my_tid(), wid = tid >> 6, lane = tid & 63, tokl = 8 * wid + ((lane & 31) >> 2), pos = s0 + tokl;
        const bf16_t* kcb = KC + (size_t)bg * NCMP_P * 128; const bf16_t* vcb = KC + (size_t)(8 + bg) * NCMP_P * 128;
        for (int i = tid; i < 64 * 132; i += 512) imp[i] = 0.f;
        if (tid < 4) unm[tid] = 0u;
        bf16x8 qr[8];
        nsa_load_q(qr, Qp, b, g, s0);
        int nvalid = 4 * blk + 3; if (nvalid > NCMP) nvalid = NCMP;
        const int ntile = (nvalid + 63) >> 6;
        float m_reg = -1e30f, l_reg = 0.f;
        nsa_cmp_sweep1(lds, qr, kcb, vcb, ntile, pos, m_reg, l_reg);
        f32x16 o[4] = {};
        nsa_cmp_sweep2(lds, qr, kcb, vcb, ntile, pos, tokl, m_reg, l_reg, o);
        nsa_topk(lds, blk);
        nsa_branch_out<0>(lds, o, 1.f, false, 0, gates, OACC, ob, b, g, s0);
        __syncthreads();
        nsa_load_q(qr, Qr, b, g, s0);
        {
            const unsigned sel0 = selm[tokl * 4 + 0], sel1 = selm[tokl * 4 + 1], sel2 = selm[tokl * 4 + 2], sel3 = selm[tokl * 4 + 3];
            const unsigned un0 = unm[0], un1 = unm[1], un2 = unm[2], un3 = unm[3];
#pragma unroll
            for (int d0 = 0; d0 < 4; ++d0) o[d0] = f32x16{};
            m_reg = -1e30f; l_reg = 0.f;
            attn_sweep<MK_SLC, 8>(lds, qr, kv + (size_t)(2 * 8 + bg) * SEQ * 128, kv + (size_t)(3 * 8 + bg) * SEQ * 128, 0, blk + 1, pos, sel0, sel1, sel2, sel3, un0, un1, un2, un3, o, m_reg, l_reg, SCALE, 7);
            nsa_branch_out<1>(lds, o, l_reg, true, 1, gates, OACC, ob, b, g, s0);
        }
        {
#pragma unroll
            for (int d0 = 0; d0 < 4; ++d0) o[d0] = f32x16{};
            m_reg = -1e30f; l_reg = 0.f;
            attn_sweep<MK_WINDOW, 8>(lds, qr, kv + (size_t)(4 * 8 + bg) * SEQ * 128, kv + (size_t)(5 * 8 + bg) * SEQ * 128, blk > 8 ? blk - 8 : 0, blk + 1, pos, 0, 0, 0, 0, 0, 0, 0, 0, o, m_reg, l_reg, SCALE, 7);
            nsa_branch_out<2>(lds, o, l_reg, true, 2, gates, OACC, ob, b, g, s0);
        }
        __syncthreads();
    }
}

struct Args { const float* in[25]; float* out; unsigned char* ws; int ph_lo, ph_hi; };
enum { I_X = 0, I_HG_WIN, I_HG_LB, I_HG_NG, I_HG_WOUT, I_DA_WIN, I_DA_LAM, I_DA_NG, I_DA_WOUT, I_NSA_WIN, I_NSA_PE, I_NSA_W1, I_NSA_W2, I_NSA_WOUT,
       I_SB_WIN, I_SB_WOUT, I_FFN_WG, I_FFN_WU, I_FFN_WD, I_MOE_WR, I_MOE_WG, I_MOE_WU, I_MOE_WD, I_LN_G, I_LN_B };
__device__ __forceinline__ void rope_table(f32x2* tab, int half, double ratio, int wg, int nwg) {
    for (int i = wg * 512 + my_tid(); i < SEQ * half; i += nwg * 512) {
        const int s = i / half, j = i % half;
        double inv = 1.0; for (int k = 0; k < j; ++k) inv *= ratio;
        const float ang = (float)s * (float)inv;
        const double rev = (double)ang * 0.15915494309189535; const float fr = (float)(rev - floor(rev));
        tab[i] = (f32x2){__builtin_amdgcn_cosf(fr), __builtin_amdgcn_sinf(fr)};
    }
}
__device__ __forceinline__ void prologue_phase(ldsp_t lds, const Args& a, int wg, int nwg) {
    unsigned char* ws = a.ws; const int tid = my_tid();
    { const float* x = a.in[I_X]; bf16_t* hb = (bf16_t*)(ws + WS_HB);
      for (size_t i = ((size_t)wg * 512 + tid) * 8; i < (size_t)NT * DM; i += (size_t)nwg * 512 * 8)
          *(bf16x8*)(hb + i) = pack8(*(const f32x4*)(x + i), *(const f32x4*)(x + i + 4)); }
    if (wg == 0) { float* lbv = (float*)(ws + WS_LBV); const float* L = a.in[I_HG_LB];
        for (int d = tid; d < DM; d += 512) { float mx = L[d];
            for (int r = 1; r < 5; ++r) mx = fmaxf(mx, L[r * DM + d]);
            float s = 0.f; for (int r = 0; r < 5; ++r) s += __expf(L[r * DM + d] - mx);
            lbv[d] = __expf(L[d] - mx) / s; } }
    for (int u = wg; u < 64; u += nwg) { const int jj = u >> 5, p = u & 31; LAS float* red = (LAS float*)lds;
        const float* pe = a.in[I_NSA_PE] + (size_t)jj * 4096 + p * 128; const float* w1 = a.in[I_NSA_W1] + ((size_t)jj * 4096 + p * 128) * 128;
        const int nn = tid & 127, sub = tid >> 7; float sacc = 0.f;
#pragma unroll 8
        for (int k = sub * 32; k < sub * 32 + 32; ++k) sacc += pe[k] * w1[(size_t)k * 128 + nn];
        red[sub * 128 + nn] = sacc; __syncthreads();
        if (tid < 128) ((float*)(ws + WS_CMPBIAS))[(jj * 32 + p) * 128 + tid] = (red[tid] + red[128 + tid]) + (red[256 + tid] + red[384 + tid]);
        __syncthreads(); }
    rope_table((f32x2*)(ws + WS_ROPE_DA), 32, 0.7498942093324559, wg, nwg);
    rope_table((f32x2*)(ws + WS_ROPE_NSA), 64, 0.8659643233600653, wg, nwg);
    __syncthreads();
    convert_T(lds, (bf16_t*)(ws + WS_W_HGIN), 1, 0, 4096, 1024, MapId{a.in[I_HG_WIN], 4096, 4096}, wg, nwg);
    convert_T(lds, (bf16_t*)(ws + WS_W_HGOUT), 1, 0, 1024, 1024, MapId{a.in[I_HG_WOUT], 1024, 1024}, wg, nwg);
    convert_T(lds, (bf16_t*)(ws + WS_W_DAIN), 1, 0, 3072, 1024, MapRope64{a.in[I_DA_WIN], 3072}, wg, nwg);
    convert_T(lds, (bf16_t*)(ws + WS_W_DAOUT), 1, 0, 1024, 1024, MapId{a.in[I_DA_WOUT], 1024, 1024}, wg, nwg);
    convert_T(lds, (bf16_t*)(ws + WS_W_NSAIN), 1, 0, NSA_NPAD, 1024, MapNsa{a.in[I_NSA_WIN], 2584}, wg, nwg);
    convert_T(lds, (bf16_t*)(ws + WS_W_NSAOUT), 1, 0, 1024, 1024, MapId{a.in[I_NSA_WOUT], 1024, 1024}, wg, nwg);
    convert_T(lds, (bf16_t*)(ws + WS_W_SBIN), 1, 0, 3072, 1024, MapId{a.in[I_SB_WIN], 3072, 3072}, wg, nwg);
    convert_T(lds, (bf16_t*)(ws + WS_W_SBOUT), 1, 0, 1024, 1024, MapId{a.in[I_SB_WOUT], 1024, 1024}, wg, nwg);
    for (int j = 0; j < 2; ++j) {
        convert_T(lds, (bf16_t*)(ws + WS_W_FFNGU) + (size_t)j * 5632 * 1024, 1, 0, 5632, 1024, MapGU{a.in[I_FFN_WG] + (size_t)j * 1024 * DFF, a.in[I_FFN_WU] + (size_t)j * 1024 * DFF, DFF}, wg, nwg);
        convert_T(lds, (bf16_t*)(ws + WS_W_FFND) + (size_t)j * 1024 * DFF, 1, 0, 1024, DFF, MapId{a.in[I_FFN_WD] + (size_t)j * DFF * 1024, 1024, 1024}, wg, nwg);
        convert_T(lds, (bf16_t*)(ws + WS_W_CMP1) + (size_t)j * 128 * 4096, 1, 0, 128, 4096, MapId{a.in[I_NSA_W1] + (size_t)j * 4096 * 128, 128, 128}, wg, nwg);
        convert_T(lds, (bf16_t*)(ws + WS_W_CMP2) + (size_t)j * 128 * 128, 1, 0, 128, 128, MapId{a.in[I_NSA_W2] + (size_t)j * 128 * 128, 128, 128}, wg, nwg);
    }
}
__device__ __forceinline__ void moe_down_sub(ldsp_t lds, const bf16_t* A, const bf16_t* Bt, const pg8::Unit u, int rq, int cq, bf16_t* y) {
    using namespace pg8;
    constexpr int K = DFFE, nt = K / BK, STG = 16384, NST = 8;
    const int tid = my_tid(), wid = __builtin_amdgcn_readfirstlane(tid >> 6), lane = tid & 63, wm = wid >> 1, wc2 = wid & 1, fr = lane & 15, fq = lane >> 4;
    unsigned voffA, voffB;
    { int R, C; stage_rc(tid * 16, R, C); voffA = (unsigned)(R * K + C) * 2u; const int Rb = (R & ~31) + perm32(R & 31); voffB = (unsigned)(Rb * K + C) * 2u; }
    const char* cA = (const char*)A + ((size_t)u.pm * 256 + (size_t)rq * 64) * K * 2;
    const char* cB = (const char*)Bt + ((size_t)u.pn * 256 + (size_t)cq * 64) * K * 2;
    const unsigned ldsw = (unsigned)wid * 1024u;
    const int aoff = lds_byte(wm * 16 + fr, fq * 8), boff = 8192 + lds_byte(wc2 * 32 + fr, fq * 8);
#define MS_STAGE(s, t) do { const size_t ko_ = (size_t)(t) * (BK * 2); \
        __builtin_amdgcn_global_load_lds((const unsigned*)(cA + ko_ + voffA), (LAS unsigned*)(lds + (s) * STG + ldsw), 16, 0, 0); \
        __builtin_amdgcn_global_load_lds((const unsigned*)(cB + ko_ + voffB), (LAS unsigned*)(lds + (s) * STG + 8192 + ldsw), 16, 0, 0); } while (0)
    f32x4 acc[2] = {(f32x4){0.f, 0.f, 0.f, 0.f}, (f32x4){0.f, 0.f, 0.f, 0.f}};
#pragma unroll
    for (int t = 0; t < NST - 1; ++t) MS_STAGE(t, t);
    for (int t = 0; t < nt; ++t) {
        asm volatile("s_waitcnt vmcnt(12)" ::: "memory");
        __builtin_amdgcn_s_barrier();
        asm volatile("" ::: "memory");
        { const int tn = (t + NST - 1 < nt) ? t + NST - 1 : nt - 1;
          MS_STAGE((t + NST - 1) & (NST - 1), tn); }
        const int s = t & (NST - 1);
        bf16x8 At[2], Bf[2][2];
#pragma unroll
        for (int k = 0; k < 2; ++k) At[k] = *(const LAS bf16x8*)(lds + s * STG + aoff + k * 1024);
#pragma unroll
        for (int n = 0; n < 2; ++n)
#pragma unroll
            for (int k = 0; k < 2; ++k) Bf[n][k] = *(const LAS bf16x8*)(lds + s * STG + boff + n * 2048 + k * 1024);
#pragma unroll
        for (int n = 0; n < 2; ++n)
#pragma unroll
            for (int k = 0; k < 2; ++k) acc[n] = __builtin_amdgcn_mfma_f32_16x16x32_bf16(Bf[n][k], At[k], acc[n], 0, 0, 0);
        asm volatile("" ::: "memory");
    }
#undef MS_STAGE
    asm volatile("s_waitcnt vmcnt(0)" ::: "memory");
    { const int row = u.pm * 256 + rq * 64 + wm * 16 + fr, colL = (u.pn & 3) * 256 + cq * 64 + wc2 * 32 + 8 * fq;
      *(bf16x8*)(y + (size_t)row * DM + colL) = pack8(acc[0], acc[1]); }
    __syncthreads();
}
__device__ __forceinline__ void moe_convert_phase(ldsp_t lds, const Args& a, int j, int wg, int nwg) {
    unsigned char* ws = a.ws;
    const size_t eo = (size_t)(j * 8) * 1024 * DFFE;
    convert_T(lds, (bf16_t*)(ws + WS_W_MOEGU), 8, (size_t)1024 * DFFE, 7168, 1024, MapGU{a.in[I_MOE_WG] + eo, a.in[I_MOE_WU] + eo, DFFE}, wg, nwg);
    convert_T(lds, (bf16_t*)(ws + WS_W_MOED), 8, (size_t)1024 * DFFE, 1024, DFFE, MapId{a.in[I_MOE_WD] + eo, 1024, 1024}, wg, nwg);
}

__global__ void __launch_bounds__(512, 2) mega(Args a) {
    extern __shared__ __attribute__((aligned(16))) unsigned char lds_raw[];
    ldsp_t lds = (ldsp_t)lds_raw;
    const int tid = my_tid(), wg = blockIdx.x, nwg = gridDim.x;
    const int lo = a.ph_lo, hi = a.ph_hi;
    unsigned char* ws = a.ws;
    volatile LAS unsigned* misc = (volatile LAS unsigned*)(lds + LDS_MISC);
    XcdBarrier bar; bar.bar = (unsigned*)(ws + WS_BAR); bar.x = 0; bar.st = misc;
    if (hi - lo > 1) { if (tid == 0) { misc[0] = 0u; misc[1] = 0u; misc[2] = 0u; misc[3] = 0u; } __syncthreads(); bar = xcd_barrier_post((unsigned*)(ws + WS_BAR), misc); }
    int ph = 0;
#ifndef PH_MASK
#define PH_MASK 0xffffffffu
#endif
#ifndef REPEAT_ID
#define REPEAT_ID (-1)
#define REPEAT_N 1
#endif
#define PH_BEGIN(ID) if (((PH_MASK >> (ID)) & 1u) && ph >= lo && ph < hi) { for (int rep_ = 0; rep_ < ((ID) == REPEAT_ID ? REPEAT_N : 1); ++rep_) {
#define PH_END   } if (ph + 1 < hi) xcd_barrier(bar); } ++ph;
    bf16_t* hb = (bf16_t*)(ws + WS_HB); bf16_t* ob = (bf16_t*)(ws + WS_OB);
    unsigned* ctl = (unsigned*)(ws + WS_CTL);

    PH_BEGIN(0) prologue_phase(lds, a, wg, nwg); PH_END

    for (int layer = 0; layer < 4; ++layer) {
        if (layer == 0) {
            PH_BEGIN(1) { pg8::Gemm g{hb, (const bf16_t*)(ws + WS_W_HGIN), NT, 4096, 1024}; pg8::StaticOrder S; S.init(NT, 4096, nwg, wg);
                EpiHgIn E{(bf16_t*)(ws + SC_HG_QS), (bf16_t*)(ws + SC_HG_VV), (bf16_t*)(ws + SC_HG_SG), (float*)(ws + SC_HG_LF), (const float*)(ws + WS_LBV)};
                pg8::gemm_phase(lds, g, S, E); } PH_END
            PH_BEGIN(2) hgrn_passA(lds, (const float*)(ws + SC_HG_LF), (const bf16_t*)(ws + SC_HG_VV), (bf16_t*)(ws + SC_HG_ST), (float*)(ws + SC_HG_DEC), wg, nwg); PH_END
            PH_BEGIN(3) hgrn_passB((bf16_t*)(ws + SC_HG_ST), (const float*)(ws + SC_HG_DEC), wg, nwg); PH_END
            PH_BEGIN(4) hgrn_passC(lds, (const bf16_t*)(ws + SC_HG_QS), (const float*)(ws + SC_HG_LF), (const bf16_t*)(ws + SC_HG_VV), (const bf16_t*)(ws + SC_HG_SG),
                                (const bf16_t*)(ws + SC_HG_ST), a.in[I_HG_NG], ob, wg, nwg); PH_END
        } else if (layer == 1) {
            PH_BEGIN(5) { pg8::Gemm g{hb, (const bf16_t*)(ws + WS_W_DAIN), NT, 3072, 1024}; pg8::StaticOrder S; S.init(NT, 3072, nwg, wg);
                EpiDaIn E{(bf16_t*)(ws + SC_DA_Q), (bf16_t*)(ws + SC_DA_K), (bf16_t*)(ws + SC_DA_V), (const f32x2*)(ws + WS_ROPE_DA)};
                pg8::gemm_phase(lds, g, S, E); } PH_END
            PH_BEGIN(6) da_attn_phase(lds, (const bf16_t*)(ws + SC_DA_Q), (const bf16_t*)(ws + SC_DA_K), (const bf16_t*)(ws + SC_DA_V), a.in[I_DA_LAM], a.in[I_DA_NG], ob, wg, nwg); PH_END
        } else if (layer == 2) {
            PH_BEGIN(8) { pg8::Gemm g{hb, (const bf16_t*)(ws + WS_W_NSAIN), NT, NSA_NPAD, 1024}; pg8::StaticOrder S; S.init(NT, NSA_NPAD, nwg, wg);
                EpiNsaIn E{(bf16_t*)(ws + SC_NSA_Q), (bf16_t*)(ws + SC_NSA_QR), (bf16_t*)(ws + SC_NSA_KV), (float*)(ws + SC_NSA_GATE), (const f32x2*)(ws + WS_ROPE_NSA)};
                pg8::gemm_phase(lds, g, S, E); } PH_END
            PH_BEGIN(9) nsa_compress_phase(lds, (const bf16_t*)(ws + SC_NSA_KV), (const bf16_t*)(ws + WS_W_CMP1), (const bf16_t*)(ws + WS_W_CMP2), (const float*)(ws + WS_CMPBIAS), (bf16_t*)(ws + SC_NSA_KC), wg, nwg); PH_END
            PH_BEGIN(10) nsa_attn_phase(lds, (const bf16_t*)(ws + SC_NSA_Q), (const bf16_t*)(ws + SC_NSA_QR), (const bf16_t*)(ws + SC_NSA_KV), (const bf16_t*)(ws + SC_NSA_KC),
                                    (const float*)(ws + SC_NSA_GATE), (float*)(ws + SC_NSA_OACC), ob, wg, nwg); PH_END
        } else {
            PH_BEGIN(11) { pg8::Gemm g{hb, (const bf16_t*)(ws + WS_W_SBIN), NT, 3072, 1024}; pg8::StaticOrder S; S.init(NT, 3072, nwg, wg);
                EpiSbIn E{(bf16_t*)(ws + SC_SB_Q)};
                pg8::gemm_phase(lds, g, S, E); } PH_END
            PH_BEGIN(12) sb_attn_phase(lds, (const bf16_t*)(ws + SC_SB_Q), (const bf16_t*)(ws + SC_SB_K), (const bf16_t*)(ws + SC_SB_V), ob, wg, nwg); PH_END
        }
        const size_t wout_off = (layer == 0) ? WS_W_HGOUT : (layer == 1) ? WS_W_DAOUT : (layer == 2) ? WS_W_NSAOUT : WS_W_SBOUT;
        PH_BEGIN(13) { pg8::Gemm g{ob, (const bf16_t*)(ws + wout_off), NT, 1024, 1024}; pg8::StaticOrder S; S.init(NT, 1024, nwg, wg);
            bf16_t* zdst = rep_ ? (bf16_t*)a.out : hb;
            if (layer == 0) { EpiRes<true> E{a.in[I_X], zdst}; pg8::gemm_phase(lds, g, S, E); }
            else { EpiRes<false> E{hb, zdst}; pg8::gemm_phase(lds, g, S, E); } } PH_END
        const int j = layer >> 1;
        unsigned* cnt = ctl + 64 * j;
        const Route* route = (const Route*)(ws + SC_MOE_ROUTE);
        PH_BEGIN(14) ln_phase(lds, hb, rep_ ? a.out : nullptr, rep_ ? nullptr : hb, a.in[I_LN_G] + (size_t)(layer * 2) * DM, a.in[I_LN_B] + (size_t)(layer * 2) * DM, nullptr, nullptr, nullptr,
                          ((layer & 1) && !rep_) ? a.in[I_MOE_WR] + (size_t)j * DM * 8 : nullptr, (Route*)(ws + SC_MOE_ROUTE), cnt, wg, nwg); PH_END
        if ((layer & 1) == 0) {
            PH_BEGIN(15) { pg8::Gemm g{hb, (const bf16_t*)(ws + WS_W_FFNGU) + (size_t)j * 5632 * 1024, NT, 5632, 1024}; pg8::StaticOrder S; S.init(NT, 5632, nwg, wg);
                EpiSwiglu E{(bf16_t*)(ws + SC_FF_ACT), DFF, 22};
                pg8::gemm_phase(lds, g, S, E); } PH_END
            PH_BEGIN(16) { pg8::Gemm g{(const bf16_t*)(ws + SC_FF_ACT), (const bf16_t*)(ws + WS_W_FFND) + (size_t)j * 1024 * DFF, NT, 1024, DFF}; pg8::StaticOrder S; S.init(NT, 1024, nwg, wg);
                EpiRes<false> E{hb, rep_ ? (bf16_t*)a.out : hb};
                pg8::gemm_phase(lds, g, S, E); } PH_END
            PH_BEGIN(17) ln_phase(lds, hb, (layer == 3 || rep_) ? a.out : nullptr, rep_ ? nullptr : hb, a.in[I_LN_G] + (size_t)(layer * 2 + 1) * DM, a.in[I_LN_B] + (size_t)(layer * 2 + 1) * DM, nullptr, nullptr, nullptr,
                              nullptr, nullptr, nullptr, wg, nwg); PH_END
        } else {
            PH_BEGIN(18) moe_convert_phase(lds, a, j, wg, nwg);
                         moe_build_table(lds, (int*)(ws + SC_MOE_XS), route, cnt, wg, nwg); PH_END
            for (int ck = 0; ck < 2; ++ck) {
                int seg_tile[8], nT_, tile_lo_ = ck * MOE_CHUNK_TILES;
                { int s_ = 0;
#pragma unroll
                  for (int e = 0; e < 8; ++e) { seg_tile[e] = s_ >> 8; s_ += (int)((cnt[e] + 255u) & ~255u); }
                  int nt_all = s_ >> 8; int t_hi = tile_lo_ + MOE_CHUNK_TILES; if (t_hi > nt_all) t_hi = nt_all; nT_ = t_hi - tile_lo_; }
                PH_BEGIN(19) { MoeOrderT<true> MO; MO.G = nwg; MO.c = wg; MO.tile_lo = tile_lo_; MO.nT = nT_; MO.nNt = 28; MO.tok = (const int*)(ws + SC_MOE_XS);
#pragma unroll
                    for (int e = 0; e < 8; ++e) MO.seg_tile[e] = seg_tile[e];
                    pg8::Gemm g{hb, (const bf16_t*)(ws + WS_W_MOEGU), MOE_CHUNK_ROWS, 7168, 1024};
                    EpiSwiglu E{(bf16_t*)(ws + SC_MOE_ACT), DFFE, 28};
                    pg8::gemm_phase(lds, g, MO, E); } PH_END
                PH_BEGIN(20) { MoeOrderT<false> MO; MO.G = nwg; MO.c = wg; MO.tile_lo = tile_lo_; MO.nT = nT_; MO.nNt = 4; MO.tok = nullptr;
#pragma unroll
                    for (int e = 0; e < 8; ++e) MO.seg_tile[e] = seg_tile[e];
                    pg8::Gemm g{(const bf16_t*)(ws + SC_MOE_ACT), (const bf16_t*)(ws + WS_W_MOED), MOE_CHUNK_ROWS, 1024, DFFE};
                    EpiMoeDown E{(bf16_t*)(ws + SC_MOE_Y) + (size_t)ck * MOE_CHUNK_ROWS * DM};
                    const int nu_ = nT_ > 0 ? nT_ * 4 : 0, nfull_ = nu_ / nwg, ntail_ = nu_ - nfull_ * nwg;
                    const bool stail_ = (ntail_ > 0 && ntail_ <= 16 && nwg == 256);
                    if (stail_) MO.imax = nfull_;
                    pg8::gemm_phase(lds, g, MO, E);
                    if (stail_) { __syncthreads();
                        const int j_ = wg >> 3, uidx_ = (wg & 7) + 8 * (j_ >> 4), sub_ = j_ & 15;
                        if (uidx_ < ntail_) { pg8::Unit u_; MO.at((long)nfull_ * nwg + uidx_, u_); moe_down_sub(lds, g.A, g.Bt, u_, sub_ >> 2, sub_ & 3, E.y); } } } PH_END
            }
            PH_BEGIN(21) ln_phase(lds, hb, (layer == 3 || rep_) ? a.out : nullptr, rep_ ? nullptr : hb, a.in[I_LN_G] + (size_t)(layer * 2 + 1) * DM, a.in[I_LN_B] + (size_t)(layer * 2 + 1) * DM,
                              route, (const bf16_t*)(ws + SC_MOE_Y), cnt, nullptr, nullptr, nullptr, wg, nwg); PH_END
        }
    }
#undef PH_BEGIN
#undef PH_END
}
constexpr int NPHASES = 38;

#ifdef DBG_REPORT
__global__ void dbg_stats(const void* buf, size_t n, int isbf, float* acc, int slot) {
    float bad = 0.f, ss = 0.f;
    for (size_t i = (size_t)blockIdx.x * blockDim.x + threadIdx.x; i < n; i += (size_t)gridDim.x * blockDim.x) {
        const float v = isbf ? bf2f(((const bf16_t*)buf)[i]) : ((const float*)buf)[i];
        if (!(fabsf(v) < 3e38f)) bad += 1.f; else ss += v * v; }
    bad = wave_sum(bad); ss = wave_sum(ss);
    if ((threadIdx.x & 63) == 0) { atomicAdd(acc + 2 * slot, bad); atomicAdd(acc + 2 * slot + 1, ss); }
}
__global__ void dbg_write(const float* acc, int nslot, float* out, size_t nout) {
    float code = 1.f;
    for (int k = 0; k < nslot; ++k) if (acc[2 * k] > 0.f) code += (float)(1 << k);
    const float c = 10.f * code;
    for (size_t i = (size_t)blockIdx.x * blockDim.x + threadIdx.x; i < nout; i += (size_t)gridDim.x * blockDim.x) out[i] = c;
}
#endif
extern "C" void kernel_launch(void* const* d_in, const int* in_sizes, int n_in, void* d_out, int out_size, void* d_ws, size_t ws_size, hipStream_t stream) {
    static int grid = 0;
    if (grid == 0) {
        if (n_in != 25 || out_size != NT * DM || ws_size < WS_END) { fprintf(stderr, "kernel_launch: unexpected shapes / workspace (%d inputs, out %d, ws %zu < %zu)\n", n_in, out_size, ws_size, (size_t)WS_END); grid = -1; return; }
        int dev = 0, cus = 0;
        if (hipGetDevice(&dev) != hipSuccess || hipDeviceGetAttribute(&cus, hipDeviceAttributeMultiprocessorCount, dev) != hipSuccess) { grid = -1; return; }
        if (hipFuncSetAttribute((const void*)mega, hipFuncAttributeMaxDynamicSharedMemorySize, LDS_BYTES) != hipSuccess) { fprintf(stderr, "kernel_launch: hipFuncSetAttribute failed\n"); grid = -1; return; }
        int per_cu = 0;
        if (hipOccupancyMaxActiveBlocksPerMultiprocessor(&per_cu, (const void*)mega, 512, LDS_BYTES) != hipSuccess || per_cu < 1) { fprintf(stderr, "kernel_launch: occupancy query says %d blocks per CU\n", per_cu); }
        (void)hipGetLastError();
        grid = cus;
    }
    if (grid < 0) return;
    (void)hipMemsetAsync((char*)d_ws, 0, WS_ZERO_BYTES, stream);
    Args a{};
    for (int i = 0; i < 25; ++i) a.in[i] = (const float*)d_in[i];
    a.out = (float*)d_out; a.ws = (unsigned char*)d_ws;
#if MK_FUSED
    a.ph_lo = 0; a.ph_hi = NPHASES;
    hipLaunchKernelGGL(mega, dim3(grid), dim3(512), LDS_BYTES, stream, a);
#else
#ifndef DBG_NPH
#define DBG_NPH NPHASES
#endif
    for (int p = 0; p < DBG_NPH; ++p) { a.ph_lo = p; a.ph_hi = p + 1; hipLaunchKernelGGL(mega, dim3(grid), dim3(512), LDS_BYTES, stream, a); }
#ifdef DBG_REPORT
    { float* acc = (float*)((char*)d_ws + WS_CTL + 2048); char* w = (char*)d_ws;
      hipLaunchKernelGGL(dbg_stats, dim3(1024), dim3(256), 0, stream, (const void*)(w + SC_HG_VV), (size_t)NT * DM, 1, acc, 0);
      hipLaunchKernelGGL(dbg_stats, dim3(1024), dim3(256), 0, stream, (const void*)(w + SC_HG_ST), (size_t)4096 * 128 * 128, 1, acc, 1);
      hipLaunchKernelGGL(dbg_stats, dim3(1024), dim3(256), 0, stream, (const void*)(w + SC_HG_SG), (size_t)NT * DM, 1, acc, 2);
      hipLaunchKernelGGL(dbg_stats, dim3(1024), dim3(256), 0, stream, (const void*)(w + SC_HG_LF), (size_t)NT * DM, 0, acc, 3);
      hipLaunchKernelGGL(dbg_write, dim3(1024), dim3(256), 0, stream, (const float*)acc, 4, (float*)d_out, (size_t)NT * DM); }
#endif
#endif
}
```

```cpp
#include <hip/hip_runtime.h>
#include <stdint.h>
#include <stdio.h>

#ifndef MK_FUSED
#define MK_FUSED 1
#endif


#define LAS __attribute__((address_space(3)))
typedef unsigned short bf16_t;
typedef short bf16x8 __attribute__((ext_vector_type(8)));
typedef short s16x4 __attribute__((ext_vector_type(4)));
typedef float f32x2 __attribute__((ext_vector_type(2)));
typedef float f32x4 __attribute__((ext_vector_type(4)));
typedef float f32x16 __attribute__((ext_vector_type(16)));
typedef unsigned u32x2 __attribute__((ext_vector_type(2)));
typedef unsigned u32x4 __attribute__((ext_vector_type(4)));
typedef LAS unsigned char* ldsp_t;

constexpr int DM = 1024, NB = 4, SEQ = 8192, NT = NB * SEQ, NHEAD = 8, HDIM = 128;
constexpr int DFF = 2816, NEXP = 8, DFFE = 3584;
constexpr float ALPHA = 1.681792830507429f;
constexpr float LN_EPS = 1e-5f;
constexpr int NSA_NPAD = 2816;
constexpr int NCMP = 511, NCMP_P = 512;
constexpr int MOE_TILES_MAX = 264, MOE_CHUNK_TILES = 132, MOE_ROWS_MAX = MOE_TILES_MAX * 256, MOE_CHUNK_ROWS = MOE_CHUNK_TILES * 256;

constexpr size_t al256(size_t x) { return (x + 255) & ~(size_t)255; }
constexpr size_t WS_BAR = 0;
constexpr size_t WS_CTL = 16384;
constexpr size_t WS_ZERO_BYTES = 16384 + 4096;
constexpr size_t WS_SMALL = WS_ZERO_BYTES;
constexpr size_t WS_LBV = WS_SMALL;
constexpr size_t WS_CMPBIAS = WS_LBV + 4096;
constexpr size_t WS_ROPE_DA = WS_CMPBIAS + 32768;
constexpr size_t WS_ROPE_NSA = WS_ROPE_DA + (size_t)SEQ * 32 * 8;
constexpr size_t WS_HB = al256(WS_ROPE_NSA + (size_t)SEQ * 64 * 8);
constexpr size_t WS_OB = WS_HB + (size_t)NT * DM * 2;
constexpr size_t WS_W_HGIN = WS_OB + (size_t)NT * DM * 2;
constexpr size_t WS_W_HGOUT = WS_W_HGIN + (size_t)4096 * 1024 * 2;
constexpr size_t WS_W_DAIN = WS_W_HGOUT + (size_t)1024 * 1024 * 2;
constexpr size_t WS_W_DAOUT = WS_W_DAIN + (size_t)3072 * 1024 * 2;
constexpr size_t WS_W_NSAIN = WS_W_DAOUT + (size_t)1024 * 1024 * 2;
constexpr size_t WS_W_NSAOUT = WS_W_NSAIN + (size_t)NSA_NPAD * 1024 * 2;
constexpr size_t WS_W_SBIN = WS_W_NSAOUT + (size_t)1024 * 1024 * 2;
constexpr size_t WS_W_SBOUT = WS_W_SBIN + (size_t)3072 * 1024 * 2;
constexpr size_t WS_W_FFNGU = WS_W_SBOUT + (size_t)1024 * 1024 * 2;
constexpr size_t WS_W_FFND = WS_W_FFNGU + (size_t)2 * 5632 * 1024 * 2;
constexpr size_t WS_W_CMP1 = WS_W_FFND + (size_t)2 * 1024 * 2816 * 2;
constexpr size_t WS_W_CMP2 = WS_W_CMP1 + (size_t)2 * 128 * 4096 * 2;
constexpr size_t WS_W_MOEGU = WS_W_CMP2 + (size_t)2 * 128 * 128 * 2;
constexpr size_t WS_W_MOED = WS_W_MOEGU + (size_t)8 * 7168 * 1024 * 2;
constexpr size_t WS_SCR = al256(WS_W_MOED + (size_t)8 * 1024 * 3584 * 2);
constexpr size_t SC_HG_QS = WS_SCR;
constexpr size_t SC_HG_VV = SC_HG_QS + (size_t)NT * DM * 2;
constexpr size_t SC_HG_SG = SC_HG_VV + (size_t)NT * DM * 2;
constexpr size_t SC_HG_LF = SC_HG_SG + (size_t)NT * DM * 2;
constexpr size_t SC_HG_ST = SC_HG_LF + (size_t)NT * DM * 4;
constexpr size_t SC_HG_DEC = SC_HG_ST + (size_t)4096 * 128 * 128 * 2;
constexpr size_t SC_HG_END = SC_HG_DEC + (size_t)4096 * 128 * 4;
constexpr size_t SC_FF_ACT = WS_SCR;
constexpr size_t SC_FF_END = SC_FF_ACT + (size_t)NT * DFF * 2;
constexpr size_t SC_DA_Q = WS_SCR;
constexpr size_t SC_DA_K = SC_DA_Q + (size_t)NT * DM * 2;
constexpr size_t SC_DA_V = SC_DA_K + (size_t)NT * DM * 2;
constexpr size_t SC_DA_END = SC_DA_V + (size_t)NT * DM * 2;
constexpr size_t SC_MOE_ROUTE = WS_SCR;
constexpr size_t SC_MOE_XS = SC_MOE_ROUTE + (size_t)NT * 32;
constexpr size_t SC_MOE_ACT = SC_MOE_XS + al256((size_t)MOE_ROWS_MAX * 4);
constexpr size_t SC_MOE_Y = SC_MOE_ACT + (size_t)MOE_CHUNK_ROWS * DFFE * 2;
constexpr size_t SC_MOE_END = SC_MOE_Y + (size_t)MOE_ROWS_MAX * DM * 2;
constexpr size_t SC_NSA_Q = WS_SCR;
constexpr size_t SC_NSA_QR = SC_NSA_Q + (size_t)NT * DM * 2;
constexpr size_t SC_NSA_KV = SC_NSA_QR + (size_t)NT * DM * 2;
constexpr size_t SC_NSA_GATE = SC_NSA_KV + (size_t)6 * NT * 256 * 2;
constexpr size_t SC_NSA_KC = SC_NSA_GATE + (size_t)NT * 24 * 4;
constexpr size_t SC_NSA_OACC = SC_NSA_KC + (size_t)2 * 8 * NCMP_P * 128 * 2;
constexpr size_t SC_NSA_END = SC_NSA_OACC + (size_t)NT * DM * 4;
constexpr size_t SC_SB_Q = WS_SCR;
constexpr size_t SC_SB_K = SC_SB_Q + (size_t)NT * DM * 2;
constexpr size_t SC_SB_V = SC_SB_K + (size_t)NT * DM * 2;
constexpr size_t SC_SB_END = SC_SB_V + (size_t)NT * DM * 2;
constexpr size_t cmax(size_t a, size_t b) { return a > b ? a : b; }
constexpr size_t WS_END = cmax(cmax(cmax(SC_HG_END, SC_FF_END), cmax(SC_DA_END, SC_MOE_END)), cmax(SC_NSA_END, SC_SB_END));
static_assert(WS_END <= (size_t)981882880, "workspace budget (sum of the inputs)");

constexpr int LDS_BYTES = 152 * 1024;
constexpr int LDS_MISC = 150 * 1024;

__device__ __forceinline__ unsigned bf16_rne_bits(float f) { const unsigned u = __float_as_uint(f); return (u + 0x7fffu + ((u >> 16) & 1u)) >> 16; }
__device__ __forceinline__ unsigned cvtpk(float lo, float hi) {
    typedef __bf16 bf2_t __attribute__((ext_vector_type(2)));
    typedef float f2_t __attribute__((ext_vector_type(2)));
    const bf2_t r = __builtin_convertvector((f2_t){lo, hi}, bf2_t);
    return __builtin_bit_cast(unsigned, r);
}
__device__ __forceinline__ float bf2f(bf16_t b) { return __uint_as_float(((unsigned)b) << 16); }
__device__ __forceinline__ bf16_t f2bf(float f) { return (bf16_t)(cvtpk(f, 0.f) & 0xffffu); }
__device__ __forceinline__ bf16x8 pack8(f32x4 a, f32x4 b) { u32x4 w = {cvtpk(a[0], a[1]), cvtpk(a[2], a[3]), cvtpk(b[0], b[1]), cvtpk(b[2], b[3])}; return *reinterpret_cast<bf16x8*>(&w); }
__device__ __forceinline__ float sigmoidf_(float x) { return __builtin_amdgcn_rcpf(1.f + __expf(-x)); }
__device__ __forceinline__ float siluf_(float x) { return x * __builtin_amdgcn_rcpf(1.f + __expf(-x)); }
__device__ __forceinline__ int my_tid() { int t = threadIdx.x; asm volatile("" : "+v"(t)); return t; }
template <int CTRL> __device__ __forceinline__ int dpp_i(int v) { return __builtin_amdgcn_update_dpp(v, v, CTRL, 0xf, 0xf, false); }
template <int CTRL> __device__ __forceinline__ float dpp_f(float v) { return __int_as_float(__builtin_amdgcn_update_dpp(__float_as_int(v), __float_as_int(v), CTRL, 0xf, 0xf, false)); }
__device__ __forceinline__ float lane_xor1(float v) { return dpp_f<0xB1>(v); }
__device__ __forceinline__ float lane_xor2(float v) { return dpp_f<0x4E>(v); }
__device__ __forceinline__ float sum_rows16(float v) { auto rr = __builtin_amdgcn_permlane16_swap(__float_as_uint(v), __float_as_uint(v), false, false); return __uint_as_float(rr[0]) + __uint_as_float(rr[1]); }
__device__ __forceinline__ float sum_halves32(float v) { auto rr = __builtin_amdgcn_permlane32_swap(__float_as_uint(v), __float_as_uint(v), false, false); return __uint_as_float(rr[0]) + __uint_as_float(rr[1]); }
__device__ __forceinline__ float other_half32(float v, int hi) { auto rr = __builtin_amdgcn_permlane32_swap(__float_as_uint(v), __float_as_uint(v), false, false); return __uint_as_float(hi ? rr[0] : rr[1]); }
__device__ __forceinline__ float row16_sum(float v) { v += dpp_f<0xB1>(v); v += dpp_f<0x4E>(v); v += dpp_f<0x141>(v); v += dpp_f<0x140>(v); return v; }
__device__ __forceinline__ float wave_sum(float v) { return sum_halves32(sum_rows16(row16_sum(v))); }

#define XB_TMO      128
#define XB_XCNT(j)  (256  + 64 * (j))
#define XB_XSUB(j)  (1280 + 64 * (j))
#define XB_XGEN(j)  (2304 + 64 * (j))
#define XB_TOP      3328
#define XB_TOPGEN   3392
#define XCD_BAR_WORDS 3456
#define XB_SPIN_CAP (1u << 18)
__device__ __forceinline__ unsigned xb_ld(unsigned* p)              { return __hip_atomic_load(p, __ATOMIC_RELAXED, __HIP_MEMORY_SCOPE_AGENT); }
__device__ __forceinline__ unsigned xb_add(unsigned* p, unsigned v) { return __hip_atomic_fetch_add(p, v, __ATOMIC_RELAXED, __HIP_MEMORY_SCOPE_AGENT); }
__device__ __forceinline__ unsigned xb_xcc_id() { return (unsigned)__builtin_amdgcn_s_getreg((3 << 11) | 20) & 0xFu; }
#define XB_SPIN(cond, bar) do { unsigned _sp = 0; while (cond) { __builtin_amdgcn_s_sleep(1); \
    if ((++_sp & 255u) == 0u) { if (xb_ld(&(bar)[XB_TMO])) break; if (_sp > XB_SPIN_CAP) { atomicAdd(&(bar)[XB_TMO], 1u); break; } } } } while (0)
struct XcdBarrier { unsigned* bar; unsigned x; volatile LAS unsigned* st; };
__device__ __forceinline__ XcdBarrier xcd_barrier_post(unsigned* bar, volatile LAS unsigned* st) {
    XcdBarrier b; b.bar = bar; b.x = xb_xcc_id(); b.st = st;
    if (threadIdx.x == 0) (void)xb_add(&bar[XB_XCNT(b.x)], 1u);
    return b;
}
__device__ __forceinline__ void xcd_barrier_complete(unsigned* bar, unsigned x, unsigned& nloc, unsigned& nx) {
    const unsigned G = gridDim.x * gridDim.y * gridDim.z;
    unsigned sum, cnt, mine, sp = 0u;
    for (;;) {
        sum = 0u; cnt = 0u; mine = 0u;
#pragma unroll
        for (unsigned j = 0; j < 16; ++j) { const unsigned c = xb_ld(&bar[XB_XCNT(j)]); sum += c; cnt += (c > 0u) ? 1u : 0u; mine = (j == x) ? c : mine; }
        if (sum == G) break;
        __builtin_amdgcn_s_sleep(1);
        if ((++sp & 255u) == 0u) { if (xb_ld(&bar[XB_TMO])) break; if (sp > XB_SPIN_CAP) { atomicAdd(&bar[XB_TMO], 1u); break; } }
    }
    nloc = mine > 0u ? mine : 1u; nx = cnt > 0u ? cnt : 1u;
}
__device__ __forceinline__ void xcd_barrier(const XcdBarrier& b) {
    asm volatile("s_waitcnt vmcnt(0)" ::: "memory");
    __syncthreads();
    if (threadIdx.x == 0) {
        unsigned* bar = b.bar;
        __builtin_amdgcn_s_waitcnt(0);
        unsigned nloc = b.st[0], nx = b.st[1];
        if (nloc == 0u) { xcd_barrier_complete(bar, b.x, nloc, nx); b.st[0] = nloc; b.st[1] = nx; }
        const unsigned old = xb_add(&bar[XB_XSUB(b.x)], 1u);
        const unsigned gen = old / nloc;
        if (old + 1u == (gen + 1u) * nloc) {
            __builtin_amdgcn_fence(__ATOMIC_RELEASE, "agent");
            asm volatile("s_waitcnt vmcnt(0)" ::: "memory");
            const unsigned og = xb_add(&bar[XB_TOP], 1u);
            const unsigned tg = og / nx;
            if (og + 1u == (tg + 1u) * nx) xb_add(&bar[XB_TOPGEN], 1u);
            else XB_SPIN(xb_ld(&bar[XB_TOPGEN]) == tg, bar);
            __builtin_amdgcn_fence(__ATOMIC_ACQUIRE, "agent");
            xb_add(&bar[XB_XGEN(b.x)], 1u);
            asm volatile("s_waitcnt vmcnt(0)" ::: "memory");
        } else {
            XB_SPIN(xb_ld(&bar[XB_XGEN(b.x)]) == gen, bar);
            __builtin_amdgcn_fence(__ATOMIC_ACQUIRE, "agent");
            asm volatile("s_waitcnt vmcnt(0)" ::: "memory");
        }
    }
    __syncthreads();
}

namespace pg8 {
constexpr int BM = 256, BK = 64, HALF = 128, HTB = HALF * BK * 2, STAGE_BYTES = 8 * HTB, NXCD = 8, WGM = 8;
__host__ __device__ __forceinline__ int lds_byte(int r, int c) { const int st = (r >> 4) * 2 + (c >> 5), rr = r & 15, cc = c & 31, ob = rr * 64 + cc * 2; return st * 1024 + (ob ^ (((ob >> 9) & 1) << 5)); }
__host__ __device__ __forceinline__ void stage_rc(int b, int& R, int& C) { const int st = b / 1024, sb = b % 1024, swz = sb ^ (((sb >> 9) & 1) << 5); R = (st >> 1) * 16 + swz / 64; C = (st & 1) * 32 + (swz % 64) / 2; }
__host__ __device__ __forceinline__ int perm32(int rho) { const int n = rho >> 4, i = rho & 15; return 8 * (i >> 2) + 4 * n + (i & 3); }
struct Unit { int pm, pn; };
struct Gemm { const bf16_t* A; const bf16_t* Bt; int M, N, K; };
struct StaticOrder {
    static constexpr bool GATHER = false; static constexpr int tile_lo = 0;
    __device__ __forceinline__ int row_token(int) const { return 0; }
    int nM, nN, nwg, G, c;
    __device__ void init(int M, int N, int G_, int c_) { nM = M / BM; nN = N / BM; nwg = nM * nN; G = G_; c = c_; }
    __device__ bool next(int i, Unit& u) const {
        const long L = (long)i * G + c; if (L >= nwg) return false;
        int wgid = (int)L; { const int q = nwg / NXCD, r = nwg % NXCD, xcd = wgid % NXCD, off = wgid / NXCD; wgid = (xcd < r ? xcd * (q + 1) : r * (q + 1) + (xcd - r) * q) + off; }
        const int nig = WGM * nN, gid = wgid / nig, fm = gid * WGM, gsz = (nM - fm) < WGM ? (nM - fm) : WGM;
        u.pm = fm + ((wgid % nig) % gsz); u.pn = (wgid % nig) / gsz; return true;
    }
};
template <class Epi, class Sched>
__device__ __forceinline__ void gemm_phase(ldsp_t lds, const Gemm g, const Sched& S, const Epi& E) {
    constexpr bool GA = Sched::GATHER;
    const int tid = my_tid(), wid = __builtin_amdgcn_readfirstlane(tid >> 6), lane = tid & 63, wr = wid >> 2, wc = wid & 3, fr = lane & 15, fq = lane >> 4;
    const int K = g.K, nt = K / BK;
    unsigned voffA[2], voffB[2]; int Rr[2]; unsigned Cc2[2];
#pragma unroll
    for (int i = 0; i < 2; ++i) { int R, C; stage_rc(tid * 16 + i * 8192, R, C); const int Rb = (R & ~31) + perm32(R & 31);
        voffA[i] = (unsigned)(R * K + C) * 2u; voffB[i] = (unsigned)(Rb * K + C) * 2u; Rr[i] = R; Cc2[i] = (unsigned)C * 2u; }
    LAS int* gtab = (LAS int*)(lds + STAGE_BYTES);
    if (GA) { Unit u_; for (int i = 0; S.next(i, u_); ++i) { if (tid < 256) gtab[i * 256 + tid] = S.row_token((S.tile_lo + u_.pm) * 256 + tid); }
        __syncthreads(); }
    unsigned vC[2][2], vN[2][2], vX[2][2];
#define PG8_LOADV(V, UI) do { _Pragma("unroll") for (int h_ = 0; h_ < 2; ++h_) _Pragma("unroll") for (int i_ = 0; i_ < 2; ++i_) \
        V[h_][i_] = (unsigned)gtab[(UI) * 256 + h_ * 128 + Rr[i_]] * (unsigned)(K * 2) + Cc2[i_]; } while (0)
    const size_t kstep = (size_t)(BK * 2);
    const size_t hstep = (size_t)HALF * K * 2;
    const size_t tstep = 2 * hstep;
    const unsigned ldsw = (unsigned)wid * 1024u;
    const int aoff = lds_byte(wr * 64 + fr, fq * 8), boff = lds_byte(wc * 32 + fr, fq * 8);
#define PG8_SA(b, h) (((b) * 2 + (h)) * HTB)
#define PG8_SB(b, h) ((4 + (b) * 2 + (h)) * HTB)
#define PG8_STAGE(bufoff, gbase, voff) do { _Pragma("unroll") for (int _i = 0; _i < 2; ++_i) \
        __builtin_amdgcn_global_load_lds((const unsigned*)((const char*)(gbase) + (voff)[_i]), (LAS unsigned*)(lds + (bufoff) + ldsw + _i * 8192), 16, 0, 0); } while (0)
#define PG8_STAGE_A(bufoff, gbase, H, V) do { _Pragma("unroll") for (int _i = 0; _i < 2; ++_i) \
        __builtin_amdgcn_global_load_lds((const unsigned*)((const char*)(gbase) + (GA ? (size_t)0 : (size_t)(H) * hstep) + (GA ? (V)[H][_i] : voffA[_i])), (LAS unsigned*)(lds + (bufoff) + ldsw + _i * 8192), 16, 0, 0); } while (0)
#define PG8_LDA(dst, b, h) do { _Pragma("unroll") for (int m = 0; m < 4; ++m) _Pragma("unroll") for (int k = 0; k < 2; ++k) dst[m][k] = *(const LAS bf16x8*)(lds + PG8_SA(b, h) + aoff + m * 2048 + k * 1024); } while (0)
#define PG8_LDB(dst, b, h) do { _Pragma("unroll") for (int n = 0; n < 2; ++n) _Pragma("unroll") for (int k = 0; k < 2; ++k) dst[n][k] = *(const LAS bf16x8*)(lds + PG8_SB(b, h) + boff + n * 2048 + k * 1024); } while (0)
#define PG8_MMA(ai, bj, At, Bt) do { __builtin_amdgcn_s_setprio(1); _Pragma("unroll") for (int m = 0; m < 4; ++m) _Pragma("unroll") for (int n = 0; n < 2; ++n) _Pragma("unroll") for (int k = 0; k < 2; ++k) \
        acc[ai][bj][m][n] = __builtin_amdgcn_mfma_f32_16x16x32_bf16(Bt[n][k], At[m][k], acc[ai][bj][m][n], 0, 0, 0); __builtin_amdgcn_s_setprio(0); } while (0)
#define PG8_WAIT_V(n) asm volatile("s_waitcnt vmcnt(" #n ")" ::: "memory")
#define PG8_WAIT_L(n) asm volatile("s_waitcnt lgkmcnt(" #n ")" ::: "memory")
#define PG8_BAR __builtin_amdgcn_s_barrier()
#define PG8_SCHED __builtin_amdgcn_sched_barrier(0)
    Unit cur, nxt; int ui = 0;
    if (!S.next(0, cur)) return;
    f32x4 acc[2][2][4][2];
#pragma unroll
    for (int a = 0; a < 2; ++a)
#pragma unroll
        for (int b = 0; b < 2; ++b)
#pragma unroll
            for (int m = 0; m < 4; ++m)
#pragma unroll
                for (int n = 0; n < 2; ++n) acc[a][b][m][n] = (f32x4){0.f, 0.f, 0.f, 0.f};
    bf16x8 At[4][2], B0[2][2], B1[2][2];
    const char* cA = (const char*)g.A + (GA ? (size_t)0 : (size_t)cur.pm * tstep); const char* cB = (const char*)g.Bt + (size_t)cur.pn * tstep;
    if (GA) { PG8_LOADV(vC, 0); }
    PG8_STAGE(PG8_SB(0, 0), cB, voffB); PG8_STAGE(PG8_SB(0, 1), cB + hstep, voffB); PG8_STAGE_A(PG8_SA(0, 0), cA, 0, vC); PG8_STAGE_A(PG8_SA(0, 1), cA, 1, vC);
    if (wr == 1) PG8_BAR;
    PG8_WAIT_V(2); PG8_BAR;
    PG8_STAGE(PG8_SB(1, 0), cB + kstep, voffB); PG8_STAGE_A(PG8_SA(1, 0), cA + kstep, 0, vC); PG8_STAGE(PG8_SB(1, 1), cB + hstep + kstep, voffB);
    PG8_WAIT_V(6); PG8_BAR;
    for (;;) {
        const bool has_next = S.next(ui + 1, nxt);
        const char* nA = (has_next && !GA) ? (const char*)g.A + (size_t)nxt.pm * tstep : cA; const char* nB = has_next ? (const char*)g.Bt + (size_t)nxt.pn * tstep : cB;
        if (GA) { if (has_next) { PG8_LOADV(vN, ui + 1); } else {
#pragma unroll
            for (int h_ = 0; h_ < 2; ++h_)
#pragma unroll
                for (int i_ = 0; i_ < 2; ++i_) vN[h_][i_] = vC[h_][i_]; } }
        for (int t = 0; t < nt; t += 2) {
            const bool last = (t == nt - 2);
            if (GA) {
#pragma unroll
                for (int h_ = 0; h_ < 2; ++h_)
#pragma unroll
                    for (int i_ = 0; i_ < 2; ++i_) vX[h_][i_] = last ? vN[h_][i_] : vC[h_][i_]; }
            const char* a1 = cA + (size_t)(t + 1) * kstep;
            const char* a2 = last ? nA : cA + (size_t)(t + 2) * kstep; const char* b2 = last ? nB : cB + (size_t)(t + 2) * kstep;
            const char* a3 = a2 + kstep; const char* b3 = b2 + kstep;
            PG8_LDB(B0, 0, 0); PG8_LDB(B1, 0, 1); PG8_SCHED; PG8_LDA(At, 0, 0); PG8_STAGE_A(PG8_SA(1, 1), a1, 1, vC);
            PG8_WAIT_V(8); PG8_WAIT_L(0); PG8_BAR; PG8_MMA(0, 0, At, B0); PG8_MMA(0, 1, At, B1); PG8_BAR; PG8_SCHED;
            PG8_LDA(At, 0, 1); PG8_STAGE(PG8_SB(0, 0), b2, voffB); PG8_STAGE(PG8_SB(0, 1), b2 + hstep, voffB); PG8_STAGE_A(PG8_SA(0, 0), a2, 0, vX);
            PG8_WAIT_V(8); PG8_WAIT_L(0); PG8_BAR; PG8_MMA(1, 0, At, B0); PG8_MMA(1, 1, At, B1); PG8_BAR; PG8_SCHED;
            PG8_LDB(B0, 1, 0); PG8_LDB(B1, 1, 1); PG8_SCHED; PG8_LDA(At, 1, 0); PG8_STAGE_A(PG8_SA(0, 1), a2, 1, vX);
            PG8_WAIT_V(8); PG8_WAIT_L(0); PG8_BAR; PG8_MMA(0, 0, At, B0); PG8_MMA(0, 1, At, B1); PG8_BAR; PG8_SCHED;
            PG8_LDA(At, 1, 1); PG8_STAGE(PG8_SB(1, 0), b3, voffB); PG8_STAGE(PG8_SB(1, 1), b3 + hstep, voffB); PG8_STAGE_A(PG8_SA(1, 0), a3, 0, vX);
            PG8_WAIT_V(8); PG8_WAIT_L(0); PG8_BAR; PG8_MMA(1, 0, At, B0); PG8_MMA(1, 1, At, B1); PG8_BAR; PG8_SCHED;
        }
        if (wr == 0) PG8_BAR;
        E(acc, cur, wr, wc, fr, fq);
        if (!has_next) break;
#pragma unroll
        for (int a = 0; a < 2; ++a)
#pragma unroll
            for (int b = 0; b < 2; ++b)
#pragma unroll
                for (int m = 0; m < 4; ++m)
#pragma unroll
                    for (int n = 0; n < 2; ++n) acc[a][b][m][n] = (f32x4){0.f, 0.f, 0.f, 0.f};
        cur = nxt; cA = nA; cB = nB; ++ui;
        if (GA) {
#pragma unroll
            for (int h_ = 0; h_ < 2; ++h_)
#pragma unroll
                for (int i_ = 0; i_ < 2; ++i_) vC[h_][i_] = vN[h_][i_]; }
        if (wr == 1) PG8_BAR;
    }
    PG8_WAIT_V(0);
    PG8_BAR;
#undef PG8_SA
#undef PG8_SB
#undef PG8_STAGE
#undef PG8_STAGE_A
#undef PG8_LOADV
#undef PG8_LDA
#undef PG8_LDB
#undef PG8_MMA
#undef PG8_WAIT_V
#undef PG8_WAIT_L
#undef PG8_BAR
#undef PG8_SCHED
}
}
using pg8::Unit;
typedef f32x4 acc_t[2][2][4][2];
#define EPI_BEGIN \
    _Pragma("unroll") for (int ai = 0; ai < 2; ++ai) _Pragma("unroll") for (int m = 0; m < 4; ++m) _Pragma("unroll") for (int bj = 0; bj < 2; ++bj) { \
        const int row = u.pm * 256 + ai * 128 + wr * 64 + m * 16 + fr; const int col = u.pn * 256 + bj * 128 + wc * 32 + 8 * fq; \
        const f32x4 v0 = acc[ai][bj][m][0], v1 = acc[ai][bj][m][1];
#define EPI_END if (bj == 1 && (m & 1)) asm volatile("" ::: "memory"); }

template <bool RES_F32>
struct EpiRes {
    const void* res; bf16_t* out;
    __device__ __forceinline__ void operator()(const acc_t& acc, const Unit& u, int wr, int wc, int fr, int fq) const {
        asm volatile("" : "+v"(fr), "+v"(fq));
        constexpr int MB = RES_F32 ? 2 : 4;
#pragma unroll
        for (int ai = 0; ai < 2; ++ai)
#pragma unroll
            for (int mp = 0; mp < 4 / MB; ++mp) {
                f32x4 rf[MB][2][2]; u32x4 rb[MB][2];
#pragma unroll
                for (int mm = 0; mm < MB; ++mm)
#pragma unroll
                    for (int bj = 0; bj < 2; ++bj) { const size_t o = (size_t)(u.pm * 256 + ai * 128 + wr * 64 + (MB * mp + mm) * 16 + fr) * DM + u.pn * 256 + bj * 128 + wc * 32 + 8 * fq;
                        if (RES_F32) { rf[mm][bj][0] = *(const f32x4*)((const float*)res + o); rf[mm][bj][1] = *(const f32x4*)((const float*)res + o + 4); }
                        else rb[mm][bj] = *(const u32x4*)((const bf16_t*)res + o); }
#pragma unroll
                for (int mm = 0; mm < MB; ++mm)
#pragma unroll
                    for (int bj = 0; bj < 2; ++bj) { const int m = MB * mp + mm; const size_t o = (size_t)(u.pm * 256 + ai * 128 + wr * 64 + m * 16 + fr) * DM + u.pn * 256 + bj * 128 + wc * 32 + 8 * fq;
                        f32x4 r0, r1;
                        if (RES_F32) { r0 = rf[mm][bj][0]; r1 = rf[mm][bj][1]; }
                        else { const u32x4 w = rb[mm][bj];
                            r0 = (f32x4){__uint_as_float(w[0] << 16), __uint_as_float(w[0] & 0xffff0000u), __uint_as_float(w[1] << 16), __uint_as_float(w[1] & 0xffff0000u)};
                            r1 = (f32x4){__uint_as_float(w[2] << 16), __uint_as_float(w[2] & 0xffff0000u), __uint_as_float(w[3] << 16), __uint_as_float(w[3] & 0xffff0000u)}; }
                        *(bf16x8*)(out + o) = pack8(r0 * ALPHA + acc[ai][bj][m][0], r1 * ALPHA + acc[ai][bj][m][1]); }
                asm volatile("" ::: "memory");
            }
    }
};
struct EpiHgIn {
    bf16_t* qs; bf16_t* vv; bf16_t* sg; float* lf; const float* lbv;
    __device__ __forceinline__ void operator()(const acc_t& acc, const Unit& u, int wr, int wc, int fr, int fq) const {
        asm volatile("" : "+v"(fr), "+v"(fq));
        const int typ = u.pn >> 2;
        EPI_BEGIN { const int c = col & 1023; const size_t o = (size_t)row * DM + c;
            if (typ == 0) { f32x4 a, b;
#pragma unroll
                for (int e = 0; e < 4; ++e) { a[e] = siluf_(v0[e]); b[e] = siluf_(v1[e]); }
                *(bf16x8*)(qs + o) = pack8(a, b); }
            else if (typ == 1) { const f32x4 l0 = *(const f32x4*)(lbv + c), l1 = *(const f32x4*)(lbv + c + 4); f32x4 a, b;
#pragma unroll
                for (int e = 0; e < 4; ++e) { a[e] = __logf(l0[e] + (1.f - l0[e]) * sigmoidf_(v0[e])); b[e] = __logf(l1[e] + (1.f - l1[e]) * sigmoidf_(v1[e])); }
                *(f32x4*)(lf + o) = a; *(f32x4*)(lf + o + 4) = b; }
            else if (typ == 2) { *(bf16x8*)(vv + o) = pack8(v0, v1); }
            else { f32x4 a, b;
#pragma unroll
                for (int e = 0; e < 4; ++e) { a[e] = sigmoidf_(v0[e]); b[e] = sigmoidf_(v1[e]); }
                *(bf16x8*)(sg + o) = pack8(a, b); } } EPI_END
    }
};
struct EpiSwiglu {
    bf16_t* act; int ldact; int ntile;
    __device__ __forceinline__ void operator()(const acc_t& acc, const Unit& u, int wr, int wc, int fr, int fq) const {
        asm volatile("" : "+v"(fr), "+v"(fq));
        const int pnl = u.pn % ntile;
#pragma unroll
        for (int ai = 0; ai < 2; ++ai)
#pragma unroll
            for (int m = 0; m < 4; ++m) { const int row = u.pm * 256 + ai * 128 + wr * 64 + m * 16 + fr, cl = pnl * 128 + wc * 32 + 8 * fq;
                const f32x4 g0 = acc[ai][0][m][0], g1 = acc[ai][0][m][1], u0 = acc[ai][1][m][0], u1 = acc[ai][1][m][1];
                f32x4 a, b;
#pragma unroll
                for (int e = 0; e < 4; ++e) { a[e] = siluf_(g0[e]) * u0[e]; b[e] = siluf_(g1[e]) * u1[e]; }
                *(bf16x8*)(act + (size_t)row * ldact + cl) = pack8(a, b);
                if (m & 1) asm volatile("" ::: "memory"); }
    }
};
struct EpiMoeDown {
    bf16_t* y;
    __device__ __forceinline__ void operator()(const acc_t& acc, const Unit& u, int wr, int wc, int fr, int fq) const {
        asm volatile("" : "+v"(fr), "+v"(fq));
        const int pnl = u.pn & 3;
        EPI_BEGIN { *(bf16x8*)(y + (size_t)row * DM + pnl * 256 + (col & 255)) = pack8(v0, v1); } EPI_END
    }
};
struct EpiDaIn {
    bf16_t* q; bf16_t* k; bf16_t* v; const f32x2* rope;
    __device__ __forceinline__ void operator()(const acc_t& acc, const Unit& u, int wr, int wc, int fr, int fq) const {
        asm volatile("" : "+v"(fr), "+v"(fq));
        const bool isqk = (u.pn * 256 < 2048);
        if (isqk) {
            const int blk = u.pn * 4 + wc, which = blk >> 4, hb = blk & 15, j0 = 8 * fq;
#pragma unroll
            for (int ai = 0; ai < 2; ++ai)
#pragma unroll
                for (int mp = 0; mp < 2; ++mp) {
                    f32x4 t[2][4];
#pragma unroll
                    for (int mm = 0; mm < 2; ++mm) { const int row = u.pm * 256 + ai * 128 + wr * 64 + (2 * mp + mm) * 16 + fr, pos = row & (SEQ - 1);
#pragma unroll
                        for (int i = 0; i < 4; ++i) t[mm][i] = *(const f32x4*)(rope + (size_t)pos * 32 + j0 + 2 * i); }
#pragma unroll
                    for (int mm = 0; mm < 2; ++mm) { const int m = 2 * mp + mm; const int row = u.pm * 256 + ai * 128 + wr * 64 + m * 16 + fr, b = row >> 13, pos = row & (SEQ - 1);
                        f32x4 y1[2], y2[2];
#pragma unroll
                        for (int h = 0; h < 2; ++h) { const f32x4 x1 = acc[ai][0][m][h], x2 = acc[ai][1][m][h]; const f32x4 ta = t[mm][2 * h], tb = t[mm][2 * h + 1];
                            const float cs[4] = {ta[0], ta[2], tb[0], tb[2]}, sn[4] = {ta[1], ta[3], tb[1], tb[3]};
#pragma unroll
                            for (int e = 0; e < 4; ++e) { y1[h][e] = x1[e] * cs[e] - x2[e] * sn[e]; y2[h][e] = x2[e] * cs[e] + x1[e] * sn[e]; } }
                        bf16_t* dst = (which ? k : q) + (((size_t)b * 8 + (hb >> 1)) * SEQ + pos) * 128 + (hb & 1) * 64 + j0;
                        *(bf16x8*)dst = pack8(y1[0], y1[1]); *(bf16x8*)(dst + 32) = pack8(y2[0], y2[1]); }
                    asm volatile("" ::: "memory");
                }
        } else {
            EPI_BEGIN { const int b = row >> 13, pos = row & (SEQ - 1), h = (col - 2048) >> 7, d = col & 127;
                *(bf16x8*)(v + (((size_t)b * 8 + h) * SEQ + pos) * 128 + d) = pack8(v0, v1); } EPI_END
        }
    }
};
struct EpiNsaIn {
    bf16_t* q; bf16_t* qr; bf16_t* kv; float* gates; const f32x2* rope;
    __device__ __forceinline__ void operator()(const acc_t& acc, const Unit& u, int wr, int wc, int fr, int fq) const {
        asm volatile("" : "+v"(fr), "+v"(fq));
        const bool isrope = (u.pn < 10);
        if (isrope) {
            const int blk = u.pn * 2 + (wc >> 1), j0 = 32 * (wc & 1) + 8 * fq;
            const int jj = (blk - 8) >> 1, g = (blk - 8) & 1; const bool rot = (jj == 2) || (jj == 4);
#pragma unroll
            for (int ai = 0; ai < 2; ++ai)
#pragma unroll
                for (int mp = 0; mp < 2; ++mp) {
                    f32x4 t[2][4];
#pragma unroll
                    for (int mm = 0; mm < 2; ++mm) { const int row = u.pm * 256 + ai * 128 + wr * 64 + (2 * mp + mm) * 16 + fr, pos = row & (SEQ - 1);
#pragma unroll
                        for (int i = 0; i < 4; ++i) t[mm][i] = *(const f32x4*)(rope + (size_t)pos * 64 + j0 + 2 * i); }
#pragma unroll
                    for (int mm = 0; mm < 2; ++mm) { const int m = 2 * mp + mm; const int row = u.pm * 256 + ai * 128 + wr * 64 + m * 16 + fr, b = row >> 13, pos = row & (SEQ - 1);
                        f32x4 y1[2], y2[2];
#pragma unroll
                        for (int h = 0; h < 2; ++h) { const f32x4 x1 = acc[ai][0][m][h], x2 = acc[ai][1][m][h]; const f32x4 ta = t[mm][2 * h], tb = t[mm][2 * h + 1];
                            const float cs[4] = {ta[0], ta[2], tb[0], tb[2]}, sn[4] = {ta[1], ta[3], tb[1], tb[3]};
#pragma unroll
                            for (int e = 0; e < 4; ++e) { y1[h][e] = x1[e] * cs[e] - x2[e] * sn[e]; y2[h][e] = x2[e] * cs[e] + x1[e] * sn[e]; } }
                        const bf16x8 p1 = pack8(acc[ai][0][m][0], acc[ai][0][m][1]), p2 = pack8(acc[ai][1][m][0], acc[ai][1][m][1]);
                        const bf16x8 r1 = pack8(y1[0], y1[1]), r2 = pack8(y2[0], y2[1]);
                        if (blk < 8) { const size_t o = (((size_t)b * 8 + blk) * SEQ + pos) * 128 + j0;
                            *(bf16x8*)(q + o) = p1; *(bf16x8*)(q + o + 64) = p2; *(bf16x8*)(qr + o) = r1; *(bf16x8*)(qr + o + 64) = r2; }
                        else { const size_t o = (((size_t)jj * 8 + b * 2 + g) * SEQ + pos) * 128 + j0;
                            *(bf16x8*)(kv + o) = rot ? r1 : p1; *(bf16x8*)(kv + o + 64) = rot ? r2 : p2; } }
                    asm volatile("" ::: "memory");
                }
        } else {
            EPI_BEGIN { const int gi = col - 2560;
                if (gi < 24) { f32x4 a, bb;
#pragma unroll
                    for (int e = 0; e < 4; ++e) { a[e] = sigmoidf_(v0[e]); bb[e] = sigmoidf_(v1[e]); }
                    *(f32x4*)(gates + (size_t)row * 24 + gi) = a; *(f32x4*)(gates + (size_t)row * 24 + gi + 4) = bb; } } EPI_END
        }
    }
};
struct EpiSbIn {
    bf16_t* qkv;
    __device__ __forceinline__ void operator()(const acc_t& acc, const Unit& u, int wr, int wc, int fr, int fq) const {
        asm volatile("" : "+v"(fr), "+v"(fq));
        EPI_BEGIN { const int b = row >> 13, pos = row & (SEQ - 1), which = col >> 10, h = (col >> 7) & 7, d = col & 127;
            *(bf16x8*)(qkv + (size_t)which * NT * DM + (((size_t)b * 8 + h) * SEQ + pos) * 128 + d) = pack8(v0, v1); } EPI_END
    }
};
using pg8::NXCD; using pg8::WGM;
template <bool GATHER_>
struct MoeOrderT {
    static constexpr bool GATHER = GATHER_;
    int G, c, tile_lo, nT, nNt; int seg_tile[8]; const int* tok; int imax = 0x7fffffff;
    __device__ __forceinline__ int row_token(int r) const { return tok[r]; }
    __device__ __forceinline__ bool next(int i, Unit& u) const { return i < imax && at((long)i * G + c, u); }
    __device__ __forceinline__ bool at(long L, Unit& u) const {
        const int nwg = nT * nNt;
        if (nT <= 0 || L >= (long)nwg) return false;
        int wgid = (int)L; { const int q = nwg / NXCD, r = nwg % NXCD, xcd = wgid % NXCD, off = wgid / NXCD; wgid = (xcd < r ? xcd * (q + 1) : r * (q + 1) + (xcd - r) * q) + off; }
        const int nig = WGM * nNt, gid = wgid / nig, fm = gid * WGM, gsz = (nT - fm) < WGM ? (nT - fm) : WGM;
        const int pml = fm + ((wgid % nig) % gsz), pn = (wgid % nig) / gsz, tile = tile_lo + pml;
        int e = 0;
#pragma unroll
        for (int k = 1; k < 8; ++k) e += (tile >= seg_tile[k]) ? 1 : 0;
        u.pm = pml; u.pn = e * nNt + pn; return true;
    }
};

struct MapId { const float* src; int ld, nsrc; __device__ __forceinline__ const float* operator()(int n) const { return n < nsrc ? src + n : nullptr; }
    __device__ __forceinline__ MapId shifted(size_t off) const { return MapId{src + off, ld, nsrc}; } };
struct MapRope64 { const float* src; int ld; __device__ __forceinline__ const float* operator()(int n) const {
    if (n >= 2048) return src + n; const int l = n & 255; return src + (n & ~255) + 64 * ((l >> 5) & 3) + 32 * (l >> 7) + (l & 31); }
    __device__ __forceinline__ MapRope64 shifted(size_t off) const { return MapRope64{src + off, ld}; } };
struct MapNsa { const float* src; int ld; __device__ __forceinline__ const float* operator()(int n) const {
    if (n >= 2584) return nullptr; if (n >= 2560) return src + n; const int l = n & 255, wc = (l >> 5) & 3; return src + (n & ~255) + 128 * (wc >> 1) + 64 * (l >> 7) + 32 * (wc & 1) + (l & 31); }
    __device__ __forceinline__ MapNsa shifted(size_t off) const { return MapNsa{src + off, ld}; } };
struct MapGU { const float* gate; const float* up; int ld; __device__ __forceinline__ const float* operator()(int n) const {
    const int u = n >> 8, c = n & 255; return c < 128 ? gate + 128 * u + c : up + 128 * u + (c - 128); }
    __device__ __forceinline__ MapGU shifted(size_t off) const { return MapGU{gate + off, up + off, ld}; } };
template <class Map>
__device__ __forceinline__ void convert_T(ldsp_t lds, bf16_t* dst, int nb, size_t src_bstride, int Ndst, int K, const Map map0, int wg, int nwg) {
    const int tid = my_tid(), ntn = Ndst >> 6, per = ntn * (K >> 6), ntiles = per * nb;
    LAS bf16_t* tl = (LAS bf16_t*)lds;
    const int ln = tid & 63, lk = tid >> 6, sn = tid >> 3, skc = (tid & 7) * 8;
    float va[8], vb[8];
#define CT_LOAD(V, TILE) do { const int bi_ = (TILE) / per, tt_ = (TILE) % per, n0_ = (tt_ % ntn) << 6, k0_ = (tt_ / ntn) << 6; \
        const Map m_ = map0.shifted((size_t)bi_ * src_bstride); const float* cp_ = m_(n0_ + ln); \
        _Pragma("unroll") for (int it = 0; it < 8; ++it) V[it] = cp_ ? __builtin_nontemporal_load(cp_ + (size_t)(k0_ + lk + 8 * it) * m_.ld) : 0.f; } while (0)
    float vc[8], vd[8];
    int tile = wg, buf = 0;
    if (tile < ntiles) CT_LOAD(va, tile);
    if (tile + nwg < ntiles) CT_LOAD(vb, tile + nwg);
    if (tile + 2 * nwg < ntiles) CT_LOAD(vc, tile + 2 * nwg);
#define CT_STEP(VCUR, VNEW) do { if (tile < ntiles) { \
        if (tile + 3 * nwg < ntiles) CT_LOAD(VNEW, tile + 3 * nwg); \
        LAS bf16_t* tb = tl + buf * (64 * 66); \
        _Pragma("unroll") for (int it = 0; it < 8; ++it) tb[ln * 66 + lk + 8 * it] = f2bf(VCUR[it]); \
        __syncthreads(); \
        { const int bi = tile / per, tt = tile % per, n0 = (tt % ntn) << 6, k0 = (tt / ntn) << 6; \
          const LAS unsigned* rp = (const LAS unsigned*)(tb + sn * 66 + skc); \
          const u32x4 w = {rp[0], rp[1], rp[2], rp[3]}; \
          *(u32x4*)(dst + ((size_t)bi * Ndst + n0 + sn) * K + k0 + skc) = w; } \
        tile += nwg; buf ^= 1; } } while (0)
    while (tile < ntiles) { CT_STEP(va, vd); CT_STEP(vb, va); CT_STEP(vc, vb); CT_STEP(vd, vc); }
#undef CT_STEP
    __syncthreads();
#undef CT_LOAD
}

struct Route { int e0, e1, p0, p1; float g0, g1; int pad0, pad1; };
__device__ __forceinline__ void moe_segments_lds(const unsigned* cnt, LAS int* segL) {
    if (threadIdx.x == 0) { int s = 0;
        for (int e = 0; e < 8; ++e) { segL[e] = s; s += (int)((cnt[e] + 255u) & ~255u); }
        segL[8] = s; }
    __syncthreads();
}
__device__ __forceinline__ void ln_phase(ldsp_t lds, const bf16_t* src, float* dst_f32, bf16_t* dst_bf16, const float* lng, const float* lnb,
                                         const Route* route_in, const bf16_t* ybuf, const unsigned* cnt_in,
                                         const float* wrouter, Route* route_out, unsigned* cnt_out, int wg, int nwg) {
    const int tid = my_tid(), wid = tid >> 6, lane = tid & 63;
    LAS float* wl = (LAS float*)lds;
    LAS int* rinfo = (LAS int*)(lds + 32768);
    LAS unsigned* cntL = (LAS unsigned*)(lds + 32768 + 4096);
    LAS int* seg_start = (LAS int*)(lds + 32768 + 4096 + 256);
    if (route_in) moe_segments_lds(cnt_in, seg_start);
    if (wrouter) { for (int i = tid; i < 8192; i += 512) { const int d = i >> 3, e = i & 7; wl[e * 1024 + d] = wrouter[i]; } }
    f32x4 gv[4], bv[4];
#pragma unroll
    for (int q = 0; q < 4; ++q) { gv[q] = *(const f32x4*)(lng + 4 * lane + 256 * q); bv[q] = *(const f32x4*)(lnb + 4 * lane + 256 * q); }
    for (int chunk = wg; chunk < NT / 128; chunk += nwg) {
        if (wrouter) { if (tid < 8) cntL[tid] = 0u; }
        __syncthreads();
        u32x2 zn[4], yan[4], ybn[4]; Route rn; rn.e0 = 0; rn.e1 = 0; rn.p0 = 0; rn.p1 = 0; rn.g0 = 0.f; rn.g1 = 0.f; rn.pad0 = 0; rn.pad1 = 0;
#define LN_LOAD(ROW) do { _Pragma("unroll") for (int q = 0; q < 4; ++q) zn[q] = *(const u32x2*)(src + (size_t)(ROW) * DM + 4 * lane + 256 * q); \
            if (route_in) { rn = route_in[(ROW)]; const size_t s0_ = (size_t)(seg_start[rn.e0] + rn.p0) * DM, s1_ = (size_t)(seg_start[rn.e1] + rn.p1) * DM; \
                _Pragma("unroll") for (int q = 0; q < 4; ++q) { yan[q] = *(const u32x2*)(ybuf + s0_ + 4 * lane + 256 * q); ybn[q] = *(const u32x2*)(ybuf + s1_ + 4 * lane + 256 * q); } } } while (0)
        LN_LOAD(chunk * 128 + wid * 16);
        for (int i = 0; i < 16; ++i) {
            const int rl = wid * 16 + i, row = chunk * 128 + rl;
            f32x4 z[4]; u32x2 ya[4], yb[4]; const Route r = rn;
#pragma unroll
            for (int q = 0; q < 4; ++q) { const u32x2 w = zn[q]; ya[q] = yan[q]; yb[q] = ybn[q];
                z[q] = (f32x4){__uint_as_float(w[0] << 16), __uint_as_float(w[0] & 0xffff0000u), __uint_as_float(w[1] << 16), __uint_as_float(w[1] & 0xffff0000u)}; }
            if (i + 1 < 16) LN_LOAD(row + 1);
            if (route_in) {
#pragma unroll
                for (int q = 0; q < 4; ++q) { const u32x2 a = ya[q], b = yb[q];
                    z[q][0] = z[q][0] * ALPHA + r.g0 * __uint_as_float(a[0] << 16) + r.g1 * __uint_as_float(b[0] << 16);
                    z[q][1] = z[q][1] * ALPHA + r.g0 * __uint_as_float(a[0] & 0xffff0000u) + r.g1 * __uint_as_float(b[0] & 0xffff0000u);
                    z[q][2] = z[q][2] * ALPHA + r.g0 * __uint_as_float(a[1] << 16) + r.g1 * __uint_as_float(b[1] << 16);
                    z[q][3] = z[q][3] * ALPHA + r.g0 * __uint_as_float(a[1] & 0xffff0000u) + r.g1 * __uint_as_float(b[1] & 0xffff0000u); }
            }
            float s = 0.f;
#pragma unroll
            for (int q = 0; q < 4; ++q) s += (z[q][0] + z[q][1]) + (z[q][2] + z[q][3]);
            const float mean = wave_sum(s) * (1.f / DM);
            float v = 0.f;
#pragma unroll
            for (int q = 0; q < 4; ++q) { z[q] = z[q] - mean; v += (z[q][0] * z[q][0] + z[q][1] * z[q][1]) + (z[q][2] * z[q][2] + z[q][3] * z[q][3]); }
            const float rstd = rsqrtf(wave_sum(v) * (1.f / DM) + LN_EPS);
#pragma unroll
            for (int q = 0; q < 4; ++q) { z[q] = z[q] * rstd * gv[q] + bv[q]; if (dst_f32) *(f32x4*)(dst_f32 + (size_t)row * DM + 4 * lane + 256 * q) = z[q]; }
            if (dst_bf16) {
#pragma unroll
                for (int q = 0; q < 4; ++q) *(u32x2*)(dst_bf16 + (size_t)row * DM + 4 * lane + 256 * q) = (u32x2){cvtpk(z[q][0], z[q][1]), cvtpk(z[q][2], z[q][3])};
            }
            if (wrouter) {
                float lg[8];
#pragma unroll
                for (int e = 0; e < 8; ++e) { float a = 0.f;
#pragma unroll
                    for (int q = 0; q < 4; ++q) { const f32x4 w = *(const LAS f32x4*)(wl + e * 1024 + 4 * lane + 256 * q); a += z[q][0] * w[0] + z[q][1] * w[1] + z[q][2] * w[2] + z[q][3] * w[3]; }
                    lg[e] = wave_sum(a); }
                int e0 = 0; float v0 = lg[0];
#pragma unroll
                for (int e = 1; e < 8; ++e) if (lg[e] > v0) { v0 = lg[e]; e0 = e; }
                int e1 = -1; float v1 = -3.0e38f;
#pragma unroll
                for (int e = 0; e < 8; ++e) if (e != e0 && lg[e] > v1) { v1 = lg[e]; e1 = e; }
                if (e1 < 0) { e1 = (e0 + 1) & 7; v1 = v0; }
                if (lane == 0) {
                    const float g1 = 1.f / (1.f + __expf(v0 - v1)), g0 = 1.f - g1;
                    const int p0 = (int)atomicAdd((unsigned*)(cntL + e0), 1u), p1 = (int)atomicAdd((unsigned*)(cntL + e1), 1u);
                    rinfo[rl * 6 + 0] = e0; rinfo[rl * 6 + 1] = e1; rinfo[rl * 6 + 2] = p0; rinfo[rl * 6 + 3] = p1;
                    rinfo[rl * 6 + 4] = __float_as_int(g0); rinfo[rl * 6 + 5] = __float_as_int(g1);
                }
            }
        }
        if (wrouter) {
            __syncthreads();
            if (tid < 8) cntL[8 + tid] = atomicAdd(cnt_out + tid, cntL[tid]);
            __syncthreads();
            if (tid < 128) { Route r; r.e0 = rinfo[tid * 6 + 0]; r.e1 = rinfo[tid * 6 + 1];
                r.p0 = rinfo[tid * 6 + 2] + (int)cntL[8 + r.e0]; r.p1 = rinfo[tid * 6 + 3] + (int)cntL[8 + r.e1];
                r.g0 = __int_as_float(rinfo[tid * 6 + 4]); r.g1 = __int_as_float(rinfo[tid * 6 + 5]); r.pad0 = 0; r.pad1 = 0;
                route_out[chunk * 128 + tid] = r; }
            __syncthreads();
        }
    }
}
#undef LN_LOAD
__device__ __forceinline__ void moe_build_table(ldsp_t lds, int* tab, const Route* route, const unsigned* cnt, int wg, int nwg) {
    const int tid = my_tid();
    LAS int* seg_start = (LAS int*)lds; moe_segments_lds(cnt, seg_start);
    for (int t = wg * 512 + tid; t < NT; t += nwg * 512) { const Route r = route[t]; tab[seg_start[r.e0] + r.p0] = t; tab[seg_start[r.e1] + r.p1] = t; }
    for (int i = wg * 512 + tid; i < 8 * 256; i += nwg * 512) { const int e = i >> 8, k = i & 255; const int c = (int)cnt[e], pad = (c + 255) & ~255;
        if (c + k < pad) tab[seg_start[e] + c + k] = 0; }
    __syncthreads();
}

constexpr int HG_P144 = 144, HG_P272 = 272;
__device__ __forceinline__ void hgrn_passA(ldsp_t lds, const float* lf, const bf16_t* vv, bf16_t* ST, float* dec, int wg, int nwg) {
    const int tid = my_tid(), wid = tid >> 6, lane = tid & 63, r32 = lane & 31, hi = lane >> 5;
    const int d = tid & 127, sq = tid >> 7;
    ldsp_t KhT = lds, VT = lds + 128 * HG_P144; LAS float* tot = (LAS float*)(lds + 2 * 128 * HG_P144);
    float lfn[16]; bf16_t vnx[16];
#define HA_LOAD(IT) do { const int bh_ = (IT) >> 7, c_ = (IT) & 127, b_ = bh_ >> 3, h_ = bh_ & 7; const size_t t0_ = (size_t)b_ * SEQ + c_ * 64; \
        _Pragma("unroll") for (int tt = 0; tt < 16; ++tt) { const size_t o_ = (t0_ + 16 * sq + tt) * DM + h_ * 128 + d; lfn[tt] = lf[o_]; vnx[tt] = vv[o_]; } } while (0)
    if (wg < 4096) HA_LOAD(wg);
    for (int it = wg; it < 4096; it += nwg) {
        const int bh = it >> 7, c = it & 127, b = bh >> 3, h = bh & 7;
        const size_t tok0 = (size_t)b * SEQ + c * 64; (void)tok0; (void)b; (void)h;
        float lfv[16], cs[16]; bf16_t vraw[16];
#pragma unroll
        for (int tt = 0; tt < 16; ++tt) { lfv[tt] = lfn[tt]; vraw[tt] = vnx[tt]; }
        if (it + nwg < 4096) HA_LOAD(it + nwg);
        float run = 0.f;
#pragma unroll
        for (int tt = 0; tt < 16; ++tt) { run += lfv[tt]; cs[tt] = run; }
        tot[sq * 128 + d] = run;
        __syncthreads();
        float off = 0.f, cl = 0.f;
#pragma unroll
        for (int q = 0; q < 4; ++q) { const float t = tot[q * 128 + d]; cl += t; off += (q < sq) ? t : 0.f; }
        if (sq == 0) dec[(size_t)it * 128 + d] = __expf(cl);
        { unsigned w[8];
#pragma unroll
          for (int p = 0; p < 8; ++p) { const float c0 = off + cs[2 * p], c1 = off + cs[2 * p + 1];
              w[p] = cvtpk((1.f - __expf(lfv[2 * p])) * __expf(cl - c0), (1.f - __expf(lfv[2 * p + 1])) * __expf(cl - c1)); }
          *(LAS u32x4*)(KhT + d * HG_P144 + sq * 32) = (u32x4){w[0], w[1], w[2], w[3]};
          *(LAS u32x4*)(KhT + d * HG_P144 + sq * 32 + 16) = (u32x4){w[4], w[5], w[6], w[7]};
          unsigned x[8];
#pragma unroll
          for (int p = 0; p < 8; ++p) x[p] = (unsigned)vraw[2 * p] | ((unsigned)vraw[2 * p + 1] << 16);
          *(LAS u32x4*)(VT + d * HG_P144 + sq * 32) = (u32x4){x[0], x[1], x[2], x[3]};
          *(LAS u32x4*)(VT + d * HG_P144 + sq * 32 + 16) = (u32x4){x[4], x[5], x[6], x[7]}; }
        __syncthreads();
        const int mt = wid >> 1;
#pragma unroll
        for (int nn = 0; nn < 2; ++nn) { const int nt = (wid & 1) * 2 + nn; f32x16 acc = {};
#pragma unroll
            for (int ks = 0; ks < 4; ++ks) {
                const bf16x8 a = *(const LAS bf16x8*)(VT + (32 * mt + r32) * HG_P144 + (16 * ks + 8 * hi) * 2);
                const bf16x8 bb = *(const LAS bf16x8*)(KhT + (32 * nt + r32) * HG_P144 + (16 * ks + 8 * hi) * 2);
                acc = __builtin_amdgcn_mfma_f32_32x32x16_bf16(a, bb, acc, 0, 0, 0); }
#pragma unroll
            for (int r = 0; r < 16; ++r) { const int v = 32 * mt + (r & 3) + 8 * (r >> 2) + 4 * hi;
                ST[((size_t)it * 128 + v) * 128 + 32 * nt + r32] = f2bf(acc[r]); } }
        __syncthreads();
    }
}
#undef HA_LOAD
__device__ __forceinline__ void hgrn_passB(bf16_t* ST, const float* dec, int wg, int nwg) {
    for (int eg = wg * 512 + my_tid(); eg < 32 * 4096; eg += nwg * 512) {
        const int bh = eg >> 12, w = eg & 4095, v = w >> 5, d4 = (w & 31) * 4;
        float st[4] = {0.f, 0.f, 0.f, 0.f};
        for (int c0 = 0; c0 < 128; c0 += 8) {
            u32x2 kvr[8]; f32x4 dc[8];
#pragma unroll
            for (int j = 0; j < 8; ++j) { const size_t it = (size_t)bh * 128 + c0 + j;
                kvr[j] = *(const u32x2*)(ST + (it * 128 + v) * 128 + d4); dc[j] = *(const f32x4*)(dec + it * 128 + d4); }
#pragma unroll
            for (int j = 0; j < 8; ++j) { const size_t it = (size_t)bh * 128 + c0 + j;
                *(u32x2*)(ST + (it * 128 + v) * 128 + d4) = (u32x2){cvtpk(st[0], st[1]), cvtpk(st[2], st[3])};
                st[0] = dc[j][0] * st[0] + __uint_as_float(kvr[j][0] << 16); st[1] = dc[j][1] * st[1] + __uint_as_float(kvr[j][0] & 0xffff0000u);
                st[2] = dc[j][2] * st[2] + __uint_as_float(kvr[j][1] << 16); st[3] = dc[j][3] * st[3] + __uint_as_float(kvr[j][1] & 0xffff0000u); }
        }
    }
}
__device__ __forceinline__ void hgrn_passC(ldsp_t lds, const bf16_t* qs, const float* lf, const bf16_t* vv, const bf16_t* sg, const bf16_t* ST, const float* normg, bf16_t* ob, int wg, int nwg) {
    const int tid = my_tid(), wid = tid >> 6, lane = tid & 63, c16 = lane & 15, g = lane >> 4;
    const int d = tid & 127, sq = tid >> 7;
    ldsp_t Qi = lds, Qc = lds + 17408, Kt = lds + 2 * 17408, VT = lds + 2 * 17408 + 43520, STl = VT + 18432;
    LAS float* refs = (LAS float*)(STl + 34816); LAS float* tot = refs + 512; LAS float* ssq = tot + 512;
    float lfn[16]; bf16_t qn[16], vn[16]; u32x4 stn[4];
#define HC_LOAD(IT) do { const int bh_ = (IT) >> 7, c_ = (IT) & 127, b_ = bh_ >> 3, h_ = bh_ & 7; const size_t t0_ = (size_t)b_ * SEQ + c_ * 64; \
        _Pragma("unroll") for (int tt = 0; tt < 16; ++tt) { const size_t o_ = (t0_ + 16 * sq + tt) * DM + h_ * 128 + d; lfn[tt] = lf[o_]; qn[tt] = qs[o_]; vn[tt] = vv[o_]; } \
        _Pragma("unroll") for (int i4 = 0; i4 < 4; ++i4) { const int p = tid + 512 * i4, v = p >> 4, ch = p & 15; stn[i4] = *(const u32x4*)(ST + ((size_t)(IT) * 128 + v) * 128 + ch * 8); } } while (0)
    if (wg < 4096) HC_LOAD(wg);
    for (int it = wg; it < 4096; it += nwg) {
        const int bh = it >> 7, c = it & 127, b = bh >> 3, h = bh & 7;
        const size_t tok0 = (size_t)b * SEQ + c * 64;
        float lfv[16], cum[16]; bf16_t qraw[16], vraw[16];
#pragma unroll
        for (int tt = 0; tt < 16; ++tt) { lfv[tt] = lfn[tt]; qraw[tt] = qn[tt]; vraw[tt] = vn[tt]; }
        float run = 0.f;
#pragma unroll
        for (int tt = 0; tt < 16; ++tt) { run += lfv[tt]; cum[tt] = run; }
        tot[sq * 128 + d] = run;
#pragma unroll
        for (int i4 = 0; i4 < 4; ++i4) { const int p = tid + 512 * i4, v = p >> 4, ch = p & 15;
            *(LAS u32x4*)(STl + v * HG_P272 + ch * 16) = stn[i4]; }
        { unsigned x[8];
#pragma unroll
          for (int p = 0; p < 8; ++p) x[p] = (unsigned)vraw[2 * p] | ((unsigned)vraw[2 * p + 1] << 16);
          *(LAS u32x4*)(VT + d * HG_P144 + sq * 32) = (u32x4){x[0], x[1], x[2], x[3]};
          *(LAS u32x4*)(VT + d * HG_P144 + sq * 32 + 16) = (u32x4){x[4], x[5], x[6], x[7]}; }
        if (it + nwg < 4096) HC_LOAD(it + nwg);
        __syncthreads();
        float off = 0.f;
#pragma unroll
        for (int q = 0; q < 4; ++q) { const float t = tot[q * 128 + d]; off += (q < sq) ? t : 0.f; }
#pragma unroll
        for (int tt = 0; tt < 16; ++tt) cum[tt] += off;
        refs[sq * 128 + d] = cum[0];
        __syncthreads();
        float rf[4];
#pragma unroll
        for (int i = 0; i < 4; ++i) rf[i] = refs[i * 128 + d];
        float rme = rf[0];
#pragma unroll
        for (int i = 1; i < 4; ++i) rme = (sq == i) ? rf[i] : rme;
#pragma unroll
        for (int tt = 0; tt < 16; ++tt) { const int t = 16 * sq + tt; const float qv = bf2f(qraw[tt]);
            *(LAS bf16_t*)(Qi + t * HG_P272 + d * 2) = f2bf(qv * __expf(cum[tt] - rme));
            *(LAS bf16_t*)(Qc + t * HG_P272 + d * 2) = f2bf(qv * __expf(cum[tt]));
            const float kvv = 1.f - __expf(lfv[tt]);
#pragma unroll
            for (int i = 0; i < 4; ++i) { const int rb = (i == 0) ? 0 : (i == 1) ? 16 : (i == 2) ? 48 : 96;
                if (i >= sq) *(LAS bf16_t*)(Kt + (rb + t) * HG_P272 + d * 2) = f2bf(kvv * __expf(rf[i] - cum[tt])); } }
        __syncthreads();
        const int ib = wid >> 1, vh = wid & 1;
        const int rbI = (ib == 0) ? 0 : (ib == 1) ? 16 : (ib == 2) ? 48 : 96;
        f32x4 sc[4];
#pragma unroll
        for (int a = 0; a < 4; ++a) { sc[a] = (f32x4){0.f, 0.f, 0.f, 0.f};
            if (a <= ib) {
#pragma unroll
                for (int ks = 0; ks < 4; ++ks) {
                    const bf16x8 A = *(const LAS bf16x8*)(Kt + (rbI + 16 * a + c16) * HG_P272 + (32 * ks + 8 * g) * 2);
                    const bf16x8 B = *(const LAS bf16x8*)(Qi + (16 * ib + c16) * HG_P272 + (32 * ks + 8 * g) * 2);
                    sc[a] = __builtin_amdgcn_mfma_f32_16x16x32_bf16(A, B, sc[a], 0, 0, 0); }
                if (a == ib) {
#pragma unroll
                    for (int r = 0; r < 4; ++r) if (4 * g + r > c16) sc[a][r] = 0.f; } } }
        bf16x8 pb[2];
#pragma unroll
        for (int p = 0; p < 2; ++p) { const u32x4 w = {cvtpk(sc[2 * p][0], sc[2 * p][1]), cvtpk(sc[2 * p][2], sc[2 * p][3]), cvtpk(sc[2 * p + 1][0], sc[2 * p + 1][1]), cvtpk(sc[2 * p + 1][2], sc[2 * p + 1][3])};
            pb[p] = *reinterpret_cast<const bf16x8*>(&w); }
        f32x4 ao[4]; float ssl = 0.f;
#pragma unroll
        for (int vt = 0; vt < 4; ++vt) { ao[vt] = (f32x4){0.f, 0.f, 0.f, 0.f}; const int vrow = 16 * (4 * vh + vt) + c16;
#pragma unroll
            for (int p = 0; p < 2; ++p) if (2 * p <= ib) {
                const u32x2 lo = *(const LAS u32x2*)(VT + vrow * HG_P144 + (32 * p + 4 * g) * 2), hi2 = *(const LAS u32x2*)(VT + vrow * HG_P144 + (32 * p + 16 + 4 * g) * 2);
                const u32x4 w = {lo[0], lo[1], hi2[0], hi2[1]};
                ao[vt] = __builtin_amdgcn_mfma_f32_16x16x32_bf16(*reinterpret_cast<const bf16x8*>(&w), pb[p], ao[vt], 0, 0, 0); }
#pragma unroll
            for (int ks = 0; ks < 4; ++ks) {
                const bf16x8 A = *(const LAS bf16x8*)(STl + vrow * HG_P272 + (32 * ks + 8 * g) * 2);
                const bf16x8 B = *(const LAS bf16x8*)(Qc + (16 * ib + c16) * HG_P272 + (32 * ks + 8 * g) * 2);
                ao[vt] = __builtin_amdgcn_mfma_f32_16x16x32_bf16(A, B, ao[vt], 0, 0, 0); }
            ssl += ao[vt][0] * ao[vt][0] + ao[vt][1] * ao[vt][1] + ao[vt][2] * ao[vt][2] + ao[vt][3] * ao[vt][3]; }
        ssl = sum_halves32(sum_rows16(ssl));
        if (g == 0) ssq[vh * 64 + 16 * ib + c16] = ssl;
        __syncthreads();
        const float rs = rsqrtf((ssq[16 * ib + c16] + ssq[64 + 16 * ib + c16]) * (1.f / 128.f) + LN_EPS);
        const size_t trow = (tok0 + 16 * ib + c16) * DM + h * 128;
#pragma unroll
        for (int vt = 0; vt < 4; ++vt) { const int v0 = 16 * (4 * vh + vt) + 4 * g;
            const f32x4 ng = *(const f32x4*)(normg + v0); const u32x2 sgr = *(const u32x2*)(sg + trow + v0);
            const float o0 = ao[vt][0] * rs * ng[0] * __uint_as_float(sgr[0] << 16), o1 = ao[vt][1] * rs * ng[1] * __uint_as_float(sgr[0] & 0xffff0000u);
            const float o2 = ao[vt][2] * rs * ng[2] * __uint_as_float(sgr[1] << 16), o3 = ao[vt][3] * rs * ng[3] * __uint_as_float(sgr[1] & 0xffff0000u);
            *(u32x2*)(ob + trow + v0) = (u32x2){cvtpk(o0, o1), cvtpk(o2, o3)}; }
        __syncthreads();
    }
}

#undef HC_LOAD
#define KSWZ(row, colB) ((row) * 256 + ((colB) ^ (((row) & 7) << 4)))
__device__ __forceinline__ int q_park(int wid) { return wid < 4 ? 2 * 32768 + wid * 8192 : 3 * 32768 + 2048 + (wid - 4) * 8192; }
constexpr int AT_V = 0, AT_K = 16384, AT_BUF = 32768, AT_WS = 3 * 32768, AT_END = 3 * 32768 + 8 * 64 * 4;
__device__ __forceinline__ int v_st(int k, int c) { const int kk = (k & ~0xC) | ((k & 4) << 1) | ((k & 8) >> 1); return ((kk >> 3) * 4 + (c >> 5)) * 512 + ((kk & 7) * 32 + (c & 31)) * 2; }
__device__ __forceinline__ int v_rd_base(int lane) { return ((lane & 3) << 3) | (((lane >> 2) & 3) << 6) | (((lane >> 4) & 1) << 5) | (((lane >> 5) & 1) << 8); }
constexpr int v_rd_off(int d0, int ks, int half) { return d0 * 512 + ks * 4096 + half * 2048; }
__device__ __forceinline__ int crow(int r, int hi) { return (r & 3) + 8 * (r >> 2) + 4 * hi; }
template <int D0_LO, int D0_HI>
__device__ __forceinline__ void qkt_range(f32x16& p0, f32x16& p1, ldsp_t Kt, int r32, int hi, const bf16x8* qr) {
    p0 = f32x16{}; p1 = f32x16{};
    ldsp_t kb[4];
#pragma unroll
    for (int dd = 0; dd < 4; ++dd) kb[dd] = Kt + KSWZ(r32, (dd * 16 + hi * 8) * 2);
#pragma unroll
    for (int d0 = D0_LO; d0 < D0_HI; ++d0) {
        ldsp_t a = kb[d0 & 3] + (d0 >> 2) * 128;
        const bf16x8 b0 = *(const LAS bf16x8*)(a);
        const bf16x8 b1 = *(const LAS bf16x8*)(a + 32 * 256);
        p0 = __builtin_amdgcn_mfma_f32_32x32x16_bf16(b0, qr[d0], p0, 0, 0, 0);
        p1 = __builtin_amdgcn_mfma_f32_32x32x16_bf16(b1, qr[d0], p1, 0, 0, 0); }
}
template <int D0_LO, int D0_HI>
__device__ __forceinline__ void qkt_range_lq(f32x16& p0, f32x16& p1, ldsp_t Kt, ldsp_t Qw, int r32, int hi) {
    p0 = f32x16{}; p1 = f32x16{};
    int ko[4];
#pragma unroll
    for (int dd = 0; dd < 4; ++dd) ko[dd] = KSWZ(r32, (dd * 16 + hi * 8) * 2);
#pragma unroll
    for (int d0 = D0_LO; d0 < D0_HI; ++d0) {
        const int off = ko[d0 & 3] + (d0 >> 2) * 128;
        const bf16x8 b0 = *(const LAS bf16x8*)(Kt + off);
        const bf16x8 b1 = *(const LAS bf16x8*)(Kt + off + 32 * 256);
        const bf16x8 q = *(const LAS bf16x8*)(Qw + off);
        p0 = __builtin_amdgcn_mfma_f32_32x32x16_bf16(b0, q, p0, 0, 0, 0);
        p1 = __builtin_amdgcn_mfma_f32_32x32x16_bf16(b1, q, p1, 0, 0, 0); }
}
template <int ND>
__device__ __forceinline__ void qkt(f32x16& p0, f32x16& p1, ldsp_t Kt, int r32, int hi, const bf16x8* qr) {
    p0 = f32x16{}; p1 = f32x16{};
    ldsp_t kb[4];
#pragma unroll
    for (int dd = 0; dd < 4; ++dd) kb[dd] = Kt + KSWZ(r32, (dd * 16 + hi * 8) * 2);
#pragma unroll
    for (int d0 = 0; d0 < ND; ++d0) {
        ldsp_t a = kb[d0 & 3] + (d0 >> 2) * 128;
        const bf16x8 b0 = *(const LAS bf16x8*)(a);
        const bf16x8 b1 = *(const LAS bf16x8*)(a + 32 * 256);
        p0 = __builtin_amdgcn_mfma_f32_32x32x16_bf16(b0, qr[d0], p0, 0, 0, 0);
        p1 = __builtin_amdgcn_mfma_f32_32x32x16_bf16(b1, qr[d0], p1, 0, 0, 0); }
}
__device__ __forceinline__ void pv_tile(f32x16* o, unsigned vb0, bf16x8 pa0, bf16x8 pa1, bf16x8 pa2, bf16x8 pa3) {
#define TRRD(dst, off) asm volatile("ds_read_b64_tr_b16 %0, %1 offset:%2" : "=&v"(dst) : "v"(vb0), "i"(off) : "memory")
#define PV_D0(d0) do { s16x4 l0, l1, l2, l3, h0, h1, h2, h3; constexpr int b_ = v_rd_off(d0, 0, 0); \
        TRRD(l0, b_); TRRD(h0, b_ + 2048); TRRD(l1, b_ + 4096); TRRD(h1, b_ + 6144); TRRD(l2, b_ + 8192); TRRD(h2, b_ + 10240); TRRD(l3, b_ + 12288); TRRD(h3, b_ + 14336); \
        asm volatile("s_waitcnt lgkmcnt(0)" ::: "memory"); __builtin_amdgcn_sched_barrier(0); \
        o[d0] = __builtin_amdgcn_mfma_f32_32x32x16_bf16(pa0, (bf16x8){l0[0], l0[1], l0[2], l0[3], h0[0], h0[1], h0[2], h0[3]}, o[d0], 0, 0, 0);   \
        o[d0] = __builtin_amdgcn_mfma_f32_32x32x16_bf16(pa1, (bf16x8){l1[0], l1[1], l1[2], l1[3], h1[0], h1[1], h1[2], h1[3]}, o[d0], 0, 0, 0);   \
        o[d0] = __builtin_amdgcn_mfma_f32_32x32x16_bf16(pa2, (bf16x8){l2[0], l2[1], l2[2], l2[3], h2[0], h2[1], h2[2], h2[3]}, o[d0], 0, 0, 0);   \
        o[d0] = __builtin_amdgcn_mfma_f32_32x32x16_bf16(pa3, (bf16x8){l3[0], l3[1], l3[2], l3[3], h3[0], h3[1], h3[2], h3[3]}, o[d0], 0, 0, 0); } while (0)
    PV_D0(0); PV_D0(1); PV_D0(2); PV_D0(3);
#undef PV_D0
#undef TRRD
}
__device__ __forceinline__ void pv_tile_h(f32x16* o, unsigned vb0, bf16x8 pa0, bf16x8 pa1, bf16x8 pa2, bf16x8 pa3) {
#define TRRD(dst, off) asm volatile("ds_read_b64_tr_b16 %0, %1 offset:%2" : "=&v"(dst) : "v"(vb0), "i"(off) : "memory")
#define PV_D0(d0) do { constexpr int b_ = v_rd_off(d0, 0, 0); \
        { s16x4 l0, l1, h0, h1; TRRD(l0, b_); TRRD(h0, b_ + 2048); TRRD(l1, b_ + 4096); TRRD(h1, b_ + 6144); \
          asm volatile("s_waitcnt lgkmcnt(0)" ::: "memory"); __builtin_amdgcn_sched_barrier(0); \
          o[d0] = __builtin_amdgcn_mfma_f32_32x32x16_bf16(pa0, (bf16x8){l0[0], l0[1], l0[2], l0[3], h0[0], h0[1], h0[2], h0[3]}, o[d0], 0, 0, 0);   \
          o[d0] = __builtin_amdgcn_mfma_f32_32x32x16_bf16(pa1, (bf16x8){l1[0], l1[1], l1[2], l1[3], h1[0], h1[1], h1[2], h1[3]}, o[d0], 0, 0, 0); } \
        { s16x4 l2, l3, h2, h3; TRRD(l2, b_ + 8192); TRRD(h2, b_ + 10240); TRRD(l3, b_ + 12288); TRRD(h3, b_ + 14336); \
          asm volatile("s_waitcnt lgkmcnt(0)" ::: "memory"); __builtin_amdgcn_sched_barrier(0); \
          o[d0] = __builtin_amdgcn_mfma_f32_32x32x16_bf16(pa2, (bf16x8){l2[0], l2[1], l2[2], l2[3], h2[0], h2[1], h2[2], h2[3]}, o[d0], 0, 0, 0);   \
          o[d0] = __builtin_amdgcn_mfma_f32_32x32x16_bf16(pa3, (bf16x8){l3[0], l3[1], l3[2], l3[3], h3[0], h3[1], h3[2], h3[3]}, o[d0], 0, 0, 0); } } while (0)
    PV_D0(0); PV_D0(1); PV_D0(2); PV_D0(3);
#undef PV_D0
#undef TRRD
}
__device__ __forceinline__ void pv_tile2(f32x16* oa, f32x16* ob_, unsigned vb0, const bf16x8* pa, const bf16x8* pb) {
#define TRRD(dst, off) asm volatile("ds_read_b64_tr_b16 %0, %1 offset:%2" : "=&v"(dst) : "v"(vb0), "i"(off) : "memory")
#define PV_D0(d0) do { s16x4 l0, l1, l2, l3, h0, h1, h2, h3; constexpr int b_ = v_rd_off(d0, 0, 0); \
        TRRD(l0, b_); TRRD(h0, b_ + 2048); TRRD(l1, b_ + 4096); TRRD(h1, b_ + 6144); TRRD(l2, b_ + 8192); TRRD(h2, b_ + 10240); TRRD(l3, b_ + 12288); TRRD(h3, b_ + 14336); \
        asm volatile("s_waitcnt lgkmcnt(0)" ::: "memory"); __builtin_amdgcn_sched_barrier(0); \
        const bf16x8 v0_ = (bf16x8){l0[0], l0[1], l0[2], l0[3], h0[0], h0[1], h0[2], h0[3]}, v1_ = (bf16x8){l1[0], l1[1], l1[2], l1[3], h1[0], h1[1], h1[2], h1[3]}; \
        const bf16x8 v2_ = (bf16x8){l2[0], l2[1], l2[2], l2[3], h2[0], h2[1], h2[2], h2[3]}, v3_ = (bf16x8){l3[0], l3[1], l3[2], l3[3], h3[0], h3[1], h3[2], h3[3]}; \
        oa[d0] = __builtin_amdgcn_mfma_f32_32x32x16_bf16(pa[0], v0_, oa[d0], 0, 0, 0); ob_[d0] = __builtin_amdgcn_mfma_f32_32x32x16_bf16(pb[0], v0_, ob_[d0], 0, 0, 0); \
        oa[d0] = __builtin_amdgcn_mfma_f32_32x32x16_bf16(pa[1], v1_, oa[d0], 0, 0, 0); ob_[d0] = __builtin_amdgcn_mfma_f32_32x32x16_bf16(pb[1], v1_, ob_[d0], 0, 0, 0); \
        oa[d0] = __builtin_amdgcn_mfma_f32_32x32x16_bf16(pa[2], v2_, oa[d0], 0, 0, 0); ob_[d0] = __builtin_amdgcn_mfma_f32_32x32x16_bf16(pb[2], v2_, ob_[d0], 0, 0, 0); \
        oa[d0] = __builtin_amdgcn_mfma_f32_32x32x16_bf16(pa[3], v3_, oa[d0], 0, 0, 0); ob_[d0] = __builtin_amdgcn_mfma_f32_32x32x16_bf16(pb[3], v3_, ob_[d0], 0, 0, 0); } while (0)
    PV_D0(0); PV_D0(1); PV_D0(2); PV_D0(3);
#undef PV_D0
#undef TRRD
}
__device__ __forceinline__ void partialSM(f32x16& p0, f32x16& p1, float& m_reg, float& alpha, float scale, float C2) {
    float pmax = p0[0];
#pragma unroll
    for (int r = 1; r < 16; ++r) pmax = fmaxf(pmax, p0[r]);
#pragma unroll
    for (int r = 0; r < 16; ++r) pmax = fmaxf(pmax, p1[r]);
    { auto rr = __builtin_amdgcn_permlane32_swap(__float_as_uint(pmax), __float_as_uint(pmax), false, false);
      pmax = fmaxf(__uint_as_float(rr[0]), __uint_as_float(rr[1])); }
    float mn;
    if (__all((pmax - m_reg) * scale <= 8.f)) { mn = m_reg; alpha = 1.f; }
    else { mn = fmaxf(m_reg, pmax); alpha = __builtin_amdgcn_exp2f((m_reg - mn) * C2); m_reg = mn; }
    const float mnL = -mn * C2;
#pragma unroll
    for (int r = 0; r < 16; ++r) { p0[r] = __builtin_amdgcn_exp2f(fmaf(p0[r], C2, mnL)); p1[r] = __builtin_amdgcn_exp2f(fmaf(p1[r], C2, mnL)); }
}
__device__ __forceinline__ float rowsum32(const f32x16& p0, const f32x16& p1) {
    float ps = 0.f;
#pragma unroll
    for (int r = 0; r < 16; ++r) ps += p0[r];
#pragma unroll
    for (int r = 0; r < 16; ++r) ps += p1[r];
    auto rr = __builtin_amdgcn_permlane32_swap(__float_as_uint(ps), __float_as_uint(ps), false, false);
    return __uint_as_float(rr[0]) + __uint_as_float(rr[1]);
}
__device__ __forceinline__ void packP(const f32x16& p0, const f32x16& p1, bf16x8& pa0, bf16x8& pa1, bf16x8& pa2, bf16x8& pa3) {
#define PK4(P, B_, OUT) do { unsigned a0 = cvtpk(P[B_+0], P[B_+1]), a1 = cvtpk(P[B_+2], P[B_+3]);                          \
        unsigned b0 = cvtpk(P[B_+4], P[B_+5]), b1 = cvtpk(P[B_+6], P[B_+7]);                                             \
        auto r0 = __builtin_amdgcn_permlane32_swap(a0, b0, false, false); auto r1 = __builtin_amdgcn_permlane32_swap(a1, b1, false, false); \
        u32x4 w = {r0[0], r1[0], r0[1], r1[1]}; OUT = *reinterpret_cast<bf16x8*>(&w); } while (0)
    PK4(p0, 0, pa0); PK4(p0, 8, pa1); PK4(p1, 0, pa2); PK4(p1, 8, pa3);
#undef PK4
}
__device__ __forceinline__ void rescaleO(f32x16* o, float alpha, LAS float* al_l, int r32, int hi) {
    if (__any(alpha < 1.f)) {
        if (hi == 0) al_l[r32] = alpha;
        asm volatile("s_waitcnt lgkmcnt(0)" ::: "memory");
#pragma unroll
        for (int q = 0; q < 4; ++q) { const f32x4 a = *(const LAS f32x4*)(al_l + 8 * q + 4 * hi);
#pragma unroll
            for (int d_ = 0; d_ < 4; ++d_)
#pragma unroll
                for (int i = 0; i < 4; ++i) o[d_][4 * q + i] *= a[i]; }
    }
}
__device__ __forceinline__ void row_scalars(float x, float* out16, LAS float* li_l, int r32, int hi) {
    if (hi == 0) li_l[r32] = x;
    asm volatile("s_waitcnt lgkmcnt(0)" ::: "memory");
#pragma unroll
    for (int r = 0; r < 16; ++r) out16[r] = li_l[crow(r, hi)];
    asm volatile("s_waitcnt lgkmcnt(0)" ::: "memory");
}
struct KVStage { bf16x8 k0, k1, v0, v1; };
template <int ND, bool WITH_V>
__device__ __forceinline__ void stage_load(KVStage& s, const bf16_t* Kg, const bf16_t* Vg, int tid) {
    if (ND == 8) { const int sr = tid >> 4, sc = (tid & 15) * 8;
        s.k0 = *(const bf16x8*)(Kg + (size_t)sr * 128 + sc); s.k1 = *(const bf16x8*)(Kg + (size_t)(32 + sr) * 128 + sc); }
    else { const int key = tid >> 3, c8 = (tid & 7) * 8; s.k0 = *(const bf16x8*)(Kg + (size_t)key * 64 + c8); }
    if (WITH_V) { const int sr = tid >> 4, sc = (tid & 15) * 8;
        s.v0 = *(const bf16x8*)(Vg + (size_t)sr * 128 + sc); s.v1 = *(const bf16x8*)(Vg + (size_t)(32 + sr) * 128 + sc); }
}
template <int ND, bool WITH_V>
__device__ __forceinline__ void stage_write(const KVStage& s, ldsp_t lds, int tid) {
    if (ND == 8) { const int sr = tid >> 4, sc = (tid & 15) * 8, kws = KSWZ(sr, sc * 2);
        *(LAS bf16x8*)(lds + AT_K + kws) = s.k0; *(LAS bf16x8*)(lds + AT_K + kws + 32 * 256) = s.k1; }
    else { const int key = tid >> 3, c8 = (tid & 7) * 8; *(LAS bf16x8*)(lds + AT_K + KSWZ(key, c8 * 2)) = s.k0; }
    if (WITH_V) { const int sr = tid >> 4, sc = (tid & 15) * 8;
        *(LAS bf16x8*)(lds + AT_V + v_st(sr, sc)) = s.v0; *(LAS bf16x8*)(lds + AT_V + v_st(32 + sr, sc)) = s.v1; }
}
__device__ __forceinline__ void stage_dma(ldsp_t buf, const bf16_t* Kg, const bf16_t* Vg, int wid_u, int lane) {
#pragma unroll
    for (int i = 0; i < 2; ++i) { const int q = (i * 8 + wid_u) * 64 + lane, row = q >> 4, cpos = q & 15;
        __builtin_amdgcn_global_load_lds((const unsigned*)(Kg + (size_t)row * 128 + ((cpos ^ (row & 7)) * 8)), (LAS unsigned*)(buf + AT_K + (i * 8 + wid_u) * 1024), 16, 0, 0); }
#pragma unroll
    for (int i = 0; i < 2; ++i) { const int q = (i * 8 + wid_u) * 64 + lane, sub = q >> 5, w5 = q & 31;
        const int kk = (sub >> 2) * 8 + (w5 >> 2), c = (sub & 3) * 32 + (w5 & 3) * 8, k = (kk & ~0xC) | ((kk & 4) << 1) | ((kk & 8) >> 1);
        __builtin_amdgcn_global_load_lds((const unsigned*)(Vg + (size_t)k * 128 + c), (LAS unsigned*)(buf + AT_V + (i * 8 + wid_u) * 1024), 16, 0, 0); }
}
enum { MK_CAUSAL = 0, MK_WINDOW = 1, MK_SLC = 2 };
template <int MK>
__device__ __forceinline__ int sweep_next(int j, int j_hi, unsigned un0, unsigned un1, unsigned un2, unsigned un3) {
    if (MK == MK_SLC) { while (j < j_hi) { const unsigned uw = (j < 32) ? un0 : (j < 64) ? un1 : (j < 96) ? un2 : un3; if ((uw >> (j & 31)) & 1u) break; ++j; } }
    return j;
}
template <int MK, int ND>
__device__ __forceinline__ void attn_sweep(ldsp_t lds, const bf16x8* qr, const bf16_t* Kg, const bf16_t* Vg, int j_lo, int j_hi, int pos,
                                           unsigned sel0, unsigned sel1, unsigned sel2, unsigned sel3, unsigned un0, unsigned un1, unsigned un2, unsigned un3,
                                           f32x16* o, float& m_reg, float& l_reg, float scale, int wspan) {
    const int tid = my_tid(), wid = tid >> 6, lane = tid & 63, r32 = lane & 31, hi = lane >> 5;
    const float C2 = scale * 1.4426950408889634f;
    LAS float* al_l = (LAS float*)(lds + AT_WS) + wid * 64;
    const unsigned vb0 = (unsigned)(size_t)(lds + AT_V) + v_rd_base(lane);
    const float NEG = -__builtin_inff();
    const int wpos0 = __builtin_amdgcn_readfirstlane(pos);
    static_assert(ND == 8, "LDS-DMA staging is written for 128-wide K rows");
    const int wid_u = __builtin_amdgcn_readfirstlane(wid);
    int j = sweep_next<MK>(j_lo, j_hi, un0, un1, un2, un3);
    if (j >= j_hi) { __syncthreads(); return; }
    int j1 = sweep_next<MK>(j + 1, j_hi, un0, un1, un2, un3);
    stage_dma(lds, Kg + (size_t)j * 64 * 128, Vg + (size_t)j * 64 * 128, wid_u, lane);
    if (j1 < j_hi) stage_dma(lds + AT_BUF, Kg + (size_t)j1 * 64 * 128, Vg + (size_t)j1 * 64 * 128, wid_u, lane);
    if (j1 < j_hi) asm volatile("s_waitcnt vmcnt(4)" ::: "memory"); else asm volatile("s_waitcnt vmcnt(0)" ::: "memory");
    __builtin_amdgcn_s_barrier(); asm volatile("" ::: "memory");
    int cur = 0;
    for (;;) {
        const int j2 = (j1 < j_hi) ? sweep_next<MK>(j1 + 1, j_hi, un0, un1, un2, un3) : j_hi;
        const int nb2 = cur >= 1 ? cur - 1 : 2;
        if (j2 < j_hi) stage_dma(lds + nb2 * AT_BUF, Kg + (size_t)j2 * 64 * 128, Vg + (size_t)j2 * 64 * 128, wid_u, lane);
        bool tsel = true;
        if (MK == MK_SLC) { const unsigned sw = (j < 32) ? sel0 : (j < 64) ? sel1 : (j < 96) ? sel2 : sel3; tsel = (sw >> (j & 31)) & 1u; }
        if (MK != MK_SLC || __any(tsel)) {
        f32x16 p0, p1; qkt<ND>(p0, p1, lds + cur * AT_BUF + AT_K, r32, hi, qr);
        bool need = (j * 64 + 63 > wpos0);
        if (MK == MK_WINDOW) need = need || (j * 64 <= wpos0 + wspan - 512);
        if (need) { const int kb = j * 64 + 4 * hi;
#pragma unroll
            for (int r = 0; r < 16; ++r) { const int k0 = kb + (r & 3) + 8 * (r >> 2), k1 = k0 + 32;
                bool ok0 = k0 <= pos, ok1 = k1 <= pos;
                if (MK == MK_WINDOW) { ok0 = ok0 && (k0 > pos - 512); ok1 = ok1 && (k1 > pos - 512); }
                if (!ok0) p0[r] = NEG; if (!ok1) p1[r] = NEG; } }
        if (MK == MK_SLC) { if (!__all(tsel)) {
#pragma unroll
            for (int r = 0; r < 16; ++r) { p0[r] = tsel ? p0[r] : NEG; p1[r] = tsel ? p1[r] : NEG; } } }
        float alpha; partialSM(p0, p1, m_reg, alpha, scale, C2);
        rescaleO(o, alpha, al_l, r32, hi);
        l_reg = l_reg * alpha + rowsum32(p0, p1);
        bf16x8 pa0, pa1, pa2, pa3; packP(p0, p1, pa0, pa1, pa2, pa3);
        pv_tile(o, vb0 + cur * AT_BUF, pa0, pa1, pa2, pa3);
        }
        if (j2 < j_hi) asm volatile("s_waitcnt vmcnt(4) lgkmcnt(0)" ::: "memory"); else asm volatile("s_waitcnt vmcnt(0) lgkmcnt(0)" ::: "memory");
        __builtin_amdgcn_s_barrier(); asm volatile("" ::: "memory");
        if (j1 >= j_hi) break;
        j = j1; j1 = j2; cur = cur == 2 ? 0 : cur + 1;
    }
}
__device__ __forceinline__ void store_O_bf16(const f32x16* o, const float* rs16, bf16_t* base  , size_t ld, int r32, int hi) {
#pragma unroll
    for (int r = 0; r < 16; ++r) { const int orow = crow(r, hi);
#pragma unroll
        for (int d0 = 0; d0 < 4; ++d0) { const float v = o[d0][r] * rs16[r]; const float vn = lane_xor1(v);
            if ((r32 & 1) == 0) *(unsigned*)(base + (size_t)orow * ld + d0 * 32 + r32) = cvtpk(v, vn); } }
}
__device__ __forceinline__ void da_sweep(ldsp_t lds, const bf16_t* Q, const bf16_t* K, const bf16_t* V, int bh, int qb, f32x16* o0, f32x16* o1, float& l0, float& l1) {
    const float SCALE = 0.125f, C2 = SCALE * 1.4426950408889634f, NEG = -__builtin_inff();
    const int tid = my_tid(), wid = tid >> 6, lane = tid & 63, r32 = lane & 31, hi = lane >> 5;
    LAS float* al_l = (LAS float*)(lds + AT_WS) + wid * 64;
    const unsigned vb0 = (unsigned)(size_t)(lds + AT_V) + v_rd_base(lane);
    const bf16_t* Kg = K + (size_t)bh * SEQ * 128; const bf16_t* Vg = V + (size_t)bh * SEQ * 128;
    ldsp_t Qw = lds + q_park(wid);
    { const bf16_t* Qb = Q + ((size_t)bh * SEQ + qb * 256 + wid * 32 + r32) * 128;
#pragma unroll
      for (int d0 = 0; d0 < 8; ++d0) *(LAS bf16x8*)(Qw + KSWZ(r32, (d0 * 16 + hi * 8) * 2)) = *(const bf16x8*)(Qb + d0 * 16 + hi * 8); }
    float m0 = -1e30f, m1 = -1e30f;
    const int wpos0 = qb * 256 + wid * 32, pos = wpos0 + r32, j_hi = 4 * (qb + 1);
    const int wid_u = __builtin_amdgcn_readfirstlane(wid);
    __syncthreads();
    stage_dma(lds, Kg, Vg, wid_u, lane);
    __syncthreads();
    int cur = 0;
    for (int j = 0; j < j_hi; ++j) {
        const bool has = j + 1 < j_hi;
        if (has) stage_dma(lds + (cur ^ 1) * AT_BUF, Kg + (size_t)(j + 1) * 64 * 128, Vg + (size_t)(j + 1) * 64 * 128, wid_u, lane);
        const bool need = (j * 64 + 63 > wpos0);
        const int kb = j * 64 + 4 * hi;
        if (j * 64 <= wpos0 + 31) {
        { f32x16 p0, p1; qkt_range_lq<0, 4>(p0, p1, lds + cur * AT_BUF + AT_K, Qw, r32, hi);
          if (need) {
#pragma unroll
              for (int r = 0; r < 16; ++r) { const int k0 = kb + (r & 3) + 8 * (r >> 2); if (k0 > pos) p0[r] = NEG; if (k0 + 32 > pos) p1[r] = NEG; } }
          float a0; partialSM(p0, p1, m0, a0, SCALE, C2); l0 = l0 * a0 + rowsum32(p0, p1);
          bf16x8 pa0, pa1, pa2, pa3; packP(p0, p1, pa0, pa1, pa2, pa3);
          rescaleO(o0, a0, al_l, r32, hi); pv_tile_h(o0, vb0 + cur * AT_BUF, pa0, pa1, pa2, pa3); }
        { f32x16 p0, p1; qkt_range_lq<4, 8>(p0, p1, lds + cur * AT_BUF + AT_K, Qw, r32, hi);
          if (need) {
#pragma unroll
              for (int r = 0; r < 16; ++r) { const int k0 = kb + (r & 3) + 8 * (r >> 2); if (k0 > pos) p0[r] = NEG; if (k0 + 32 > pos) p1[r] = NEG; } }
          float a1; partialSM(p0, p1, m1, a1, SCALE, C2); l1 = l1 * a1 + rowsum32(p0, p1);
          bf16x8 pa0, pa1, pa2, pa3; packP(p0, p1, pa0, pa1, pa2, pa3);
          rescaleO(o1, a1, al_l, r32, hi); pv_tile_h(o1, vb0 + cur * AT_BUF, pa0, pa1, pa2, pa3); }
        }
        __syncthreads();
        cur ^= 1;
    }
}
__device__ __forceinline__ void da_epilogue(ldsp_t lds, const f32x16* o0, const f32x16* o1, float l0, float l1, const float* lam, const float* normg, bf16_t* ob, int b, int h, int qb) {
    const float LAM_INIT = 0.35550906759096934f;
    const int tid = my_tid(), wid = tid >> 6, lane = tid & 63, r32 = lane & 31, hi = lane >> 5;
    LAS float* li_l = (LAS float*)(lds + AT_WS) + wid * 64 + 32;
    const float s1 = wave_sum(lam[lane] * lam[64 + lane]), s2 = wave_sum(lam[128 + lane] * lam[192 + lane]);
    const float lmb = __expf(s1) - __expf(s2) + LAM_INIT;
    float i0[16], i1[16]; row_scalars(1.f / l0, i0, li_l, r32, hi); row_scalars(lmb / l1, i1, li_l, r32, hi);
    float ng[4];
#pragma unroll
    for (int d0 = 0; d0 < 4; ++d0) ng[d0] = normg[d0 * 32 + r32] * (1.f - LAM_INIT);
    bf16_t* Ob = ob + ((size_t)b * SEQ + qb * 256 + wid * 32) * DM + h * 128;
#pragma unroll
    for (int r = 0; r < 16; ++r) {
        float x[4], ss = 0.f;
#pragma unroll
        for (int d0 = 0; d0 < 4; ++d0) { x[d0] = o0[d0][r] * i0[r] - o1[d0][r] * i1[r]; ss += x[d0] * x[d0]; }
        ss = sum_rows16(row16_sum(ss));
        const float rs = rsqrtf(ss * (1.f / 128.f) + LN_EPS);
        const int orow = crow(r, hi);
#pragma unroll
        for (int d0 = 0; d0 < 4; ++d0) { const float v = x[d0] * rs * ng[d0]; const float vn = lane_xor1(v);
            if ((r32 & 1) == 0) *(unsigned*)(Ob + (size_t)orow * DM + d0 * 32 + r32) = cvtpk(v, vn); } }
}
__device__ __forceinline__ void da_attn_phase(ldsp_t lds, const bf16_t* Q, const bf16_t* K, const bf16_t* V, const float* lam, const float* normg, bf16_t* ob, int wg, int nwg) {
    const int nround = (1024 + nwg - 1) / nwg;
    for (int n = 0; n < nround; ++n) {
        const int idx = n * nwg + ((n & 1) ? (nwg - 1 - wg) : wg);
        if (idx >= 1024) continue;
        const int qb = 31 - (idx >> 5), bh = idx & 31, b = bh >> 3, h = bh & 7;
        f32x16 o0[4] = {}, o1[4] = {}; float l0 = 0.f, l1 = 0.f;
        da_sweep(lds, Q, K, V, bh, qb, o0, o1, l0, l1);
        da_epilogue(lds, o0, o1, l0, l1, lam, normg, ob, b, h, qb);
        __syncthreads();
    }
}
__device__ __forceinline__ void sb_attn_phase(ldsp_t lds, const bf16_t* Q, const bf16_t* K, const bf16_t* V, bf16_t* ob, int wg, int nwg) {
    const int tid = my_tid(), wid = tid >> 6, lane = tid & 63, r32 = lane & 31, hi = lane >> 5;
    const float SCALE = 0.08838834764831845f;
    LAS int* flags = (LAS int*)(lds + LDS_MISC - 64);
    const unsigned vb0 = (unsigned)(size_t)(lds + AT_V) + v_rd_base(lane);
    for (int idx = wg; idx < 1024; idx += nwg) {
        const int qb = idx >> 5, bh = idx & 31, b = bh >> 3, h = bh & 7;
        const bf16_t* Qb = Q + ((size_t)bh * SEQ + qb * 256 + wid * 32 + r32) * 128;
        const bf16_t* Kb = K + (size_t)bh * SEQ * 128; const bf16_t* Vb = V + (size_t)bh * SEQ * 128;
        ldsp_t Qw = lds + q_park(wid);
#pragma unroll
        for (int d0 = 0; d0 < 8; ++d0) *(LAS bf16x8*)(Qw + KSWZ(r32, (d0 * 16 + hi * 8) * 2)) = *(const bf16x8*)(Qb + d0 * 16 + hi * 8);
        f32x16 o[4] = {}; float R = 0.f; bool done = false;
        const int wpos0 = qb * 256 + wid * 32, pos = wpos0 + r32;
        const int wid_u = __builtin_amdgcn_readfirstlane(wid);
        stage_dma(lds, Kb + (size_t)(4 * qb + 3) * 64 * 128, Vb + (size_t)(4 * qb + 3) * 64 * 128, wid_u, lane);
        int cur = 0;
        for (int j = 4 * qb + 3; j >= 0; --j) {
            if (lane == 0) flags[wid] = done ? 1 : 0;
            __syncthreads();
            int alld = 1;
#pragma unroll
            for (int k = 0; k < 8; ++k) alld &= flags[k];
            if (alld) break;
            if (j > 0) stage_dma(lds + (cur ^ 1) * AT_BUF, Kb + (size_t)(j - 1) * 64 * 128, Vb + (size_t)(j - 1) * 64 * 128, wid_u, lane);
            const unsigned vbc = vb0 + cur * AT_BUF; ldsp_t Kt = lds + cur * AT_BUF + AT_K;
            cur ^= 1;
            if (!done && 64 * j < wpos0 + 31) {
                f32x16 p0, p1; qkt_range_lq<0, 8>(p0, p1, Kt, Qw, r32, hi);
                float l0[16], l1[16];
                const int kb = j * 64 + 4 * hi;
#pragma unroll
                for (int r = 0; r < 16; ++r) { const int k0 = kb + (r & 3) + 8 * (r >> 2), k1 = k0 + 32;
                    const float z0 = p0[r] * SCALE, z1 = p1[r] * SCALE;
                    const float sp0 = fmaxf(z0, 0.f) + __logf(1.f + __expf(-fabsf(z0))), sp1 = fmaxf(z1, 0.f) + __logf(1.f + __expf(-fabsf(z1)));
                    l0[r] = (k0 < pos) ? -sp0 : 0.f; l1[r] = (k1 < pos) ? -sp1 : 0.f; p0[r] = z0; p1[r] = z1; }
                float gs0[4], gs1[4], pg0[4], pg1[4], A0[4], A1[4];
#pragma unroll
                for (int q = 0; q < 4; ++q) { gs0[q] = (l0[4 * q] + l0[4 * q + 1]) + (l0[4 * q + 2] + l0[4 * q + 3]); gs1[q] = (l1[4 * q] + l1[4 * q + 1]) + (l1[4 * q + 2] + l1[4 * q + 3]); }
#pragma unroll
                for (int q = 0; q < 4; ++q) { pg0[q] = other_half32(gs0[q], hi); pg1[q] = other_half32(gs1[q], hi); }
                const float t00 = gs0[0] + pg0[0], t01 = gs0[1] + pg0[1], t02 = gs0[2] + pg0[2], t03 = gs0[3] + pg0[3];
                const float t10 = gs1[0] + pg1[0], t11 = gs1[1] + pg1[1], t12 = gs1[2] + pg1[2], t13 = gs1[3] + pg1[3];
                const float T1 = (t10 + t11) + (t12 + t13), T0 = (t00 + t01) + (t02 + t03);
                A0[3] = T1; A0[2] = A0[3] + t03; A0[1] = A0[2] + t02; A0[0] = A0[1] + t01;
                A1[3] = 0.f; A1[2] = t13; A1[1] = A1[2] + t12; A1[0] = A1[1] + t11;
                if (hi == 0) {
#pragma unroll
                    for (int q = 0; q < 4; ++q) { A0[q] += pg0[q]; A1[q] += pg1[q]; } }
#pragma unroll
                for (int q = 0; q < 4; ++q) {
                    float af0 = A0[q] + R, af1 = A1[q] + R;
#pragma unroll
                    for (int i = 3; i >= 0; --i) { const int r = 4 * q + i; const int k0 = kb + i + 8 * q, k1 = k0 + 32;
                        const float a0 = (k0 < pos) ? __expf(p0[r] + l0[r] + af0) : 0.f, a1 = (k1 < pos) ? __expf(p1[r] + l1[r] + af1) : 0.f;
                        af0 += l0[r]; af1 += l1[r]; p0[r] = a0; p1[r] = a1; } }
                R += T0 + T1;
                bf16x8 pa0, pa1, pa2, pa3; packP(p0, p1, pa0, pa1, pa2, pa3);
                pv_tile(o, vbc, pa0, pa1, pa2, pa3);
                done = __all(R < -104.f);
            }
        }
        __syncthreads();
        float one[16];
#pragma unroll
        for (int r = 0; r < 16; ++r) one[r] = 1.f;
        store_O_bf16(o, one, ob + ((size_t)b * SEQ + qb * 256 + wid * 32) * DM + h * 128, DM, r32, hi);
    }
}

__device__ __forceinline__ float gelu_tanh(float x) { const float u = 0.7978845608028654f * (x + 0.044715f * x * x * x); const float e = __expf(2.f * u); const float th = 1.f - 2.f / (e + 1.f); return 0.5f * x * (1.f + th); }
__device__ __forceinline__ void nsa_compress_phase(ldsp_t lds, const bf16_t* kv, const bf16_t* W1t, const bf16_t* W2t, const float* biasp, bf16_t* KC, int wg, int nwg) {
    const int tid = my_tid(), wid = tid >> 6, lane = tid & 63, c16 = lane & 15, g = lane >> 4;
    const int rg = wid & 1, ch = wid >> 1;
    ldsp_t H1 = lds;
    LAS float* biasL = (LAS float*)(lds + 32 * HG_P272);
    if (tid < 256) { float sacc = 0.f; for (int p = 0; p < 32; ++p) sacc += biasp[((tid >> 7) * 32 + p) * 128 + (tid & 127)]; biasL[tid] = sacc; }
    __syncthreads();
    for (int it = wg; it < 256; it += nwg) {
        const int jj = it >> 7, bg = (it >> 4) & 7, ct = it & 15;
        const bf16_t* X = kv + ((size_t)(jj * 8 + bg) * SEQ) * 128;
        const bf16_t* W1 = W1t + (size_t)jj * 128 * 4096; const bf16_t* W2 = W2t + (size_t)jj * 128 * 128;
        LAS float* part = (LAS float*)(lds + 16384);
        { int cr0 = ct * 32 + c16, cr1 = cr0 + 16; if (cr0 > 510) cr0 = 510; if (cr1 > 510) cr1 = 510;
          const bf16_t* A0p = X + (size_t)cr0 * 16 * 128 + wid * 512 + 8 * g; const bf16_t* A1p = X + (size_t)cr1 * 16 * 128 + wid * 512 + 8 * g;
          const bf16_t* Bp = W1 + (size_t)c16 * 4096 + wid * 512 + 8 * g;
          f32x4 acc[2][8];
#pragma unroll
          for (int rt = 0; rt < 2; ++rt)
#pragma unroll
              for (int nt = 0; nt < 8; ++nt) acc[rt][nt] = (f32x4){0.f, 0.f, 0.f, 0.f};
          bf16x8 Aa[2], Ba[8], Ab[2], Bb[8];
#define NC_LOAD(A, B, KS) do { A[0] = *(const bf16x8*)(A0p + (KS) * 32); A[1] = *(const bf16x8*)(A1p + (KS) * 32); \
              _Pragma("unroll") for (int nt = 0; nt < 8; ++nt) B[nt] = *(const bf16x8*)(Bp + (size_t)(16 * nt) * 4096 + (KS) * 32); } while (0)
#define NC_MMA(A, B) do { _Pragma("unroll") for (int rt = 0; rt < 2; ++rt) _Pragma("unroll") for (int nt = 0; nt < 8; ++nt) \
              acc[rt][nt] = __builtin_amdgcn_mfma_f32_16x16x32_bf16(A[rt], B[nt], acc[rt][nt], 0, 0, 0); } while (0)
          NC_LOAD(Aa, Ba, 0); __builtin_amdgcn_sched_barrier(0);
          for (int ks = 0; ks < 16; ks += 2) {
              NC_LOAD(Ab, Bb, ks + 1); __builtin_amdgcn_sched_barrier(0);
              NC_MMA(Aa, Ba); __builtin_amdgcn_sched_barrier(0);
              if (ks + 2 < 16) NC_LOAD(Aa, Ba, ks + 2);
              __builtin_amdgcn_sched_barrier(0);
              NC_MMA(Ab, Bb); __builtin_amdgcn_sched_barrier(0); }
#undef NC_LOAD
#undef NC_MMA
#pragma unroll
          for (int rt = 0; rt < 2; ++rt)
#pragma unroll
              for (int nt = 0; nt < 8; ++nt)
#pragma unroll
                  for (int r = 0; r < 4; ++r) part[(wid * 32 + 16 * rt + 4 * g + r) * 128 + 16 * nt + c16] = acc[rt][nt][r]; }
        __syncthreads();
        { const int row = tid >> 4, c0 = (tid & 15) * 8;
          f32x4 s0 = {0.f, 0.f, 0.f, 0.f}, s1 = {0.f, 0.f, 0.f, 0.f};
#pragma unroll
          for (int w = 0; w < 8; ++w) { s0 += *(const LAS f32x4*)(part + (w * 32 + row) * 128 + c0); s1 += *(const LAS f32x4*)(part + (w * 32 + row) * 128 + c0 + 4); }
          f32x4 h0, h1;
#pragma unroll
          for (int e = 0; e < 4; ++e) { h0[e] = gelu_tanh(s0[e] + biasL[jj * 128 + c0 + e]); h1[e] = gelu_tanh(s1[e] + biasL[jj * 128 + c0 + 4 + e]); }
          *(LAS bf16x8*)(H1 + row * HG_P272 + c0 * 2) = pack8(h0, h1); }
        __syncthreads();
        f32x4 ac2[2];
#pragma unroll
        for (int nt = 0; nt < 2; ++nt) { ac2[nt] = (f32x4){0.f, 0.f, 0.f, 0.f};
#pragma unroll
            for (int ks = 0; ks < 4; ++ks) { const bf16x8 A = *(const LAS bf16x8*)(H1 + (16 * rg + c16) * HG_P272 + (32 * ks + 8 * g) * 2);
                const bf16x8 B = *(const bf16x8*)(W2 + (size_t)(32 * ch + 16 * nt + c16) * 128 + 32 * ks + 8 * g);
                ac2[nt] = __builtin_amdgcn_mfma_f32_16x16x32_bf16(A, B, ac2[nt], 0, 0, 0); } }
#pragma unroll
        for (int nt = 0; nt < 2; ++nt)
#pragma unroll
            for (int r = 0; r < 4; ++r) { const int c = ct * 32 + rg * 16 + 4 * g + r; const int n = 32 * ch + 16 * nt + c16;
                KC[((size_t)(jj * 8 + bg) * NCMP_P + c) * 128 + n] = (c <= 510) ? f2bf(ac2[nt][r]) : (bf16_t)0; }
        __syncthreads();
    }
}
constexpr int NS_IMPP = AT_END, NS_IMPS = NS_IMPP + 4096, NS_IMP = NS_IMPS + 4096, NS_CARRY = NS_IMP + 33792, NS_SEL = NS_CARRY + 512, NS_UN = NS_SEL + 1024, NS_END = NS_UN + 16;
static_assert(NS_END <= LDS_MISC, "NSA LDS");
__device__ __forceinline__ void nsa_cmp_sweep1(ldsp_t lds, const bf16x8* qr, const bf16_t* kcb, const bf16_t* vcb, int ntile, int pos, float& m_reg, float& l_reg) {
    const int tid = my_tid(), wid_u = __builtin_amdgcn_readfirstlane(tid >> 6), lane = tid & 63, r32 = lane & 31, hi = lane >> 5;
    const float SCALE = 0.08838834764831845f, C2 = SCALE * 1.4426950408889634f, NEG = -__builtin_inff();
    stage_dma(lds, kcb, vcb, wid_u, lane);
    int cur = 0;
    for (int jt = 0; jt < ntile; ++jt) {
        __syncthreads();
        if (jt + 1 < ntile) stage_dma(lds + (cur ^ 1) * AT_BUF, kcb + (size_t)(jt + 1) * 64 * 128, vcb + (size_t)(jt + 1) * 64 * 128, wid_u, lane);
        f32x16 p0, p1; qkt<8>(p0, p1, lds + cur * AT_BUF + AT_K, r32, hi, qr);
        const int kb = jt * 64 + 4 * hi;
#pragma unroll
        for (int r = 0; r < 16; ++r) { const int c0 = kb + (r & 3) + 8 * (r >> 2), c1 = c0 + 32;
            if (!(c0 < NCMP && 16 * c0 + 31 <= pos)) p0[r] = NEG; if (!(c1 < NCMP && 16 * c1 + 31 <= pos)) p1[r] = NEG; }
        float alpha; partialSM(p0, p1, m_reg, alpha, SCALE, C2);
        l_reg = l_reg * alpha + rowsum32(p0, p1);
        cur ^= 1;
    }
    __syncthreads();
}
__device__ __forceinline__ void nsa_cmp_sweep2(ldsp_t lds, const bf16x8* qr, const bf16_t* kcb, const bf16_t* vcb, int ntile, int pos, int tokl, float m_reg, float l_reg, f32x16* o) {
    const int tid = my_tid(), lane = tid & 63, r32 = lane & 31, hi = lane >> 5;
    const float SCALE = 0.08838834764831845f, C2 = SCALE * 1.4426950408889634f;
    LAS float* impP = (LAS float*)(lds + NS_IMPP); LAS float* impS = (LAS float*)(lds + NS_IMPS);
    LAS float* imp = (LAS float*)(lds + NS_IMP); LAS float* carry = (LAS float*)(lds + NS_CARRY);
    const unsigned vb0 = (unsigned)(size_t)(lds + AT_V) + v_rd_base(lane);
    const float inv_l = l_reg > 0.f ? 1.f / l_reg : 0.f;
    const float mL = -m_reg * C2;
    const int wid_u = __builtin_amdgcn_readfirstlane(tid >> 6);
    stage_dma(lds, kcb, vcb, wid_u, lane);
    int cur = 0;
    for (int jt = 0; jt < ntile; ++jt) {
        __syncthreads();
        if (jt + 1 < ntile) stage_dma(lds + (cur ^ 1) * AT_BUF, kcb + (size_t)(jt + 1) * 64 * 128, vcb + (size_t)(jt + 1) * 64 * 128, wid_u, lane);
        f32x16 p0, p1; qkt<8>(p0, p1, lds + cur * AT_BUF + AT_K, r32, hi, qr);
        const int kb = jt * 64 + 4 * hi;
#pragma unroll
        for (int r = 0; r < 16; ++r) { const int c0 = kb + (r & 3) + 8 * (r >> 2), c1 = c0 + 32;
            const bool ok0 = (c0 < NCMP && 16 * c0 + 31 <= pos), ok1 = (c1 < NCMP && 16 * c1 + 31 <= pos);
            p0[r] = ok0 ? __builtin_amdgcn_exp2f(fmaf(p0[r], C2, mL)) * inv_l : 0.f; p1[r] = ok1 ? __builtin_amdgcn_exp2f(fmaf(p1[r], C2, mL)) * inv_l : 0.f; }
#pragma unroll
        for (int q = 0; q < 4; ++q) {
            float sp0 = 0.5f * p0[4 * q + 3], sp1 = 0.5f * p1[4 * q + 3];
            float mn0 = (p0[4 * q] + p0[4 * q + 1]) + (p0[4 * q + 2] + sp0), mn1 = (p1[4 * q] + p1[4 * q + 1]) + (p1[4 * q + 2] + sp1);
            mn0 += lane_xor1(mn0); mn0 += lane_xor2(mn0); mn1 += lane_xor1(mn1); mn1 += lane_xor2(mn1);
            sp0 += lane_xor1(sp0); sp0 += lane_xor2(sp0); sp1 += lane_xor1(sp1); sp1 += lane_xor2(sp1);
            if ((r32 & 3) == 0) { const int i0 = tokl * 16 + 2 * q + hi; impP[i0] = mn0; impS[i0] = sp0; impP[i0 + 8] = mn1; impS[i0 + 8] = sp1; } }
        bf16x8 pa0, pa1, pa2, pa3; packP(p0, p1, pa0, pa1, pa2, pa3);
        pv_tile(o, vb0 + cur * AT_BUF, pa0, pa1, pa2, pa3);
        cur ^= 1;
        __syncthreads();
        { const int tk = tid >> 3, part = tid & 7;
#pragma unroll
          for (int e = 0; e < 2; ++e) { const int nb = 2 * part + e; float mm = impP[tk * 16 + nb];
              if (nb > 0) mm += impS[tk * 16 + nb - 1];
              if (nb == 0 && jt > 0) mm += carry[((jt - 1) & 1) * 64 + tk];
              imp[tk * 132 + 16 * jt + nb] = mm; }
          if (part == 7) carry[(jt & 1) * 64 + tk] = impS[tk * 16 + 15]; }
    }
    __syncthreads();
}
__device__ __forceinline__ void nsa_topk(ldsp_t lds, int cur) {
    const int tid = my_tid(), tk = tid >> 3, part = tid & 7;
    const float NEG = -__builtin_inff();
    LAS float* imp = (LAS float*)(lds + NS_IMP);
    LAS unsigned* selm = (LAS unsigned*)(lds + NS_SEL); LAS unsigned* unm = (LAS unsigned*)(lds + NS_UN);
    float vals[16]; unsigned mym = 0u;
#pragma unroll
    for (int q = 0; q < 4; ++q) { const f32x4 t = *(const LAS f32x4*)(imp + tk * 132 + part * 16 + 4 * q);
#pragma unroll
        for (int e = 0; e < 4; ++e) vals[4 * q + e] = t[e]; }
#pragma unroll
    for (int k = 0; k < 16; ++k) { const int nn = part * 16 + k; const bool forced = (nn == 0 || nn == cur || nn == cur - 1);
        mym |= forced ? (1u << k) : 0u; vals[k] = (nn > cur || forced) ? NEG : vals[k]; }
    const int nforced = cur >= 2 ? 3 : cur + 1;
    for (int rnd = nforced; rnd < 16; ++rnd) {
        float best = vals[0]; int bi = 0;
#pragma unroll
        for (int k = 1; k < 16; ++k) if (vals[k] > best) { best = vals[k]; bi = k; }
        int gi = part * 16 + bi;
        { const float ov = dpp_f<0xB1>(best); const int oi = dpp_i<0xB1>(gi); const bool t = (ov > best) || (ov == best && oi < gi); best = t ? ov : best; gi = t ? oi : gi; }
        { const float ov = dpp_f<0x4E>(best); const int oi = dpp_i<0x4E>(gi); const bool t = (ov > best) || (ov == best && oi < gi); best = t ? ov : best; gi = t ? oi : gi; }
        { const float ov = dpp_f<0x141>(best); const int oi = dpp_i<0x141>(gi); const bool t = (ov > best) || (ov == best && oi < gi); best = t ? ov : best; gi = t ? oi : gi; }
        const bool win = (best > -5e29f) && ((gi >> 4) == part);
        const int kk = win ? (gi & 15) : 16;
        mym |= win ? (1u << (gi & 15)) : 0u;
#pragma unroll
        for (int k = 0; k < 16; ++k) vals[k] = (k == kk) ? NEG : vals[k];
    }
    unsigned mw = mym << (16 * (part & 1));
    mw |= (unsigned)dpp_i<0xB1>((int)mw);
    if ((part & 1) == 0) { selm[tk * 4 + (part >> 1)] = mw; atomicOr((unsigned*)(unm + (part >> 1)), mw); }
}
__device__ __forceinline__ void nsa_load_q(bf16x8* qr, const bf16_t* Q, int b, int g, int s0) {
    const int tid = my_tid(), wid = tid >> 6, lane = tid & 63, r32 = lane & 31, hi = lane >> 5, hh = r32 & 3, tokl = 8 * wid + (r32 >> 2);
    const bf16_t* p = Q + (((size_t)b * 8 + g * 4 + hh) * SEQ + s0 + tokl) * 128 + hi * 8;
#pragma unroll
    for (int d0 = 0; d0 < 8; ++d0) qr[d0] = *(const bf16x8*)(p + d0 * 16);
}
template <int MODE>
__device__ __forceinline__ void nsa_branch_out(ldsp_t lds, f32x16* o, float l_reg, bool normalise, int which, const float* gates, float* OACC, bf16_t* ob, int b, int g, int s0) {
    const int tid = my_tid(), wid = tid >> 6, lane = tid & 63, r32 = lane & 31, hi = lane >> 5, hh = r32 & 3, tokl = 8 * wid + (r32 >> 2);
    LAS float* li_l = (LAS float*)(lds + AT_WS) + wid * 64 + 32;
    const float gt = gates[((size_t)b * SEQ + s0 + tokl) * 24 + (g * 4 + hh) * 3 + which];
    float gsc[16]; row_scalars(normalise ? gt * (l_reg > 0.f ? 1.f / l_reg : 0.f) : gt, gsc, li_l, r32, hi);
    f32x4* op = (f32x4*)(OACC + ((size_t)b * SEQ + s0) * DM + (size_t)g * (64 * 512)) + tid;
    const size_t base = ((size_t)b * SEQ + s0 + 8 * wid) * DM + (size_t)g * 512;
#pragma unroll
    for (int d0 = 0; d0 < 4; ++d0)
#pragma unroll
        for (int k = 0; k < 4; ++k) {
            f32x4 v = {o[d0][4 * k] * gsc[4 * k], o[d0][4 * k + 1] * gsc[4 * k + 1], o[d0][4 * k + 2] * gsc[4 * k + 2], o[d0][4 * k + 3] * gsc[4 * k + 3]};
            if (MODE == 0) op[(d0 * 4 + k) * 512] = v;
            else if (MODE == 1) op[(d0 * 4 + k) * 512] += v;
            else { v += op[(d0 * 4 + k) * 512];
#pragma unroll
                for (int e = 0; e < 4; ++e) { const int r = 4 * k + e; const int qi = crow(r, hi); const size_t ro = base + (size_t)(qi >> 2) * DM + (qi & 3) * 128;
                    const float vn = lane_xor1(v[e]);
                    if ((r32 & 1) == 0) *(unsigned*)(ob + ro + d0 * 32 + r32) = cvtpk(v[e], vn); } } }
}
__device__ __forceinline__ void nsa_attn_phase(ldsp_t lds, const bf16_t* Qp, const bf16_t* Qr, const bf16_t* kv, const bf16_t* KC, const float* gates, float* OACC, bf16_t* ob, int wg, int nwg) {
    const float SCALE = 0.08838834764831845f;
    LAS float* imp = (LAS float*)(lds + NS_IMP);
    LAS unsigned* selm = (LAS unsigned*)(lds + NS_SEL); LAS unsigned* unm = (LAS unsigned*)(lds + NS_UN);
    const int nround = (1024 + nwg - 1) / nwg;
    for (int n = 0; n < nround; ++n) {
        const int idx = n * nwg + ((n & 1) ? (nwg - 1 - wg) : wg);
        if (idx >= 1024) continue;
        const int blk = 127 - (idx >> 3), bg = idx & 7, b = bg >> 1, g = bg & 1;
        const int s0 = blk * 64;
        const int tid = my_tid(), wid = tid >> 6, lane = tid & 63, tokl = 8 * wid + ((lane & 31) >> 2), pos = s0 + tokl;
        const bf16_t* kcb = KC + (size_t)bg * NCMP_P * 128; const bf16_t* vcb = KC + (size_t)(8 + bg) * NCMP_P * 128;
        for (int i = tid; i < 64 * 132; i += 512) imp[i] = 0.f;
        if (tid < 4) unm[tid] = 0u;
        bf16x8 qr[8];
        nsa_load_q(qr, Qp, b, g, s0);
        int nvalid = 4 * blk + 3; if (nvalid > NCMP) nvalid = NCMP;
        const int ntile = (nvalid + 63) >> 6;
        float m_reg = -1e30f, l_reg = 0.f;
        nsa_cmp_sweep1(lds, qr, kcb, vcb, ntile, pos, m_reg, l_reg);
        f32x16 o[4] = {};
        nsa_cmp_sweep2(lds, qr, kcb, vcb, ntile, pos, tokl, m_reg, l_reg, o);
        nsa_topk(lds, blk);
        nsa_branch_out<0>(lds, o, 1.f, false, 0, gates, OACC, ob, b, g, s0);
        __syncthreads();
        nsa_load_q(qr, Qr, b, g, s0);
        {
            const unsigned sel0 = selm[tokl * 4 + 0], sel1 = selm[tokl * 4 + 1], sel2 = selm[tokl * 4 + 2], sel3 = selm[tokl * 4 + 3];
            const unsigned un0 = unm[0], un1 = unm[1], un2 = unm[2], un3 = unm[3];
#pragma unroll
            for (int d0 = 0; d0 < 4; ++d0) o[d0] = f32x16{};
            m_reg = -1e30f; l_reg = 0.f;
            attn_sweep<MK_SLC, 8>(lds, qr, kv + (size_t)(2 * 8 + bg) * SEQ * 128, kv + (size_t)(3 * 8 + bg) * SEQ * 128, 0, blk + 1, pos, sel0, sel1, sel2, sel3, un0, un1, un2, un3, o, m_reg, l_reg, SCALE, 7);
            nsa_branch_out<1>(lds, o, l_reg, true, 1, gates, OACC, ob, b, g, s0);
        }
        {
#pragma unroll
            for (int d0 = 0; d0 < 4; ++d0) o[d0] = f32x16{};
            m_reg = -1e30f; l_reg = 0.f;
            attn_sweep<MK_WINDOW, 8>(lds, qr, kv + (size_t)(4 * 8 + bg) * SEQ * 128, kv + (size_t)(5 * 8 + bg) * SEQ * 128, blk > 8 ? blk - 8 : 0, blk + 1, pos, 0, 0, 0, 0, 0, 0, 0, 0, o, m_reg, l_reg, SCALE, 7);
            nsa_branch_out<2>(lds, o, l_reg, true, 2, gates, OACC, ob, b, g, s0);
        }
        __syncthreads();
    }
}

struct Args { const float* in[25]; float* out; unsigned char* ws; int ph_lo, ph_hi; };
enum { I_X = 0, I_HG_WIN, I_HG_LB, I_HG_NG, I_HG_WOUT, I_DA_WIN, I_DA_LAM, I_DA_NG, I_DA_WOUT, I_NSA_WIN, I_NSA_PE, I_NSA_W1, I_NSA_W2, I_NSA_WOUT,
       I_SB_WIN, I_SB_WOUT, I_FFN_WG, I_FFN_WU, I_FFN_WD, I_MOE_WR, I_MOE_WG, I_MOE_WU, I_MOE_WD, I_LN_G, I_LN_B };
__device__ __forceinline__ void rope_table(f32x2* tab, int half, double ratio, int wg, int nwg) {
    for (int i = wg * 512 + my_tid(); i < SEQ * half; i += nwg * 512) {
        const int s = i / half, j = i % half;
        double inv = 1.0; for (int k = 0; k < j; ++k) inv *= ratio;
        const float ang = (float)s * (float)inv;
        const double rev = (double)ang * 0.15915494309189535; const float fr = (float)(rev - floor(rev));
        tab[i] = (f32x2){__builtin_amdgcn_cosf(fr), __builtin_amdgcn_sinf(fr)};
    }
}
__device__ __forceinline__ void prologue_phase(ldsp_t lds, const Args& a, int wg, int nwg) {
    unsigned char* ws = a.ws; const int tid = my_tid();
    { const float* x = a.in[I_X]; bf16_t* hb = (bf16_t*)(ws + WS_HB);
      for (size_t i = ((size_t)wg * 512 + tid) * 8; i < (size_t)NT * DM; i += (size_t)nwg * 512 * 8)
          *(bf16x8*)(hb + i) = pack8(*(const f32x4*)(x + i), *(const f32x4*)(x + i + 4)); }
    if (wg == 0) { float* lbv = (float*)(ws + WS_LBV); const float* L = a.in[I_HG_LB];
        for (int d = tid; d < DM; d += 512) { float mx = L[d];
            for (int r = 1; r < 5; ++r) mx = fmaxf(mx, L[r * DM + d]);
            float s = 0.f; for (int r = 0; r < 5; ++r) s += __expf(L[r * DM + d] - mx);
            lbv[d] = __expf(L[d] - mx) / s; } }
    for (int u = wg; u < 64; u += nwg) { const int jj = u >> 5, p = u & 31; LAS float* red = (LAS float*)lds;
        const float* pe = a.in[I_NSA_PE] + (size_t)jj * 4096 + p * 128; const float* w1 = a.in[I_NSA_W1] + ((size_t)jj * 4096 + p * 128) * 128;
        const int nn = tid & 127, sub = tid >> 7; float sacc = 0.f;
#pragma unroll 8
        for (int k = sub * 32; k < sub * 32 + 32; ++k) sacc += pe[k] * w1[(size_t)k * 128 + nn];
        red[sub * 128 + nn] = sacc; __syncthreads();
        if (tid < 128) ((float*)(ws + WS_CMPBIAS))[(jj * 32 + p) * 128 + tid] = (red[tid] + red[128 + tid]) + (red[256 + tid] + red[384 + tid]);
        __syncthreads(); }
    rope_table((f32x2*)(ws + WS_ROPE_DA), 32, 0.7498942093324559, wg, nwg);
    rope_table((f32x2*)(ws + WS_ROPE_NSA), 64, 0.8659643233600653, wg, nwg);
    __syncthreads();
    convert_T(lds, (bf16_t*)(ws + WS_W_HGIN), 1, 0, 4096, 1024, MapId{a.in[I_HG_WIN], 4096, 4096}, wg, nwg);
    convert_T(lds, (bf16_t*)(ws + WS_W_HGOUT), 1, 0, 1024, 1024, MapId{a.in[I_HG_WOUT], 1024, 1024}, wg, nwg);
    convert_T(lds, (bf16_t*)(ws + WS_W_DAIN), 1, 0, 3072, 1024, MapRope64{a.in[I_DA_WIN], 3072}, wg, nwg);
    convert_T(lds, (bf16_t*)(ws + WS_W_DAOUT), 1, 0, 1024, 1024, MapId{a.in[I_DA_WOUT], 1024, 1024}, wg, nwg);
    convert_T(lds, (bf16_t*)(ws + WS_W_NSAIN), 1, 0, NSA_NPAD, 1024, MapNsa{a.in[I_NSA_WIN], 2584}, wg, nwg);
    convert_T(lds, (bf16_t*)(ws + WS_W_NSAOUT), 1, 0, 1024, 1024, MapId{a.in[I_NSA_WOUT], 1024, 1024}, wg, nwg);
    convert_T(lds, (bf16_t*)(ws + WS_W_SBIN), 1, 0, 3072, 1024, MapId{a.in[I_SB_WIN], 3072, 3072}, wg, nwg);
    convert_T(lds, (bf16_t*)(ws + WS_W_SBOUT), 1, 0, 1024, 1024, MapId{a.in[I_SB_WOUT], 1024, 1024}, wg, nwg);
    for (int j = 0; j < 2; ++j) {
        convert_T(lds, (bf16_t*)(ws + WS_W_FFNGU) + (size_t)j * 5632 * 1024, 1, 0, 5632, 1024, MapGU{a.in[I_FFN_WG] + (size_t)j * 1024 * DFF, a.in[I_FFN_WU] + (size_t)j * 1024 * DFF, DFF}, wg, nwg);
        convert_T(lds, (bf16_t*)(ws + WS_W_FFND) + (size_t)j * 1024 * DFF, 1, 0, 1024, DFF, MapId{a.in[I_FFN_WD] + (size_t)j * DFF * 1024, 1024, 1024}, wg, nwg);
        convert_T(lds, (bf16_t*)(ws + WS_W_CMP1) + (size_t)j * 128 * 4096, 1, 0, 128, 4096, MapId{a.in[I_NSA_W1] + (size_t)j * 4096 * 128, 128, 128}, wg, nwg);
        convert_T(lds, (bf16_t*)(ws + WS_W_CMP2) + (size_t)j * 128 * 128, 1, 0, 128, 128, MapId{a.in[I_NSA_W2] + (size_t)j * 128 * 128, 128, 128}, wg, nwg);
    }
}
__device__ __forceinline__ void moe_down_sub(ldsp_t lds, const bf16_t* A, const bf16_t* Bt, const pg8::Unit u, int rq, int cq, bf16_t* y) {
    using namespace pg8;
    constexpr int K = DFFE, nt = K / BK, STG = 16384, NST = 8;
    const int tid = my_tid(), wid = __builtin_amdgcn_readfirstlane(tid >> 6), lane = tid & 63, wm = wid >> 1, wc2 = wid & 1, fr = lane & 15, fq = lane >> 4;
    unsigned voffA, voffB;
    { int R, C; stage_rc(tid * 16, R, C); voffA = (unsigned)(R * K + C) * 2u; const int Rb = (R & ~31) + perm32(R & 31); voffB = (unsigned)(Rb * K + C) * 2u; }
    const char* cA = (const char*)A + ((size_t)u.pm * 256 + (size_t)rq * 64) * K * 2;
    const char* cB = (const char*)Bt + ((size_t)u.pn * 256 + (size_t)cq * 64) * K * 2;
    const unsigned ldsw = (unsigned)wid * 1024u;
    const int aoff = lds_byte(wm * 16 + fr, fq * 8), boff = 8192 + lds_byte(wc2 * 32 + fr, fq * 8);
#define MS_STAGE(s, t) do { const size_t ko_ = (size_t)(t) * (BK * 2); \
        __builtin_amdgcn_global_load_lds((const unsigned*)(cA + ko_ + voffA), (LAS unsigned*)(lds + (s) * STG + ldsw), 16, 0, 0); \
        __builtin_amdgcn_global_load_lds((const unsigned*)(cB + ko_ + voffB), (LAS unsigned*)(lds + (s) * STG + 8192 + ldsw), 16, 0, 0); } while (0)
    f32x4 acc[2] = {(f32x4){0.f, 0.f, 0.f, 0.f}, (f32x4){0.f, 0.f, 0.f, 0.f}};
#pragma unroll
    for (int t = 0; t < NST - 1; ++t) MS_STAGE(t, t);
    for (int t = 0; t < nt; ++t) {
        asm volatile("s_waitcnt vmcnt(12)" ::: "memory");
        __builtin_amdgcn_s_barrier();
        asm volatile("" ::: "memory");
        { const int tn = (t + NST - 1 < nt) ? t + NST - 1 : nt - 1;
          MS_STAGE((t + NST - 1) & (NST - 1), tn); }
        const int s = t & (NST - 1);
        bf16x8 At[2], Bf[2][2];
#pragma unroll
        for (int k = 0; k < 2; ++k) At[k] = *(const LAS bf16x8*)(lds + s * STG + aoff + k * 1024);
#pragma unroll
        for (int n = 0; n < 2; ++n)
#pragma unroll
            for (int k = 0; k < 2; ++k) Bf[n][k] = *(const LAS bf16x8*)(lds + s * STG + boff + n * 2048 + k * 1024);
#pragma unroll
        for (int n = 0; n < 2; ++n)
#pragma unroll
            for (int k = 0; k < 2; ++k) acc[n] = __builtin_amdgcn_mfma_f32_16x16x32_bf16(Bf[n][k], At[k], acc[n], 0, 0, 0);
        asm volatile("" ::: "memory");
    }
#undef MS_STAGE
    asm volatile("s_waitcnt vmcnt(0)" ::: "memory");
    { const int row = u.pm * 256 + rq * 64 + wm * 16 + fr, colL = (u.pn & 3) * 256 + cq * 64 + wc2 * 32 + 8 * fq;
      *(bf16x8*)(y + (size_t)row * DM + colL) = pack8(acc[0], acc[1]); }
    __syncthreads();
}
__device__ __forceinline__ void moe_convert_phase(ldsp_t lds, const Args& a, int j, int wg, int nwg) {
    unsigned char* ws = a.ws;
    const size_t eo = (size_t)(j * 8) * 1024 * DFFE;
    convert_T(lds, (bf16_t*)(ws + WS_W_MOEGU), 8, (size_t)1024 * DFFE, 7168, 1024, MapGU{a.in[I_MOE_WG] + eo, a.in[I_MOE_WU] + eo, DFFE}, wg, nwg);
    convert_T(lds, (bf16_t*)(ws + WS_W_MOED), 8, (size_t)1024 * DFFE, 1024, DFFE, MapId{a.in[I_MOE_WD] + eo, 1024, 1024}, wg, nwg);
}

__global__ void __launch_bounds__(512, 2) mega(Args a) {
    extern __shared__ __attribute__((aligned(16))) unsigned char lds_raw[];
    ldsp_t lds = (ldsp_t)lds_raw;
    const int tid = my_tid(), wg = blockIdx.x, nwg = gridDim.x;
    const int lo = a.ph_lo, hi = a.ph_hi;
    unsigned char* ws = a.ws;
    volatile LAS unsigned* misc = (volatile LAS unsigned*)(lds + LDS_MISC);
    XcdBarrier bar; bar.bar = (unsigned*)(ws + WS_BAR); bar.x = 0; bar.st = misc;
    if (hi - lo > 1) { if (tid == 0) { misc[0] = 0u; misc[1] = 0u; misc[2] = 0u; misc[3] = 0u; } __syncthreads(); bar = xcd_barrier_post((unsigned*)(ws + WS_BAR), misc); }
    int ph = 0;
#ifndef PH_MASK
#define PH_MASK 0xffffffffu
#endif
#ifndef REPEAT_ID
#define REPEAT_ID (-1)
#define REPEAT_N 1
#endif
#define PH_BEGIN(ID) if (((PH_MASK >> (ID)) & 1u) && ph >= lo && ph < hi) { for (int rep_ = 0; rep_ < ((ID) == REPEAT_ID ? REPEAT_N : 1); ++rep_) {
#define PH_END   } if (ph + 1 < hi) xcd_barrier(bar); } ++ph;
    bf16_t* hb = (bf16_t*)(ws + WS_HB); bf16_t* ob = (bf16_t*)(ws + WS_OB);
    unsigned* ctl = (unsigned*)(ws + WS_CTL);

    PH_BEGIN(0) prologue_phase(lds, a, wg, nwg); PH_END

    for (int layer = 0; layer < 4; ++layer) {
        if (layer == 0) {
            PH_BEGIN(1) { pg8::Gemm g{hb, (const bf16_t*)(ws + WS_W_HGIN), NT, 4096, 1024}; pg8::StaticOrder S; S.init(NT, 4096, nwg, wg);
                EpiHgIn E{(bf16_t*)(ws + SC_HG_QS), (bf16_t*)(ws + SC_HG_VV), (bf16_t*)(ws + SC_HG_SG), (float*)(ws + SC_HG_LF), (const float*)(ws + WS_LBV)};
                pg8::gemm_phase(lds, g, S, E); } PH_END
            PH_BEGIN(2) hgrn_passA(lds, (const float*)(ws + SC_HG_LF), (const bf16_t*)(ws + SC_HG_VV), (bf16_t*)(ws + SC_HG_ST), (float*)(ws + SC_HG_DEC), wg, nwg); PH_END
            PH_BEGIN(3) hgrn_passB((bf16_t*)(ws + SC_HG_ST), (const float*)(ws + SC_HG_DEC), wg, nwg); PH_END
            PH_BEGIN(4) hgrn_passC(lds, (const bf16_t*)(ws + SC_HG_QS), (const float*)(ws + SC_HG_LF), (const bf16_t*)(ws + SC_HG_VV), (const bf16_t*)(ws + SC_HG_SG),
                                (const bf16_t*)(ws + SC_HG_ST), a.in[I_HG_NG], ob, wg, nwg); PH_END
        } else if (layer == 1) {
            PH_BEGIN(5) { pg8::Gemm g{hb, (const bf16_t*)(ws + WS_W_DAIN), NT, 3072, 1024}; pg8::StaticOrder S; S.init(NT, 3072, nwg, wg);
                EpiDaIn E{(bf16_t*)(ws + SC_DA_Q), (bf16_t*)(ws + SC_DA_K), (bf16_t*)(ws + SC_DA_V), (const f32x2*)(ws + WS_ROPE_DA)};
                pg8::gemm_phase(lds, g, S, E); } PH_END
            PH_BEGIN(6) da_attn_phase(lds, (const bf16_t*)(ws + SC_DA_Q), (const bf16_t*)(ws + SC_DA_K), (const bf16_t*)(ws + SC_DA_V), a.in[I_DA_LAM], a.in[I_DA_NG], ob, wg, nwg); PH_END
        } else if (layer == 2) {
            PH_BEGIN(8) { pg8::Gemm g{hb, (const bf16_t*)(ws + WS_W_NSAIN), NT, NSA_NPAD, 1024}; pg8::StaticOrder S; S.init(NT, NSA_NPAD, nwg, wg);
                EpiNsaIn E{(bf16_t*)(ws + SC_NSA_Q), (bf16_t*)(ws + SC_NSA_QR), (bf16_t*)(ws + SC_NSA_KV), (float*)(ws + SC_NSA_GATE), (const f32x2*)(ws + WS_ROPE_NSA)};
                pg8::gemm_phase(lds, g, S, E); } PH_END
            PH_BEGIN(9) nsa_compress_phase(lds, (const bf16_t*)(ws + SC_NSA_KV), (const bf16_t*)(ws + WS_W_CMP1), (const bf16_t*)(ws + WS_W_CMP2), (const float*)(ws + WS_CMPBIAS), (bf16_t*)(ws + SC_NSA_KC), wg, nwg); PH_END
            PH_BEGIN(10) nsa_attn_phase(lds, (const bf16_t*)(ws + SC_NSA_Q), (const bf16_t*)(ws + SC_NSA_QR), (const bf16_t*)(ws + SC_NSA_KV), (const bf16_t*)(ws + SC_NSA_KC),
                                    (const float*)(ws + SC_NSA_GATE), (float*)(ws + SC_NSA_OACC), ob, wg, nwg); PH_END
        } else {
            PH_BEGIN(11) { pg8::Gemm g{hb, (const bf16_t*)(ws + WS_W_SBIN), NT, 3072, 1024}; pg8::StaticOrder S; S.init(NT, 3072, nwg, wg);
                EpiSbIn E{(bf16_t*)(ws + SC_SB_Q)};
                pg8::gemm_phase(lds, g, S, E); } PH_END
            PH_BEGIN(12) sb_attn_phase(lds, (const bf16_t*)(ws + SC_SB_Q), (const bf16_t*)(ws + SC_SB_K), (const bf16_t*)(ws + SC_SB_V), ob, wg, nwg); PH_END
        }
        const size_t wout_off = (layer == 0) ? WS_W_HGOUT : (layer == 1) ? WS_W_DAOUT : (layer == 2) ? WS_W_NSAOUT : WS_W_SBOUT;
        PH_BEGIN(13) { pg8::Gemm g{ob, (const bf16_t*)(ws + wout_off), NT, 1024, 1024}; pg8::StaticOrder S; S.init(NT, 1024, nwg, wg);
            bf16_t* zdst = rep_ ? (bf16_t*)a.out : hb;
            if (layer == 0) { EpiRes<true> E{a.in[I_X], zdst}; pg8::gemm_phase(lds, g, S, E); }
            else { EpiRes<false> E{hb, zdst}; pg8::gemm_phase(lds, g, S, E); } } PH_END
        const int j = layer >> 1;
        unsigned* cnt = ctl + 64 * j;
        const Route* route = (const Route*)(ws + SC_MOE_ROUTE);
        PH_BEGIN(14) ln_phase(lds, hb, rep_ ? a.out : nullptr, rep_ ? nullptr : hb, a.in[I_LN_G] + (size_t)(layer * 2) * DM, a.in[I_LN_B] + (size_t)(layer * 2) * DM, nullptr, nullptr, nullptr,
                          ((layer & 1) && !rep_) ? a.in[I_MOE_WR] + (size_t)j * DM * 8 : nullptr, (Route*)(ws + SC_MOE_ROUTE), cnt, wg, nwg); PH_END
        if ((layer & 1) == 0) {
            PH_BEGIN(15) { pg8::Gemm g{hb, (const bf16_t*)(ws + WS_W_FFNGU) + (size_t)j * 5632 * 1024, NT, 5632, 1024}; pg8::StaticOrder S; S.init(NT, 5632, nwg, wg);
                EpiSwiglu E{(bf16_t*)(ws + SC_FF_ACT), DFF, 22};
                pg8::gemm_phase(lds, g, S, E); } PH_END
            PH_BEGIN(16) { pg8::Gemm g{(const bf16_t*)(ws + SC_FF_ACT), (const bf16_t*)(ws + WS_W_FFND) + (size_t)j * 1024 * DFF, NT, 1024, DFF}; pg8::StaticOrder S; S.init(NT, 1024, nwg, wg);
                EpiRes<false> E{hb, rep_ ? (bf16_t*)a.out : hb};
                pg8::gemm_phase(lds, g, S, E); } PH_END
            PH_BEGIN(17) ln_phase(lds, hb, (layer == 3 || rep_) ? a.out : nullptr, rep_ ? nullptr : hb, a.in[I_LN_G] + (size_t)(layer * 2 + 1) * DM, a.in[I_LN_B] + (size_t)(layer * 2 + 1) * DM, nullptr, nullptr, nullptr,
                              nullptr, nullptr, nullptr, wg, nwg); PH_END
        } else {
            PH_BEGIN(18) moe_convert_phase(lds, a, j, wg, nwg);
                         moe_build_table(lds, (int*)(ws + SC_MOE_XS), route, cnt, wg, nwg); PH_END
            for (int ck = 0; ck < 2; ++ck) {
                int seg_tile[8], nT_, tile_lo_ = ck * MOE_CHUNK_TILES;
                { int s_ = 0;
#pragma unroll
                  for (int e = 0; e < 8; ++e) { seg_tile[e] = s_ >> 8; s_ += (int)((cnt[e] + 255u) & ~255u); }
                  int nt_all = s_ >> 8; int t_hi = tile_lo_ + MOE_CHUNK_TILES; if (t_hi > nt_all) t_hi = nt_all; nT_ = t_hi - tile_lo_; }
                PH_BEGIN(19) { MoeOrderT<true> MO; MO.G = nwg; MO.c = wg; MO.tile_lo = tile_lo_; MO.nT = nT_; MO.nNt = 28; MO.tok = (const int*)(ws + SC_MOE_XS);
#pragma unroll
                    for (int e = 0; e < 8; ++e) MO.seg_tile[e] = seg_tile[e];
                    pg8::Gemm g{hb, (const bf16_t*)(ws + WS_W_MOEGU), MOE_CHUNK_ROWS, 7168, 1024};
                    EpiSwiglu E{(bf16_t*)(ws + SC_MOE_ACT), DFFE, 28};
                    pg8::gemm_phase(lds, g, MO, E); } PH_END
                PH_BEGIN(20) { MoeOrderT<false> MO; MO.G = nwg; MO.c = wg; MO.tile_lo = tile_lo_; MO.nT = nT_; MO.nNt = 4; MO.tok = nullptr;
#pragma unroll
                    for (int e = 0; e < 8; ++e) MO.seg_tile[e] = seg_tile[e];
                    pg8::Gemm g{(const bf16_t*)(ws + SC_MOE_ACT), (const bf16_t*)(ws + WS_W_MOED), MOE_CHUNK_ROWS, 1024, DFFE};
                    EpiMoeDown E{(bf16_t*)(ws + SC_MOE_Y) + (size_t)ck * MOE_CHUNK_ROWS * DM};
                    const int nu_ = nT_ > 0 ? nT_ * 4 : 0, nfull_ = nu_ / nwg, ntail_ = nu_ - nfull_ * nwg;
                    const bool stail_ = (ntail_ > 0 && ntail_ <= 16 && nwg == 256);
                    if (stail_) MO.imax = nfull_;
                    pg8::gemm_phase(lds, g, MO, E);
                    if (stail_) { __syncthreads();
                        const int j_ = wg >> 3, uidx_ = (wg & 7) + 8 * (j_ >> 4), sub_ = j_ & 15;
                        if (uidx_ < ntail_) { pg8::Unit u_; MO.at((long)nfull_ * nwg + uidx_, u_); moe_down_sub(lds, g.A, g.Bt, u_, sub_ >> 2, sub_ & 3, E.y); } } } PH_END
            }
            PH_BEGIN(21) ln_phase(lds, hb, (layer == 3 || rep_) ? a.out : nullptr, rep_ ? nullptr : hb, a.in[I_LN_G] + (size_t)(layer * 2 + 1) * DM, a.in[I_LN_B] + (size_t)(layer * 2 + 1) * DM,
                              route, (const bf16_t*)(ws + SC_MOE_Y), cnt, nullptr, nullptr, nullptr, wg, nwg); PH_END
        }
    }
#undef PH_BEGIN
#undef PH_END
}
constexpr int NPHASES = 38;

#ifdef DBG_REPORT
__global__ void dbg_stats(const void* buf, size_t n, int isbf, float* acc, int slot) {
    float bad = 0.f, ss = 0.f;
    for (size_t i = (size_t)blockIdx.x * blockDim.x + threadIdx.x; i < n; i += (size_t)gridDim.x * blockDim.x) {
        const float v = isbf ? bf2f(((const bf16_t*)buf)[i]) : ((const float*)buf)[i];
        if (!(fabsf(v) < 3e38f)) bad += 1.f; else ss += v * v; }
    bad = wave_sum(bad); ss = wave_sum(ss);
    if ((threadIdx.x & 63) == 0) { atomicAdd(acc + 2 * slot, bad); atomicAdd(acc + 2 * slot + 1, ss); }
}
__global__ void dbg_write(const float* acc, int nslot, float* out, size_t nout) {
    float code = 1.f;
    for (int k = 0; k < nslot; ++k) if (acc[2 * k] > 0.f) code += (float)(1 << k);
    const float c = 10.f * code;
    for (size_t i = (size_t)blockIdx.x * blockDim.x + threadIdx.x; i < nout; i += (size_t)gridDim.x * blockDim.x) out[i] = c;
}
#endif
extern "C" void kernel_launch(void* const* d_in, const int* in_sizes, int n_in, void* d_out, int out_size, void* d_ws, size_t ws_size, hipStream_t stream) {
    static int grid = 0;
    if (grid == 0) {
        if (n_in != 25 || out_size != NT * DM || ws_size < WS_END) { fprintf(stderr, "kernel_launch: unexpected shapes / workspace (%d inputs, out %d, ws %zu < %zu)\n", n_in, out_size, ws_size, (size_t)WS_END); grid = -1; return; }
        int dev = 0, cus = 0;
        if (hipGetDevice(&dev) != hipSuccess || hipDeviceGetAttribute(&cus, hipDeviceAttributeMultiprocessorCount, dev) != hipSuccess) { grid = -1; return; }
        if (hipFuncSetAttribute((const void*)mega, hipFuncAttributeMaxDynamicSharedMemorySize, LDS_BYTES) != hipSuccess) { fprintf(stderr, "kernel_launch: hipFuncSetAttribute failed\n"); grid = -1; return; }
        int per_cu = 0;
        if (hipOccupancyMaxActiveBlocksPerMultiprocessor(&per_cu, (const void*)mega, 512, LDS_BYTES) != hipSuccess || per_cu < 1) { fprintf(stderr, "kernel_launch: occupancy query says %d blocks per CU\n", per_cu); }
        (void)hipGetLastError();
        grid = cus;
    }
    if (grid < 0) return;
    (void)hipMemsetAsync((char*)d_ws, 0, WS_ZERO_BYTES, stream);
    Args a{};
    for (int i = 0; i < 25; ++i) a.in[i] = (const float*)d_in[i];
    a.out = (float*)d_out; a.ws = (unsigned char*)d_ws;
#if MK_FUSED
    a.ph_lo = 0; a.ph_hi = NPHASES;
    hipLaunchKernelGGL(mega, dim3(grid), dim3(512), LDS_BYTES, stream, a);
#else
#ifndef DBG_NPH
#define DBG_NPH NPHASES
#endif
    for (int p = 0; p < DBG_NPH; ++p) { a.ph_lo = p; a.ph_hi = p + 1; hipLaunchKernelGGL(mega, dim3(grid), dim3(512), LDS_BYTES, stream, a); }
#ifdef DBG_REPORT
    { float* acc = (float*)((char*)d_ws + WS_CTL + 2048); char* w = (char*)d_ws;
      hipLaunchKernelGGL(dbg_stats, dim3(1024), dim3(256), 0, stream, (const void*)(w + SC_HG_VV), (size_t)NT * DM, 1, acc, 0);
      hipLaunchKernelGGL(dbg_stats, dim3(1024), dim3(256), 0, stream, (const void*)(w + SC_HG_ST), (size_t)4096 * 128 * 128, 1, acc, 1);
      hipLaunchKernelGGL(dbg_stats, dim3(1024), dim3(256), 0, stream, (const void*)(w + SC_HG_SG), (size_t)NT * DM, 1, acc, 2);
      hipLaunchKernelGGL(dbg_stats, dim3(1024), dim3(256), 0, stream, (const void*)(w + SC_HG_LF), (size_t)NT * DM, 0, acc, 3);
      hipLaunchKernelGGL(dbg_write, dim3(1024), dim3(256), 0, stream, (const float*)acc, 4, (float*)d_out, (size_t)NT * DM); }
#endif
#endif
}
```
